# Optimizing an MI355X kernel written in HIP

```python
import jax, jax.numpy as jnp
from jax import lax
import numpy as np

D_MODEL = 1024
BATCH = 8
SEQ = 4096
DEPTH = 2

N_A = DEPTH // 2
N_B = DEPTH - N_A
CHUNK = 128
GMLP_WIDTH = 2 * D_MODEL
GMLP_GROUPS = 8
GMLP_GROUP_DIM = GMLP_WIDTH // GMLP_GROUPS
HEAD_DIM = 64
N_HEADS = D_MODEL // HEAD_DIM
Q_BLOCK = 128
N_EXPERTS = 32
TOP_K = 4
D_EXPERT = D_MODEL
SWIGLU_LIMIT = 7.0
SWIGLU_ALPHA = 1.702
EXPERT_BLOCK = 256
EPS = 1e-6
NEG_INF = -1e30

kernel_name = "yoco_gmlp_fox_moe_adaln"


def rms_norm(x, g):
    xf = x.astype(jnp.float32)
    y = xf * lax.rsqrt(jnp.mean(xf * xf, axis=-1, keepdims=True) + EPS)
    return (y * g.astype(jnp.float32)).astype(x.dtype)


def layer_norm(x, g, b):
    xf = x.astype(jnp.float32)
    mu = jnp.mean(xf, axis=-1, keepdims=True)
    var = jnp.mean(jnp.square(xf - mu), axis=-1, keepdims=True)
    y = (xf - mu) * lax.rsqrt(var + EPS)
    return (y * g.astype(jnp.float32) + b.astype(jnp.float32)).astype(x.dtype)


def modulate(h, shift, scale):
    return h * (1 + scale) + shift


def ada_chunks(c, w, b, n):
    mod = jax.nn.silu(c) @ w + b
    return [m[:, None, :] for m in jnp.split(mod, n, axis=-1)]


def gmlp_mixer(h, w_in, v_g, v_b, w_s, b_s, w_out):
    bsz, s, _ = h.shape
    z = jax.nn.gelu(h @ w_in, approximate=False)
    u, v = jnp.split(z, 2, axis=-1)
    v = layer_norm(v, v_g, v_b)
    v = v.reshape(bsz, s // CHUNK, CHUNK, GMLP_GROUPS, GMLP_GROUP_DIM)
    causal = jnp.tril(jnp.ones((CHUNK, CHUNK), dtype=bool))
    w_causal = jnp.where(causal[None], w_s, 0).astype(v.dtype)
    mixed = jnp.einsum('gts,bnsgd->bntgd', w_causal, v) + b_s.T[:, :, None]
    gated = u * mixed.reshape(bsz, s, GMLP_WIDTH)
    return gated @ w_out


def shared_kv(x, c, kv_ada_w, kv_ada_b, kv_norm_g, kv_w, k_norm_g, fgate_b):
    bsz, s, _ = x.shape
    shift, scale = ada_chunks(c, kv_ada_w, kv_ada_b, 2)
    h = modulate(rms_norm(x, kv_norm_g), shift, scale)
    proj = h @ kv_w
    k = proj[..., :D_MODEL].reshape(bsz, s, N_HEADS, HEAD_DIM)
    v = proj[..., D_MODEL:2 * D_MODEL].reshape(bsz, s, N_HEADS, HEAD_DIM)
    k = rms_norm(k, k_norm_g)
    log_f = jax.nn.log_sigmoid((proj[..., 2 * D_MODEL:] + fgate_b).astype(jnp.float32))
    log_f_cum = jnp.cumsum(log_f, axis=1)
    return k, v, log_f_cum


def forgetting_attention(q, k, v, log_f_cum):
    bsz, s, nh, dh = q.shape
    scale = dh ** -0.5
    lf = jnp.transpose(log_f_cum, (0, 2, 1))
    outs = []
    for i in range(s // Q_BLOCK):
        q0, end = i * Q_BLOCK, (i + 1) * Q_BLOCK
        qb, kb, vb = q[:, q0:end], k[:, :end], v[:, :end]
        logits = jnp.einsum('bqhd,bkhd->bhqk', qb, kb).astype(jnp.float32) * scale
        logits = logits + (lf[:, :, q0:end, None] - lf[:, :, None, :end])
        q_pos = q0 + jnp.arange(Q_BLOCK)
        k_pos = jnp.arange(end)
        logits = jnp.where(k_pos[None, :] <= q_pos[:, None], logits, NEG_INF)
        p = jax.nn.softmax(logits, axis=-1).astype(vb.dtype)
        outs.append(jnp.einsum('bhqk,bkhd->bqhd', p, vb))
    return jnp.concatenate(outs, axis=1)


def fox_mixer(h, k, v, log_f_cum, w_qg, q_norm_g, w_o):
    bsz, s, _ = h.shape
    qg = h @ w_qg
    q = rms_norm(qg[..., :D_MODEL].reshape(bsz, s, N_HEADS, HEAD_DIM), q_norm_g)
    o = forgetting_attention(q, k, v, log_f_cum).reshape(bsz, s, D_MODEL)
    o = o * jax.nn.sigmoid(qg[..., D_MODEL:])
    return o @ w_o


def moe(h, router_w, router_b, w1, b1, w2, b2):
    bsz, s, d = h.shape
    t = bsz * s
    tk = t * TOP_K
    xt = h.reshape(t, d)
    logits = (xt @ router_w + router_b).astype(jnp.float32)
    top_val, top_idx = lax.top_k(logits, TOP_K)
    gates = jax.nn.softmax(top_val, axis=-1)
    e_flat = top_idx.reshape(-1)
    tok_flat = jnp.arange(tk) // TOP_K
    order = jnp.argsort(e_flat)
    e_sorted = e_flat[order]
    counts = jnp.bincount(e_flat, length=N_EXPERTS)
    starts = jnp.cumsum(counts) - counts
    padded = (counts + EXPERT_BLOCK - 1) // EXPERT_BLOCK * EXPERT_BLOCK
    pends = jnp.cumsum(padded)
    pstarts = pends - padded
    dest_sorted = pstarts[e_sorted] + (jnp.arange(tk) - starts[e_sorted])
    dest = jnp.zeros((tk,), dtype=dest_sorted.dtype).at[order].set(dest_sorted)
    n_blocks = -(-(tk + N_EXPERTS * (EXPERT_BLOCK - 1)) // EXPERT_BLOCK)
    buf = jnp.zeros((n_blocks * EXPERT_BLOCK, d), dtype=xt.dtype).at[dest].set(xt[tok_flat])
    block_expert = jnp.minimum(
        jnp.searchsorted(pends, jnp.arange(n_blocks) * EXPERT_BLOCK, side='right'),
        N_EXPERTS - 1)

    def run_block(args):
        xb, e = args
        gu = xb @ w1[e] + b1[e]
        glu_in, lin = jnp.split(gu, 2, axis=-1)
        glu_in = jnp.minimum(glu_in, SWIGLU_LIMIT)
        lin = jnp.clip(lin, -SWIGLU_LIMIT, SWIGLU_LIMIT)
        act = (lin + 1) * (glu_in * jax.nn.sigmoid(SWIGLU_ALPHA * glu_in))
        return act @ w2[e] + b2[e]

    y_buf = lax.map(run_block, (buf.reshape(n_blocks, EXPERT_BLOCK, d), block_expert))
    y = y_buf.reshape(-1, d)[dest].reshape(t, TOP_K, d)
    out = jnp.einsum('tk,tkd->td', gates.astype(y.dtype), y)
    return out.reshape(bsz, s, d)


def setup_inputs(seed: int = 0) -> dict:
    key = jax.random.key(seed)
    ks = jax.random.split(key, 32)
    D = D_MODEL

    def nrm(k, shape, s):
        return jax.random.normal(k, shape, jnp.float32) * s

    return {
        "x": nrm(ks[0], (BATCH, SEQ, D), 1.0),
        "c": nrm(ks[1], (BATCH, D), 1.0),
        "ada_w": nrm(ks[2], (DEPTH, D, 6 * D), 0.5 * D ** -0.5),
        "ada_b": nrm(ks[3], (DEPTH, 6 * D), 0.02),
        "norm_mix_g": 1.0 + nrm(ks[4], (DEPTH, D), 0.05),
        "norm_ffn_g": 1.0 + nrm(ks[5], (DEPTH, D), 0.05),
        "gmlp_w_in": nrm(ks[6], (N_A, D, 2 * GMLP_WIDTH), D ** -0.5),
        "gmlp_v_g": 1.0 + nrm(ks[7], (N_A, GMLP_WIDTH), 0.05),
        "gmlp_v_b": nrm(ks[8], (N_A, GMLP_WIDTH), 0.02),
        "gmlp_w_s": nrm(ks[9], (N_A, GMLP_GROUPS, CHUNK, CHUNK), 0.5 * CHUNK ** -0.5),
        "gmlp_b_s": 1.0 + nrm(ks[10], (N_A, GMLP_GROUPS, CHUNK), 0.1),
        "gmlp_w_out": nrm(ks[11], (N_A, GMLP_WIDTH, D), GMLP_WIDTH ** -0.5),
        "kv_ada_w": nrm(ks[12], (D, 2 * D), 0.5 * D ** -0.5),
        "kv_ada_b": nrm(ks[13], (2 * D,), 0.02),
        "kv_norm_g": 1.0 + nrm(ks[14], (D,), 0.05),
        "kv_w": nrm(ks[15], (D, 2 * D + N_HEADS), D ** -0.5),
        "k_norm_g": 1.0 + nrm(ks[16], (HEAD_DIM,), 0.05),
        "fgate_b": 2.0 + nrm(ks[17], (N_HEADS,), 0.1),
        "fox_w_qg": nrm(ks[18], (N_B, D, 2 * D), D ** -0.5),
        "q_norm_g": 1.0 + nrm(ks[19], (N_B, HEAD_DIM), 0.05),
        "fox_w_o": nrm(ks[20], (N_B, D, D), D ** -0.5),
        "router_w": nrm(ks[21], (DEPTH, D, N_EXPERTS), D ** -0.5),
        "router_b": nrm(ks[22], (DEPTH, N_EXPERTS), 0.01),
        "exp_w1": nrm(ks[23], (DEPTH, N_EXPERTS, D, 2 * D_EXPERT), D ** -0.5),
        "exp_b1": nrm(ks[24], (DEPTH, N_EXPERTS, 2 * D_EXPERT), 0.01),
        "exp_w2": nrm(ks[25], (DEPTH, N_EXPERTS, D_EXPERT, D), D_EXPERT ** -0.5),
        "exp_b2": nrm(ks[26], (DEPTH, N_EXPERTS, D), 0.01),
        "final_g": 1.0 + nrm(ks[27], (D,), 0.05),
    }


def reference(x, c, ada_w, ada_b, norm_mix_g, norm_ffn_g, gmlp_w_in, gmlp_v_g, gmlp_v_b,
              gmlp_w_s, gmlp_b_s, gmlp_w_out, kv_ada_w, kv_ada_b, kv_norm_g, kv_w, k_norm_g,
              fgate_b, fox_w_qg, q_norm_g, fox_w_o, router_w, router_b, exp_w1, exp_b1,
              exp_w2, exp_b2, final_g):
    k_sh = v_sh = lf_sh = None
    for l in range(DEPTH):
        sh_m, sc_m, gt_m, sh_f, sc_f, gt_f = ada_chunks(c, ada_w[l], ada_b[l], 6)
        if l == N_A:
            k_sh, v_sh, lf_sh = shared_kv(x, c, kv_ada_w, kv_ada_b, kv_norm_g, kv_w,
                                          k_norm_g, fgate_b)
        h = modulate(rms_norm(x, norm_mix_g[l]), sh_m, sc_m)
        if l < N_A:
            y = gmlp_mixer(h, gmlp_w_in[l], gmlp_v_g[l], gmlp_v_b[l], gmlp_w_s[l],
                           gmlp_b_s[l], gmlp_w_out[l])
        else:
            j = l - N_A
            y = fox_mixer(h, k_sh, v_sh, lf_sh, fox_w_qg[j], q_norm_g[j], fox_w_o[j])
        x = x + gt_m * y
        h = modulate(rms_norm(x, norm_ffn_g[l]), sh_f, sc_f)
        x = x + gt_f * moe(h, router_w[l], router_b[l], exp_w1[l], exp_b1[l],
                           exp_w2[l], exp_b2[l])
    return rms_norm(x, final_g)
```

```cpp
#include <hip/hip_runtime.h>
#include <cstdio>
#include <cstdint>

#define LAS __attribute__((address_space(3)))
#define GAS __attribute__((address_space(1)))
typedef unsigned short bf16_t;
typedef float f32x4 __attribute__((ext_vector_type(4)));
typedef short bf16x8 __attribute__((ext_vector_type(8)));
typedef unsigned u32x4 __attribute__((ext_vector_type(4)));
typedef unsigned u32x2 __attribute__((ext_vector_type(2)));
typedef int i32x4 __attribute__((ext_vector_type(4)));

constexpr int NB = 8, SEQ = 4096, DM = 1024, T = NB * SEQ;
constexpr int GW = 2048, NG = 8, GD = 256, CH = 128;
constexpr int NH = 16, HD = 64;
constexpr int NE = 32, TOPK = 4;
constexpr int MAXBLK = 544, MAXROWS = MAXBLK * 256;
constexpr float EPS = 1e-6f;
constexpr float LOG2E = 1.4426950408889634f;
constexpr float C2 = 0.125f * LOG2E;

constexpr size_t MiB = 1u << 20;
constexpr size_t WS_CTL = 0;
constexpr size_t WS_MODS = 1 * MiB;
constexpr size_t WS_RB2 = 1 * MiB + 3 * 8 * 6144 * 4;
constexpr size_t WS_FB2 = WS_RB2 + 2 * 8 * 32 * 4;
constexpr size_t WS_HIST = 2 * MiB;
constexpr size_t WS_BLKE = 2 * MiB + 65536;
constexpr size_t WS_TOPE = 3 * MiB;
constexpr size_t WS_TOPG = 4 * MiB;
constexpr size_t WS_DEST = 5 * MiB;
constexpr size_t WS_LIST = 6 * MiB;
constexpr size_t WS_ROWG = 7 * MiB;
constexpr size_t WS_VSTAT = 8 * MiB;
constexpr size_t WS_LOGF = 9 * MiB;
constexpr size_t WS_FC = 11 * MiB;
constexpr size_t WS_G3 = 13 * MiB;
constexpr size_t WS_WIN = 32 * MiB;
constexpr size_t WS_WOUT = 40 * MiB;
constexpr size_t WS_WKV = 44 * MiB;
constexpr size_t WS_WQG = 48 * MiB;
constexpr size_t WS_WO = 52 * MiB;
constexpr size_t WS_WS = 54 * MiB;
constexpr size_t WS_W1 = 64 * MiB;
constexpr size_t WS_W2 = 320 * MiB;
constexpr size_t WS_XN = 448 * MiB;
constexpr size_t WS_HKV = 512 * MiB;
constexpr size_t WS_XR = 576 * MiB;
constexpr size_t WS_Z = 704 * MiB;
constexpr size_t WS_GATED = 960 * MiB;
constexpr size_t WS_ACT = 704 * MiB;
constexpr size_t WS_YB = 976 * MiB;
constexpr size_t WS_PKV = 704 * MiB;
constexpr size_t WS_PQG = 960 * MiB;
constexpr size_t WS_Q = 1248 * MiB;
constexpr size_t WS_K = 1312 * MiB;
constexpr size_t WS_V = 1376 * MiB;
constexpr size_t WS_GS = 1440 * MiB;
constexpr size_t WS_O = 1504 * MiB;
constexpr size_t WS_END = 1568 * MiB;

__device__ __forceinline__ float bf2f(bf16_t v) { return __uint_as_float(((unsigned)v) << 16); }
__device__ __forceinline__ unsigned f2bf(float f) { unsigned u = __float_as_uint(f); return (u + 0x7fffu + ((u >> 16) & 1u)) >> 16; }
__device__ __forceinline__ unsigned pk2(float lo, float hi) { return f2bf(lo) | (f2bf(hi) << 16); }
__device__ __forceinline__ float wave_sum(float v) {
#pragma unroll
    for (int o = 1; o < 64; o <<= 1) v += __shfl_xor(v, o);
    return v;
}
__device__ __forceinline__ float siluf(float x) { return x / (1.f + expf(-x)); }
__device__ __forceinline__ float sigmoidf_(float x) { return 1.f / (1.f + expf(-x)); }

struct In {
    const float *x, *c, *ada_w, *ada_b, *norm_mix_g, *norm_ffn_g, *w_in, *v_g, *v_b, *w_s, *b_s, *w_out, *kv_ada_w, *kv_ada_b, *kv_norm_g, *kv_w, *k_norm_g, *fgate_b,
        *w_qg, *q_norm_g, *w_o, *router_w, *router_b, *exp_w1, *exp_b1, *exp_w2, *exp_b2, *final_g;
};

typedef const In __attribute__((address_space(4)))* InP;
__device__ __forceinline__ InP kin() { auto p = __builtin_amdgcn_kernarg_segment_ptr(); asm volatile("" : "+s"(p)); return (InP)p; }
__device__ __forceinline__ unsigned char* opq(unsigned char* p) { size_t z = 0; asm volatile("" : "+s"(z)); return p + z; }
struct KA { In in; unsigned char* ws; float* out; int L; int pad; };

__device__ __forceinline__ void transpose_item(const float* W, int K, int N, int ldw, bf16_t* WT, LAS float* scr, int item, int lane) {
    const int nblk = N / 32, kb = item / nblk, nb = item % nblk, k0 = 64 * kb, n0 = 32 * nb;
#pragma unroll 32
    for (int i = 0; i < 32; ++i) { const int kk = 2 * i + (lane >> 5); scr[kk * 33 + (lane & 31)] = W[(size_t)(k0 + kk) * ldw + n0 + (lane & 31)]; }
    __builtin_amdgcn_s_waitcnt(0xc07f); asm volatile("" ::: "memory");
    const int c = lane & 7;
#pragma unroll
    for (int j = 0; j < 4; ++j) { const int n = (lane >> 3) + 8 * j; const LAS float* s = scr + (8 * c) * 33 + n;
        u32x4 o; o.x = pk2(s[0 * 33], s[1 * 33]); o.y = pk2(s[2 * 33], s[3 * 33]); o.z = pk2(s[4 * 33], s[5 * 33]); o.w = pk2(s[6 * 33], s[7 * 33]);
        *(u32x4*)(WT + (size_t)(n0 + n) * K + k0 + 8 * c) = o; }
    __builtin_amdgcn_s_waitcnt(0xc07f); asm volatile("" ::: "memory");
}
constexpr int IT_WIN = 16 * 128, IT_WOUT = 32 * 32, IT_WKV = 16 * 64, IT_WQG = 16 * 64, IT_WO = 16 * 32, IT_W1 = 16 * 64  , IT_W2 = 16 * 32;
constexpr int IT_SMALL = IT_WIN + IT_WOUT + IT_WKV + IT_WQG + IT_WO;
constexpr int IT_ALL = IT_SMALL + 64 * IT_W1 + 64 * IT_W2;
constexpr int IT_FG = IT_SMALL + 32 * IT_W1 + 32 * IT_W2, IT_BG = 32 * IT_W1 + 32 * IT_W2;
__host__ __device__ __forceinline__ int fg_item(int i) { return i < IT_SMALL + 32 * IT_W1 ? i : i + 32 * IT_W1; }
__host__ __device__ __forceinline__ int bg_item(int k) { return k < 32 * IT_W1 ? IT_SMALL + 32 * IT_W1 + k : IT_SMALL + 64 * IT_W1 + 32 * IT_W2 + (k - 32 * IT_W1); }
constexpr int CW_CVT = 2048;
__device__ __forceinline__ void cvt_item(InP inp, unsigned char* ws, int it, LAS float* scr, int lane) {
    if (it < IT_WIN) { transpose_item(inp->w_in, 1024, 4096, 4096, (bf16_t*)(ws + WS_WIN), scr, it, lane); return; } it -= IT_WIN;
    if (it < IT_WOUT) { transpose_item(inp->w_out, 2048, 1024, 1024, (bf16_t*)(ws + WS_WOUT), scr, it, lane); return; } it -= IT_WOUT;
    if (it < IT_WKV) { transpose_item(inp->kv_w, 1024, 2048, 2064, (bf16_t*)(ws + WS_WKV), scr, it, lane); return; } it -= IT_WKV;
    if (it < IT_WQG) { transpose_item(inp->w_qg, 1024, 2048, 2048, (bf16_t*)(ws + WS_WQG), scr, it, lane); return; } it -= IT_WQG;
    if (it < IT_WO) { transpose_item(inp->w_o, 1024, 1024, 1024, (bf16_t*)(ws + WS_WO), scr, it, lane); return; } it -= IT_WO;
    if (it < 64 * IT_W1) { const int e = it / IT_W1; transpose_item(inp->exp_w1 + (size_t)e * 1024 * 2048, 1024, 2048, 2048, (bf16_t*)(ws + WS_W1) + (size_t)e * 2048 * 1024, scr, it % IT_W1, lane); return; } it -= 64 * IT_W1;
    { const int e = it / IT_W2; transpose_item(inp->exp_w2 + (size_t)e * 1024 * 1024, 1024, 1024, 1024, (bf16_t*)(ws + WS_W2) + (size_t)e * 1024 * 1024, scr, it % IT_W2, lane); }
}
constexpr int ADA_ITEMS = 96 + 96 + 32;
__device__ __forceinline__ void ada_item(InP inp, float* mods, int item, const LAS float* sc  , LAS float* red  , int tid) {
    const int lane = tid & 63, wave = tid >> 6;
    int which, cg; const float* w; const float* bias; int ldw;
    if (item < 96) { which = 0; cg = item; w = inp->ada_w; bias = inp->ada_b; ldw = 6144; }
    else if (item < 192) { which = 1; cg = item - 96; w = inp->ada_w + (size_t)1024 * 6144; bias = inp->ada_b + 6144; ldw = 6144; }
    else { which = 2; cg = item - 192; w = inp->kv_ada_w; bias = inp->kv_ada_b; ldw = 2048; }
    const int col = cg * 64 + lane;
    float acc[8];
#pragma unroll
    for (int b = 0; b < 8; ++b) acc[b] = 0.f;
    for (int k = wave * 128; k < wave * 128 + 128; ++k) {
        const float wv = w[(size_t)k * ldw + col];
#pragma unroll
        for (int b = 0; b < 8; ++b) acc[b] += sc[b * 1024 + k] * wv;
    }
#pragma unroll
    for (int b = 0; b < 8; ++b) red[(wave * 8 + b) * 64 + lane] = acc[b];
    __syncthreads();
    {
        const int b = tid >> 6; float s = 0.f;
#pragma unroll
        for (int w8 = 0; w8 < 8; ++w8) s += red[(w8 * 8 + b) * 64 + lane];
        mods[((size_t)which * 8 + b) * 6144 + col] = s + bias[col];
    }
    __syncthreads();
}
__device__ __forceinline__ void row_load(const float* xrow, int lane, f32x4 (&v)[4]) {
#pragma unroll
    for (int j = 0; j < 2; ++j) { v[2 * j] = ((const f32x4*)xrow)[2 * lane + 128 * j]; v[2 * j + 1] = ((const f32x4*)xrow)[2 * lane + 128 * j + 1]; }
}
__device__ __forceinline__ void bf8_to_f32(u32x4 w, f32x4& a, f32x4& b) {
    a = (f32x4){__uint_as_float(w.x << 16), __uint_as_float(w.x & 0xffff0000u), __uint_as_float(w.y << 16), __uint_as_float(w.y & 0xffff0000u)};
    b = (f32x4){__uint_as_float(w.z << 16), __uint_as_float(w.z & 0xffff0000u), __uint_as_float(w.w << 16), __uint_as_float(w.w & 0xffff0000u)};
}
__device__ __forceinline__ void row_load_bf(const bf16_t* xrow, int lane, f32x4 (&v)[4]) {
#pragma unroll
    for (int j = 0; j < 2; ++j) bf8_to_f32(((const u32x4*)xrow)[lane + 64 * j], v[2 * j], v[2 * j + 1]);
}
__device__ __forceinline__ float row_rstd(const f32x4 (&v)[4]) {
    float s = 0.f;
#pragma unroll
    for (int j = 0; j < 4; ++j) s += (v[j].x * v[j].x + v[j].y * v[j].y) + (v[j].z * v[j].z + v[j].w * v[j].w);
    return 1.f / sqrtf(wave_sum(s) * (1.f / 1024.f) + EPS);
}
__device__ __forceinline__ f32x4 row_vec(const float* p, int lane, int q) { return ((const f32x4*)p)[2 * lane + 128 * (q >> 1) + (q & 1)]; }
__device__ __forceinline__ void row_modnorm(const f32x4 (&v)[4], float rstd, const float* g, const float* sh, const float* sc, int lane, f32x4 (&h)[4]) {
#pragma unroll
    for (int q = 0; q < 4; ++q) h[q] = (v[q] * rstd * row_vec(g, lane, q)) * (1.f + row_vec(sc, lane, q)) + row_vec(sh, lane, q);
}
__device__ __forceinline__ void row_store_bf16(bf16_t* orow, int lane, const f32x4 (&h)[4]) {
#pragma unroll
    for (int j = 0; j < 2; ++j) { u32x4 w; w.x = pk2(h[2 * j].x, h[2 * j].y); w.y = pk2(h[2 * j].z, h[2 * j].w); w.z = pk2(h[2 * j + 1].x, h[2 * j + 1].y); w.w = pk2(h[2 * j + 1].z, h[2 * j + 1].w);
        ((u32x4*)orow)[lane + 64 * j] = w; }
}

__device__ __forceinline__ void row4_norm_mod_store(const float* xrow, const float* g, const float* sh, const float* sc, bf16_t* orow, int lane) {
    f32x4 v[4]; float s = 0.f;
#pragma unroll
    for (int j = 0; j < 4; ++j) { v[j] = ((const f32x4*)xrow)[lane + 64 * j]; s += (v[j].x * v[j].x + v[j].y * v[j].y) + (v[j].z * v[j].z + v[j].w * v[j].w); }
    const float rstd = 1.f / sqrtf(wave_sum(s) * (1.f / 1024.f) + EPS);
#pragma unroll
    for (int j = 0; j < 4; ++j) { const f32x4 gg = ((const f32x4*)g)[lane + 64 * j], s1 = ((const f32x4*)sc)[lane + 64 * j], s0 = ((const f32x4*)sh)[lane + 64 * j];
        const f32x4 h = (v[j] * rstd * gg) * (1.f + s1) + s0; u32x2 w; w.x = pk2(h.x, h.y); w.y = pk2(h.z, h.w); ((u32x2*)orow)[lane + 64 * j] = w; }
}
__device__ __forceinline__ void row_store_f32(float* orow, int lane, const f32x4 (&h)[4]) {
#pragma unroll
    for (int j = 0; j < 2; ++j)
#pragma unroll
        for (int sq = 0; sq < 2; ++sq) { const int src = 32 * sq + (lane >> 1); f32x4 a, c;
#pragma unroll
            for (int i = 0; i < 4; ++i) { a[i] = __shfl(h[2 * j][i], src); c[i] = __shfl(h[2 * j + 1][i], src); }
            ((f32x4*)orow)[128 * j + 64 * sq + lane] = (lane & 1) ? c : a; }
}

__device__ __forceinline__ void route_row(const LAS float* hs  , const float* rw, const float* rb, int lane, int (&te)[4], float (&tg)[4]) {
    const int e = lane & 31, half = lane >> 5; float acc = 0.f;
    for (int k = half * 512; k < half * 512 + 512; ++k) acc += hs[k] * rw[k * 32 + e];
    acc += __shfl_xor(acc, 32);
    float val = acc + rb[e];
    float tv[4];
#pragma unroll
    for (int q = 0; q < 4; ++q) {
        float bv = val; int bi = e;
#pragma unroll
        for (int o = 1; o < 32; o <<= 1) { const float ov = __shfl_xor(bv, o); const int oi = __shfl_xor(bi, o); if (ov > bv || (ov == bv && oi < bi)) { bv = ov; bi = oi; } }
        te[q] = bi; tv[q] = bv; if (e == bi) val = -INFINITY;
    }
    float s = 0.f;
#pragma unroll
    for (int q = 0; q < 4; ++q) { tg[q] = expf(tv[q] - tv[0]); s += tg[q]; }
#pragma unroll
    for (int q = 0; q < 4; ++q) tg[q] /= s;
}

namespace pg {
constexpr int BM = 256, BK = 64, HALF = 128, HTB = HALF * BK * 2  , STAGE_BYTES = 8 * HTB, NXCD = 8, WGM = 8;
__host__ __device__ __forceinline__ int lds_byte(int r, int c) { const int st = (r >> 4) * 2 + (c >> 5), rr = r & 15, cc = c & 31, ob = rr * 64 + cc * 2; return st * 1024 + (ob ^ (((ob >> 9) & 1) << 5)); }
__host__ __device__ __forceinline__ void stage_rc(int b, int& R, int& C) { const int st = b / 1024, sb = b % 1024, swz = sb ^ (((sb >> 9) & 1) << 5); R = (st >> 1) * 16 + swz / 64; C = (st & 1) * 32 + (swz % 64) / 2; }
__host__ __device__ __forceinline__ int perm32(int rho) { const int n = rho >> 4, i = rho & 15; return 8 * (i >> 2) + 4 * n + (i & 3); }
struct Unit { int pm, pn; };
struct StaticOrder {
    int nM, nN, nwg, G, c;
    __device__ void init(int nM_, int nN_, int G_, int c_) { nM = nM_; nN = nN_; nwg = nM * nN; G = G_; c = c_; }
    __device__ bool next(int i, Unit& u) const {
        const long L = (long)i * G + c; if (L >= nwg) return false;
        int wgid = (int)L; { const int q = nwg / NXCD, r = nwg % NXCD, xcd = wgid % NXCD, off = wgid / NXCD; wgid = (xcd < r ? xcd * (q + 1) : r * (q + 1) + (xcd - r) * q) + off; }
        const int nig = WGM * nN, gid = wgid / nig, fm = gid * WGM, gsz = (nM - fm) < WGM ? (nM - fm) : WGM;
        u.pm = fm + ((wgid % nig) % gsz); u.pn = (wgid % nig) / gsz; return true;
    }
};
__device__ __forceinline__ unsigned cvt_pk_bf16(float lo, float hi) { unsigned r; asm volatile("v_cvt_pk_bf16_f32 %0, %1, %2" : "=v"(r) : "v"(lo), "v"(hi)); return r; }
typedef float f32x2 __attribute__((ext_vector_type(2)));
__device__ __forceinline__ f32x2 gelu_pk(f32x2 v) {
    const f32x2 av = __builtin_elementwise_abs(v), d = av * 0.2316418882f + 1.0f;
    f32x2 t; t.x = __builtin_amdgcn_rcpf(d.x); t.y = __builtin_amdgcn_rcpf(d.y);
    f32x2 q = t * 0.5307027145f + (-0.7265760135f); q = q * t + 0.7107068705f; q = q * t + (-0.142248368f); q = q * t + 0.127414796f; q = q * t;
    const f32x2 s = (v * v) * (-0.72134752044f);
    f32x2 e; e.x = __builtin_amdgcn_exp2f(s.x); e.y = __builtin_amdgcn_exp2f(s.y);
    const f32x2 m = v * (q * e), r = v - m;
    f32x2 o; o.x = v.x < 0.f ? m.x : r.x; o.y = v.y < 0.f ? m.y : r.y; return o;
}
__device__ __forceinline__ float fast_sigmoid(float x) { return __builtin_amdgcn_rcpf(1.f + __builtin_amdgcn_exp2f(-LOG2E * x)); }

template <bool PERM> struct SrcPlain { const char* B; int K2;
    __device__ __forceinline__ unsigned arow_off(const Unit& u, int h, int R) const { return (unsigned)(u.pm * BM + h * HALF + R) * (unsigned)K2; }
    __device__ __forceinline__ const char* bhalf(const Unit& u, int h) const { return B + (size_t)(u.pn * BM + h * HALF) * K2; }
    static __device__ __forceinline__ int brow(int R) { return PERM ? ((R & ~31) + perm32(R & 31)) : R; } };
struct SrcHeads { const char* B; int K2;
    __device__ __forceinline__ unsigned arow_off(const Unit& u, int h, int R) const { return (unsigned)(u.pm * BM + h * HALF + R) * (unsigned)K2; }
    __device__ __forceinline__ const char* bhalf(const Unit& u, int h) const { return B + (size_t)(u.pn * BM + h * 32) * K2; }
    static __device__ __forceinline__ int brow(int R) { return 64 * (R >> 5) + perm32(R & 31); } };
struct SrcMoeA { const char* W1; const int* list; const int* blke; int K2;
    __device__ __forceinline__ unsigned arow_off(const Unit& u, int h, int R) const { int t = list[u.pm * BM + h * HALF + R]; t = t < 0 ? 0 : t; return (unsigned)t * (unsigned)K2; }
    __device__ __forceinline__ const char* bhalf(const Unit& u, int h) const { const int e = blke[u.pm]; return W1 + ((size_t)e * 2048 + h * 1024 + u.pn * 128) * K2; }
    static __device__ __forceinline__ int brow(int R) { return (R & ~31) + perm32(R & 31); } };
struct SrcMoeB { const char* W2; const int* blke; int K2;
    __device__ __forceinline__ unsigned arow_off(const Unit& u, int h, int R) const { return (unsigned)(u.pm * BM + h * HALF + R) * (unsigned)K2; }
    __device__ __forceinline__ const char* bhalf(const Unit& u, int h) const { const int e = blke[u.pm]; return W2 + ((size_t)e * 1024 + u.pn * BM + h * HALF) * K2; }
    static __device__ __forceinline__ int brow(int R) { return (R & ~31) + perm32(R & 31); } };

struct EpGeluZ { bf16_t* Z;
    __device__ __forceinline__ void operator()(const f32x4 (&acc)[2][2][4][2], const Unit& u, int wr, int wc, int fr, int fq) const {
        const int row0 = u.pm * BM + wr * 64 + fr, col0 = u.pn * BM + wc * 32 + 8 * fq;
#pragma unroll
        for (int ai = 0; ai < 2; ++ai)
#pragma unroll
            for (int m = 0; m < 4; ++m) { bf16_t* rowp = Z + (size_t)(row0 + ai * HALF + m * 16) * 4096 + col0;
#pragma unroll
                for (int bj = 0; bj < 2; ++bj) { const f32x4 v0 = acc[ai][bj][m][0], v1 = acc[ai][bj][m][1];
                    const f32x2 a = gelu_pk((f32x2){v0[0], v0[1]}), b = gelu_pk((f32x2){v0[2], v0[3]}), c = gelu_pk((f32x2){v1[0], v1[1]}), d = gelu_pk((f32x2){v1[2], v1[3]});
                    u32x4 w; w.x = cvt_pk_bf16(a.x, a.y); w.y = cvt_pk_bf16(b.x, b.y); w.z = cvt_pk_bf16(c.x, c.y); w.w = cvt_pk_bf16(d.x, d.y);
                    *(u32x4*)(rowp + bj * HALF) = w; } }
    } };
template <bool F32BASE> struct EpResid { const void* base; bf16_t* out; const float* gate;
    __device__ __forceinline__ void operator()(const f32x4 (&acc)[2][2][4][2], const Unit& u, int wr, int wc, int fr, int fq) const {
        const int b = u.pm >> 4; const float* gt = gate + (size_t)b * 6144; const int col0 = u.pn * BM + wc * 32 + 8 * fq;
        f32x4 gv[2][2];
#pragma unroll
        for (int bj = 0; bj < 2; ++bj)
#pragma unroll
            for (int n = 0; n < 2; ++n) gv[bj][n] = *(const f32x4*)(gt + col0 + bj * HALF + 4 * n);
#pragma unroll
        for (int ai = 0; ai < 2; ++ai)
#pragma unroll
            for (int m = 0; m < 4; ++m) { const size_t off = (size_t)(u.pm * BM + ai * HALF + wr * 64 + m * 16 + fr) * DM + col0;
#pragma unroll
                for (int bj = 0; bj < 2; ++bj) { f32x4 b0, b1;
                    if constexpr (F32BASE) { b0 = *(const f32x4*)((const float*)base + off + bj * HALF); b1 = *(const f32x4*)((const float*)base + off + bj * HALF + 4); }
                    else bf8_to_f32(*(const u32x4*)((const bf16_t*)base + off + bj * HALF), b0, b1);
                    const f32x4 r0 = b0 + gv[bj][0] * acc[ai][bj][m][0], r1 = b1 + gv[bj][1] * acc[ai][bj][m][1];
                    u32x4 w; w.x = cvt_pk_bf16(r0[0], r0[1]); w.y = cvt_pk_bf16(r0[2], r0[3]); w.z = cvt_pk_bf16(r1[0], r1[1]); w.w = cvt_pk_bf16(r1[2], r1[3]);
                    *(u32x4*)(out + off + bj * HALF) = w; } }
    } };
struct EpSwiglu { bf16_t* act; const float* b1; const int* blke;
    __device__ __forceinline__ void operator()(const f32x4 (&acc)[2][2][4][2], const Unit& u, int wr, int wc, int fr, int fq) const {
        const int e = blke[u.pm]; const int col0 = u.pn * 128 + wc * 32 + 8 * fq; const float* bb = b1 + (size_t)e * 2048 + col0;
        f32x4 bg[2], bl[2];
#pragma unroll
        for (int n = 0; n < 2; ++n) { bg[n] = *(const f32x4*)(bb + 4 * n); bl[n] = *(const f32x4*)(bb + 1024 + 4 * n); }
#pragma unroll
        for (int ai = 0; ai < 2; ++ai)
#pragma unroll
            for (int m = 0; m < 4; ++m) { const int row = u.pm * BM + ai * HALF + wr * 64 + m * 16 + fr; float a[8];
#pragma unroll
                for (int n = 0; n < 2; ++n) { const f32x4 g4 = acc[ai][0][m][n] + bg[n], l4 = acc[ai][1][m][n] + bl[n];
#pragma unroll
                    for (int j = 0; j < 4; j += 2) {
                        f32x2 g = {fminf(g4[j], 7.f), fminf(g4[j + 1], 7.f)}; f32x2 l = {__builtin_amdgcn_fmed3f(l4[j], -7.f, 7.f), __builtin_amdgcn_fmed3f(l4[j + 1], -7.f, 7.f)};
                        const f32x2 x = g * (-1.702f * LOG2E); f32x2 e; e.x = __builtin_amdgcn_exp2f(x.x); e.y = __builtin_amdgcn_exp2f(x.y);
                        const f32x2 d = e + 1.0f; f32x2 r; r.x = __builtin_amdgcn_rcpf(d.x); r.y = __builtin_amdgcn_rcpf(d.y);
                        const f32x2 o = (l + 1.0f) * (g * r); a[4 * n + j] = o.x; a[4 * n + j + 1] = o.y; } }
                u32x4 w; w.x = cvt_pk_bf16(a[0], a[1]); w.y = cvt_pk_bf16(a[2], a[3]); w.z = cvt_pk_bf16(a[4], a[5]); w.w = cvt_pk_bf16(a[6], a[7]);
                *(u32x4*)(act + (size_t)row * 1024 + col0) = w; }
    } };
struct EpMoeOut { bf16_t* yb; const float* b2; const int* blke; const float* rowg;
    __device__ __forceinline__ void operator()(const f32x4 (&acc)[2][2][4][2], const Unit& u, int wr, int wc, int fr, int fq) const {
        const int e = blke[u.pm]; const int col0 = u.pn * BM + wc * 32 + 8 * fq;
        f32x4 bv[2][2];
#pragma unroll
        for (int bj = 0; bj < 2; ++bj)
#pragma unroll
            for (int n = 0; n < 2; ++n) bv[bj][n] = *(const f32x4*)(b2 + (size_t)e * 1024 + col0 + bj * HALF + 4 * n);
#pragma unroll
        for (int ai = 0; ai < 2; ++ai)
#pragma unroll
            for (int m = 0; m < 4; ++m) { const int row = u.pm * BM + ai * HALF + wr * 64 + m * 16 + fr; const float rg = rowg[row];
#pragma unroll
                for (int bj = 0; bj < 2; ++bj) { const f32x4 v0 = (acc[ai][bj][m][0] + bv[bj][0]) * rg, v1 = (acc[ai][bj][m][1] + bv[bj][1]) * rg;
                    u32x4 w; w.x = cvt_pk_bf16(v0[0], v0[1]); w.y = cvt_pk_bf16(v0[2], v0[3]); w.z = cvt_pk_bf16(v1[0], v1[1]); w.w = cvt_pk_bf16(v1[2], v1[3]);
                    *(u32x4*)(yb + (size_t)row * 1024 + col0 + bj * HALF) = w; } }
    } };
template <int MODE> struct EpHeads { bf16_t* o0; bf16_t* o1; const float* g;
    __device__ __forceinline__ void operator()(const f32x4 (&acc)[2][2][4][2], const Unit& u, int wr, int wc, int fr, int fq) const {
        const bool first = u.pn < 4; bf16_t* O = first ? o0 : o1; const int colbase = (u.pn & 3) * 256 + wc * 64 + 8 * fq;
        f32x4 gv[2][2];
#pragma unroll
        for (int bj = 0; bj < 2; ++bj)
#pragma unroll
            for (int n = 0; n < 2; ++n) gv[bj][n] = *(const f32x4*)(g + 32 * bj + 8 * fq + 4 * n);
#pragma unroll
        for (int ai = 0; ai < 2; ++ai)
#pragma unroll
            for (int m = 0; m < 4; ++m) { const int row = u.pm * BM + ai * HALF + wr * 64 + m * 16 + fr; f32x4 v[2][2];
                if (first) { float ss = 0.f;
#pragma unroll
                    for (int bj = 0; bj < 2; ++bj)
#pragma unroll
                        for (int n = 0; n < 2; ++n) { const f32x4 x = acc[ai][bj][m][n]; ss += (x[0] * x[0] + x[1] * x[1]) + (x[2] * x[2] + x[3] * x[3]); }
                    ss += __shfl_xor(ss, 16); ss += __shfl_xor(ss, 32);
                    float r = 1.f / sqrtf(ss * (1.f / 64.f) + EPS); if (MODE == 1) r *= C2;
#pragma unroll
                    for (int bj = 0; bj < 2; ++bj)
#pragma unroll
                        for (int n = 0; n < 2; ++n) v[bj][n] = acc[ai][bj][m][n] * r * gv[bj][n];
                } else {
#pragma unroll
                    for (int bj = 0; bj < 2; ++bj)
#pragma unroll
                        for (int n = 0; n < 2; ++n) { f32x4 x = acc[ai][bj][m][n]; if (MODE == 1) { x[0] = fast_sigmoid(x[0]); x[1] = fast_sigmoid(x[1]); x[2] = fast_sigmoid(x[2]); x[3] = fast_sigmoid(x[3]); } v[bj][n] = x; }
                }
#pragma unroll
                for (int bj = 0; bj < 2; ++bj) { u32x4 w; w.x = cvt_pk_bf16(v[bj][0][0], v[bj][0][1]); w.y = cvt_pk_bf16(v[bj][0][2], v[bj][0][3]); w.z = cvt_pk_bf16(v[bj][1][0], v[bj][1][1]); w.w = cvt_pk_bf16(v[bj][1][2], v[bj][1][3]);
                    *(u32x4*)(O + (size_t)row * DM + colbase + 32 * bj) = w; } }
    } };

template <class Epi, class Sched, class Src, bool ALIGN_EPI>
__device__ __forceinline__ void gemm_phase(LAS unsigned char* lds, const char* Abase, int K, const Sched& S, const Src& src, const Epi& E) {
    int tid_ = threadIdx.x; asm volatile("" : "+v"(tid_));
    const int tid = tid_, wid = __builtin_amdgcn_readfirstlane(tid >> 6), lane = tid & 63, wr = wid >> 2, wc = wid & 3, fr = lane & 15, fq = lane >> 4;
    const int nt = K / BK;
    int sR[2], sC[2]; unsigned voffB[2];
#pragma unroll
    for (int i = 0; i < 2; ++i) { stage_rc(tid * 16 + i * 8192, sR[i], sC[i]); voffB[i] = (unsigned)(Src::brow(sR[i]) * K + sC[i]) * 2u; }
    const size_t kstep = (size_t)(BK * 2);
    const unsigned ldsw = (unsigned)wid * 1024u;
    const int aoff = lds_byte(wr * 64 + fr, fq * 8), boff = lds_byte(wc * 32 + fr, fq * 8);
#define PG_SA(b, h) (((b) * 2 + (h)) * HTB)
#define PG_SB(b, h) ((4 + (b) * 2 + (h)) * HTB)
#define PG_STAGE(bufoff, gbase, v0, v1) do { \
        __builtin_amdgcn_global_load_lds((const unsigned*)((const char*)(gbase) + (v0)), (LAS unsigned*)(lds + (bufoff) + ldsw), 16, 0, 0); \
        __builtin_amdgcn_global_load_lds((const unsigned*)((const char*)(gbase) + (v1)), (LAS unsigned*)(lds + (bufoff) + ldsw + 8192), 16, 0, 0); } while (0)
#define PG_LDA(dst, b, h) do { _Pragma("unroll") for (int m = 0; m < 4; ++m) _Pragma("unroll") for (int k = 0; k < 2; ++k) dst[m][k] = *(const LAS bf16x8*)(lds + PG_SA(b, h) + aoff + m * 2048 + k * 1024); } while (0)
#define PG_LDB(dst, b, h) do { _Pragma("unroll") for (int n = 0; n < 2; ++n) _Pragma("unroll") for (int k = 0; k < 2; ++k) dst[n][k] = *(const LAS bf16x8*)(lds + PG_SB(b, h) + boff + n * 2048 + k * 1024); } while (0)
#define PG_MMA(ai, bj, At, Bt) do { __builtin_amdgcn_s_setprio(1); _Pragma("unroll") for (int m = 0; m < 4; ++m) _Pragma("unroll") for (int n = 0; n < 2; ++n) _Pragma("unroll") for (int k = 0; k < 2; ++k) \
        acc[ai][bj][m][n] = __builtin_amdgcn_mfma_f32_16x16x32_bf16(Bt[n][k], At[m][k], acc[ai][bj][m][n], 0, 0, 0); __builtin_amdgcn_s_setprio(0); } while (0)
#define PG_WAIT_V(n) asm volatile("s_waitcnt vmcnt(" #n ")" ::: "memory")
#define PG_WAIT_L(n) asm volatile("s_waitcnt lgkmcnt(" #n ")" ::: "memory")
#define PG_BAR __builtin_amdgcn_s_barrier()
#define PG_SCHED __builtin_amdgcn_sched_barrier(0)
    Unit cur, nxt; int ui = 0;
    if (!S.next(0, cur)) return;
    f32x4 acc[2][2][4][2];
#pragma unroll
    for (int a = 0; a < 2; ++a)
#pragma unroll
        for (int b = 0; b < 2; ++b)
#pragma unroll
            for (int m = 0; m < 4; ++m)
#pragma unroll
                for (int n = 0; n < 2; ++n) acc[a][b][m][n] = (f32x4){0.f, 0.f, 0.f, 0.f};
    bf16x8 At[4][2], B0[2][2], B1[2][2];
    unsigned vc[2][2], vn[2][2];
#pragma unroll
    for (int h = 0; h < 2; ++h)
#pragma unroll
        for (int i = 0; i < 2; ++i) vc[h][i] = src.arow_off(cur, h, sR[i]) + (unsigned)sC[i] * 2u;
    const char* cB0 = src.bhalf(cur, 0); const char* cB1 = src.bhalf(cur, 1);
    const char* const cA = Abase;
    PG_STAGE(PG_SB(0, 0), cB0, voffB[0], voffB[1]); PG_STAGE(PG_SB(0, 1), cB1, voffB[0], voffB[1]); PG_STAGE(PG_SA(0, 0), cA, vc[0][0], vc[0][1]); PG_STAGE(PG_SA(0, 1), cA, vc[1][0], vc[1][1]);
    if (wr == 1) PG_BAR;
    PG_WAIT_V(2); PG_BAR;
    PG_STAGE(PG_SB(1, 0), cB0 + kstep, voffB[0], voffB[1]); PG_STAGE(PG_SA(1, 0), cA + kstep, vc[0][0], vc[0][1]); PG_STAGE(PG_SB(1, 1), cB1 + kstep, voffB[0], voffB[1]);
    PG_WAIT_V(6); PG_BAR;
    for (;;) {
        const bool has_next = S.next(ui + 1, nxt);
        const char* nB0 = cB0; const char* nB1 = cB1;
#pragma unroll
        for (int h = 0; h < 2; ++h)
#pragma unroll
            for (int i = 0; i < 2; ++i) vn[h][i] = vc[h][i];
        if (has_next) { nB0 = src.bhalf(nxt, 0); nB1 = src.bhalf(nxt, 1);
#pragma unroll
            for (int h = 0; h < 2; ++h)
#pragma unroll
                for (int i = 0; i < 2; ++i) vn[h][i] = src.arow_off(nxt, h, sR[i]) + (unsigned)sC[i] * 2u; }
        asm volatile("" : "+v"(vn[0][0]), "+v"(vn[0][1]), "+v"(vn[1][0]), "+v"(vn[1][1]));
        for (int t = 0; t < nt; t += 2) {
            const bool last = (t == nt - 2);
            const char* a1 = cA + (size_t)(t + 1) * kstep;
            const char* a2 = last ? cA : cA + (size_t)(t + 2) * kstep; const char* a3 = a2 + kstep;
            const char* b20 = last ? nB0 : cB0 + (size_t)(t + 2) * kstep; const char* b21 = last ? nB1 : cB1 + (size_t)(t + 2) * kstep;
            const char* b30 = b20 + kstep; const char* b31 = b21 + kstep;
            const unsigned w00 = last ? vn[0][0] : vc[0][0], w01 = last ? vn[0][1] : vc[0][1], w10 = last ? vn[1][0] : vc[1][0], w11 = last ? vn[1][1] : vc[1][1];
            PG_LDB(B0, 0, 0); PG_LDB(B1, 0, 1); PG_SCHED; PG_LDA(At, 0, 0); PG_STAGE(PG_SA(1, 1), a1, vc[1][0], vc[1][1]);
            PG_WAIT_V(8); PG_WAIT_L(0); PG_BAR; PG_MMA(0, 0, At, B0); PG_MMA(0, 1, At, B1); PG_BAR; PG_SCHED;
            PG_LDA(At, 0, 1); PG_STAGE(PG_SB(0, 0), b20, voffB[0], voffB[1]); PG_STAGE(PG_SB(0, 1), b21, voffB[0], voffB[1]); PG_STAGE(PG_SA(0, 0), a2, w00, w01);
            PG_WAIT_V(8); PG_WAIT_L(0); PG_BAR; PG_MMA(1, 0, At, B0); PG_MMA(1, 1, At, B1); PG_BAR; PG_SCHED;
            PG_LDB(B0, 1, 0); PG_LDB(B1, 1, 1); PG_SCHED; PG_LDA(At, 1, 0); PG_STAGE(PG_SA(0, 1), a2, w10, w11);
            PG_WAIT_V(8); PG_WAIT_L(0); PG_BAR; PG_MMA(0, 0, At, B0); PG_MMA(0, 1, At, B1); PG_BAR; PG_SCHED;
            PG_LDA(At, 1, 1); PG_STAGE(PG_SB(1, 0), b30, voffB[0], voffB[1]); PG_STAGE(PG_SB(1, 1), b31, voffB[0], voffB[1]); PG_STAGE(PG_SA(1, 0), a3, w00, w01);
            PG_WAIT_V(8); PG_WAIT_L(0); PG_BAR; PG_MMA(1, 0, At, B0); PG_MMA(1, 1, At, B1); PG_BAR; PG_SCHED;
        }
        if constexpr (ALIGN_EPI) { if (wr == 0) PG_BAR; }
        E(acc, cur, wr, wc, fr, fq);
        if (!has_next) break;
#pragma unroll
        for (int a = 0; a < 2; ++a)
#pragma unroll
            for (int b = 0; b < 2; ++b)
#pragma unroll
                for (int m = 0; m < 4; ++m)
#pragma unroll
                    for (int n = 0; n < 2; ++n) acc[a][b][m][n] = (f32x4){0.f, 0.f, 0.f, 0.f};
        cur = nxt; cB0 = nB0; cB1 = nB1; ++ui;
#pragma unroll
        for (int h = 0; h < 2; ++h)
#pragma unroll
            for (int i = 0; i < 2; ++i) vc[h][i] = vn[h][i];
        if constexpr (ALIGN_EPI) { if (wr == 1) PG_BAR; }
    }
    PG_WAIT_V(0);
    if constexpr (!ALIGN_EPI) { if (wr == 0) PG_BAR; }
    PG_BAR;
#undef PG_SA
#undef PG_SB
#undef PG_STAGE
#undef PG_LDA
#undef PG_LDB
#undef PG_MMA
#undef PG_WAIT_V
#undef PG_WAIT_L
#undef PG_BAR
#undef PG_SCHED
}
}
#include <hip/hip_bf16.h>
#include <cmath>
namespace attn_body {
using bf16=__hip_bfloat16;
using bf16x8=__attribute__((ext_vector_type(8)))short;
using s16x4=__attribute__((ext_vector_type(4)))short;
using f32x16=__attribute__((ext_vector_type(16)))float;
using u32x4=__attribute__((ext_vector_type(4)))unsigned;
constexpr int BATCH=8,NHEAD=16,SEQ=4096,D=64,DM=NHEAD*D;
constexpr int NW=8,QBLK=32,QB=QBLK*NW,KVBLK=64,NQB=SEQ/QB;
constexpr int ATTN_PITCH=DM, ATTN_UNIT_ROWS=QB;
__device__ __forceinline__ int crow(int r,int hi){return (r&3)+8*(r>>2)+4*hi;}
#define SBAR() __builtin_amdgcn_sched_barrier(0)
__device__ __forceinline__ void cmask(f32x16&p0,f32x16&p1,int jb,int qrel,int hi){
  const float NEG=-INFINITY; int kb=64*jb+4*hi;
  #pragma unroll
  for(int r=0;r<16;++r){int kv=kb+(r&3)+8*(r>>2); if(kv>qrel)p0[r]=NEG; if(kv+32>qrel)p1[r]=NEG;}
}

constexpr int NSLOT=3, SLOTB=8192;
constexpr int LDS_K=0, LDS_V=NSLOT*SLOTB, LDS_WS=2*NSLOT*SLOTB, LDS_OST=LDS_WS+NW*64*4, LDS_GPAD=LDS_OST+NW*4096, LDS_G3=LDS_GPAD+128*8, LDS_BYTES=LDS_G3+SEQ*8;
constexpr float C2_=0.125f*1.4426950408889634f;
__device__ __forceinline__ void glds16(const void*gsrc,unsigned lds_dst){unsigned keep;
  asm volatile("s_mov_b32 %0, m0\n\ts_mov_b32 m0, %2\n\ts_nop 0\n\tglobal_load_lds_dwordx4 %1, off\n\ts_mov_b32 m0, %0":"=&s"(keep):"v"(gsrc),"s"(lds_dst):"memory");}
__device__ __forceinline__ float max3f(float a,float b,float c){float r;asm("v_max3_f32 %0, %1, %2, %3":"=v"(r):"v"(a),"v"(b),"v"(c));return r;}
__device__ __forceinline__ float max2f(float a,float b){float r;asm("v_max_f32_e32 %0, %1, %2":"=v"(r):"v"(a),"v"(b));return r;}
__device__ __forceinline__ float fadd_s(float a,float b){float r;asm("v_add_f32_e32 %0, %1, %2":"=v"(r):"v"(a),"v"(b));return r;}
__device__ __forceinline__ float fsub_s(float a,float b){float r;asm("v_sub_f32_e32 %0, %1, %2":"=v"(r):"v"(a),"v"(b));return r;}
typedef float f32x2_t __attribute__((ext_vector_type(2))); typedef __bf16 bf16x2_t __attribute__((ext_vector_type(2)));
__device__ __forceinline__ unsigned cvtpk_s(float lo,float hi){f32x2_t v={lo,hi};bf16x2_t b=__builtin_convertvector(v,bf16x2_t);return __builtin_bit_cast(unsigned,b);}
#define WAIT_BAR(N) asm volatile("s_waitcnt vmcnt(" #N ") lgkmcnt(0)\n\ts_barrier":::"memory")

__device__ __forceinline__ void qkt(f32x16&p0,f32x16&p1,const char*Kslot,const bf16x8*qr,bf16x8 ka0,bf16x8 ka1,bf16x8 qa,int r32,int hi){
  const char*kb=Kslot+hi*1024+r32*16;
  { const f32x16 z=f32x16{}; p0=__builtin_amdgcn_mfma_f32_32x32x16_bf16(ka0,qa,z,0,0,0); p1=__builtin_amdgcn_mfma_f32_32x32x16_bf16(ka1,qa,z,0,0,0); }
  #pragma unroll
  for(int d0=0;d0<4;++d0){
    const bf16x8 b0=*reinterpret_cast<const bf16x8*>(kb+d0*2048);
    const bf16x8 b1=*reinterpret_cast<const bf16x8*>(kb+d0*2048+512);
    p0=__builtin_amdgcn_mfma_f32_32x32x16_bf16(b0,qr[d0],p0,0,0,0);p1=__builtin_amdgcn_mfma_f32_32x32x16_bf16(b1,qr[d0],p1,0,0,0);}
}
typedef __attribute__((address_space(3))) const char* lds_cptr;
typedef short v4i16_t __attribute__((ext_vector_type(4)));
__device__ __forceinline__ void kload8(bf16x8*kf,lds_cptr kp){
  kf[0]=*(const __attribute__((address_space(3))) bf16x8*)(kp);      kf[1]=*(const __attribute__((address_space(3))) bf16x8*)(kp+512);
  kf[2]=*(const __attribute__((address_space(3))) bf16x8*)(kp+2048); kf[3]=*(const __attribute__((address_space(3))) bf16x8*)(kp+2560);
  kf[4]=*(const __attribute__((address_space(3))) bf16x8*)(kp+4096); kf[5]=*(const __attribute__((address_space(3))) bf16x8*)(kp+4608);
  kf[6]=*(const __attribute__((address_space(3))) bf16x8*)(kp+6144); kf[7]=*(const __attribute__((address_space(3))) bf16x8*)(kp+6656);
}
__device__ __forceinline__ void kload2(bf16x8*kf,lds_cptr kp,int j){ kf[2*j]=*(const __attribute__((address_space(3))) bf16x8*)(kp+j*2048); kf[2*j+1]=*(const __attribute__((address_space(3))) bf16x8*)(kp+j*2048+512); }
__device__ __forceinline__ s16x4 vtr(lds_cptr p){ return __builtin_bit_cast(s16x4,__builtin_amdgcn_ds_read_tr16_b64_v4i16((__attribute__((address_space(3))) v4i16_t*)p)); }
__device__ __forceinline__ float rowmax(const f32x16&p0,const f32x16&p1){
  float a=max3f(p0[0],p0[1],p1[0]),b=max3f(p0[2],p0[3],p1[1]);a=max3f(a,p1[2],p1[3]);
  #pragma unroll
  for(int r=4;r<16;r+=4){a=max3f(a,p0[r],p0[r+1]);b=max3f(b,p0[r+2],p0[r+3]);a=max3f(a,p1[r],p1[r+1]);b=max3f(b,p1[r+2],p1[r+3]);}
  const float m=max2f(a,b);
  auto rr=__builtin_amdgcn_permlane32_swap(__float_as_uint(m),__float_as_uint(m),false,false);
  return max2f(__uint_as_float(rr[0]),__uint_as_float(rr[1]));
}
__device__ __forceinline__ void pv(f32x16*o,int vb,bf16x8 pa0,bf16x8 pa1,bf16x8 pa2,bf16x8 pa3){
  #pragma unroll
  for(int d0=0;d0<2;++d0){s16x4 lo[4],hi[4];
    #pragma unroll
    for(int ks=0;ks<4;++ks){
      asm volatile("ds_read_b64_tr_b16 %0,%1 offset:%c2":"=&v"(lo[ks]):"v"(vb),"i"(d0*4096+ks*1024):"memory");
      asm volatile("ds_read_b64_tr_b16 %0,%1 offset:%c2":"=&v"(hi[ks]):"v"(vb),"i"(d0*4096+ks*1024+512):"memory");}
    asm volatile("s_waitcnt lgkmcnt(0)":::"memory");SBAR();
    #define PK(k) (bf16x8){lo[k][0],lo[k][1],lo[k][2],lo[k][3],hi[k][0],hi[k][1],hi[k][2],hi[k][3]}
    o[d0]=__builtin_amdgcn_mfma_f32_32x32x16_bf16(pa0,PK(0),o[d0],0,0,0);
    o[d0]=__builtin_amdgcn_mfma_f32_32x32x16_bf16(pa1,PK(1),o[d0],0,0,0);
    o[d0]=__builtin_amdgcn_mfma_f32_32x32x16_bf16(pa2,PK(2),o[d0],0,0,0);
    o[d0]=__builtin_amdgcn_mfma_f32_32x32x16_bf16(pa3,PK(3),o[d0],0,0,0);
    #undef PK
  }
}

#ifndef ATTN_STORE16
#define ATTN_STORE16(p,v) (*(u32x4*)(p)=(v))
#endif
template<int THRL> __device__ __forceinline__ void attn_unit(int b,int h,int qb,const bf16*Q,const bf16*__restrict__ K,const bf16*__restrict__ V,const bf16*__restrict__ GATE,bf16*O,char*shm,float skipthr){
  int tid_=threadIdx.x; asm volatile("":"+v"(tid_));
  const int tid=tid_,lane=tid&63,r32=lane&31,hi=lane>>5; const int wid=__builtin_amdgcn_readfirstlane(tid>>6);
  const long rowbase=(long)b*SEQ; const int q0=qb*QB;
  const bf16*Qw=Q+(rowbase+q0+wid*QBLK)*DM+h*D;
  const unsigned lds0=(unsigned)(uintptr_t)shm;
  int tskip;
  { typedef __attribute__((address_space(3))) const unsigned long long* lds_u64q; const lds_u64q gt_=(lds_u64q)((__attribute__((address_space(3))) const char*)shm+LDS_G3);
    const int NT0=(q0+QB)/KVBLK; const unsigned long long e0=gt_[q0], e1=gt_[lane<NT0?64*lane+63:q0];
    const float G0=(__uint_as_float((unsigned)e0<<16)+__uint_as_float((unsigned)e0&0xffff0000u))+__uint_as_float((unsigned)(e0>>32)<<16);
    const float G1=(__uint_as_float((unsigned)e1<<16)+__uint_as_float((unsigned)e1&0xffff0000u))+__uint_as_float((unsigned)(e1>>32)<<16);
    const int ns=__builtin_popcountll(__ballot(lane<NT0 && (G1-G0)<skipthr)); tskip=__builtin_amdgcn_readfirstlane(min(ns&~1,NT0-6)); }
  const bf16*Kh=K+(rowbase+(long)tskip*KVBLK)*DM+h*D,*Vh=V+(rowbase+(long)tskip*KVBLK)*DM+h*D;
  float*wsf=(float*)(shm+LDS_WS)+wid*64;
  const bf16*ksrc=Kh+(long)lane*DM+wid*8;
  const bf16*vsrc=Vh+(long)(16*(wid&3)+(lane>>2))*DM+(wid>>2)*32+(lane&3)*8;
  const unsigned kdst=lds0+LDS_K+wid*1024, vdst=lds0+LDS_V+wid*1024;
  #define DMA_K(t,slot) glds16(ksrc+(long)(t)*KVBLK*DM,(unsigned)__builtin_amdgcn_readfirstlane(kdst+(slot)))
  #define DMA_V(t,slot) glds16(vsrc+(long)(t)*KVBLK*DM,(unsigned)__builtin_amdgcn_readfirstlane(vdst+(slot)))
  const int vb0=(int)(lds0+LDS_V)+((lane>>4)&1)*32+(lane&3)*8+(4*hi+((lane&15)>>2))*64;
  const char*Kbase=shm+LDS_K; bf16x8 kf[8];
  const lds_cptr shm3=(lds_cptr)shm; const lds_cptr kp0=shm3+LDS_K+hi*1024+r32*16; const lds_cptr vp0=shm3+LDS_V+((lane>>4)&1)*32+(lane&3)*8+(4*hi+((lane&15)>>2))*64;
  const int NT=(q0+QB)/KVBLK-tskip;
  DMA_K(0,0);DMA_V(0,0);DMA_K(1,SLOTB);
  bf16x8 qr[4];
  #pragma unroll
  for(int d0=0;d0<4;++d0)qr[d0]=*reinterpret_cast<const bf16x8*>(&Qw[(long)r32*DM+d0*16+hi*8]);
  float mhat=0.f,l_reg=0.f;f32x16 o[2];o[0]=f32x16{};o[1]=f32x16{};
  typedef __attribute__((address_space(3))) const unsigned long long* lds_u64p;
  const lds_u64p g3p=(lds_u64p)(shm3+LDS_G3)+tskip*KVBLK+r32;
  { const unsigned long long e=((lds_u64p)(shm3+LDS_G3))[q0+wid*QBLK+r32]; const unsigned lo_=(unsigned)e,hi_=(unsigned)(e>>32); mhat=(__uint_as_float(lo_<<16)+__uint_as_float(lo_&0xffff0000u))+__uint_as_float(hi_<<16); }
  u32x4 qa; qa.x=hi?0u:0x3f803f80u; qa.y=0u; qa.z=0u; qa.w=0u;
  #define SETREF() do{ const float x_=-mhat; const unsigned b1_=cvtpk_s(x_,0.f)&0xffffu; const float r1_=x_-__uint_as_float(b1_<<16); const unsigned b2_=cvtpk_s(r1_,0.f)&0xffffu; \
      const float r2_=r1_-__uint_as_float(b2_<<16); const unsigned b3_=cvtpk_s(r2_,0.f)&0xffffu; qa.y=hi?0u:(0x3f80u|(b1_<<16)); qa.z=hi?0u:(b2_|(b3_<<16)); asm volatile("":"+v"(qa)); }while(0)
  SETREF();
  unsigned long long ga0,ga1;
  #define GARD(t) do{ ga0=g3p[(t)*64]; ga1=g3p[(t)*64+32]; }while(0)
  #define KAF(g) __builtin_bit_cast(bf16x8,(u32x4){(unsigned)(g),(unsigned)((g)>>32),0x3f803f80u,0u})
  #define QAF() __builtin_bit_cast(bf16x8,qa)
  const int qrel=wid*QBLK+r32;
  #define CMASK(P0,P1,t) do{int jb_=(t)-(NT-4); if(jb_>=0)cmask(P0,P1,jb_,qrel,hi);}while(0)
  bool resc=false;
  #define START(P0,P1) do{ const float rm=rowmax(P0,P1); resc=false; \
    { const float dl=__builtin_fmaxf(rm,0.f); mhat=fadd_s(mhat,dl);     \
      _Pragma("unroll") for(int r=0;r<16;++r){P0[r]=fsub_s(P0[r],dl);P1[r]=fsub_s(P1[r],dl);} \
      SETREF(); } \
    _Pragma("unroll") for(int r=0;r<16;++r)P0[r]=__builtin_amdgcn_exp2f(P0[r]); }while(0)
  #define RESC() do{ if(resc){ asm volatile("s_waitcnt lgkmcnt(0)":::"memory"); \
      _Pragma("unroll") for(int d_=0;d_<2;++d_) _Pragma("unroll") for(int r=0;r<16;++r)o[d_][r]*=wsf[crow(r,hi)]; } }while(0)
  f32x16 pA0,pA1,pB0,pB1;
  int sl_prev=0,sl_cur=0,sl_next=SLOTB;
  #define ROT() do{sl_prev=sl_cur;sl_cur=sl_next;sl_next=(sl_next==(NSLOT-1)*SLOTB)?0:sl_next+SLOTB;}while(0)
  DMA_K(2,2*SLOTB);
  WAIT_BAR(3);
  GARD(0); qkt(pA0,pA1,Kbase,qr,KAF(ga0),KAF(ga1),QAF(),r32,hi);asm volatile("s_nop 15\n\ts_nop 7":"+v"(pA0),"+v"(pA1));CMASK(pA0,pA1,0);
  START(pA0,pA1);
  _Pragma("unroll") for(int r=0;r<16;++r)pA1[r]=__builtin_amdgcn_exp2f(pA1[r]);
  WAIT_BAR(0);
  DMA_K(3,0);DMA_V(1,SLOTB);
  ROT();
  kload8(kf,kp0+sl_cur); GARD(1);
  WAIT_BAR(2);
  s16x4 vlo[8],vhi[8]; u32x4 pw0,pw1,pw2,pw3;
  #define PKW(P,B) cvtpk_s(P[B],P[B+1])
  #define PAF(k) __builtin_bit_cast(bf16x8,pw##k)
  #define VFR(i) (bf16x8){vlo[i][0],vlo[i][1],vlo[i][2],vlo[i][3],vhi[i][0],vhi[i][1],vhi[i][2],vhi[i][3]}
  #define PIN(x) asm volatile("":"+v"(x))
  #define MX3(a,b,c) __builtin_fmaxf(__builtin_fmaxf((a),(b)),(c))
  #define GAPA(MF,A0,A1,A2,A3,W0,W1,PW) do{ MF; sacc+=A0; sacc+=A1; sacc+=A2; sacc+=A3; PIN(sacc); W0; W1; PIN(PW); SBAR(); }while(0)
  #define EX(v) __builtin_amdgcn_exp2f(v)
  #define GAPB(MF,X,B) do{ MF; X[B]=EX(X[B]); X[B+1]=EX(X[B+1]); X[B+2]=EX(X[B+2]); X[B+3]=EX(X[B+3]); PIN(X); SBAR(); }while(0)
  #define VRD(i) do{ vlo[i]=vtr(vp_+(((i)>>2)*4096+((i)&3)*1024)); vhi[i]=vtr(vp_+(((i)>>2)*4096+((i)&3)*1024+512)); }while(0)
  #define KRD(G,j) do{ if(G){ kload2(kf,kp0+sl_next,j); SBAR(); } }while(0)
  #define STEP(C0,C1,P0,P1,t,GK,GV,GL) do{ SBAR(); \
    const lds_cptr vp_=vp0+sl_prev; \
    { const f32x16 z_=f32x16{}; C0=__builtin_amdgcn_mfma_f32_32x32x16_bf16(KAF(ga0),QAF(),z_,0,0,0); C1=__builtin_amdgcn_mfma_f32_32x32x16_bf16(KAF(ga1),QAF(),z_,0,0,0); } SBAR(); \
    VRD(0); SBAR(); float sacc=(P0[0]+P0[1]); \
    GAPA(C0=__builtin_amdgcn_mfma_f32_32x32x16_bf16(kf[0],qr[0],C0,0,0,0), P0[2],P0[3],P0[4],P0[5],     pw0[0]=PKW(P0,0), pw0[1]=PKW(P0,2), pw0); \
    VRD(4); SBAR(); GAPA(C1=__builtin_amdgcn_mfma_f32_32x32x16_bf16(kf[1],qr[0],C1,0,0,0), P0[6],P0[7],P0[8],P0[9],     pw0[2]=PKW(P0,4), pw0[3]=PKW(P0,6), pw0); \
    VRD(1); SBAR(); GAPA(C0=__builtin_amdgcn_mfma_f32_32x32x16_bf16(kf[2],qr[1],C0,0,0,0),   P0[10],P0[11],P0[12],P0[13], pw1[0]=PKW(P0,8), pw1[1]=PKW(P0,10), pw1); \
    VRD(5); SBAR(); GAPA(C1=__builtin_amdgcn_mfma_f32_32x32x16_bf16(kf[3],qr[1],C1,0,0,0),   P0[14],P0[15],P1[0],P1[1],   pw1[2]=PKW(P0,12),pw1[3]=PKW(P0,14), pw1); \
    VRD(2); SBAR(); GAPA(C0=__builtin_amdgcn_mfma_f32_32x32x16_bf16(kf[4],qr[2],C0,0,0,0),   P1[2],P1[3],P1[4],P1[5],     pw2[0]=PKW(P1,0), pw2[1]=PKW(P1,2), pw2); \
    VRD(6); SBAR(); GAPA(C1=__builtin_amdgcn_mfma_f32_32x32x16_bf16(kf[5],qr[2],C1,0,0,0),   P1[6],P1[7],P1[8],P1[9],     pw2[2]=PKW(P1,4), pw2[3]=PKW(P1,6), pw2); \
    VRD(3); SBAR(); GAPA(C0=__builtin_amdgcn_mfma_f32_32x32x16_bf16(kf[6],qr[3],C0,0,0,0),   P1[10],P1[11],P1[12],P1[13], pw3[0]=PKW(P1,8), pw3[1]=PKW(P1,10), pw3); \
    VRD(7); SBAR(); GAPA(C1=__builtin_amdgcn_mfma_f32_32x32x16_bf16(kf[7],qr[3],C1,0,0,0),   P1[14],P1[15],0.f,0.f,       pw3[2]=PKW(P1,12),pw3[3]=PKW(P1,14), pw3); \
    l_reg+=sacc; \
    if(GK){DMA_K((t)+3,sl_cur);} if(GV){DMA_V((t)+1,sl_next);} \
    CMASK(C0,C1,t); \
    { float a=MX3(C0[0],C0[1],C1[0]),b=MX3(C0[2],C0[3],C1[1]); a=MX3(a,C1[2],C1[3]); \
      _Pragma("unroll") for(int r=4;r<16;r+=4){a=MX3(a,C0[r],C0[r+1]);b=MX3(b,C0[r+2],C0[r+3]);a=MX3(a,C1[r],C1[r+1]);b=MX3(b,C1[r+2],C1[r+3]);} \
      float rm=__builtin_fmaxf(a,b); { auto rr=__builtin_amdgcn_permlane32_swap(__float_as_uint(rm),__float_as_uint(rm),false,false); rm=__builtin_fmaxf(__uint_as_float(rr[0]),__uint_as_float(rr[1])); } \
      resc=false; \
      if(__builtin_expect(__any(rm>(float)THRL),0)){ const float dl=__builtin_fmaxf(rm,0.f); mhat+=dl; \
        _Pragma("unroll") for(int r=0;r<16;++r){C0[r]-=dl;C1[r]-=dl;} \
        SETREF(); \
        const float f=__builtin_amdgcn_exp2f(-dl); l_reg*=f; if(hi==0)wsf[r32]=f; resc=true; } } \
    SBAR(); \
    GAPB(o[0]=__builtin_amdgcn_mfma_f32_32x32x16_bf16(PAF(0),VFR(0),o[0],0,0,0), C0,0); \
    GAPB(o[1]=__builtin_amdgcn_mfma_f32_32x32x16_bf16(PAF(0),VFR(4),o[1],0,0,0), C0,4); \
    KRD(GL,0); GAPB(o[0]=__builtin_amdgcn_mfma_f32_32x32x16_bf16(PAF(1),VFR(1),o[0],0,0,0), C0,8); \
    KRD(GL,1); GAPB(o[1]=__builtin_amdgcn_mfma_f32_32x32x16_bf16(PAF(1),VFR(5),o[1],0,0,0), C0,12); \
    KRD(GL,2); GAPB(o[0]=__builtin_amdgcn_mfma_f32_32x32x16_bf16(PAF(2),VFR(2),o[0],0,0,0), C1,0); \
    KRD(GL,3); GAPB(o[1]=__builtin_amdgcn_mfma_f32_32x32x16_bf16(PAF(2),VFR(6),o[1],0,0,0), C1,4); \
    if(GL){ GARD((t)+1); SBAR(); } GAPB(o[0]=__builtin_amdgcn_mfma_f32_32x32x16_bf16(PAF(3),VFR(3),o[0],0,0,0), C1,8); \
    GAPB(o[1]=__builtin_amdgcn_mfma_f32_32x32x16_bf16(PAF(3),VFR(7),o[1],0,0,0), C1,12); \
    }while(0)
  int t=1;
  #undef CMASK
  #define CMASK(P0,P1,t) do{}while(0)
  for(;t+5<NT;t+=2){
    STEP(pB0,pB1,pA0,pA1,t,true,true,true);     WAIT_BAR(2); RESC(); ROT();
    STEP(pA0,pA1,pB0,pB1,t+1,true,true,true);   WAIT_BAR(2); RESC(); ROT();
  }
  #undef CMASK
  #define CMASK(P0,P1,t) do{int jb_=(t)-(NT-4); if(jb_>=0)cmask(P0,P1,jb_,qrel,hi);}while(0)
  #define ENDW(tt) do{ if((tt)+3<NT){WAIT_BAR(2);} else if((tt)+2<NT){WAIT_BAR(1);} else {WAIT_BAR(0);} }while(0)
  #undef CMASK
  #define CMASK(P0,P1,t) do{}while(0)
  STEP(pB0,pB1,pA0,pA1,NT-5,true,true,true);   WAIT_BAR(2); RESC(); ROT();
  #undef CMASK
  #define CMASK(P0,P1,t) cmask(P0,P1,0,qrel,hi)
  STEP(pA0,pA1,pB0,pB1,NT-4,true,true,true);   WAIT_BAR(2); RESC(); ROT();
  #undef CMASK
  #define CMASK(P0,P1,t) cmask(P0,P1,1,qrel,hi)
  STEP(pB0,pB1,pA0,pA1,NT-3,false,true,true);  WAIT_BAR(1); RESC(); ROT();
  #undef CMASK
  #define CMASK(P0,P1,t) cmask(P0,P1,2,qrel,hi)
  STEP(pA0,pA1,pB0,pB1,NT-2,false,true,true);  WAIT_BAR(0); RESC(); ROT();
  #undef CMASK
  #define CMASK(P0,P1,t) cmask(P0,P1,3,qrel,hi)
  STEP(pB0,pB1,pA0,pA1,NT-1,false,false,false); RESC();
  { float sacc=pB0[0]+pB0[1]; _Pragma("unroll") for(int r=2;r<16;++r)sacc+=pB0[r]; _Pragma("unroll") for(int r=0;r<16;++r)sacc+=pB1[r]; l_reg+=sacc;
    pw0=(u32x4){PKW(pB0,0),PKW(pB0,2),PKW(pB0,4),PKW(pB0,6)};pw1=(u32x4){PKW(pB0,8),PKW(pB0,10),PKW(pB0,12),PKW(pB0,14)};pw2=(u32x4){PKW(pB1,0),PKW(pB1,2),PKW(pB1,4),PKW(pB1,6)};pw3=(u32x4){PKW(pB1,8),PKW(pB1,10),PKW(pB1,12),PKW(pB1,14)};
    SBAR(); pv(o,vb0+sl_cur,PAF(0),PAF(1),PAF(2),PAF(3)); }
  #undef PKW
  #undef PAF
  #undef VFR
  #undef PIN
  #undef MX3
  #undef GAPA
  #undef GAPB
  #undef EX
  #undef VRD
  #undef KRD
  #undef STEP
  #undef ENDW
  {auto rr=__builtin_amdgcn_permlane32_swap(__float_as_uint(l_reg),__float_as_uint(l_reg),false,false);l_reg=__uint_as_float(rr[0])+__uint_as_float(rr[1]);}
  if(hi==0)wsf[32+r32]=l_reg;asm volatile("s_waitcnt lgkmcnt(0)":::"memory");
  float rli[16];
  #pragma unroll
  for(int r=0;r<16;++r)rli[r]=__builtin_amdgcn_rcpf(wsf[32+crow(r,hi)]);
  bf16*Ow=O+(rowbase+q0+wid*QBLK)*DM+h*D; const bf16*Gw=GATE+(rowbase+q0+wid*QBLK)*DM+h*D;
  { bf16*stg=(bf16*)(shm+LDS_OST)+wid*2048;
    #pragma unroll
    for(int r=0;r<16;++r){const int orow=crow(r,hi);
      #pragma unroll
      for(int d0=0;d0<2;++d0)stg[orow*64+d0*32+r32]=__float2bfloat16(o[d0][r]*rli[r]);}
    asm volatile("s_waitcnt lgkmcnt(0)":::"memory");
    #pragma unroll
    for(int i=0;i<4;++i){const int row=i*8+(lane>>3),ch=lane&7; const u32x4 v=*(const u32x4*)(stg+row*64+ch*8); const u32x4 gv=*(const u32x4*)(Gw+(long)row*DM+ch*8); u32x4 w;
      #define GMUL(a,g) cvtpk_s(__uint_as_float((a)<<16)*__uint_as_float((g)<<16),__uint_as_float((a)&0xffff0000u)*__uint_as_float((g)&0xffff0000u))
      w.x=GMUL(v.x,gv.x); w.y=GMUL(v.y,gv.y); w.z=GMUL(v.z,gv.z); w.w=GMUL(v.w,gv.w);
      #undef GMUL
      ATTN_STORE16(Ow+(long)row*DM+ch*8,w);} }
  asm volatile("s_waitcnt lgkmcnt(0)\n\ts_barrier":::"memory");
  #undef DMA_K
  #undef DMA_V
  #undef CMASK
  #undef START
  #undef RESC
  #undef ROT
  #undef SETREF
  #undef GARD
  #undef KAF
  #undef QAF
}
constexpr int ATTN_LDS_BYTES=LDS_BYTES;
struct AttnTensors { const bf16* Q; const bf16* K; const bf16* V; const bf16* GATE; bf16* O; const unsigned long long* G3; const float* qg; const float* kg; };
template<int THRL=8> __device__ __forceinline__ void attn_phase(char*lds,const AttnTensors&T,int grid,int block){
  const int v0=(grid%8==0)?(block%8)*(grid/8)+block/8:block;
  float skipthr; { float a=fabsf(T.qg[threadIdx.x&63]),b=fabsf(T.kg[threadIdx.x&63]);
    #pragma unroll
    for(int o=1;o<64;o<<=1){a=fmaxf(a,__shfl_xor(a,o));b=fmaxf(b,__shfl_xor(b,o));}
    const float qkmax=64.f*a*b*C2_*1.05f; skipthr=-(42.f+3.f*qkmax); }
  for(int v=v0;v<BATCH*NHEAD*2;v+=grid){
    const int bh=v>>1,odd=v&1;
    {
      const u32x4*src=(const u32x4*)(T.G3+(size_t)bh*SEQ); u32x4*dst=(u32x4*)(lds+LDS_G3);
      #pragma unroll
      for(int i=0;i<4;++i)dst[threadIdx.x+512*i]=src[threadIdx.x+512*i];
      if(threadIdx.x<128)((unsigned long long*)(lds+LDS_GPAD))[threadIdx.x]=0x3f80000000000000ull|0xc6eaull;
      asm volatile("s_waitcnt vmcnt(0) lgkmcnt(0)\n\ts_barrier":::"memory"); }
    #pragma unroll 1
    for(int i=0;i<8;++i){ const int j=i>>1; const int qb=(i&1)?(15-2*j-odd):(2*j+odd); attn_unit<THRL>(bh/NHEAD,bh%NHEAD,qb,T.Q,T.K,T.V,T.GATE,T.O,lds,skipthr); }
  }
}
#undef SBAR
#undef WAIT_BAR
}

constexpr int RING_BYTES = 131072;
constexpr int LDS_BYTES = 163840;
constexpr int LDSCTL_OFF = LDS_BYTES - 1024, MISC_OFF = LDSCTL_OFF + 320;
constexpr int CW_BAR = 4096;
typedef GAS unsigned gu32;
#define RLX_AGENT __ATOMIC_RELAXED, __HIP_MEMORY_SCOPE_AGENT
#define XB_TMO      128
#define XB_XCNT(j)  (256  + 64 * (j))
#define XB_XSUB(j)  (1280 + 64 * (j))
#define XB_XGEN(j)  (2304 + 64 * (j))
#define XB_TOP      3328
#define XB_TOPGEN   3392
#define XCD_BAR_WORDS 3456
#define XB_SPIN_CAP (1u << 18)
__device__ __forceinline__ unsigned xb_ld(unsigned* p)              { return __hip_atomic_load(p, __ATOMIC_RELAXED, __HIP_MEMORY_SCOPE_AGENT); }
__device__ __forceinline__ unsigned xb_add(unsigned* p, unsigned v) { return __hip_atomic_fetch_add(p, v, __ATOMIC_RELAXED, __HIP_MEMORY_SCOPE_AGENT); }
__device__ __forceinline__ unsigned xb_xcc_id() { return (unsigned)__builtin_amdgcn_s_getreg((3 << 11) | 20) & 0xFu; }
#define XB_SPIN(cond, bar) do { unsigned _sp = 0; while (cond) { __builtin_amdgcn_s_sleep(1); \
    if ((++_sp & 255u) == 0u) { if (xb_ld(&(bar)[XB_TMO])) break; if (_sp > XB_SPIN_CAP) { atomicAdd(&(bar)[XB_TMO], 1u); break; } } } } while (0)
struct XcdBarrier { unsigned* bar; unsigned x; volatile LAS unsigned* st; };
__device__ __forceinline__ XcdBarrier xcd_barrier_post(unsigned* bar, volatile LAS unsigned* st) {
    XcdBarrier b; b.bar = bar; b.x = xb_xcc_id(); b.st = st;
    if (threadIdx.x == 0) (void)xb_add(&bar[XB_XCNT(b.x)], 1u);
    return b;
}
__device__ __forceinline__ void xcd_barrier_complete(unsigned* bar, unsigned x, unsigned& nloc, unsigned& nx) {
    const unsigned G = gridDim.x * gridDim.y * gridDim.z;
    unsigned sum, cnt, mine, sp = 0u;
    for (;;) {
        sum = 0u; cnt = 0u; mine = 0u;
#pragma unroll
        for (unsigned j = 0; j < 16; ++j) { const unsigned c = xb_ld(&bar[XB_XCNT(j)]); sum += c; cnt += (c > 0u) ? 1u : 0u; mine = (j == x) ? c : mine; }
        if (sum == G) break;
        __builtin_amdgcn_s_sleep(1);
        if ((++sp & 255u) == 0u) { if (xb_ld(&bar[XB_TMO])) break; if (sp > XB_SPIN_CAP) { atomicAdd(&bar[XB_TMO], 1u); break; } }
    }
    nloc = mine > 0u ? mine : 1u; nx = cnt > 0u ? cnt : 1u;
}
__device__ __forceinline__ void xcd_barrier(const XcdBarrier& b) {
    asm volatile("s_waitcnt vmcnt(0)" ::: "memory");
    __syncthreads();
    if (threadIdx.x == 0) {
        unsigned* bar = b.bar; unsigned bx = b.x;
        asm volatile("" : "+s"(bar), "+s"(bx));
        __builtin_amdgcn_s_waitcnt(0);
        unsigned nloc = b.st[0], nx = b.st[1];
        if (nloc == 0u) { xcd_barrier_complete(bar, bx, nloc, nx); b.st[0] = nloc; b.st[1] = nx; }
        const unsigned old = xb_add(&bar[XB_XSUB(bx)], 1u);
        const unsigned gen = old / nloc;
        if (old + 1u == (gen + 1u) * nloc) {
            __builtin_amdgcn_fence(__ATOMIC_RELEASE, "agent");
            asm volatile("s_waitcnt vmcnt(0)" ::: "memory");
            const unsigned og = xb_add(&bar[XB_TOP], 1u);
            const unsigned tg = og / nx;
            if (og + 1u == (tg + 1u) * nx) xb_add(&bar[XB_TOPGEN], 1u);
            else XB_SPIN(xb_ld(&bar[XB_TOPGEN]) == tg, bar);
            __builtin_amdgcn_fence(__ATOMIC_ACQUIRE, "agent");
            xb_add(&bar[XB_XGEN(bx)], 1u);
            asm volatile("s_waitcnt vmcnt(0)" ::: "memory");
        } else {
            XB_SPIN(xb_ld(&bar[XB_XGEN(bx)]) == gen, bar);
            __builtin_amdgcn_fence(__ATOMIC_ACQUIRE, "agent");
            asm volatile("s_waitcnt vmcnt(0)" ::: "memory");
        }
    }
    __syncthreads();
}

__device__ __forceinline__ void bg_cvt(unsigned char* ws, LAS unsigned char* lds, int wave, int lane, volatile LAS unsigned* flag) {
    const InP in = kin(); LAS float* scr = (LAS float*)(lds + wave * 8448); volatile LAS unsigned* cur = flag + 1;
    const unsigned c = blockIdx.x, G = gridDim.x;
    for (;;) {
        if (*flag != 0u) break;
        if (*cur * G + c >= (unsigned)IT_BG) break;
        unsigned k = 0u; if (lane == 0) k = __hip_atomic_fetch_add((LAS unsigned*)cur, 1u, __ATOMIC_RELAXED, __HIP_MEMORY_SCOPE_WORKGROUP); k = (unsigned)__builtin_amdgcn_readfirstlane((int)k);
        const unsigned it = k * G + c; if (it >= (unsigned)IT_BG) break;
        cvt_item(in, ws, bg_item((int)it), scr, lane);
    }
}
__device__ __forceinline__ void xcd_barrier_bg(const XcdBarrier& b, unsigned char* ws, LAS unsigned char* lds, volatile LAS unsigned* flag) {
    asm volatile("s_waitcnt vmcnt(0)" ::: "memory");
    if (threadIdx.x == 0) *flag = 0u;
    __syncthreads();
    const int wave = __builtin_amdgcn_readfirstlane((int)threadIdx.x >> 6), lane = threadIdx.x & 63;
    if (wave != 0) { bg_cvt(ws, lds, wave, lane, flag); asm volatile("s_waitcnt vmcnt(0)" ::: "memory"); }
    else if (threadIdx.x == 0) {
        unsigned* bar = b.bar; unsigned bx = b.x;
        asm volatile("" : "+s"(bar), "+s"(bx));
        __builtin_amdgcn_s_waitcnt(0);
        unsigned nloc = b.st[0], nx = b.st[1];
        if (nloc == 0u) { xcd_barrier_complete(bar, bx, nloc, nx); b.st[0] = nloc; b.st[1] = nx; }
        const unsigned old = xb_add(&bar[XB_XSUB(bx)], 1u);
        const unsigned gen = old / nloc;
        if (old + 1u == (gen + 1u) * nloc) {
            __builtin_amdgcn_fence(__ATOMIC_RELEASE, "agent");
            asm volatile("s_waitcnt vmcnt(0)" ::: "memory");
            const unsigned og = xb_add(&bar[XB_TOP], 1u);
            const unsigned tg = og / nx;
            if (og + 1u == (tg + 1u) * nx) xb_add(&bar[XB_TOPGEN], 1u);
            else XB_SPIN(xb_ld(&bar[XB_TOPGEN]) == tg, bar);
            __builtin_amdgcn_fence(__ATOMIC_ACQUIRE, "agent");
            xb_add(&bar[XB_XGEN(bx)], 1u);
            asm volatile("s_waitcnt vmcnt(0)" ::: "memory");
        } else {
            XB_SPIN(xb_ld(&bar[XB_XGEN(bx)]) == gen, bar);
            __builtin_amdgcn_fence(__ATOMIC_ACQUIRE, "agent");
            asm volatile("s_waitcnt vmcnt(0)" ::: "memory");
        }
        *flag = 1u;
    }
    __syncthreads();
}

struct Frame { unsigned char* ws; float* out; LAS unsigned char* lds; int bid, G; };
#define TID_LANE_WAVE const int tid = threadIdx.x, lane = tid & 63, wave = __builtin_amdgcn_readfirstlane(tid >> 6); (void)tid; (void)lane; (void)wave

__device__ __forceinline__ void ph_prologue(const Frame& F) {
    TID_LANE_WAVE;
    const InP in = kin(); unsigned char* ws = opq(F.ws);
    LAS float* sc = (LAS float*)F.lds; LAS float* red = (LAS float*)(F.lds + 32768);
    __syncthreads();
    if (F.bid < ADA_ITEMS) {
        for (int i = tid; i < 8 * 1024; i += 512) sc[i] = siluf(in->c[i]);
        __syncthreads();
        for (int it = F.bid; it < ADA_ITEMS; it += F.G) ada_item(in, (float*)(ws + WS_MODS), it, sc, red, tid);
    }
    __syncthreads();
    LAS float* scr = (LAS float*)(F.lds + wave * 8448);
    const int gw = F.bid * 8 + wave, ngw = F.G * 8;
    for (int it = gw; it < IT_FG; it += ngw) cvt_item(in, ws, fg_item(it), scr, lane);
    bf16_t* wsb = (bf16_t*)(ws + WS_WS);
    for (int i = F.bid * 512 + tid; i < 8 * 128 * 128; i += F.G * 512) { const int s = i & 127, t = (i >> 7) & 127; wsb[i] = (bf16_t)f2bf(s <= t ? in->w_s[i] : 0.f); }
}
__device__ __forceinline__ void ph_norm0(const Frame& F) {
    TID_LANE_WAVE; const InP in = kin(); unsigned char* ws = opq(F.ws); const int gw = F.bid * 8 + wave, ngw = F.G * 8;
    const float* mods = (const float*)(ws + WS_MODS);
    for (int r = gw; r < T; r += ngw) { const int b = r / SEQ;
        row4_norm_mod_store(in->x + (size_t)r * DM, in->norm_mix_g, mods + (size_t)b * 6144 + 0, mods + (size_t)b * 6144 + 1024, (bf16_t*)(ws + WS_XN) + (size_t)r * DM, lane); }
    LAS float* red = (LAS float*)F.lds;
    for (int it = F.bid; it < 24; it += F.G) {
        __syncthreads();
        if (it < 16) { const int L = it >> 3, b = it & 7, e = tid & 31, part = tid >> 5; const float* sh = mods + ((size_t)L * 8 + b) * 6144 + 3072; const float* rw = in->router_w + (size_t)L * 1024 * 32;
            float a = 0.f; for (int k = part * 64; k < part * 64 + 64; ++k) a += sh[k] * rw[k * 32 + e];
            red[part * 32 + e] = a; __syncthreads();
            if (tid < 32) { float t = in->router_b[L * 32 + tid]; for (int p = 0; p < 16; ++p) t += red[p * 32 + tid]; ((float*)(ws + WS_RB2))[(L * 8 + b) * 32 + tid] = t; }
        } else { const int b = it - 16, e = tid & 15, part = tid >> 4; const float* sh = mods + ((size_t)16 + b) * 6144;
            float a = 0.f; for (int k = part * 32; k < part * 32 + 32; ++k) a += sh[k] * in->kv_w[(size_t)k * 2064 + 2048 + e];
            red[part * 16 + e] = a; __syncthreads();
            if (tid < 16) { float t = in->fgate_b[tid]; for (int p = 0; p < 32; ++p) t += red[p * 16 + tid]; ((float*)(ws + WS_FB2))[b * 16 + tid] = t; }
        }
    }
}
__device__ __forceinline__ void ph_norm_router(const Frame& F, int L) {
    TID_LANE_WAVE; const InP in = kin(); unsigned char* ws = opq(F.ws);
    LAS f32x4* WP = (LAS f32x4*)F.lds;
    LAS float* lg = (LAS float*)(F.lds + 131072) + wave * 512;
    LAS int* hist = (LAS int*)(F.lds + 131072 + 16384);
    LAS float* rs_s = (LAS float*)(F.lds + 131072 + 16384 + 256) + wave * 16;
    const float* mods = (const float*)(ws + WS_MODS) + (size_t)L * 8 * 6144;
    const bf16_t* XR = (const bf16_t*)(ws + WS_XR);
    for (int grp = F.bid; grp < 256; grp += F.G) {
        const int b = grp >> 5; const float* gsc = mods + (size_t)b * 6144 + 4096; const float* gg = in->norm_ffn_g + L * 1024; const float* rw = in->router_w + (size_t)L * 1024 * 32;
        __syncthreads();
        for (int idx = tid; idx < 64 * 2 * 64; idx += 512) { const int l = idx & 63, hh = (idx >> 6) & 1, gq = (idx >> 7) & 1, s2 = idx >> 8, e = 16 * hh + (l & 15), k0 = 32 * s2 + 8 * (l >> 4) + 4 * gq;
            const f32x4 g4 = *(const f32x4*)(gg + k0), s4 = *(const f32x4*)(gsc + k0);
            f32x4 w; w.x = g4.x * (1.f + s4.x) * rw[(k0 + 0) * 32 + e]; w.y = g4.y * (1.f + s4.y) * rw[(k0 + 1) * 32 + e]; w.z = g4.z * (1.f + s4.z) * rw[(k0 + 2) * 32 + e]; w.w = g4.w * (1.f + s4.w) * rw[(k0 + 3) * 32 + e];
            WP[idx] = w; }
        if (tid < 32) hist[tid] = 0;
        __syncthreads();
        const int r0 = grp * 128 + wave * 16, j = lane & 15, kq = lane >> 4;
        {
            const bf16_t* xrow = XR + (size_t)(r0 + j) * DM + 8 * kq;
            f32x4 acc0 = {0.f, 0.f, 0.f, 0.f}, acc1 = {0.f, 0.f, 0.f, 0.f}; float ssq = 0.f;
#pragma unroll 16
            for (int s2 = 0; s2 < 32; ++s2) {
                f32x4 xv[2]; bf8_to_f32(*(const u32x4*)(xrow + 32 * s2), xv[0], xv[1]);
#pragma unroll
                for (int gq = 0; gq < 2; ++gq) { const f32x4 w0 = WP[((s2 * 2 + gq) * 2 + 0) * 64 + lane], w1 = WP[((s2 * 2 + gq) * 2 + 1) * 64 + lane];
                    ssq += (xv[gq].x * xv[gq].x + xv[gq].y * xv[gq].y) + (xv[gq].z * xv[gq].z + xv[gq].w * xv[gq].w);
#pragma unroll
                    for (int q = 0; q < 4; ++q) { acc0 = __builtin_amdgcn_mfma_f32_16x16x4f32(w0[q], xv[gq][q], acc0, 0, 0, 0); acc1 = __builtin_amdgcn_mfma_f32_16x16x4f32(w1[q], xv[gq][q], acc1, 0, 0, 0); } }
            }
            ssq += __shfl_xor(ssq, 16); ssq += __shfl_xor(ssq, 32);
            const float rstd = 1.f / sqrtf(ssq * (1.f / 1024.f) + EPS);
            const float* rb2 = (const float*)(ws + WS_RB2) + (L * 8 + b) * 32;
            const f32x4 b0 = *(const f32x4*)(rb2 + 4 * kq), b1 = *(const f32x4*)(rb2 + 16 + 4 * kq);
            *(LAS f32x4*)(lg + j * 32 + 4 * kq) = acc0 * rstd + b0; *(LAS f32x4*)(lg + j * 32 + 16 + 4 * kq) = acc1 * rstd + b1;
            if (kq == 0) rs_s[j] = rstd;
        }
        __builtin_amdgcn_s_waitcnt(0xc07f); asm volatile("" ::: "memory");
        if (lane < 16) {
            float v[32];
#pragma unroll
            for (int q = 0; q < 8; ++q) { const f32x4 t4 = *(const LAS f32x4*)(lg + lane * 32 + 4 * q); v[4 * q] = t4.x; v[4 * q + 1] = t4.y; v[4 * q + 2] = t4.z; v[4 * q + 3] = t4.w; }
            int ti[4]; float tv[4];
#pragma unroll
            for (int p = 0; p < 4; ++p) { float bv = -INFINITY; int bi = 0;
#pragma unroll
                for (int e = 0; e < 32; ++e) { bool ok = v[e] > bv;
#pragma unroll
                    for (int pp = 0; pp < p; ++pp) ok = ok && (ti[pp] != e);
                    if (ok) { bv = v[e]; bi = e; } }
                ti[p] = bi; tv[p] = bv; }
            float tg[4]; float sm = 0.f;
#pragma unroll
            for (int p = 0; p < 4; ++p) { tg[p] = expf(tv[p] - tv[0]); sm += tg[p]; }
            const int r = r0 + lane;
            *(i32x4*)((int*)(ws + WS_TOPE) + r * 4) = (i32x4){ti[0], ti[1], ti[2], ti[3]};
            *(f32x4*)((float*)(ws + WS_TOPG) + r * 4) = (f32x4){tg[0] / sm, tg[1] / sm, tg[2] / sm, tg[3] / sm};
#pragma unroll
            for (int p = 0; p < 4; ++p) __hip_atomic_fetch_add(&hist[ti[p]], 1, __ATOMIC_RELAXED, __HIP_MEMORY_SCOPE_WORKGROUP);
        }
#pragma unroll 4
        for (int i = 0; i < 16; ++i) { const int r = r0 + i; f32x4 v[4], h[4]; row_load_bf(XR + (size_t)r * DM, lane, v);
            row_modnorm(v, rs_s[i], gg, mods + (size_t)b * 6144 + 3072, gsc, lane, h); row_store_bf16((bf16_t*)(ws + WS_XN) + (size_t)r * DM, lane, h); }
        __syncthreads();
        if (tid < 32) ((int*)(ws + WS_HIST))[grp * 32 + tid] = hist[tid];
    }
}
__device__ __forceinline__ void ph_list(const Frame& F) {
    TID_LANE_WAVE; unsigned char* ws = opq(F.ws);
    LAS int* tot = (LAS int*)F.lds; LAS int* before = tot + 32; LAS int* pstart = tot + 64; LAS int* se = tot + 128; LAS int* part = tot + 640;
    const int* hist = (const int*)(ws + WS_HIST); const int* tope = (const int*)(ws + WS_TOPE); const float* topg = (const float*)(ws + WS_TOPG);
    int* dest = (int*)(ws + WS_DEST); int* list = (int*)(ws + WS_LIST); float* rowg = (float*)(ws + WS_ROWG); int* blke = (int*)(ws + WS_BLKE);
    for (int w = F.bid; w < 256; w += F.G) {
        __syncthreads();
        const int mye = tope[w * 512 + tid]; se[tid] = mye;
        { const int e = tid & 31, p = tid >> 5; int a = 0, bf = 0;
#pragma unroll 4
            for (int i = p * 16; i < p * 16 + 16; ++i) { const int h = hist[i * 32 + e]; a += h; bf += (i < w) ? h : 0; }
            part[p * 32 + e] = a; part[512 + p * 32 + e] = bf; }
        __syncthreads();
        if (tid < 32) { int a = 0, bf = 0;
#pragma unroll
            for (int p = 0; p < 16; ++p) { a += part[p * 32 + tid]; bf += part[512 + p * 32 + tid]; }
            tot[tid] = a; before[tid] = bf; }
        __syncthreads();
        if (tid == 0) { int p = 0; for (int e = 0; e < 32; ++e) { pstart[e] = p; p += (tot[e] + 255) / 256 * 256; } pstart[32] = p; }
        __syncthreads();
        { int rank = 0;
            for (int i4 = 0; i4 < 128; ++i4) { const i32x4 q = *(const LAS i32x4*)(se + 4 * i4); const int i0 = 4 * i4;
                rank += (q.x == mye && i0 < tid) + (q.y == mye && i0 + 1 < tid) + (q.z == mye && i0 + 2 < tid) + (q.w == mye && i0 + 3 < tid); }
            const int slot = w * 512 + tid, d = pstart[mye] + before[mye] + rank;
            dest[slot] = d; list[d] = slot >> 2; rowg[d] = topg[slot]; }
        if (w < 32) { const int e = w; for (int r = pstart[e] + tot[e] + tid; r < pstart[e + 1]; r += 512) { list[r] = -1; rowg[r] = 0.f; }
            for (int bk = pstart[e] / 256 + tid; bk < pstart[e + 1] / 256; bk += 512) blke[bk] = e; }
        if (w == 32 && tid == 0) blke[MAXBLK] = pstart[32] / 256;
    }
}
__device__ __forceinline__ void ph_combine(const Frame& F, int L) {
    TID_LANE_WAVE; const InP in = kin(); unsigned char* ws = opq(F.ws); float* out = F.out;
    LAS f32x4* WF = (LAS f32x4*)F.lds;
    LAS float* rs_s = (LAS float*)(F.lds + 65536) + wave * 16;
    const float* mods = (const float*)(ws + WS_MODS);
    bf16_t* XR = (bf16_t*)(ws + WS_XR); const bf16_t* YB = (const bf16_t*)(ws + WS_YB); const int* dest = (const int*)(ws + WS_DEST);
    for (int grp = F.bid; grp < 256; grp += F.G) {
        const int b = grp >> 5, r0 = grp * 128 + wave * 16;
        if (L == 0) {
            __syncthreads();
            const float* ksc = mods + ((size_t)16 + b) * 6144 + 1024;
            for (int idx = tid; idx < 64 * 64; idx += 512) { const int l = idx & 63, gq = (idx >> 6) & 1, s2 = idx >> 7, e = l & 15, k0 = 32 * s2 + 8 * (l >> 4) + 4 * gq;
                const f32x4 g4 = *(const f32x4*)(in->kv_norm_g + k0), s4 = *(const f32x4*)(ksc + k0); const float* kw = in->kv_w + (size_t)k0 * 2064 + 2048 + e;
                f32x4 w; w.x = g4.x * (1.f + s4.x) * kw[0]; w.y = g4.y * (1.f + s4.y) * kw[2064]; w.z = g4.z * (1.f + s4.z) * kw[2 * 2064]; w.w = g4.w * (1.f + s4.w) * kw[3 * 2064];
                WF[idx] = w; }
            __syncthreads();
        }
        const float* gt = mods + ((size_t)L * 8 + b) * 6144 + 5120;
#pragma unroll 1
        for (int i = 0; i < 16; ++i) {
            const int r = r0 + i; f32x4 v[4]; row_load_bf(XR + (size_t)r * DM, lane, v);
            f32x4 y[4];
#pragma unroll
            for (int j = 0; j < 4; ++j) y[j] = (f32x4){0.f, 0.f, 0.f, 0.f};
            const i32x4 d4 = *(const i32x4*)(dest + r * 4); const int dd[4] = {d4.x, d4.y, d4.z, d4.w};
#pragma unroll
            for (int q = 0; q < 4; ++q) { const bf16_t* yr = YB + (size_t)dd[q] * 1024;
#pragma unroll
                for (int j = 0; j < 2; ++j) { f32x4 a, c; bf8_to_f32(((const u32x4*)yr)[lane + 64 * j], a, c); y[2 * j] += a; y[2 * j + 1] += c; } }
#pragma unroll
            for (int j = 0; j < 4; ++j) v[j] = v[j] + row_vec(gt, lane, j) * y[j];
            const float rs = row_rstd(v);
            if (L == 1) { f32x4 o4[4];
#pragma unroll
                for (int j = 0; j < 4; ++j) o4[j] = v[j] * rs * row_vec(in->final_g, lane, j);
                row_store_f32(out + (size_t)r * DM, lane, o4);
                continue;
            }
            row_store_bf16(XR + (size_t)r * DM, lane, v);
            f32x4 h[4];
            row_modnorm(v, rs, in->norm_mix_g + 1024, mods + ((size_t)8 + b) * 6144 + 0, mods + ((size_t)8 + b) * 6144 + 1024, lane, h);
            row_store_bf16((bf16_t*)(ws + WS_XN) + (size_t)r * DM, lane, h);
            row_modnorm(v, rs, in->kv_norm_g, mods + ((size_t)16 + b) * 6144 + 0, mods + ((size_t)16 + b) * 6144 + 1024, lane, h);
            row_store_bf16((bf16_t*)(ws + WS_HKV) + (size_t)r * DM, lane, h);
            if (lane == 0) rs_s[i] = rs;
        }
        if (L == 0) {
            __builtin_amdgcn_fence(__ATOMIC_RELEASE, "workgroup"); asm volatile("s_waitcnt vmcnt(0) lgkmcnt(0)" ::: "memory"); __builtin_amdgcn_fence(__ATOMIC_ACQUIRE, "workgroup");
            const int j = lane & 15, kq = lane >> 4; const bf16_t* xrow = XR + (size_t)(r0 + j) * DM + 8 * kq;
            f32x4 acc = {0.f, 0.f, 0.f, 0.f};
#pragma unroll 16
            for (int s2 = 0; s2 < 32; ++s2) { f32x4 xv[2]; bf8_to_f32(__builtin_nontemporal_load((const u32x4*)(xrow + 32 * s2)), xv[0], xv[1]);
#pragma unroll
                for (int gq = 0; gq < 2; ++gq) { const f32x4 w0 = WF[(s2 * 2 + gq) * 64 + lane];
#pragma unroll
                    for (int q = 0; q < 4; ++q) acc = __builtin_amdgcn_mfma_f32_16x16x4f32(w0[q], xv[gq][q], acc, 0, 0, 0); } }
            const float rstd = rs_s[j]; const f32x4 fb = *(const f32x4*)((const float*)(ws + WS_FB2) + b * 16 + 4 * kq);
            f32x4 lf;
#pragma unroll
            for (int q = 0; q < 4; ++q) { const float xg = acc[q] * rstd + fb[q]; lf[q] = fminf(xg, 0.f) - log1pf(expf(-fabsf(xg))); }
            *(f32x4*)((float*)(ws + WS_LOGF) + (size_t)(r0 + j) * 16 + 4 * kq) = lf;
        }
    }
}
__device__ __forceinline__ void ph_cumsum(const Frame& F) {
    TID_LANE_WAVE; unsigned char* ws = opq(F.ws); LAS float* wtot = (LAS float*)F.lds;
    for (int bh = F.bid; bh < NB * NH; bh += F.G) {
        const int b = bh >> 4, h = bh & 15;
        const float* lf = (const float*)(ws + WS_LOGF); float v[8]; float run = 0.f;
#pragma unroll
        for (int i = 0; i < 8; ++i) { run += lf[((size_t)b * SEQ + tid * 8 + i) * 16 + h]; v[i] = run; }
        float inc = run;
#pragma unroll
        for (int o = 1; o < 64; o <<= 1) { const float t = __shfl_up(inc, o); if (lane >= o) inc += t; }
        if (lane == 63) wtot[wave] = inc;
        __syncthreads();
        float off = inc - run;
        for (int w8 = 0; w8 < wave; ++w8) off += wtot[w8];
        float* fc = (float*)(ws + WS_FC) + (size_t)bh * SEQ; unsigned long long* g3 = (unsigned long long*)(ws + WS_G3) + (size_t)bh * SEQ;
#pragma unroll
        for (int i = 0; i < 8; ++i) { const float Fv = v[i] + off; fc[tid * 8 + i] = Fv;
            const float g = -Fv * LOG2E; const unsigned b1 = f2bf(g); const float r1 = g - __uint_as_float(b1 << 16); const unsigned b2 = f2bf(r1); const float r2 = r1 - __uint_as_float(b2 << 16); const unsigned b3 = f2bf(r2);
            g3[tid * 8 + i] = (unsigned long long)(b1 | (b2 << 16)) | ((unsigned long long)(b3 | (0x3f80u << 16)) << 32); }
        __syncthreads();
    }
}


typedef short s16x4 __attribute__((ext_vector_type(4)));
__device__ __forceinline__ s16x4 ds_tr16(LAS unsigned char* p) { return __builtin_bit_cast(s16x4, __builtin_amdgcn_ds_read_tr16_b64_v4i16((LAS s16x4*)p)); }
__device__ __forceinline__ void ph_spatial(const Frame& F) {
    const InP in = kin(); unsigned char* ws = opq(F.ws);
    LAS unsigned char* L = F.lds;
    constexpr int VN_STRIDE = 544, WC_STRIDE = 272, OFF_VN = 0, OFF_WC = 128 * VN_STRIDE, OFF_ST = OFF_WC + 128 * WC_STRIDE;
    LAS float* st = (LAS float*)(L + OFF_ST);
    const bf16_t* Z = (const bf16_t*)(ws + WS_Z); bf16_t* GT = (bf16_t*)(ws + WS_GATED); const bf16_t* WSB = (const bf16_t*)(ws + WS_WS);
    for (int ch = F.bid; ch < T / 128; ch += F.G) {
        const int t0 = ch * 128;
        __syncthreads();
        { int tid_ = threadIdx.x; asm volatile("" : "+v"(tid_)); const int lane = tid_ & 63, wave = __builtin_amdgcn_readfirstlane(tid_ >> 6);
#pragma unroll 4
        for (int i = 0; i < 16; ++i) {
            const int tl = wave * 16 + i; const bf16_t* vrow = Z + (size_t)(t0 + tl) * 4096 + 2048;
            float v[32]; float s = 0.f;
#pragma unroll
            for (int j = 0; j < 4; ++j) { const u32x4 w = *(const u32x4*)(vrow + (lane + 64 * j) * 8); const unsigned ww[4] = {w.x, w.y, w.z, w.w};
#pragma unroll
                for (int q = 0; q < 4; ++q) { v[j * 8 + 2 * q] = __uint_as_float(ww[q] << 16); v[j * 8 + 2 * q + 1] = __uint_as_float(ww[q] & 0xffff0000u); } }
#pragma unroll
            for (int q = 0; q < 32; ++q) s += v[q];
            const float mean = wave_sum(s) * (1.f / 2048.f); float qq = 0.f;
#pragma unroll
            for (int q = 0; q < 32; ++q) { const float d = v[q] - mean; qq += d * d; }
            const float rstd = 1.f / sqrtf(wave_sum(qq) * (1.f / 2048.f) + EPS);
            if (lane == 0) { st[2 * tl] = mean; st[2 * tl + 1] = rstd; }
        } }
        u32x4 vw[8], wcw[4];
        { int tid_ = threadIdx.x; asm volatile("" : "+v"(tid_)); const int tid = tid_, c8 = tid & 31;
#pragma unroll
            for (int q = 0; q < 8; ++q) vw[q] = *(const u32x4*)(Z + (size_t)(t0 + (tid >> 5) + 16 * q) * 4096 + 2048 + c8 * 8);
#pragma unroll
            for (int q = 0; q < 4; ++q) { const int cidx = tid + 512 * q, r = cidx >> 4, c16 = cidx & 15; wcw[q] = *(const u32x4*)(WSB + r * 128 + c16 * 8); } }
#pragma unroll 1
        for (int g = 0; g < 8; ++g) {
            int tid_ = threadIdx.x; asm volatile("" : "+v"(tid_));
            const int tid = tid_, lane = tid & 63, wave = __builtin_amdgcn_readfirstlane(tid >> 6), fr = lane & 15, fq = lane >> 4;
            __syncthreads();
#pragma unroll
            for (int q = 0; q < 4; ++q) { const int cidx = tid + 512 * q, r = cidx >> 4, c16 = cidx & 15; *(LAS u32x4*)(L + OFF_WC + r * WC_STRIDE + c16 * 16) = wcw[q]; }
            {
                const int c8 = tid & 31; const float* vg = in->v_g + g * 256 + c8 * 8; const float* vb = in->v_b + g * 256 + c8 * 8;
                const f32x4 g0 = *(const f32x4*)vg, g1 = *(const f32x4*)(vg + 4), b0 = *(const f32x4*)vb, b1 = *(const f32x4*)(vb + 4);
#pragma unroll
                for (int q = 0; q < 8; ++q) { const int s = (tid >> 5) + 16 * q;
                    const u32x4 w = vw[q];
                    const float mean = st[2 * s], rstd = st[2 * s + 1];
                    f32x4 x0 = {__uint_as_float(w.x << 16), __uint_as_float(w.x & 0xffff0000u), __uint_as_float(w.y << 16), __uint_as_float(w.y & 0xffff0000u)};
                    f32x4 x1 = {__uint_as_float(w.z << 16), __uint_as_float(w.z & 0xffff0000u), __uint_as_float(w.w << 16), __uint_as_float(w.w & 0xffff0000u)};
                    x0 = (x0 - mean) * rstd * g0 + b0; x1 = (x1 - mean) * rstd * g1 + b1;
                    u32x4 o; o.x = pk2(x0[0], x0[1]); o.y = pk2(x0[2], x0[3]); o.z = pk2(x1[0], x1[1]); o.w = pk2(x1[2], x1[3]);
                    *(LAS u32x4*)(L + OFF_VN + s * VN_STRIDE + c8 * 16) = o; }
            }
            u32x2 uw[8][2]; float bsv[8];
#pragma unroll
            for (int tb = 0; tb < 8; ++tb) { const int t = 16 * tb + fr; bsv[tb] = in->b_s[g * 128 + t];
#pragma unroll
                for (int db = 0; db < 2; ++db) uw[tb][db] = *(const u32x2*)(Z + (size_t)(t0 + t) * 4096 + 256 * g + 32 * wave + 16 * db + 4 * fq); }
            __syncthreads();
            if (g < 7) { const int c8 = tid & 31;
#pragma unroll
                for (int q = 0; q < 8; ++q) vw[q] = *(const u32x4*)(Z + (size_t)(t0 + (tid >> 5) + 16 * q) * 4096 + 2048 + (g + 1) * 256 + c8 * 8);
#pragma unroll
                for (int q = 0; q < 4; ++q) { const int cidx = tid + 512 * q, r = cidx >> 4, c16 = cidx & 15; wcw[q] = *(const u32x4*)(WSB + (size_t)(g + 1) * 16384 + r * 128 + c16 * 8); } }
            f32x4 acc[8][2];
#pragma unroll
            for (int tb = 0; tb < 8; ++tb) { acc[tb][0] = (f32x4){0.f, 0.f, 0.f, 0.f}; acc[tb][1] = (f32x4){0.f, 0.f, 0.f, 0.f}; }
#pragma unroll
            for (int ks = 0; ks < 4; ++ks) {
                const int s0 = 32 * ks; bf16x8 X[2];
#pragma unroll
                for (int db = 0; db < 2; ++db) { LAS unsigned char* p = L + OFF_VN + (s0 + 4 * fq + (fr >> 2)) * VN_STRIDE + (32 * wave + 16 * db + 4 * (fr & 3)) * 2;
                    const s16x4 lo = ds_tr16(p), hi = ds_tr16(p + 16 * VN_STRIDE);
                    X[db] = (bf16x8){lo[0], lo[1], lo[2], lo[3], hi[0], hi[1], hi[2], hi[3]}; }
#pragma unroll
                for (int tb = 0; tb < 8; ++tb) if (2 * ks <= tb) {
                    LAS unsigned char* p = L + OFF_WC + (16 * tb + fr) * WC_STRIDE + (s0 + 4 * fq) * 2;
                    const u32x2 y0 = *(LAS u32x2*)p, y1 = *(LAS u32x2*)(p + 32);
                    const bf16x8 Y = __builtin_bit_cast(bf16x8, (u32x4){y0.x, y0.y, y1.x, y1.y});
                    acc[tb][0] = __builtin_amdgcn_mfma_f32_16x16x32_bf16(X[0], Y, acc[tb][0], 0, 0, 0);
                    acc[tb][1] = __builtin_amdgcn_mfma_f32_16x16x32_bf16(X[1], Y, acc[tb][1], 0, 0, 0); }
            }
#pragma unroll
            for (int tb = 0; tb < 8; ++tb) { const int t = 16 * tb + fr;
#pragma unroll
                for (int db = 0; db < 2; ++db) { const int dd = 256 * g + 32 * wave + 16 * db + 4 * fq;
                    const u32x2 uwv = uw[tb][db];
                    const f32x4 m = acc[tb][db] + bsv[tb];
                    u32x2 o; o.x = pk2(__uint_as_float(uwv.x << 16) * m[0], __uint_as_float(uwv.x & 0xffff0000u) * m[1]); o.y = pk2(__uint_as_float(uwv.y << 16) * m[2], __uint_as_float(uwv.y & 0xffff0000u) * m[3]);
                    *(u32x2*)(GT + (size_t)(t0 + t) * 2048 + dd) = o; } }
        }
    }
}

constexpr int NPH = 18;
struct PA { In in; unsigned char* ws; float* out; int ph_lo, ph_hi, li, pad; };
__global__ void __launch_bounds__(512, 2) fwd(PA args) {
    extern __shared__ __attribute__((aligned(16))) unsigned char lds[];
    Frame F; F.ws = args.ws; F.out = args.out; F.lds = (LAS unsigned char*)lds;
    F.bid = blockIdx.x; F.G = gridDim.x;
    LAS unsigned char* ldsl = (LAS unsigned char*)lds;
    volatile LAS unsigned* MISC = (volatile LAS unsigned*)(ldsl + MISC_OFF);
    for (int u = threadIdx.x; u < (LDS_BYTES - LDSCTL_OFF) / 4; u += 512) ((LAS unsigned*)(ldsl + LDSCTL_OFF))[u] = 0u;
    __syncthreads();
    unsigned char* const ws0 = args.ws;
    XcdBarrier bar = xcd_barrier_post((unsigned*)(ws0 + WS_CTL) + CW_BAR + args.li * XCD_BAR_WORDS, MISC + 8);
    const int lo = args.ph_lo, hi = args.ph_hi;
#ifndef PHMASK
#define PHMASK 0x3ffffu
#endif
#define IN(k) (((PHMASK >> (k)) & 1u) && lo <= (k) && (k) < hi)
#define SEAM(k) do { if (lo <= (k) && (k) + 1 < hi) { if ((k) <= 13) xcd_barrier_bg(bar, ws0, ldsl, MISC + 12); else xcd_barrier(bar); } } while (0)
    const int c = (int)blockIdx.x, G = (int)gridDim.x;

    if (IN(0)) { ph_prologue(F); } SEAM(0);
    if (IN(1)) { ph_norm0(F); } SEAM(1);
    if (IN(2)) {
        unsigned char* ws = opq(ws0);
        pg::StaticOrder S; S.init(T / 256, 4096 / 256, G, c);
        pg::SrcPlain<true> src{(const char*)(ws + WS_WIN), 2048}; pg::EpGeluZ E{(bf16_t*)(ws + WS_Z)};
        pg::gemm_phase<pg::EpGeluZ, pg::StaticOrder, pg::SrcPlain<true>, true>(ldsl, (const char*)(ws + WS_XN), 1024, S, src, E);
    } SEAM(2);
    if (IN(3)) { ph_spatial(F); } SEAM(3);
    if (IN(4)) {
        unsigned char* ws = opq(ws0); const float* mods = (const float*)(ws + WS_MODS);
        pg::StaticOrder S; S.init(T / 256, 1024 / 256, G, c);
        pg::SrcPlain<true> src{(const char*)(ws + WS_WOUT), 4096}; pg::EpResid<true> E{kin()->x, (bf16_t*)(ws + WS_XR), mods + 2048};
        pg::gemm_phase<pg::EpResid<true>, pg::StaticOrder, pg::SrcPlain<true>, true>(ldsl, (const char*)(ws + WS_GATED), 2048, S, src, E);
    } SEAM(4);
#define LAYER_MOE(L, P0) \
    if (IN(P0)) { ph_norm_router(F, L); } SEAM(P0); \
    if (IN(P0 + 1)) { if ((P0) == 13) { TID_LANE_WAVE; if (tid == 0) MISC[12] = 0u; __syncthreads(); bg_cvt(ws0, ldsl, wave, lane, MISC + 12); } ph_list(F); } SEAM(P0 + 1); \
    if (IN(P0 + 2)) {     \
        unsigned char* ws = opq(ws0); const int* blke = (const int*)(ws + WS_BLKE); \
        pg::StaticOrder S; S.init(blke[MAXBLK], 8, G, c); \
        pg::SrcMoeA src{(const char*)(ws + WS_W1) + (size_t)L * 32 * 2048 * 1024 * 2, (const int*)(ws + WS_LIST), blke, 2048}; pg::EpSwiglu E{(bf16_t*)(ws + WS_ACT), kin()->exp_b1 + (size_t)L * 32 * 2048, blke}; \
        pg::gemm_phase<pg::EpSwiglu, pg::StaticOrder, pg::SrcMoeA, true>(ldsl, (const char*)(ws + WS_XN), 1024, S, src, E); \
    } SEAM(P0 + 2); \
    if (IN(P0 + 3)) {     \
        unsigned char* ws = opq(ws0); const int* blke = (const int*)(ws + WS_BLKE); \
        pg::StaticOrder S; S.init(blke[MAXBLK], 4, G, c); \
        pg::SrcMoeB src{(const char*)(ws + WS_W2) + (size_t)L * 32 * 1024 * 1024 * 2, blke, 2048}; pg::EpMoeOut E{(bf16_t*)(ws + WS_YB), kin()->exp_b2 + (size_t)L * 32 * 1024, blke, (const float*)(ws + WS_ROWG)}; \
        pg::gemm_phase<pg::EpMoeOut, pg::StaticOrder, pg::SrcMoeB, true>(ldsl, (const char*)(ws + WS_ACT), 1024, S, src, E); \
    } SEAM(P0 + 3); \
    if (IN(P0 + 4)) { ph_combine(F, L); } SEAM(P0 + 4);

    LAYER_MOE(0, 5)
    if (IN(10)) {
        unsigned char* ws = opq(ws0);
        ph_cumsum(F);
        pg::StaticOrder S; S.init(T / 256, 2048 / 256, G, c);
        { pg::SrcHeads src{(const char*)(ws + WS_WKV), 2048}; pg::EpHeads<0> E{(bf16_t*)(ws + WS_K), (bf16_t*)(ws + WS_V), kin()->k_norm_g};
          pg::gemm_phase<pg::EpHeads<0>, pg::StaticOrder, pg::SrcHeads, true>(ldsl, (const char*)(ws + WS_HKV), 1024, S, src, E); }
        { pg::SrcHeads src{(const char*)(ws + WS_WQG), 2048}; pg::EpHeads<1> E{(bf16_t*)(ws + WS_Q), (bf16_t*)(ws + WS_GS), kin()->q_norm_g};
          pg::gemm_phase<pg::EpHeads<1>, pg::StaticOrder, pg::SrcHeads, true>(ldsl, (const char*)(ws + WS_XN), 1024, S, src, E); }
    } SEAM(10);
    if (IN(11)) {
        unsigned char* ws = opq(ws0);
        static_assert(attn_body::ATTN_LDS_BYTES <= RING_BYTES, "attention LDS");
        const attn_body::AttnTensors AT{(const attn_body::bf16*)(ws + WS_Q), (const attn_body::bf16*)(ws + WS_K), (const attn_body::bf16*)(ws + WS_V), (const attn_body::bf16*)(ws + WS_GS), (attn_body::bf16*)(ws + WS_O), (const unsigned long long*)(ws + WS_G3), kin()->q_norm_g, kin()->k_norm_g};
        attn_body::attn_phase<8>((char*)lds, AT, G, c);
    } SEAM(11);
    if (IN(12)) {
        unsigned char* ws = opq(ws0); const float* mods = (const float*)(ws + WS_MODS);
        pg::StaticOrder S; S.init(T / 256, 1024 / 256, G, c);
        pg::SrcPlain<true> src{(const char*)(ws + WS_WO), 2048}; pg::EpResid<false> E{(const bf16_t*)(ws + WS_XR), (bf16_t*)(ws + WS_XR), mods + 8 * 6144 + 2048};
        pg::gemm_phase<pg::EpResid<false>, pg::StaticOrder, pg::SrcPlain<true>, true>(ldsl, (const char*)(ws + WS_O), 1024, S, src, E);
    } SEAM(12);
    LAYER_MOE(1, 13)
#undef LAYER_MOE
#undef IN
#undef SEAM
}

#include <cstring>
extern "C" void kernel_launch(void* const* d_in, const int* in_sizes, int n_in, void* d_out, int out_size, void* d_ws, size_t ws_size, hipStream_t stream) {
    if (n_in != 28 || ws_size < WS_END || out_size != T * DM) { fprintf(stderr, "kernel_launch: unexpected arguments (n_in %d, ws %zu, out %d)\n", n_in, ws_size, out_size); return; }
    static int grid = 0;
    if (grid == 0) {
        int dev = 0, cus = 0, per_cu = 0;
        if (hipGetDevice(&dev) != hipSuccess || hipDeviceGetAttribute(&cus, hipDeviceAttributeMultiprocessorCount, dev) != hipSuccess) { grid = -1; return; }
        if (hipFuncSetAttribute((const void*)fwd, hipFuncAttributeMaxDynamicSharedMemorySize, LDS_BYTES) != hipSuccess) { fprintf(stderr, "kernel_launch: hipFuncSetAttribute failed\n"); grid = -1; return; }
        if (hipOccupancyMaxActiveBlocksPerMultiprocessor(&per_cu, (const void*)fwd, 512, LDS_BYTES) != hipSuccess || per_cu < 1) fprintf(stderr, "kernel_launch: occupancy query says %d\n", per_cu);
        (void)hipGetLastError();
        grid = cus;
    }
    if (grid < 0) return;
    KA a; memset((void*)&a, 0, sizeof(a));
    { const float** p = (const float**)&a.in; for (int i = 0; i < 28; ++i) p[i] = (const float*)d_in[i]; }
    a.ws = (unsigned char*)d_ws; a.out = (float*)d_out;
    PA pa; memset((void*)&pa, 0, sizeof(pa)); pa.in = a.in; pa.ws = a.ws; pa.out = a.out;
    (void)hipMemsetAsync((unsigned char*)d_ws + WS_CTL, 0, 1 * MiB, stream);
    pa.ph_lo = 0; pa.ph_hi = NPH; pa.li = 0;
    hipLaunchKernelGGL(fwd, dim3(grid), dim3(512), LDS_BYTES, stream, pa);
}
```

```cpp
#include <hip/hip_runtime.h>
#include <cstdio>
#include <cstdint>

#define LAS __attribute__((address_space(3)))
#define GAS __attribute__((address_space(1)))
typedef unsigned short bf16_t;
typedef float f32x4 __attribute__((ext_vector_type(4)));
typedef short bf16x8 __attribute__((ext_vector_type(8)));
typedef unsigned u32x4 __attribute__((ext_vector_type(4)));
typedef unsigned u32x2 __attribute__((ext_vector_type(2)));
typedef int i32x4 __attribute__((ext_vector_type(4)));

constexpr int NB = 8, SEQ = 4096, DM = 1024, T = NB * SEQ;
constexpr int GW = 2048, NG = 8, GD = 256, CH = 128;
constexpr int NH = 16, HD = 64;
constexpr int NE = 32, TOPK = 4;
constexpr int MAXBLK = 544, MAXROWS = MAXBLK * 256;
constexpr float EPS = 1e-6f;
constexpr float LOG2E = 1.4426950408889634f;
constexpr float C2 = 0.125f * LOG2E;

constexpr size_t MiB = 1u << 20;
constexpr size_t WS_CTL = 0;
constexpr size_t WS_MODS = 1 * MiB;
constexpr size_t WS_RB2 = 1 * MiB + 3 * 8 * 6144 * 4;
constexpr size_t WS_FB2 = WS_RB2 + 2 * 8 * 32 * 4;
constexpr size_t WS_HIST = 2 * MiB;
constexpr size_t WS_BLKE = 2 * MiB + 65536;
constexpr size_t WS_TOPE = 3 * MiB;
constexpr size_t WS_TOPG = 4 * MiB;
constexpr size_t WS_DEST = 5 * MiB;
constexpr size_t WS_LIST = 6 * MiB;
constexpr size_t WS_ROWG = 7 * MiB;
constexpr size_t WS_VSTAT = 8 * MiB;
constexpr size_t WS_LOGF = 9 * MiB;
constexpr size_t WS_FC = 11 * MiB;
constexpr size_t WS_G3 = 13 * MiB;
constexpr size_t WS_WIN = 32 * MiB;
constexpr size_t WS_WOUT = 40 * MiB;
constexpr size_t WS_WKV = 44 * MiB;
constexpr size_t WS_WQG = 48 * MiB;
constexpr size_t WS_WO = 52 * MiB;
constexpr size_t WS_WS = 54 * MiB;
constexpr size_t WS_W1 = 64 * MiB;
constexpr size_t WS_W2 = 320 * MiB;
constexpr size_t WS_XN = 448 * MiB;
constexpr size_t WS_HKV = 512 * MiB;
constexpr size_t WS_XR = 576 * MiB;
constexpr size_t WS_Z = 704 * MiB;
constexpr size_t WS_GATED = 960 * MiB;
constexpr size_t WS_ACT = 704 * MiB;
constexpr size_t WS_YB = 976 * MiB;
constexpr size_t WS_PKV = 704 * MiB;
constexpr size_t WS_PQG = 960 * MiB;
constexpr size_t WS_Q = 1248 * MiB;
constexpr size_t WS_K = 1312 * MiB;
constexpr size_t WS_V = 1376 * MiB;
constexpr size_t WS_GS = 1440 * MiB;
constexpr size_t WS_O = 1504 * MiB;
constexpr size_t WS_END = 1568 * MiB;

__device__ __forceinline__ float bf2f(bf16_t v) { return __uint_as_float(((unsigned)v) << 16); }
__device__ __forceinline__ unsigned f2bf(float f) { unsigned u = __float_as_uint(f); return (u + 0x7fffu + ((u >> 16) & 1u)) >> 16; }
__device__ __forceinline__ unsigned pk2(float lo, float hi) { return f2bf(lo) | (f2bf(hi) << 16); }
__device__ __forceinline__ float wave_sum(float v) {
#pragma unroll
    for (int o = 1; o < 64; o <<= 1) v += __shfl_xor(v, o);
    return v;
}
__device__ __forceinline__ float siluf(float x) { return x / (1.f + expf(-x)); }
__device__ __forceinline__ float sigmoidf_(float x) { return 1.f / (1.f + expf(-x)); }

struct In {
    const float *x, *c, *ada_w, *ada_b, *norm_mix_g, *norm_ffn_g, *w_in, *v_g, *v_b, *w_s, *b_s, *w_out, *kv_ada_w, *kv_ada_b, *kv_norm_g, *kv_w, *k_norm_g, *fgate_b,
        *w_qg, *q_norm_g, *w_o, *router_w, *router_b, *exp_w1, *exp_b1, *exp_w2, *exp_b2, *final_g;
};

typedef const In __attribute__((address_space(4)))* InP;
__device__ __forceinline__ InP kin() { auto p = __builtin_amdgcn_kernarg_segment_ptr(); asm volatile("" : "+s"(p)); return (InP)p; }
__device__ __forceinline__ unsigned char* opq(unsigned char* p) { size_t z = 0; asm volatile("" : "+s"(z)); return p + z; }
struct KA { In in; unsigned char* ws; float* out; int L; int pad; };

__device__ __forceinline__ void transpose_item(const float* W, int K, int N, int ldw, bf16_t* WT, LAS float* scr, int item, int lane) {
    const int nblk = N / 32, kb = item / nblk, nb = item % nblk, k0 = 64 * kb, n0 = 32 * nb;
#pragma unroll 32
    for (int i = 0; i < 32; ++i) { const int kk = 2 * i + (lane >> 5); scr[kk * 33 + (lane & 31)] = W[(size_t)(k0 + kk) * ldw + n0 + (lane & 31)]; }
    __builtin_amdgcn_s_waitcnt(0xc07f); asm volatile("" ::: "memory");
    const int c = lane & 7;
#pragma unroll
    for (int j = 0; j < 4; ++j) { const int n = (lane >> 3) + 8 * j; const LAS float* s = scr + (8 * c) * 33 + n;
        u32x4 o; o.x = pk2(s[0 * 33], s[1 * 33]); o.y = pk2(s[2 * 33], s[3 * 33]); o.z = pk2(s[4 * 33], s[5 * 33]); o.w = pk2(s[6 * 33], s[7 * 33]);
        *(u32x4*)(WT + (size_t)(n0 + n) * K + k0 + 8 * c) = o; }
    __builtin_amdgcn_s_waitcnt(0xc07f); asm volatile("" ::: "memory");
}
constexpr int IT_WIN = 16 * 128, IT_WOUT = 32 * 32, IT_WKV = 16 * 64, IT_WQG = 16 * 64, IT_WO = 16 * 32, IT_W1 = 16 * 64  , IT_W2 = 16 * 32;
constexpr int IT_SMALL = IT_WIN + IT_WOUT + IT_WKV + IT_WQG + IT_WO;
constexpr int IT_ALL = IT_SMALL + 64 * IT_W1 + 64 * IT_W2;
constexpr int IT_FG = IT_SMALL + 32 * IT_W1 + 32 * IT_W2, IT_BG = 32 * IT_W1 + 32 * IT_W2;
__host__ __device__ __forceinline__ int fg_item(int i) { return i < IT_SMALL + 32 * IT_W1 ? i : i + 32 * IT_W1; }
__host__ __device__ __forceinline__ int bg_item(int k) { return k < 32 * IT_W1 ? IT_SMALL + 32 * IT_W1 + k : IT_SMALL + 64 * IT_W1 + 32 * IT_W2 + (k - 32 * IT_W1); }
constexpr int CW_CVT = 2048;
__device__ __forceinline__ void cvt_item(InP inp, unsigned char* ws, int it, LAS float* scr, int lane) {
    if (it < IT_WIN) { transpose_item(inp->w_in, 1024, 4096, 4096, (bf16_t*)(ws + WS_WIN), scr, it, lane); return; } it -= IT_WIN;
    if (it < IT_WOUT) { transpose_item(inp->w_out, 2048, 1024, 1024, (bf16_t*)(ws + WS_WOUT), scr, it, lane); return; } it -= IT_WOUT;
    if (it < IT_WKV) { transpose_item(inp->kv_w, 1024, 2048, 2064, (bf16_t*)(ws + WS_WKV), scr, it, lane); return; } it -= IT_WKV;
    if (it < IT_WQG) { transpose_item(inp->w_qg, 1024, 2048, 2048, (bf16_t*)(ws + WS_WQG), scr, it, lane); return; } it -= IT_WQG;
    if (it < IT_WO) { transpose_item(inp->w_o, 1024, 1024, 1024, (bf16_t*)(ws + WS_WO), scr, it, lane); return; } it -= IT_WO;
    if (it < 64 * IT_W1) { const int e = it / IT_W1; transpose_item(inp->exp_w1 + (size_t)e * 1024 * 2048, 1024, 2048, 2048, (bf16_t*)(ws + WS_W1) + (size_t)e * 2048 * 1024, scr, it % IT_W1, lane); return; } it -= 64 * IT_W1;
    { const int e = it / IT_W2; transpose_item(inp->exp_w2 + (size_t)e * 1024 * 1024, 1024, 1024, 1024, (bf16_t*)(ws + WS_W2) + (size_t)e * 1024 * 1024, scr, it % IT_W2, lane); }
}
constexpr int ADA_ITEMS = 96 + 96 + 32;
__device__ __forceinline__ void ada_item(InP inp, float* mods, int item, const LAS float* sc  , LAS float* red  , int tid) {
    const int lane = tid & 63, wave = tid >> 6;
    int which, cg; const float* w; const float* bias; int ldw;
    if (item < 96) { which = 0; cg = item; w = inp->ada_w; bias = inp->ada_b; ldw = 6144; }
    else if (item < 192) { which = 1; cg = item - 96; w = inp->ada_w + (size_t)1024 * 6144; bias = inp->ada_b + 6144; ldw = 6144; }
    else { which = 2; cg = item - 192; w = inp->kv_ada_w; bias = inp->kv_ada_b; ldw = 2048; }
    const int col = cg * 64 + lane;
    float acc[8];
#pragma unroll
    for (int b = 0; b < 8; ++b) acc[b] = 0.f;
    for (int k = wave * 128; k < wave * 128 + 128; ++k) {
        const float wv = w[(size_t)k * ldw + col];
#pragma unroll
        for (int b = 0; b < 8; ++b) acc[b] += sc[b * 1024 + k] * wv;
    }
#pragma unroll
    for (int b = 0; b < 8; ++b) red[(wave * 8 + b) * 64 + lane] = acc[b];
    __syncthreads();
    {
        const int b = tid >> 6; float s = 0.f;
#pragma unroll
        for (int w8 = 0; w8 < 8; ++w8) s += red[(w8 * 8 + b) * 64 + lane];
        mods[((size_t)which * 8 + b) * 6144 + col] = s + bias[col];
    }
    __syncthreads();
}
__device__ __forceinline__ void row_load(const float* xrow, int lane, f32x4 (&v)[4]) {
#pragma unroll
    for (int j = 0; j < 2; ++j) { v[2 * j] = ((const f32x4*)xrow)[2 * lane + 128 * j]; v[2 * j + 1] = ((const f32x4*)xrow)[2 * lane + 128 * j + 1]; }
}
__device__ __forceinline__ void bf8_to_f32(u32x4 w, f32x4& a, f32x4& b) {
    a = (f32x4){__uint_as_float(w.x << 16), __uint_as_float(w.x & 0xffff0000u), __uint_as_float(w.y << 16), __uint_as_float(w.y & 0xffff0000u)};
    b = (f32x4){__uint_as_float(w.z << 16), __uint_as_float(w.z & 0xffff0000u), __uint_as_float(w.w << 16), __uint_as_float(w.w & 0xffff0000u)};
}
__device__ __forceinline__ void row_load_bf(const bf16_t* xrow, int lane, f32x4 (&v)[4]) {
#pragma unroll
    for (int j = 0; j < 2; ++j) bf8_to_f32(((const u32x4*)xrow)[lane + 64 * j], v[2 * j], v[2 * j + 1]);
}
__device__ __forceinline__ float row_rstd(const f32x4 (&v)[4]) {
    float s = 0.f;
#pragma unroll
    for (int j = 0; j < 4; ++j) s += (v[j].x * v[j].x + v[j].y * v[j].y) + (v[j].z * v[j].z + v[j].w * v[j].w);
    return 1.f / sqrtf(wave_sum(s) * (1.f / 1024.f) + EPS);
}
__device__ __forceinline__ f32x4 row_vec(const float* p, int lane, int q) { return ((const f32x4*)p)[2 * lane + 128 * (q >> 1) + (q & 1)]; }
__device__ __forceinline__ void row_modnorm(const f32x4 (&v)[4], float rstd, const float* g, const float* sh, const float* sc, int lane, f32x4 (&h)[4]) {
#pragma unroll
    for (int q = 0; q < 4; ++q) h[q] = (v[q] * rstd * row_vec(g, lane, q)) * (1.f + row_vec(sc, lane, q)) + row_vec(sh, lane, q);
}
__device__ __forceinline__ void row_store_bf16(bf16_t* orow, int lane, const f32x4 (&h)[4]) {
#pragma unroll
    for (int j = 0; j < 2; ++j) { u32x4 w; w.x = pk2(h[2 * j].x, h[2 * j].y); w.y = pk2(h[2 * j].z, h[2 * j].w); w.z = pk2(h[2 * j + 1].x, h[2 * j + 1].y); w.w = pk2(h[2 * j + 1].z, h[2 * j + 1].w);
        ((u32x4*)orow)[lane + 64 * j] = w; }
}

__device__ __forceinline__ void row4_norm_mod_store(const float* xrow, const float* g, const float* sh, const float* sc, bf16_t* orow, int lane) {
    f32x4 v[4]; float s = 0.f;
#pragma unroll
    for (int j = 0; j < 4; ++j) { v[j] = ((const f32x4*)xrow)[lane + 64 * j]; s += (v[j].x * v[j].x + v[j].y * v[j].y) + (v[j].z * v[j].z + v[j].w * v[j].w); }
    const float rstd = 1.f / sqrtf(wave_sum(s) * (1.f / 1024.f) + EPS);
#pragma unroll
    for (int j = 0; j < 4; ++j) { const f32x4 gg = ((const f32x4*)g)[lane + 64 * j], s1 = ((const f32x4*)sc)[lane + 64 * j], s0 = ((const f32x4*)sh)[lane + 64 * j];
        const f32x4 h = (v[j] * rstd * gg) * (1.f + s1) + s0; u32x2 w; w.x = pk2(h.x, h.y); w.y = pk2(h.z, h.w); ((u32x2*)orow)[lane + 64 * j] = w; }
}
__device__ __forceinline__ void row_store_f32(float* orow, int lane, const f32x4 (&h)[4]) {
#pragma unroll
    for (int j = 0; j < 2; ++j)
#pragma unroll
        for (int sq = 0; sq < 2; ++sq) { const int src = 32 * sq + (lane >> 1); f32x4 a, c;
#pragma unroll
            for (int i = 0; i < 4; ++i) { a[i] = __shfl(h[2 * j][i], src); c[i] = __shfl(h[2 * j + 1][i], src); }
            ((f32x4*)orow)[128 * j + 64 * sq + lane] = (lane & 1) ? c : a; }
}

__device__ __forceinline__ void route_row(const LAS float* hs  , const float* rw, const float* rb, int lane, int (&te)[4], float (&tg)[4]) {
    const int e = lane & 31, half = lane >> 5; float acc = 0.f;
    for (int k = half * 512; k < half * 512 + 512; ++k) acc += hs[k] * rw[k * 32 + e];
    acc += __shfl_xor(acc, 32);
    float val = acc + rb[e];
    float tv[4];
#pragma unroll
    for (int q = 0; q < 4; ++q) {
        float bv = val; int bi = e;
#pragma unroll
        for (int o = 1; o < 32; o <<= 1) { const float ov = __shfl_xor(bv, o); const int oi = __shfl_xor(bi, o); if (ov > bv || (ov == bv && oi < bi)) { bv = ov; bi = oi; } }
        te[q] = bi; tv[q] = bv; if (e == bi) val = -INFINITY;
    }
    float s = 0.f;
#pragma unroll
    for (int q = 0; q < 4; ++q) { tg[q] = expf(tv[q] - tv[0]); s += tg[q]; }
#pragma unroll
    for (int q = 0; q < 4; ++q) tg[q] /= s;
}

namespace pg {
constexpr int BM = 256, BK = 64, HALF = 128, HTB = HALF * BK * 2  , STAGE_BYTES = 8 * HTB, NXCD = 8, WGM = 8;
__host__ __device__ __forceinline__ int lds_byte(int r, int c) { const int st = (r >> 4) * 2 + (c >> 5), rr = r & 15, cc = c & 31, ob = rr * 64 + cc * 2; return st * 1024 + (ob ^ (((ob >> 9) & 1) << 5)); }
__host__ __device__ __forceinline__ void stage_rc(int b, int& R, int& C) { const int st = b / 1024, sb = b % 1024, swz = sb ^ (((sb >> 9) & 1) << 5); R = (st >> 1) * 16 + swz / 64; C = (st & 1) * 32 + (swz % 64) / 2; }
__host__ __device__ __forceinline__ int perm32(int rho) { const int n = rho >> 4, i = rho & 15; return 8 * (i >> 2) + 4 * n + (i & 3); }
struct Unit { int pm, pn; };
struct StaticOrder {
    int nM, nN, nwg, G, c;
    __device__ void init(int nM_, int nN_, int G_, int c_) { nM = nM_; nN = nN_; nwg = nM * nN; G = G_; c = c_; }
    __device__ bool next(int i, Unit& u) const {
        const long L = (long)i * G + c; if (L >= nwg) return false;
        int wgid = (int)L; { const int q = nwg / NXCD, r = nwg % NXCD, xcd = wgid % NXCD, off = wgid / NXCD; wgid = (xcd < r ? xcd * (q + 1) : r * (q + 1) + (xcd - r) * q) + off; }
        const int nig = WGM * nN, gid = wgid / nig, fm = gid * WGM, gsz = (nM - fm) < WGM ? (nM - fm) : WGM;
        u.pm = fm + ((wgid % nig) % gsz); u.pn = (wgid % nig) / gsz; return true;
    }
};
__device__ __forceinline__ unsigned cvt_pk_bf16(float lo, float hi) { unsigned r; asm volatile("v_cvt_pk_bf16_f32 %0, %1, %2" : "=v"(r) : "v"(lo), "v"(hi)); return r; }
typedef float f32x2 __attribute__((ext_vector_type(2)));
__device__ __forceinline__ f32x2 gelu_pk(f32x2 v) {
    const f32x2 av = __builtin_elementwise_abs(v), d = av * 0.2316418882f + 1.0f;
    f32x2 t; t.x = __builtin_amdgcn_rcpf(d.x); t.y = __builtin_amdgcn_rcpf(d.y);
    f32x2 q = t * 0.5307027145f + (-0.7265760135f); q = q * t + 0.7107068705f; q = q * t + (-0.142248368f); q = q * t + 0.127414796f; q = q * t;
    const f32x2 s = (v * v) * (-0.72134752044f);
    f32x2 e; e.x = __builtin_amdgcn_exp2f(s.x); e.y = __builtin_amdgcn_exp2f(s.y);
    const f32x2 m = v * (q * e), r = v - m;
    f32x2 o; o.x = v.x < 0.f ? m.x : r.x; o.y = v.y < 0.f ? m.y : r.y; return o;
}
__device__ __forceinline__ float fast_sigmoid(float x) { return __builtin_amdgcn_rcpf(1.f + __builtin_amdgcn_exp2f(-LOG2E * x)); }

template <bool PERM> struct SrcPlain { const char* B; int K2;
    __device__ __forceinline__ unsigned arow_off(const Unit& u, int h, int R) const { return (unsigned)(u.pm * BM + h * HALF + R) * (unsigned)K2; }
    __device__ __forceinline__ const char* bhalf(const Unit& u, int h) const { return B + (size_t)(u.pn * BM + h * HALF) * K2; }
    static __device__ __forceinline__ int brow(int R) { return PERM ? ((R & ~31) + perm32(R & 31)) : R; } };
struct SrcHeads { const char* B; int K2;
    __device__ __forceinline__ unsigned arow_off(const Unit& u, int h, int R) const { return (unsigned)(u.pm * BM + h * HALF + R) * (unsigned)K2; }
    __device__ __forceinline__ const char* bhalf(const Unit& u, int h) const { return B + (size_t)(u.pn * BM + h * 32) * K2; }
    static __device__ __forceinline__ int brow(int R) { return 64 * (R >> 5) + perm32(R & 31); } };
struct SrcMoeA { const char* W1; const int* list; const int* blke; int K2;
    __device__ __forceinline__ unsigned arow_off(const Unit& u, int h, int R) const { int t = list[u.pm * BM + h * HALF + R]; t = t < 0 ? 0 : t; return (unsigned)t * (unsigned)K2; }
    __device__ __forceinline__ const char* bhalf(const Unit& u, int h) const { const int e = blke[u.pm]; return W1 + ((size_t)e * 2048 + h * 1024 + u.pn * 128) * K2; }
    static __device__ __forceinline__ int brow(int R) { return (R & ~31) + perm32(R & 31); } };
struct SrcMoeB { const char* W2; const int* blke; int K2;
    __device__ __forceinline__ unsigned arow_off(const Unit& u, int h, int R) const { return (unsigned)(u.pm * BM + h * HALF + R) * (unsigned)K2; }
    __device__ __forceinline__ const char* bhalf(const Unit& u, int h) const { const int e = blke[u.pm]; return W2 + ((size_t)e * 1024 + u.pn * BM + h * HALF) * K2; }
    static __device__ __forceinline__ int brow(int R) { return (R & ~31) + perm32(R & 31); } };

struct EpGeluZ { bf16_t* Z;
    __device__ __forceinline__ void operator()(const f32x4 (&acc)[2][2][4][2], const Unit& u, int wr, int wc, int fr, int fq) const {
        const int row0 = u.pm * BM + wr * 64 + fr, col0 = u.pn * BM + wc * 32 + 8 * fq;
#pragma unroll
        for (int ai = 0; ai < 2; ++ai)
#pragma unroll
            for (int m = 0; m < 4; ++m) { bf16_t* rowp = Z + (size_t)(row0 + ai * HALF + m * 16) * 4096 + col0;
#pragma unroll
                for (int bj = 0; bj < 2; ++bj) { const f32x4 v0 = acc[ai][bj][m][0], v1 = acc[ai][bj][m][1];
                    const f32x2 a = gelu_pk((f32x2){v0[0], v0[1]}), b = gelu_pk((f32x2){v0[2], v0[3]}), c = gelu_pk((f32x2){v1[0], v1[1]}), d = gelu_pk((f32x2){v1[2], v1[3]});
                    u32x4 w; w.x = cvt_pk_bf16(a.x, a.y); w.y = cvt_pk_bf16(b.x, b.y); w.z = cvt_pk_bf16(c.x, c.y); w.w = cvt_pk_bf16(d.x, d.y);
                    *(u32x4*)(rowp + bj * HALF) = w; } }
    } };
template <bool F32BASE> struct EpResid { const void* base; bf16_t* out; const float* gate;
    __device__ __forceinline__ void operator()(const f32x4 (&acc)[2][2][4][2], const Unit& u, int wr, int wc, int fr, int fq) const {
        const int b = u.pm >> 4; const float* gt = gate + (size_t)b * 6144; const int col0 = u.pn * BM + wc * 32 + 8 * fq;
        f32x4 gv[2][2];
#pragma unroll
        for (int bj = 0; bj < 2; ++bj)
#pragma unroll
            for (int n = 0; n < 2; ++n) gv[bj][n] = *(const f32x4*)(gt + col0 + bj * HALF + 4 * n);
#pragma unroll
        for (int ai = 0; ai < 2; ++ai)
#pragma unroll
            for (int m = 0; m < 4; ++m) { const size_t off = (size_t)(u.pm * BM + ai * HALF + wr * 64 + m * 16 + fr) * DM + col0;
#pragma unroll
                for (int bj = 0; bj < 2; ++bj) { f32x4 b0, b1;
                    if constexpr (F32BASE) { b0 = *(const f32x4*)((const float*)base + off + bj * HALF); b1 = *(const f32x4*)((const float*)base + off + bj * HALF + 4); }
                    else bf8_to_f32(*(const u32x4*)((const bf16_t*)base + off + bj * HALF), b0, b1);
                    const f32x4 r0 = b0 + gv[bj][0] * acc[ai][bj][m][0], r1 = b1 + gv[bj][1] * acc[ai][bj][m][1];
                    u32x4 w; w.x = cvt_pk_bf16(r0[0], r0[1]); w.y = cvt_pk_bf16(r0[2], r0[3]); w.z = cvt_pk_bf16(r1[0], r1[1]); w.w = cvt_pk_bf16(r1[2], r1[3]);
                    *(u32x4*)(out + off + bj * HALF) = w; } }
    } };
struct EpSwiglu { bf16_t* act; const float* b1; const int* blke;
    __device__ __forceinline__ void operator()(const f32x4 (&acc)[2][2][4][2], const Unit& u, int wr, int wc, int fr, int fq) const {
        const int e = blke[u.pm]; const int col0 = u.pn * 128 + wc * 32 + 8 * fq; const float* bb = b1 + (size_t)e * 2048 + col0;
        f32x4 bg[2], bl[2];
#pragma unroll
        for (int n = 0; n < 2; ++n) { bg[n] = *(const f32x4*)(bb + 4 * n); bl[n] = *(const f32x4*)(bb + 1024 + 4 * n); }
#pragma unroll
        for (int ai = 0; ai < 2; ++ai)
#pragma unroll
            for (int m = 0; m < 4; ++m) { const int row = u.pm * BM + ai * HALF + wr * 64 + m * 16 + fr; float a[8];
#pragma unroll
                for (int n = 0; n < 2; ++n) { const f32x4 g4 = acc[ai][0][m][n] + bg[n], l4 = acc[ai][1][m][n] + bl[n];
#pragma unroll
                    for (int j = 0; j < 4; j += 2) {
                        f32x2 g = {fminf(g4[j], 7.f), fminf(g4[j + 1], 7.f)}; f32x2 l = {__builtin_amdgcn_fmed3f(l4[j], -7.f, 7.f), __builtin_amdgcn_fmed3f(l4[j + 1], -7.f, 7.f)};
                        const f32x2 x = g * (-1.702f * LOG2E); f32x2 e; e.x = __builtin_amdgcn_exp2f(x.x); e.y = __builtin_amdgcn_exp2f(x.y);
                        const f32x2 d = e + 1.0f; f32x2 r; r.x = __builtin_amdgcn_rcpf(d.x); r.y = __builtin_amdgcn_rcpf(d.y);
                        const f32x2 o = (l + 1.0f) * (g * r); a[4 * n + j] = o.x; a[4 * n + j + 1] = o.y; } }
                u32x4 w; w.x = cvt_pk_bf16(a[0], a[1]); w.y = cvt_pk_bf16(a[2], a[3]); w.z = cvt_pk_bf16(a[4], a[5]); w.w = cvt_pk_bf16(a[6], a[7]);
                *(u32x4*)(act + (size_t)row * 1024 + col0) = w; }
    } };
struct EpMoeOut { bf16_t* yb; const float* b2; const int* blke; const float* rowg;
    __device__ __forceinline__ void operator()(const f32x4 (&acc)[2][2][4][2], const Unit& u, int wr, int wc, int fr, int fq) const {
        const int e = blke[u.pm]; const int col0 = u.pn * BM + wc * 32 + 8 * fq;
        f32x4 bv[2][2];
#pragma unroll
        for (int bj = 0; bj < 2; ++bj)
#pragma unroll
            for (int n = 0; n < 2; ++n) bv[bj][n] = *(const f32x4*)(b2 + (size_t)e * 1024 + col0 + bj * HALF + 4 * n);
#pragma unroll
        for (int ai = 0; ai < 2; ++ai)
#pragma unroll
            for (int m = 0; m < 4; ++m) { const int row = u.pm * BM + ai * HALF + wr * 64 + m * 16 + fr; const float rg = rowg[row];
#pragma unroll
                for (int bj = 0; bj < 2; ++bj) { const f32x4 v0 = (acc[ai][bj][m][0] + bv[bj][0]) * rg, v1 = (acc[ai][bj][m][1] + bv[bj][1]) * rg;
                    u32x4 w; w.x = cvt_pk_bf16(v0[0], v0[1]); w.y = cvt_pk_bf16(v0[2], v0[3]); w.z = cvt_pk_bf16(v1[0], v1[1]); w.w = cvt_pk_bf16(v1[2], v1[3]);
                    *(u32x4*)(yb + (size_t)row * 1024 + col0 + bj * HALF) = w; } }
    } };
template <int MODE> struct EpHeads { bf16_t* o0; bf16_t* o1; const float* g;
    __device__ __forceinline__ void operator()(const f32x4 (&acc)[2][2][4][2], const Unit& u, int wr, int wc, int fr, int fq) const {
        const bool first = u.pn < 4; bf16_t* O = first ? o0 : o1; const int colbase = (u.pn & 3) * 256 + wc * 64 + 8 * fq;
        f32x4 gv[2][2];
#pragma unroll
        for (int bj = 0; bj < 2; ++bj)
#pragma unroll
            for (int n = 0; n < 2; ++n) gv[bj][n] = *(const f32x4*)(g + 32 * bj + 8 * fq + 4 * n);
#pragma unroll
        for (int ai = 0; ai < 2; ++ai)
#pragma unroll
            for (int m = 0; m < 4; ++m) { const int row = u.pm * BM + ai * HALF + wr * 64 + m * 16 + fr; f32x4 v[2][2];
                if (first) { float ss = 0.f;
#pragma unroll
                    for (int bj = 0; bj < 2; ++bj)
#pragma unroll
                        for (int n = 0; n < 2; ++n) { const f32x4 x = acc[ai][bj][m][n]; ss += (x[0] * x[0] + x[1] * x[1]) + (x[2] * x[2] + x[3] * x[3]); }
                    ss += __shfl_xor(ss, 16); ss += __shfl_xor(ss, 32);
                    float r = 1.f / sqrtf(ss * (1.f / 64.f) + EPS); if (MODE == 1) r *= C2;
#pragma unroll
                    for (int bj = 0; bj < 2; ++bj)
#pragma unroll
                        for (int n = 0; n < 2; ++n) v[bj][n] = acc[ai][bj][m][n] * r * gv[bj][n];
                } else {
#pragma unroll
                    for (int bj = 0; bj < 2; ++bj)
#pragma unroll
                        for (int n = 0; n < 2; ++n) { f32x4 x = acc[ai][bj][m][n]; if (MODE == 1) { x[0] = fast_sigmoid(x[0]); x[1] = fast_sigmoid(x[1]); x[2] = fast_sigmoid(x[2]); x[3] = fast_sigmoid(x[3]); } v[bj][n] = x; }
                }
#pragma unroll
                for (int bj = 0; bj < 2; ++bj) { u32x4 w; w.x = cvt_pk_bf16(v[bj][0][0], v[bj][0][1]); w.y = cvt_pk_bf16(v[bj][0][2], v[bj][0][3]); w.z = cvt_pk_bf16(v[bj][1][0], v[bj][1][1]); w.w = cvt_pk_bf16(v[bj][1][2], v[bj][1][3]);
                    *(u32x4*)(O + (size_t)row * DM + colbase + 32 * bj) = w; } }
    } };

template <class Epi, class Sched, class Src, bool ALIGN_EPI>
__device__ __forceinline__ void gemm_phase(LAS unsigned char* lds, const char* Abase, int K, const Sched& S, const Src& src, const Epi& E) {
    int tid_ = threadIdx.x; asm volatile("" : "+v"(tid_));
    const int tid = tid_, wid = __builtin_amdgcn_readfirstlane(tid >> 6), lane = tid & 63, wr = wid >> 2, wc = wid & 3, fr = lane & 15, fq = lane >> 4;
    const int nt = K / BK;
    int sR[2], sC[2]; unsigned voffB[2];
#pragma unroll
    for (int i = 0; i < 2; ++i) { stage_rc(tid * 16 + i * 8192, sR[i], sC[i]); voffB[i] = (unsigned)(Src::brow(sR[i]) * K + sC[i]) * 2u; }
    const size_t kstep = (size_t)(BK * 2);
    const unsigned ldsw = (unsigned)wid * 1024u;
    const int aoff = lds_byte(wr * 64 + fr, fq * 8), boff = lds_byte(wc * 32 + fr, fq * 8);
#define PG_SA(b, h) (((b) * 2 + (h)) * HTB)
#define PG_SB(b, h) ((4 + (b) * 2 + (h)) * HTB)
#define PG_STAGE(bufoff, gbase, v0, v1) do { \
        __builtin_amdgcn_global_load_lds((const unsigned*)((const char*)(gbase) + (v0)), (LAS unsigned*)(lds + (bufoff) + ldsw), 16, 0, 0); \
        __builtin_amdgcn_global_load_lds((const unsigned*)((const char*)(gbase) + (v1)), (LAS unsigned*)(lds + (bufoff) + ldsw + 8192), 16, 0, 0); } while (0)
#define PG_LDA(dst, b, h) do { _Pragma("unroll") for (int m = 0; m < 4; ++m) _Pragma("unroll") for (int k = 0; k < 2; ++k) dst[m][k] = *(const LAS bf16x8*)(lds + PG_SA(b, h) + aoff + m * 2048 + k * 1024); } while (0)
#define PG_LDB(dst, b, h) do { _Pragma("unroll") for (int n = 0; n < 2; ++n) _Pragma("unroll") for (int k = 0; k < 2; ++k) dst[n][k] = *(const LAS bf16x8*)(lds + PG_SB(b, h) + boff + n * 2048 + k * 1024); } while (0)
#define PG_MMA(ai, bj, At, Bt) do { __builtin_amdgcn_s_setprio(1); _Pragma("unroll") for (int m = 0; m < 4; ++m) _Pragma("unroll") for (int n = 0; n < 2; ++n) _Pragma("unroll") for (int k = 0; k < 2; ++k) \
        acc[ai][bj][m][n] = __builtin_amdgcn_mfma_f32_16x16x32_bf16(Bt[n][k], At[m][k], acc[ai][bj][m][n], 0, 0, 0); __builtin_amdgcn_s_setprio(0); } while (0)
#define PG_WAIT_V(n) asm volatile("s_waitcnt vmcnt(" #n ")" ::: "memory")
#define PG_WAIT_L(n) asm volatile("s_waitcnt lgkmcnt(" #n ")" ::: "memory")
#define PG_BAR __builtin_amdgcn_s_barrier()
#define PG_SCHED __builtin_amdgcn_sched_barrier(0)
    Unit cur, nxt; int ui = 0;
    if (!S.next(0, cur)) return;
    f32x4 acc[2][2][4][2];
#pragma unroll
    for (int a = 0; a < 2; ++a)
#pragma unroll
        for (int b = 0; b < 2; ++b)
#pragma unroll
            for (int m = 0; m < 4; ++m)
#pragma unroll
                for (int n = 0; n < 2; ++n) acc[a][b][m][n] = (f32x4){0.f, 0.f, 0.f, 0.f};
    bf16x8 At[4][2], B0[2][2], B1[2][2];
    unsigned vc[2][2], vn[2][2];
#pragma unroll
    for (int h = 0; h < 2; ++h)
#pragma unroll
        for (int i = 0; i < 2; ++i) vc[h][i] = src.arow_off(cur, h, sR[i]) + (unsigned)sC[i] * 2u;
    const char* cB0 = src.bhalf(cur, 0); const char* cB1 = src.bhalf(cur, 1);
    const char* const cA = Abase;
    PG_STAGE(PG_SB(0, 0), cB0, voffB[0], voffB[1]); PG_STAGE(PG_SB(0, 1), cB1, voffB[0], voffB[1]); PG_STAGE(PG_SA(0, 0), cA, vc[0][0], vc[0][1]); PG_STAGE(PG_SA(0, 1), cA, vc[1][0], vc[1][1]);
    if (wr == 1) PG_BAR;
    PG_WAIT_V(2); PG_BAR;
    PG_STAGE(PG_SB(1, 0), cB0 + kstep, voffB[0], voffB[1]); PG_STAGE(PG_SA(1, 0), cA + kstep, vc[0][0], vc[0][1]); PG_STAGE(PG_SB(1, 1), cB1 + kstep, voffB[0], voffB[1]);
    PG_WAIT_V(6); PG_BAR;
    for (;;) {
        const bool has_next = S.next(ui + 1, nxt);
        const char* nB0 = cB0; const char* nB1 = cB1;
#pragma unroll
        for (int h = 0; h < 2; ++h)
#pragma unroll
            for (int i = 0; i < 2; ++i) vn[h][i] = vc[h][i];
        if (has_next) { nB0 = src.bhalf(nxt, 0); nB1 = src.bhalf(nxt, 1);
#pragma unroll
            for (int h = 0; h < 2; ++h)
#pragma unroll
                for (int i = 0; i < 2; ++i) vn[h][i] = src.arow_off(nxt, h, sR[i]) + (unsigned)sC[i] * 2u; }
        asm volatile("" : "+v"(vn[0][0]), "+v"(vn[0][1]), "+v"(vn[1][0]), "+v"(vn[1][1]));
        for (int t = 0; t < nt; t += 2) {
            const bool last = (t == nt - 2);
            const char* a1 = cA + (size_t)(t + 1) * kstep;
            const char* a2 = last ? cA : cA + (size_t)(t + 2) * kstep; const char* a3 = a2 + kstep;
            const char* b20 = last ? nB0 : cB0 + (size_t)(t + 2) * kstep; const char* b21 = last ? nB1 : cB1 + (size_t)(t + 2) * kstep;
            const char* b30 = b20 + kstep; const char* b31 = b21 + kstep;
            const unsigned w00 = last ? vn[0][0] : vc[0][0], w01 = last ? vn[0][1] : vc[0][1], w10 = last ? vn[1][0] : vc[1][0], w11 = last ? vn[1][1] : vc[1][1];
            PG_LDB(B0, 0, 0); PG_LDB(B1, 0, 1); PG_SCHED; PG_LDA(At, 0, 0); PG_STAGE(PG_SA(1, 1), a1, vc[1][0], vc[1][1]);
            PG_WAIT_V(8); PG_WAIT_L(0); PG_BAR; PG_MMA(0, 0, At, B0); PG_MMA(0, 1, At, B1); PG_BAR; PG_SCHED;
            PG_LDA(At, 0, 1); PG_STAGE(PG_SB(0, 0), b20, voffB[0], voffB[1]); PG_STAGE(PG_SB(0, 1), b21, voffB[0], voffB[1]); PG_STAGE(PG_SA(0, 0), a2, w00, w01);
            PG_WAIT_V(8); PG_WAIT_L(0); PG_BAR; PG_MMA(1, 0, At, B0); PG_MMA(1, 1, At, B1); PG_BAR; PG_SCHED;
            PG_LDB(B0, 1, 0); PG_LDB(B1, 1, 1); PG_SCHED; PG_LDA(At, 1, 0); PG_STAGE(PG_SA(0, 1), a2, w10, w11);
            PG_WAIT_V(8); PG_WAIT_L(0); PG_BAR; PG_MMA(0, 0, At, B0); PG_MMA(0, 1, At, B1); PG_BAR; PG_SCHED;
            PG_LDA(At, 1, 1); PG_STAGE(PG_SB(1, 0), b30, voffB[0], voffB[1]); PG_STAGE(PG_SB(1, 1), b31, voffB[0], voffB[1]); PG_STAGE(PG_SA(1, 0), a3, w00, w01);
            PG_WAIT_V(8); PG_WAIT_L(0); PG_BAR; PG_MMA(1, 0, At, B0); PG_MMA(1, 1, At, B1); PG_BAR; PG_SCHED;
        }
        if constexpr (ALIGN_EPI) { if (wr == 0) PG_BAR; }
        E(acc, cur, wr, wc, fr, fq);
        if (!has_next) break;
#pragma unroll
        for (int a = 0; a < 2; ++a)
#pragma unroll
            for (int b = 0; b < 2; ++b)
#pragma unroll
                for (int m = 0; m < 4; ++m)
#pragma unroll
                    for (int n = 0; n < 2; ++n) acc[a][b][m][n] = (f32x4){0.f, 0.f, 0.f, 0.f};
        cur = nxt; cB0 = nB0; cB1 = nB1; ++ui;
#pragma unroll
        for (int h = 0; h < 2; ++h)
#pragma unroll
            for (int i = 0; i < 2; ++i) vc[h][i] = vn[h][i];
        if constexpr (ALIGN_EPI) { if (wr == 1) PG_BAR; }
    }
    PG_WAIT_V(0);
    if constexpr (!ALIGN_EPI) { if (wr == 0) PG_BAR; }
    PG_BAR;
#undef PG_SA
#undef PG_SB
#undef PG_STAGE
#undef PG_LDA
#undef PG_LDB
#undef PG_MMA
#undef PG_WAIT_V
#undef PG_WAIT_L
#undef PG_BAR
#undef PG_SCHED
}
}
#include <hip/hip_bf16.h>
#include <cmath>
namespace attn_body {
using bf16=__hip_bfloat16;
using bf16x8=__attribute__((ext_vector_type(8)))short;
using s16x4=__attribute__((ext_vector_type(4)))short;
using f32x16=__attribute__((ext_vector_type(16)))float;
using u32x4=__attribute__((ext_vector_type(4)))unsigned;
constexpr int BATCH=8,NHEAD=16,SEQ=4096,D=64,DM=NHEAD*D;
constexpr int NW=8,QBLK=32,QB=QBLK*NW,KVBLK=64,NQB=SEQ/QB;
constexpr int ATTN_PITCH=DM, ATTN_UNIT_ROWS=QB;
__device__ __forceinline__ int crow(int r,int hi){return (r&3)+8*(r>>2)+4*hi;}
#define SBAR() __builtin_amdgcn_sched_barrier(0)
__device__ __forceinline__ void cmask(f32x16&p0,f32x16&p1,int jb,int qrel,int hi){
  const float NEG=-INFINITY; int kb=64*jb+4*hi;
  #pragma unroll
  for(int r=0;r<16;++r){int kv=kb+(r&3)+8*(r>>2); if(kv>qrel)p0[r]=NEG; if(kv+32>qrel)p1[r]=NEG;}
}

constexpr int NSLOT=3, SLOTB=8192;
constexpr int LDS_K=0, LDS_V=NSLOT*SLOTB, LDS_WS=2*NSLOT*SLOTB, LDS_OST=LDS_WS+NW*64*4, LDS_GPAD=LDS_OST+NW*4096, LDS_G3=LDS_GPAD+128*8, LDS_BYTES=LDS_G3+SEQ*8;
constexpr float C2_=0.125f*1.4426950408889634f;
__device__ __forceinline__ void glds16(const void*gsrc,unsigned lds_dst){unsigned keep;
  asm volatile("s_mov_b32 %0, m0\n\ts_mov_b32 m0, %2\n\ts_nop 0\n\tglobal_load_lds_dwordx4 %1, off\n\ts_mov_b32 m0, %0":"=&s"(keep):"v"(gsrc),"s"(lds_dst):"memory");}
__device__ __forceinline__ float max3f(float a,float b,float c){float r;asm("v_max3_f32 %0, %1, %2, %3":"=v"(r):"v"(a),"v"(b),"v"(c));return r;}
__device__ __forceinline__ float max2f(float a,float b){float r;asm("v_max_f32_e32 %0, %1, %2":"=v"(r):"v"(a),"v"(b));return r;}
__device__ __forceinline__ float fadd_s(float a,float b){float r;asm("v_add_f32_e32 %0, %1, %2":"=v"(r):"v"(a),"v"(b));return r;}
__device__ __forceinline__ float fsub_s(float a,float b){float r;asm("v_sub_f32_e32 %0, %1, %2":"=v"(r):"v"(a),"v"(b));return r;}
typedef float f32x2_t __attribute__((ext_vector_type(2))); typedef __bf16 bf16x2_t __attribute__((ext_vector_type(2)));
__device__ __forceinline__ unsigned cvtpk_s(float lo,float hi){f32x2_t v={lo,hi};bf16x2_t b=__builtin_convertvector(v,bf16x2_t);return __builtin_bit_cast(unsigned,b);}
#define WAIT_BAR(N) asm volatile("s_waitcnt vmcnt(" #N ") lgkmcnt(0)\n\ts_barrier":::"memory")

__device__ __forceinline__ void qkt(f32x16&p0,f32x16&p1,const char*Kslot,const bf16x8*qr,bf16x8 ka0,bf16x8 ka1,bf16x8 qa,int r32,int hi){
  const char*kb=Kslot+hi*1024+r32*16;
  { const f32x16 z=f32x16{}; p0=__builtin_amdgcn_mfma_f32_32x32x16_bf16(ka0,qa,z,0,0,0); p1=__builtin_amdgcn_mfma_f32_32x32x16_bf16(ka1,qa,z,0,0,0); }
  #pragma unroll
  for(int d0=0;d0<4;++d0){
    const bf16x8 b0=*reinterpret_cast<const bf16x8*>(kb+d0*2048);
    const bf16x8 b1=*reinterpret_cast<const bf16x8*>(kb+d0*2048+512);
    p0=__builtin_amdgcn_mfma_f32_32x32x16_bf16(b0,qr[d0],p0,0,0,0);p1=__builtin_amdgcn_mfma_f32_32x32x16_bf16(b1,qr[d0],p1,0,0,0);}
}
typedef __attribute__((address_space(3))) const char* lds_cptr;
typedef short v4i16_t __attribute__((ext_vector_type(4)));
__device__ __forceinline__ void kload8(bf16x8*kf,lds_cptr kp){
  kf[0]=*(const __attribute__((address_space(3))) bf16x8*)(kp);      kf[1]=*(const __attribute__((address_space(3))) bf16x8*)(kp+512);
  kf[2]=*(const __attribute__((address_space(3))) bf16x8*)(kp+2048); kf[3]=*(const __attribute__((address_space(3))) bf16x8*)(kp+2560);
  kf[4]=*(const __attribute__((address_space(3))) bf16x8*)(kp+4096); kf[5]=*(const __attribute__((address_space(3))) bf16x8*)(kp+4608);
  kf[6]=*(const __attribute__((address_space(3))) bf16x8*)(kp+6144); kf[7]=*(const __attribute__((address_space(3))) bf16x8*)(kp+6656);
}
__device__ __forceinline__ void kload2(bf16x8*kf,lds_cptr kp,int j){ kf[2*j]=*(const __attribute__((address_space(3))) bf16x8*)(kp+j*2048); kf[2*j+1]=*(const __attribute__((address_space(3))) bf16x8*)(kp+j*2048+512); }
__device__ __forceinline__ s16x4 vtr(lds_cptr p){ return __builtin_bit_cast(s16x4,__builtin_amdgcn_ds_read_tr16_b64_v4i16((__attribute__((address_space(3))) v4i16_t*)p)); }
__device__ __forceinline__ float rowmax(const f32x16&p0,const f32x16&p1){
  float a=max3f(p0[0],p0[1],p1[0]),b=max3f(p0[2],p0[3],p1[1]);a=max3f(a,p1[2],p1[3]);
  #pragma unroll
  for(int r=4;r<16;r+=4){a=max3f(a,p0[r],p0[r+1]);b=max3f(b,p0[r+2],p0[r+3]);a=max3f(a,p1[r],p1[r+1]);b=max3f(b,p1[r+2],p1[r+3]);}
  const float m=max2f(a,b);
  auto rr=__builtin_amdgcn_permlane32_swap(__float_as_uint(m),__float_as_uint(m),false,false);
  return max2f(__uint_as_float(rr[0]),__uint_as_float(rr[1]));
}
__device__ __forceinline__ void pv(f32x16*o,int vb,bf16x8 pa0,bf16x8 pa1,bf16x8 pa2,bf16x8 pa3){
  #pragma unroll
  for(int d0=0;d0<2;++d0){s16x4 lo[4],hi[4];
    #pragma unroll
    for(int ks=0;ks<4;++ks){
      asm volatile("ds_read_b64_tr_b16 %0,%1 offset:%c2":"=&v"(lo[ks]):"v"(vb),"i"(d0*4096+ks*1024):"memory");
      asm volatile("ds_read_b64_tr_b16 %0,%1 offset:%c2":"=&v"(hi[ks]):"v"(vb),"i"(d0*4096+ks*1024+512):"memory");}
    asm volatile("s_waitcnt lgkmcnt(0)":::"memory");SBAR();
    #define PK(k) (bf16x8){lo[k][0],lo[k][1],lo[k][2],lo[k][3],hi[k][0],hi[k][1],hi[k][2],hi[k][3]}
    o[d0]=__builtin_amdgcn_mfma_f32_32x32x16_bf16(pa0,PK(0),o[d0],0,0,0);
    o[d0]=__builtin_amdgcn_mfma_f32_32x32x16_bf16(pa1,PK(1),o[d0],0,0,0);
    o[d0]=__builtin_amdgcn_mfma_f32_32x32x16_bf16(pa2,PK(2),o[d0],0,0,0);
    o[d0]=__builtin_amdgcn_mfma_f32_32x32x16_bf16(pa3,PK(3),o[d0],0,0,0);
    #undef PK
  }
}

#ifndef ATTN_STORE16
#define ATTN_STORE16(p,v) (*(u32x4*)(p)=(v))
#endif
template<int THRL> __device__ __forceinline__ void attn_unit(int b,int h,int qb,const bf16*Q,const bf16*__restrict__ K,const bf16*__restrict__ V,const bf16*__restrict__ GATE,bf16*O,char*shm,float skipthr){
  int tid_=threadIdx.x; asm volatile("":"+v"(tid_));
  const int tid=tid_,lane=tid&63,r32=lane&31,hi=lane>>5; const int wid=__builtin_amdgcn_readfirstlane(tid>>6);
  const long rowbase=(long)b*SEQ; const int q0=qb*QB;
  const bf16*Qw=Q+(rowbase+q0+wid*QBLK)*DM+h*D;
  const unsigned lds0=(unsigned)(uintptr_t)shm;
  int tskip;
  { typedef __attribute__((address_space(3))) const unsigned long long* lds_u64q; const lds_u64q gt_=(lds_u64q)((__attribute__((address_space(3))) const char*)shm+LDS_G3);
    const int NT0=(q0+QB)/KVBLK; const unsigned long long e0=gt_[q0], e1=gt_[lane<NT0?64*lane+63:q0];
    const float G0=(__uint_as_float((unsigned)e0<<16)+__uint_as_float((unsigned)e0&0xffff0000u))+__uint_as_float((unsigned)(e0>>32)<<16);
    const float G1=(__uint_as_float((unsigned)e1<<16)+__uint_as_float((unsigned)e1&0xffff0000u))+__uint_as_float((unsigned)(e1>>32)<<16);
    const int ns=__builtin_popcountll(__ballot(lane<NT0 && (G1-G0)<skipthr)); tskip=__builtin_amdgcn_readfirstlane(min(ns&~1,NT0-6)); }
  const bf16*Kh=K+(rowbase+(long)tskip*KVBLK)*DM+h*D,*Vh=V+(rowbase+(long)tskip*KVBLK)*DM+h*D;
  float*wsf=(float*)(shm+LDS_WS)+wid*64;
  const bf16*ksrc=Kh+(long)lane*DM+wid*8;
  const bf16*vsrc=Vh+(long)(16*(wid&3)+(lane>>2))*DM+(wid>>2)*32+(lane&3)*8;
  const unsigned kdst=lds0+LDS_K+wid*1024, vdst=lds0+LDS_V+wid*1024;
  #define DMA_K(t,slot) glds16(ksrc+(long)(t)*KVBLK*DM,(unsigned)__builtin_amdgcn_readfirstlane(kdst+(slot)))
  #define DMA_V(t,slot) glds16(vsrc+(long)(t)*KVBLK*DM,(unsigned)__builtin_amdgcn_readfirstlane(vdst+(slot)))
  const int vb0=(int)(lds0+LDS_V)+((lane>>4)&1)*32+(lane&3)*8+(4*hi+((lane&15)>>2))*64;
  const char*Kbase=shm+LDS_K; bf16x8 kf[8];
  const lds_cptr shm3=(lds_cptr)shm; const lds_cptr kp0=shm3+LDS_K+hi*1024+r32*16; const lds_cptr vp0=shm3+LDS_V+((lane>>4)&1)*32+(lane&3)*8+(4*hi+((lane&15)>>2))*64;
  const int NT=(q0+QB)/KVBLK-tskip;
  DMA_K(0,0);DMA_V(0,0);DMA_K(1,SLOTB);
  bf16x8 qr[4];
  #pragma unroll
  for(int d0=0;d0<4;++d0)qr[d0]=*reinterpret_cast<const bf16x8*>(&Qw[(long)r32*DM+d0*16+hi*8]);
  float mhat=0.f,l_reg=0.f;f32x16 o[2];o[0]=f32x16{};o[1]=f32x16{};
  typedef __attribute__((address_space(3))) const unsigned long long* lds_u64p;
  const lds_u64p g3p=(lds_u64p)(shm3+LDS_G3)+tskip*KVBLK+r32;
  { const unsigned long long e=((lds_u64p)(shm3+LDS_G3))[q0+wid*QBLK+r32]; const unsigned lo_=(unsigned)e,hi_=(unsigned)(e>>32); mhat=(__uint_as_float(lo_<<16)+__uint_as_float(lo_&0xffff0000u))+__uint_as_float(hi_<<16); }
  u32x4 qa; qa.x=hi?0u:0x3f803f80u; qa.y=0u; qa.z=0u; qa.w=0u;
  #define SETREF() do{ const float x_=-mhat; const unsigned b1_=cvtpk_s(x_,0.f)&0xffffu; const float r1_=x_-__uint_as_float(b1_<<16); const unsigned b2_=cvtpk_s(r1_,0.f)&0xffffu; \
      const float r2_=r1_-__uint_as_float(b2_<<16); const unsigned b3_=cvtpk_s(r2_,0.f)&0xffffu; qa.y=hi?0u:(0x3f80u|(b1_<<16)); qa.z=hi?0u:(b2_|(b3_<<16)); asm volatile("":"+v"(qa)); }while(0)
  SETREF();
  unsigned long long ga0,ga1;
  #define GARD(t) do{ ga0=g3p[(t)*64]; ga1=g3p[(t)*64+32]; }while(0)
  #define KAF(g) __builtin_bit_cast(bf16x8,(u32x4){(unsigned)(g),(unsigned)((g)>>32),0x3f803f80u,0u})
  #define QAF() __builtin_bit_cast(bf16x8,qa)
  const int qrel=wid*QBLK+r32;
  #define CMASK(P0,P1,t) do{int jb_=(t)-(NT-4); if(jb_>=0)cmask(P0,P1,jb_,qrel,hi);}while(0)
  bool resc=false;
  #define START(P0,P1) do{ const float rm=rowmax(P0,P1); resc=false; \
    { const float dl=__builtin_fmaxf(rm,0.f); mhat=fadd_s(mhat,dl);     \
      _Pragma("unroll") for(int r=0;r<16;++r){P0[r]=fsub_s(P0[r],dl);P1[r]=fsub_s(P1[r],dl);} \
      SETREF(); } \
    _Pragma("unroll") for(int r=0;r<16;++r)P0[r]=__builtin_amdgcn_exp2f(P0[r]); }while(0)
  #define RESC() do{ if(resc){ asm volatile("s_waitcnt lgkmcnt(0)":::"memory"); \
      _Pragma("unroll") for(int d_=0;d_<2;++d_) _Pragma("unroll") for(int r=0;r<16;++r)o[d_][r]*=wsf[crow(r,hi)]; } }while(0)
  f32x16 pA0,pA1,pB0,pB1;
  int sl_prev=0,sl_cur=0,sl_next=SLOTB;
  #define ROT() do{sl_prev=sl_cur;sl_cur=sl_next;sl_next=(sl_next==(NSLOT-1)*SLOTB)?0:sl_next+SLOTB;}while(0)
  DMA_K(2,2*SLOTB);
  WAIT_BAR(3);
  GARD(0); qkt(pA0,pA1,Kbase,qr,KAF(ga0),KAF(ga1),QAF(),r32,hi);asm volatile("s_nop 15\n\ts_nop 7":"+v"(pA0),"+v"(pA1));CMASK(pA0,pA1,0);
  START(pA0,pA1);
  _Pragma("unroll") for(int r=0;r<16;++r)pA1[r]=__builtin_amdgcn_exp2f(pA1[r]);
  WAIT_BAR(0);
  DMA_K(3,0);DMA_V(1,SLOTB);
  ROT();
  kload8(kf,kp0+sl_cur); GARD(1);
  WAIT_BAR(2);
  s16x4 vlo[8],vhi[8]; u32x4 pw0,pw1,pw2,pw3;
  #define PKW(P,B) cvtpk_s(P[B],P[B+1])
  #define PAF(k) __builtin_bit_cast(bf16x8,pw##k)
  #define VFR(i) (bf16x8){vlo[i][0],vlo[i][1],vlo[i][2],vlo[i][3],vhi[i][0],vhi[i][1],vhi[i][2],vhi[i][3]}
  #define PIN(x) asm volatile("":"+v"(x))
  #define MX3(a,b,c) __builtin_fmaxf(__builtin_fmaxf((a),(b)),(c))
  #define GAPA(MF,A0,A1,A2,A3,W0,W1,PW) do{ MF; sacc+=A0; sacc+=A1; sacc+=A2; sacc+=A3; PIN(sacc); W0; W1; PIN(PW); SBAR(); }while(0)
  #define EX(v) __builtin_amdgcn_exp2f(v)
  #define GAPB(MF,X,B) do{ MF; X[B]=EX(X[B]); X[B+1]=EX(X[B+1]); X[B+2]=EX(X[B+2]); X[B+3]=EX(X[B+3]); PIN(X); SBAR(); }while(0)
  #define VRD(i) do{ vlo[i]=vtr(vp_+(((i)>>2)*4096+((i)&3)*1024)); vhi[i]=vtr(vp_+(((i)>>2)*4096+((i)&3)*1024+512)); }while(0)
  #define KRD(G,j) do{ if(G){ kload2(kf,kp0+sl_next,j); SBAR(); } }while(0)
  #define STEP(C0,C1,P0,P1,t,GK,GV,GL) do{ SBAR(); \
    const lds_cptr vp_=vp0+sl_prev; \
    { const f32x16 z_=f32x16{}; C0=__builtin_amdgcn_mfma_f32_32x32x16_bf16(KAF(ga0),QAF(),z_,0,0,0); C1=__builtin_amdgcn_mfma_f32_32x32x16_bf16(KAF(ga1),QAF(),z_,0,0,0); } SBAR(); \
    VRD(0); SBAR(); float sacc=(P0[0]+P0[1]); \
    GAPA(C0=__builtin_amdgcn_mfma_f32_32x32x16_bf16(kf[0],qr[0],C0,0,0,0), P0[2],P0[3],P0[4],P0[5],     pw0[0]=PKW(P0,0), pw0[1]=PKW(P0,2), pw0); \
    VRD(4); SBAR(); GAPA(C1=__builtin_amdgcn_mfma_f32_32x32x16_bf16(kf[1],qr[0],C1,0,0,0), P0[6],P0[7],P0[8],P0[9],     pw0[2]=PKW(P0,4), pw0[3]=PKW(P0,6), pw0); \
    VRD(1); SBAR(); GAPA(C0=__builtin_amdgcn_mfma_f32_32x32x16_bf16(kf[2],qr[1],C0,0,0,0),   P0[10],P0[11],P0[12],P0[13], pw1[0]=PKW(P0,8), pw1[1]=PKW(P0,10), pw1); \
    VRD(5); SBAR(); GAPA(C1=__builtin_amdgcn_mfma_f32_32x32x16_bf16(kf[3],qr[1],C1,0,0,0),   P0[14],P0[15],P1[0],P1[1],   pw1[2]=PKW(P0,12),pw1[3]=PKW(P0,14), pw1); \
    VRD(2); SBAR(); GAPA(C0=__builtin_amdgcn_mfma_f32_32x32x16_bf16(kf[4],qr[2],C0,0,0,0),   P1[2],P1[3],P1[4],P1[5],     pw2[0]=PKW(P1,0), pw2[1]=PKW(P1,2), pw2); \
    VRD(6); SBAR(); GAPA(C1=__builtin_amdgcn_mfma_f32_32x32x16_bf16(kf[5],qr[2],C1,0,0,0),   P1[6],P1[7],P1[8],P1[9],     pw2[2]=PKW(P1,4), pw2[3]=PKW(P1,6), pw2); \
    VRD(3); SBAR(); GAPA(C0=__builtin_amdgcn_mfma_f32_32x32x16_bf16(kf[6],qr[3],C0,0,0,0),   P1[10],P1[11],P1[12],P1[13], pw3[0]=PKW(P1,8), pw3[1]=PKW(P1,10), pw3); \
    VRD(7); SBAR(); GAPA(C1=__builtin_amdgcn_mfma_f32_32x32x16_bf16(kf[7],qr[3],C1,0,0,0),   P1[14],P1[15],0.f,0.f,       pw3[2]=PKW(P1,12),pw3[3]=PKW(P1,14), pw3); \
    l_reg+=sacc; \
    if(GK){DMA_K((t)+3,sl_cur);} if(GV){DMA_V((t)+1,sl_next);} \
    CMASK(C0,C1,t); \
    { float a=MX3(C0[0],C0[1],C1[0]),b=MX3(C0[2],C0[3],C1[1]); a=MX3(a,C1[2],C1[3]); \
      _Pragma("unroll") for(int r=4;r<16;r+=4){a=MX3(a,C0[r],C0[r+1]);b=MX3(b,C0[r+2],C0[r+3]);a=MX3(a,C1[r],C1[r+1]);b=MX3(b,C1[r+2],C1[r+3]);} \
      float rm=__builtin_fmaxf(a,b); { auto rr=__builtin_amdgcn_permlane32_swap(__float_as_uint(rm),__float_as_uint(rm),false,false); rm=__builtin_fmaxf(__uint_as_float(rr[0]),__uint_as_float(rr[1])); } \
      resc=false; \
      if(__builtin_expect(__any(rm>(float)THRL),0)){ const float dl=__builtin_fmaxf(rm,0.f); mhat+=dl; \
        _Pragma("unroll") for(int r=0;r<16;++r){C0[r]-=dl;C1[r]-=dl;} \
        SETREF(); \
        const float f=__builtin_amdgcn_exp2f(-dl); l_reg*=f; if(hi==0)wsf[r32]=f; resc=true; } } \
    SBAR(); \
    GAPB(o[0]=__builtin_amdgcn_mfma_f32_32x32x16_bf16(PAF(0),VFR(0),o[0],0,0,0), C0,0); \
    GAPB(o[1]=__builtin_amdgcn_mfma_f32_32x32x16_bf16(PAF(0),VFR(4),o[1],0,0,0), C0,4); \
    KRD(GL,0); GAPB(o[0]=__builtin_amdgcn_mfma_f32_32x32x16_bf16(PAF(1),VFR(1),o[0],0,0,0), C0,8); \
    KRD(GL,1); GAPB(o[1]=__builtin_amdgcn_mfma_f32_32x32x16_bf16(PAF(1),VFR(5),o[1],0,0,0), C0,12); \
    KRD(GL,2); GAPB(o[0]=__builtin_amdgcn_mfma_f32_32x32x16_bf16(PAF(2),VFR(2),o[0],0,0,0), C1,0); \
    KRD(GL,3); GAPB(o[1]=__builtin_amdgcn_mfma_f32_32x32x16_bf16(PAF(2),VFR(6),o[1],0,0,0), C1,4); \
    if(GL){ GARD((t)+1); SBAR(); } GAPB(o[0]=__builtin_amdgcn_mfma_f32_32x32x16_bf16(PAF(3),VFR(3),o[0],0,0,0), C1,8); \
    GAPB(o[1]=__builtin_amdgcn_mfma_f32_32x32x16_bf16(PAF(3),VFR(7),o[1],0,0,0), C1,12); \
    }while(0)
  int t=1;
  #undef CMASK
  #define CMASK(P0,P1,t) do{}while(0)
  for(;t+5<NT;t+=2){
    STEP(pB0,pB1,pA0,pA1,t,true,true,true);     WAIT_BAR(2); RESC(); ROT();
    STEP(pA0,pA1,pB0,pB1,t+1,true,true,true);   WAIT_BAR(2); RESC(); ROT();
  }
  #undef CMASK
  #define CMASK(P0,P1,t) do{int jb_=(t)-(NT-4); if(jb_>=0)cmask(P0,P1,jb_,qrel,hi);}while(0)
  #define ENDW(tt) do{ if((tt)+3<NT){WAIT_BAR(2);} else if((tt)+2<NT){WAIT_BAR(1);} else {WAIT_BAR(0);} }while(0)
  #undef CMASK
  #define CMASK(P0,P1,t) do{}while(0)
  STEP(pB0,pB1,pA0,pA1,NT-5,true,true,true);   WAIT_BAR(2); RESC(); ROT();
  #undef CMASK
  #define CMASK(P0,P1,t) cmask(P0,P1,0,qrel,hi)
  STEP(pA0,pA1,pB0,pB1,NT-4,true,true,true);   WAIT_BAR(2); RESC(); ROT();
  #undef CMASK
  #define CMASK(P0,P1,t) cmask(P0,P1,1,qrel,hi)
  STEP(pB0,pB1,pA0,pA1,NT-3,false,true,true);  WAIT_BAR(1); RESC(); ROT();
  #undef CMASK
  #define CMASK(P0,P1,t) cmask(P0,P1,2,qrel,hi)
  STEP(pA0,pA1,pB0,pB1,NT-2,false,true,true);  WAIT_BAR(0); RESC(); ROT();
  #undef CMASK
  #define CMASK(P0,P1,t) cmask(P0,P1,3,qrel,hi)
  STEP(pB0,pB1,pA0,pA1,NT-1,false,false,false); RESC();
  { float sacc=pB0[0]+pB0[1]; _Pragma("unroll") for(int r=2;r<16;++r)sacc+=pB0[r]; _Pragma("unroll") for(int r=0;r<16;++r)sacc+=pB1[r]; l_reg+=sacc;
    pw0=(u32x4){PKW(pB0,0),PKW(pB0,2),PKW(pB0,4),PKW(pB0,6)};pw1=(u32x4){PKW(pB0,8),PKW(pB0,10),PKW(pB0,12),PKW(pB0,14)};pw2=(u32x4){PKW(pB1,0),PKW(pB1,2),PKW(pB1,4),PKW(pB1,6)};pw3=(u32x4){PKW(pB1,8),PKW(pB1,10),PKW(pB1,12),PKW(pB1,14)};
    SBAR(); pv(o,vb0+sl_cur,PAF(0),PAF(1),PAF(2),PAF(3)); }
  #undef PKW
  #undef PAF
  #undef VFR
  #undef PIN
  #undef MX3
  #undef GAPA
  #undef GAPB
  #undef EX
  #undef VRD
  #undef KRD
  #undef STEP
  #undef ENDW
  {auto rr=__builtin_amdgcn_permlane32_swap(__float_as_uint(l_reg),__float_as_uint(l_reg),false,false);l_reg=__uint_as_float(rr[0])+__uint_as_float(rr[1]);}
  if(hi==0)wsf[32+r32]=l_reg;asm volatile("s_waitcnt lgkmcnt(0)":::"memory");
  float rli[16];
  #pragma unroll
  for(int r=0;r<16;++r)rli[r]=__builtin_amdgcn_rcpf(wsf[32+crow(r,hi)]);
  bf16*Ow=O+(rowbase+q0+wid*QBLK)*DM+h*D; const bf16*Gw=GATE+(rowbase+q0+wid*QBLK)*DM+h*D;
  { bf16*stg=(bf16*)(shm+LDS_OST)+wid*2048;
    #pragma unroll
    for(int r=0;r<16;++r){const int orow=crow(r,hi);
      #pragma unroll
      for(int d0=0;d0<2;++d0)stg[orow*64+d0*32+r32]=__float2bfloat16(o[d0][r]*rli[r]);}
    asm volatile("s_waitcnt lgkmcnt(0)":::"memory");
    #pragma unroll
    for(int i=0;i<4;++i){const int row=i*8+(lane>>3),ch=lane&7; const u32x4 v=*(const u32x4*)(stg+row*64+ch*8); const u32x4 gv=*(const u32x4*)(Gw+(long)row*DM+ch*8); u32x4 w;
      #define GMUL(a,g) cvtpk_s(__uint_as_float((a)<<16)*__uint_as_float((g)<<16),__uint_as_float((a)&0xffff0000u)*__uint_as_float((g)&0xffff0000u))
      w.x=GMUL(v.x,gv.x); w.y=GMUL(v.y,gv.y); w.z=GMUL(v.z,gv.z); w.w=GMUL(v.w,gv.w);
      #undef GMUL
      ATTN_STORE16(Ow+(long)row*DM+ch*8,w);} }
  asm volatile("s_waitcnt lgkmcnt(0)\n\ts_barrier":::"memory");
  #undef DMA_K
  #undef DMA_V
  #undef CMASK
  #undef START
  #undef RESC
  #undef ROT
  #undef SETREF
  #undef GARD
  #undef KAF
  #undef QAF
}
constexpr int ATTN_LDS_BYTES=LDS_BYTES;
struct AttnTensors { const bf16* Q; const bf16* K; const bf16* V; const bf16* GATE; bf16* O; const unsigned long long* G3; const float* qg; const float* kg; };
template<int THRL=8> __device__ __forceinline__ void attn_phase(char*lds,const AttnTensors&T,int grid,int block){
  const int v0=(grid%8==0)?(block%8)*(grid/8)+block/8:block;
  float skipthr; { float a=fabsf(T.qg[threadIdx.x&63]),b=fabsf(T.kg[threadIdx.x&63]);
    #pragma unroll
    for(int o=1;o<64;o<<=1){a=fmaxf(a,__shfl_xor(a,o));b=fmaxf(b,__shfl_xor(b,o));}
    const float qkmax=64.f*a*b*C2_*1.05f; skipthr=-(42.f+3.f*qkmax); }
  for(int v=v0;v<BATCH*NHEAD*2;v+=grid){
    const int bh=v>>1,odd=v&1;
    {
      const u32x4*src=(const u32x4*)(T.G3+(size_t)bh*SEQ); u32x4*dst=(u32x4*)(lds+LDS_G3);
      #pragma unroll
      for(int i=0;i<4;++i)dst[threadIdx.x+512*i]=src[threadIdx.x+512*i];
      if(threadIdx.x<128)((unsigned long long*)(lds+LDS_GPAD))[threadIdx.x]=0x3f80000000000000ull|0xc6eaull;
      asm volatile("s_waitcnt vmcnt(0) lgkmcnt(0)\n\ts_barrier":::"memory"); }
    #pragma unroll 1
    for(int i=0;i<8;++i){ const int j=i>>1; const int qb=(i&1)?(15-2*j-odd):(2*j+odd); attn_unit<THRL>(bh/NHEAD,bh%NHEAD,qb,T.Q,T.K,T.V,T.GATE,T.O,lds,skipthr); }
  }
}
#undef SBAR
#undef WAIT_BAR
}

constexpr int RING_BYTES = 131072;
constexpr int LDS_BYTES = 163840;
constexpr int LDSCTL_OFF = LDS_BYTES - 1024, MISC_OFF = LDSCTL_OFF + 320;
constexpr int CW_BAR = 4096;
typedef GAS unsigned gu32;
#define RLX_AGENT __ATOMIC_RELAXED, __HIP_MEMORY_SCOPE_AGENT
#define XB_TMO      128
#define XB_XCNT(j)  (256  + 64 * (j))
#define XB_XSUB(j)  (1280 + 64 * (j))
#define XB_XGEN(j)  (2304 + 64 * (j))
#define XB_TOP      3328
#define XB_TOPGEN   3392
#define XCD_BAR_WORDS 3456
#define XB_SPIN_CAP (1u << 18)
__device__ __forceinline__ unsigned xb_ld(unsigned* p)              { return __hip_atomic_load(p, __ATOMIC_RELAXED, __HIP_MEMORY_SCOPE_AGENT); }
__device__ __forceinline__ unsigned xb_add(unsigned* p, unsigned v) { return __hip_atomic_fetch_add(p, v, __ATOMIC_RELAXED, __HIP_MEMORY_SCOPE_AGENT); }
__device__ __forceinline__ unsigned xb_xcc_id() { return (unsigned)__builtin_amdgcn_s_getreg((3 << 11) | 20) & 0xFu; }
#define XB_SPIN(cond, bar) do { unsigned _sp = 0; while (cond) { __builtin_amdgcn_s_sleep(1); \
    if ((++_sp & 255u) == 0u) { if (xb_ld(&(bar)[XB_TMO])) break; if (_sp > XB_SPIN_CAP) { atomicAdd(&(bar)[XB_TMO], 1u); break; } } } } while (0)
struct XcdBarrier { unsigned* bar; unsigned x; volatile LAS unsigned* st; };
__device__ __forceinline__ XcdBarrier xcd_barrier_post(unsigned* bar, volatile LAS unsigned* st) {
    XcdBarrier b; b.bar = bar; b.x = xb_xcc_id(); b.st = st;
    if (threadIdx.x == 0) (void)xb_add(&bar[XB_XCNT(b.x)], 1u);
    return b;
}
__device__ __forceinline__ void xcd_barrier_complete(unsigned* bar, unsigned x, unsigned& nloc, unsigned& nx) {
    const unsigned G = gridDim.x * gridDim.y * gridDim.z;
    unsigned sum, cnt, mine, sp = 0u;
    for (;;) {
        sum = 0u; cnt = 0u; mine = 0u;
#pragma unroll
        for (unsigned j = 0; j < 16; ++j) { const unsigned c = xb_ld(&bar[XB_XCNT(j)]); sum += c; cnt += (c > 0u) ? 1u : 0u; mine = (j == x) ? c : mine; }
        if (sum == G) break;
        __builtin_amdgcn_s_sleep(1);
        if ((++sp & 255u) == 0u) { if (xb_ld(&bar[XB_TMO])) break; if (sp > XB_SPIN_CAP) { atomicAdd(&bar[XB_TMO], 1u); break; } }
    }
    nloc = mine > 0u ? mine : 1u; nx = cnt > 0u ? cnt : 1u;
}
__device__ __forceinline__ void xcd_barrier(const XcdBarrier& b) {
    asm volatile("s_waitcnt vmcnt(0)" ::: "memory");
    __syncthreads();
    if (threadIdx.x == 0) {
        unsigned* bar = b.bar; unsigned bx = b.x;
        asm volatile("" : "+s"(bar), "+s"(bx));
        __builtin_amdgcn_s_waitcnt(0);
        unsigned nloc = b.st[0], nx = b.st[1];
        if (nloc == 0u) { xcd_barrier_complete(bar, bx, nloc, nx); b.st[0] = nloc; b.st[1] = nx; }
        const unsigned old = xb_add(&bar[XB_XSUB(bx)], 1u);
        const unsigned gen = old / nloc;
        if (old + 1u == (gen + 1u) * nloc) {
            __builtin_amdgcn_fence(__ATOMIC_RELEASE, "agent");
            asm volatile("s_waitcnt vmcnt(0)" ::: "memory");
            const unsigned og = xb_add(&bar[XB_TOP], 1u);
            const unsigned tg = og / nx;
            if (og + 1u == (tg + 1u) * nx) xb_add(&bar[XB_TOPGEN], 1u);
            else XB_SPIN(xb_ld(&bar[XB_TOPGEN]) == tg, bar);
            __builtin_amdgcn_fence(__ATOMIC_ACQUIRE, "agent");
            xb_add(&bar[XB_XGEN(bx)], 1u);
            asm volatile("s_waitcnt vmcnt(0)" ::: "memory");
        } else {
            XB_SPIN(xb_ld(&bar[XB_XGEN(bx)]) == gen, bar);
            __builtin_amdgcn_fence(__ATOMIC_ACQUIRE, "agent");
            asm volatile("s_waitcnt vmcnt(0)" ::: "memory");
        }
    }
    __syncthreads();
}

__device__ __forceinline__ void bg_cvt(unsigned char* ws, LAS unsigned char* lds, int wave, int lane, volatile LAS unsigned* flag) {
    const InP in = kin(); LAS float* scr = (LAS float*)(lds + wave * 8448); volatile LAS unsigned* cur = flag + 1;
    const unsigned c = blockIdx.x, G = gridDim.x;
    for (;;) {
        if (*flag != 0u) break;
        if (*cur * G + c >= (unsigned)IT_BG) break;
        unsigned k = 0u; if (lane == 0) k = __hip_atomic_fetch_add((LAS unsigned*)cur, 1u, __ATOMIC_RELAXED, __HIP_MEMORY_SCOPE_WORKGROUP); k = (unsigned)__builtin_amdgcn_readfirstlane((int)k);
        const unsigned it = k * G + c; if (it >= (unsigned)IT_BG) break;
        cvt_item(in, ws, bg_item((int)it), scr, lane);
    }
}
__device__ __forceinline__ void xcd_barrier_bg(const XcdBarrier& b, unsigned char* ws, LAS unsigned char* lds, volatile LAS unsigned* flag) {
    asm volatile("s_waitcnt vmcnt(0)" ::: "memory");
    if (threadIdx.x == 0) *flag = 0u;
    __syncthreads();
    const int wave = __builtin_amdgcn_readfirstlane((int)threadIdx.x >> 6), lane = threadIdx.x & 63;
    if (wave != 0) { bg_cvt(ws, lds, wave, lane, flag); asm volatile("s_waitcnt vmcnt(0)" ::: "memory"); }
    else if (threadIdx.x == 0) {
        unsigned* bar = b.bar; unsigned bx = b.x;
        asm volatile("" : "+s"(bar), "+s"(bx));
        __builtin_amdgcn_s_waitcnt(0);
        unsigned nloc = b.st[0], nx = b.st[1];
        if (nloc == 0u) { xcd_barrier_complete(bar, bx, nloc, nx); b.st[0] = nloc; b.st[1] = nx; }
        const unsigned old = xb_add(&bar[XB_XSUB(bx)], 1u);
        const unsigned gen = old / nloc;
        if (old + 1u == (gen + 1u) * nloc) {
            __builtin_amdgcn_fence(__ATOMIC_RELEASE, "agent");
            asm volatile("s_waitcnt vmcnt(0)" ::: "memory");
            const unsigned og = xb_add(&bar[XB_TOP], 1u);
            const unsigned tg = og / nx;
            if (og + 1u == (tg + 1u) * nx) xb_add(&bar[XB_TOPGEN], 1u);
            else XB_SPIN(xb_ld(&bar[XB_TOPGEN]) == tg, bar);
            __builtin_amdgcn_fence(__ATOMIC_ACQUIRE, "agent");
            xb_add(&bar[XB_XGEN(bx)], 1u);
            asm volatile("s_waitcnt vmcnt(0)" ::: "memory");
        } else {
            XB_SPIN(xb_ld(&bar[XB_XGEN(bx)]) == gen, bar);
            __builtin_amdgcn_fence(__ATOMIC_ACQUIRE, "agent");
            asm volatile("s_waitcnt vmcnt(0)" ::: "memory");
        }
        *flag = 1u;
    }
    __syncthreads();
}

struct Frame { unsigned char* ws; float* out; LAS unsigned char* lds; int bid, G; };
#define TID_LANE_WAVE const int tid = threadIdx.x, lane = tid & 63, wave = __builtin_amdgcn_readfirstlane(tid >> 6); (void)tid; (void)lane; (void)wave

__device__ __forceinline__ void ph_prologue(const Frame& F) {
    TID_LANE_WAVE;
    const InP in = kin(); unsigned char* ws = opq(F.ws);
    LAS float* sc = (LAS float*)F.lds; LAS float* red = (LAS float*)(F.lds + 32768);
    __syncthreads();
    if (F.bid < ADA_ITEMS) {
        for (int i = tid; i < 8 * 1024; i += 512) sc[i] = siluf(in->c[i]);
        __syncthreads();
        for (int it = F.bid; it < ADA_ITEMS; it += F.G) ada_item(in, (float*)(ws + WS_MODS), it, sc, red, tid);
    }
    __syncthreads();
    LAS float* scr = (LAS float*)(F.lds + wave * 8448);
    const int gw = F.bid * 8 + wave, ngw = F.G * 8;
    for (int it = gw; it < IT_FG; it += ngw) cvt_item(in, ws, fg_item(it), scr, lane);
    bf16_t* wsb = (bf16_t*)(ws + WS_WS);
    for (int i = F.bid * 512 + tid; i < 8 * 128 * 128; i += F.G * 512) { const int s = i & 127, t = (i >> 7) & 127; wsb[i] = (bf16_t)f2bf(s <= t ? in->w_s[i] : 0.f); }
}
__device__ __forceinline__ void ph_norm0(const Frame& F) {
    TID_LANE_WAVE; const InP in = kin(); unsigned char* ws = opq(F.ws); const int gw = F.bid * 8 + wave, ngw = F.G * 8;
    const float* mods = (const float*)(ws + WS_MODS);
    for (int r = gw; r < T; r += ngw) { const int b = r / SEQ;
        row4_norm_mod_store(in->x + (size_t)r * DM, in->norm_mix_g, mods + (size_t)b * 6144 + 0, mods + (size_t)b * 6144 + 1024, (bf16_t*)(ws + WS_XN) + (size_t)r * DM, lane); }
}
__device__ __forceinline__ void ph_norm_router(const Frame& F, int L) {
    TID_LANE_WAVE; const InP in = kin(); unsigned char* ws = opq(F.ws);
    LAS f32x4* WP = (LAS f32x4*)F.lds;
    LAS float* lg = (LAS float*)(F.lds + 131072) + wave * 512;
    LAS int* hist = (LAS int*)(F.lds + 131072 + 16384);
    LAS float* rs_s = (LAS float*)(F.lds + 131072 + 16384 + 256) + wave * 16;
    LAS float* pb = (LAS float*)(F.lds + 131072);
    LAS float* rbl = (LAS float*)(F.lds + 131072 + 16384 + 256 + 512);
    const float* mods = (const float*)(ws + WS_MODS) + (size_t)L * 8 * 6144;
    const bf16_t* XR = (const bf16_t*)(ws + WS_XR);
    for (int grp = F.bid; grp < 256; grp += F.G) {
        const int b = grp >> 5; const float* gsc = mods + (size_t)b * 6144 + 4096; const float* gg = in->norm_ffn_g + L * 1024; const float* rw = in->router_w + (size_t)L * 1024 * 32;
        __syncthreads();
        float bpart = 0.f; const float* gsh = mods + (size_t)b * 6144 + 3072;
        for (int idx = tid; idx < 64 * 2 * 64; idx += 512) { const int l = idx & 63, hh = (idx >> 6) & 1, gq = (idx >> 7) & 1, s2 = idx >> 8, e = 16 * hh + (l & 15), k0 = 32 * s2 + 8 * (l >> 4) + 4 * gq;
            const f32x4 g4 = *(const f32x4*)(gg + k0), s4 = *(const f32x4*)(gsc + k0);
            const f32x4 h4 = *(const f32x4*)(gsh + k0); const float r0_ = rw[(k0 + 0) * 32 + e], r1_ = rw[(k0 + 1) * 32 + e], r2_ = rw[(k0 + 2) * 32 + e], r3_ = rw[(k0 + 3) * 32 + e];
            f32x4 w; w.x = g4.x * (1.f + s4.x) * r0_; w.y = g4.y * (1.f + s4.y) * r1_; w.z = g4.z * (1.f + s4.z) * r2_; w.w = g4.w * (1.f + s4.w) * r3_;
            bpart += (h4.x * r0_ + h4.y * r1_) + (h4.z * r2_ + h4.w * r3_);
            WP[idx] = w; }
        pb[tid] = bpart;
        if (tid < 32) hist[tid] = 0;
        __syncthreads();
        if (tid < 32) { float t = in->router_b[L * 32 + tid];
#pragma unroll
            for (int p = 0; p < 16; ++p) t += pb[((p >> 3) << 8) | (((p >> 2) & 1) << 7) | ((tid >> 4) << 6) | ((p & 3) << 4) | (tid & 15)];
            rbl[tid] = t; }
        __syncthreads();
        const int r0 = grp * 128 + wave * 16, j = lane & 15, kq = lane >> 4;
        {
            const bf16_t* xrow = XR + (size_t)(r0 + j) * DM + 8 * kq;
            f32x4 acc0 = {0.f, 0.f, 0.f, 0.f}, acc1 = {0.f, 0.f, 0.f, 0.f}; float ssq = 0.f;
#pragma unroll 16
            for (int s2 = 0; s2 < 32; ++s2) {
                f32x4 xv[2]; bf8_to_f32(*(const u32x4*)(xrow + 32 * s2), xv[0], xv[1]);
#pragma unroll
                for (int gq = 0; gq < 2; ++gq) { const f32x4 w0 = WP[((s2 * 2 + gq) * 2 + 0) * 64 + lane], w1 = WP[((s2 * 2 + gq) * 2 + 1) * 64 + lane];
                    ssq += (xv[gq].x * xv[gq].x + xv[gq].y * xv[gq].y) + (xv[gq].z * xv[gq].z + xv[gq].w * xv[gq].w);
#pragma unroll
                    for (int q = 0; q < 4; ++q) { acc0 = __builtin_amdgcn_mfma_f32_16x16x4f32(w0[q], xv[gq][q], acc0, 0, 0, 0); acc1 = __builtin_amdgcn_mfma_f32_16x16x4f32(w1[q], xv[gq][q], acc1, 0, 0, 0); } }
            }
            ssq += __shfl_xor(ssq, 16); ssq += __shfl_xor(ssq, 32);
            const float rstd = 1.f / sqrtf(ssq * (1.f / 1024.f) + EPS);
            const f32x4 b0 = *(const LAS f32x4*)(rbl + 4 * kq), b1 = *(const LAS f32x4*)(rbl + 16 + 4 * kq);
            *(LAS f32x4*)(lg + j * 32 + 4 * kq) = acc0 * rstd + b0; *(LAS f32x4*)(lg + j * 32 + 16 + 4 * kq) = acc1 * rstd + b1;
            if (kq == 0) rs_s[j] = rstd;
        }
        __builtin_amdgcn_s_waitcnt(0xc07f); asm volatile("" ::: "memory");
        if (lane < 16) {
            float v[32];
#pragma unroll
            for (int q = 0; q < 8; ++q) { const f32x4 t4 = *(const LAS f32x4*)(lg + lane * 32 + 4 * q); v[4 * q] = t4.x; v[4 * q + 1] = t4.y; v[4 * q + 2] = t4.z; v[4 * q + 3] = t4.w; }
            int ti[4]; float tv[4];
#pragma unroll
            for (int p = 0; p < 4; ++p) { float bv = -INFINITY; int bi = 0;
#pragma unroll
                for (int e = 0; e < 32; ++e) { bool ok = v[e] > bv;
#pragma unroll
                    for (int pp = 0; pp < p; ++pp) ok = ok && (ti[pp] != e);
                    if (ok) { bv = v[e]; bi = e; } }
                ti[p] = bi; tv[p] = bv; }
            float tg[4]; float sm = 0.f;
#pragma unroll
            for (int p = 0; p < 4; ++p) { tg[p] = expf(tv[p] - tv[0]); sm += tg[p]; }
            const int r = r0 + lane;
            *(i32x4*)((int*)(ws + WS_TOPE) + r * 4) = (i32x4){ti[0], ti[1], ti[2], ti[3]};
            *(f32x4*)((float*)(ws + WS_TOPG) + r * 4) = (f32x4){tg[0] / sm, tg[1] / sm, tg[2] / sm, tg[3] / sm};
#pragma unroll
            for (int p = 0; p < 4; ++p) __hip_atomic_fetch_add(&hist[ti[p]], 1, __ATOMIC_RELAXED, __HIP_MEMORY_SCOPE_WORKGROUP);
        }
#pragma unroll 4
        for (int i = 0; i < 16; ++i) { const int r = r0 + i; f32x4 v[4], h[4]; row_load_bf(XR + (size_t)r * DM, lane, v);
            row_modnorm(v, rs_s[i], gg, mods + (size_t)b * 6144 + 3072, gsc, lane, h); row_store_bf16((bf16_t*)(ws + WS_XN) + (size_t)r * DM, lane, h); }
        __syncthreads();
        if (tid < 32) ((int*)(ws + WS_HIST))[grp * 32 + tid] = hist[tid];
    }
}
__device__ __forceinline__ void ph_list(const Frame& F) {
    TID_LANE_WAVE; unsigned char* ws = opq(F.ws);
    LAS int* tot = (LAS int*)F.lds; LAS int* before = tot + 32; LAS int* pstart = tot + 64; LAS int* se = tot + 128; LAS int* part = tot + 640;
    const int* hist = (const int*)(ws + WS_HIST); const int* tope = (const int*)(ws + WS_TOPE); const float* topg = (const float*)(ws + WS_TOPG);
    int* dest = (int*)(ws + WS_DEST); int* list = (int*)(ws + WS_LIST); float* rowg = (float*)(ws + WS_ROWG); int* blke = (int*)(ws + WS_BLKE);
    for (int w = F.bid; w < 256; w += F.G) {
        __syncthreads();
        const int mye = tope[w * 512 + tid]; se[tid] = mye;
        { const int e = tid & 31, p = tid >> 5; int a = 0, bf = 0;
#pragma unroll 4
            for (int i = p * 16; i < p * 16 + 16; ++i) { const int h = hist[i * 32 + e]; a += h; bf += (i < w) ? h : 0; }
            part[p * 32 + e] = a; part[512 + p * 32 + e] = bf; }
        __syncthreads();
        if (tid < 32) { int a = 0, bf = 0;
#pragma unroll
            for (int p = 0; p < 16; ++p) { a += part[p * 32 + tid]; bf += part[512 + p * 32 + tid]; }
            tot[tid] = a; before[tid] = bf; }
        __syncthreads();
        if (tid == 0) { int p = 0; for (int e = 0; e < 32; ++e) { pstart[e] = p; p += (tot[e] + 255) / 256 * 256; } pstart[32] = p; }
        __syncthreads();
        { int rank = 0;
            for (int i4 = 0; i4 < 128; ++i4) { const i32x4 q = *(const LAS i32x4*)(se + 4 * i4); const int i0 = 4 * i4;
                rank += (q.x == mye && i0 < tid) + (q.y == mye && i0 + 1 < tid) + (q.z == mye && i0 + 2 < tid) + (q.w == mye && i0 + 3 < tid); }
            const int slot = w * 512 + tid, d = pstart[mye] + before[mye] + rank;
            dest[slot] = d; list[d] = slot >> 2; rowg[d] = topg[slot]; }
        if (w < 32) { const int e = w; for (int r = pstart[e] + tot[e] + tid; r < pstart[e + 1]; r += 512) { list[r] = -1; rowg[r] = 0.f; }
            for (int bk = pstart[e] / 256 + tid; bk < pstart[e + 1] / 256; bk += 512) blke[bk] = e; }
        if (w == 32 && tid == 0) blke[MAXBLK] = pstart[32] / 256;
    }
}
__device__ __forceinline__ void ph_combine(const Frame& F, int L) {
    TID_LANE_WAVE; const InP in = kin(); unsigned char* ws = opq(F.ws); float* out = F.out;
    LAS f32x4* WF = (LAS f32x4*)F.lds;
    LAS float* rs_s = (LAS float*)(F.lds + 65536) + wave * 16;
    LAS float* pb = (LAS float*)(F.lds + 65536 + 1024);
    LAS float* fbl = (LAS float*)(F.lds + 65536 + 1024 + 2048);
    const float* mods = (const float*)(ws + WS_MODS);
    bf16_t* XR = (bf16_t*)(ws + WS_XR); const bf16_t* YB = (const bf16_t*)(ws + WS_YB); const int* dest = (const int*)(ws + WS_DEST);
    for (int grp = F.bid; grp < 256; grp += F.G) {
        const int b = grp >> 5, r0 = grp * 128 + wave * 16;
        if (L == 0) {
            __syncthreads();
            const float* ksc = mods + ((size_t)16 + b) * 6144 + 1024; const float* ksh = mods + ((size_t)16 + b) * 6144; float bpart = 0.f;
            for (int idx = tid; idx < 64 * 64; idx += 512) { const int l = idx & 63, gq = (idx >> 6) & 1, s2 = idx >> 7, e = l & 15, k0 = 32 * s2 + 8 * (l >> 4) + 4 * gq;
                const f32x4 g4 = *(const f32x4*)(in->kv_norm_g + k0), s4 = *(const f32x4*)(ksc + k0); const float* kw = in->kv_w + (size_t)k0 * 2064 + 2048 + e;
                const f32x4 h4 = *(const f32x4*)(ksh + k0); const float r0_ = kw[0], r1_ = kw[2064], r2_ = kw[2 * 2064], r3_ = kw[3 * 2064];
                f32x4 w; w.x = g4.x * (1.f + s4.x) * r0_; w.y = g4.y * (1.f + s4.y) * r1_; w.z = g4.z * (1.f + s4.z) * r2_; w.w = g4.w * (1.f + s4.w) * r3_;
                bpart += (h4.x * r0_ + h4.y * r1_) + (h4.z * r2_ + h4.w * r3_);
                WF[idx] = w; }
            pb[tid] = bpart;
            __syncthreads();
            if (tid < 16) { float t = in->fgate_b[tid];
#pragma unroll
                for (int p = 0; p < 32; ++p) t += pb[(p << 4) | tid];
                fbl[tid] = t; }
            __syncthreads();
        }
        const float* gt = mods + ((size_t)L * 8 + b) * 6144 + 5120;
#pragma unroll 1
        for (int i = 0; i < 16; ++i) {
            const int r = r0 + i; f32x4 v[4]; row_load_bf(XR + (size_t)r * DM, lane, v);
            f32x4 y[4];
#pragma unroll
            for (int j = 0; j < 4; ++j) y[j] = (f32x4){0.f, 0.f, 0.f, 0.f};
            const i32x4 d4 = *(const i32x4*)(dest + r * 4); const int dd[4] = {d4.x, d4.y, d4.z, d4.w};
#pragma unroll
            for (int q = 0; q < 4; ++q) { const bf16_t* yr = YB + (size_t)dd[q] * 1024;
#pragma unroll
                for (int j = 0; j < 2; ++j) { f32x4 a, c; bf8_to_f32(((const u32x4*)yr)[lane + 64 * j], a, c); y[2 * j] += a; y[2 * j + 1] += c; } }
#pragma unroll
            for (int j = 0; j < 4; ++j) v[j] = v[j] + row_vec(gt, lane, j) * y[j];
            const float rs = row_rstd(v);
            if (L == 1) { f32x4 o4[4];
#pragma unroll
                for (int j = 0; j < 4; ++j) o4[j] = v[j] * rs * row_vec(in->final_g, lane, j);
                row_store_f32(out + (size_t)r * DM, lane, o4);
                continue;
            }
            row_store_bf16(XR + (size_t)r * DM, lane, v);
            f32x4 h[4];
            row_modnorm(v, rs, in->norm_mix_g + 1024, mods + ((size_t)8 + b) * 6144 + 0, mods + ((size_t)8 + b) * 6144 + 1024, lane, h);
            row_store_bf16((bf16_t*)(ws + WS_XN) + (size_t)r * DM, lane, h);
            row_modnorm(v, rs, in->kv_norm_g, mods + ((size_t)16 + b) * 6144 + 0, mods + ((size_t)16 + b) * 6144 + 1024, lane, h);
            row_store_bf16((bf16_t*)(ws + WS_HKV) + (size_t)r * DM, lane, h);
            if (lane == 0) rs_s[i] = rs;
        }
        if (L == 0) {
            __builtin_amdgcn_fence(__ATOMIC_RELEASE, "workgroup"); asm volatile("s_waitcnt vmcnt(0) lgkmcnt(0)" ::: "memory"); __builtin_amdgcn_fence(__ATOMIC_ACQUIRE, "workgroup");
            const int j = lane & 15, kq = lane >> 4; const bf16_t* xrow = XR + (size_t)(r0 + j) * DM + 8 * kq;
            f32x4 acc = {0.f, 0.f, 0.f, 0.f};
#pragma unroll 16
            for (int s2 = 0; s2 < 32; ++s2) { f32x4 xv[2]; bf8_to_f32(__builtin_nontemporal_load((const u32x4*)(xrow + 32 * s2)), xv[0], xv[1]);
#pragma unroll
                for (int gq = 0; gq < 2; ++gq) { const f32x4 w0 = WF[(s2 * 2 + gq) * 64 + lane];
#pragma unroll
                    for (int q = 0; q < 4; ++q) acc = __builtin_amdgcn_mfma_f32_16x16x4f32(w0[q], xv[gq][q], acc, 0, 0, 0); } }
            const float rstd = rs_s[j]; const f32x4 fb = *(const LAS f32x4*)(fbl + 4 * kq);
            f32x4 lf;
#pragma unroll
            for (int q = 0; q < 4; ++q) { const float xg = acc[q] * rstd + fb[q]; lf[q] = fminf(xg, 0.f) - log1pf(expf(-fabsf(xg))); }
            *(f32x4*)((float*)(ws + WS_LOGF) + (size_t)(r0 + j) * 16 + 4 * kq) = lf;
        }
    }
}
__device__ __forceinline__ void ph_cumsum(const Frame& F) {
    TID_LANE_WAVE; unsigned char* ws = opq(F.ws); LAS float* wtot = (LAS float*)F.lds;
    for (int bh = F.bid; bh < NB * NH; bh += F.G) {
        const int b = bh >> 4, h = bh & 15;
        const float* lf = (const float*)(ws + WS_LOGF); float v[8]; float run = 0.f;
#pragma unroll
        for (int i = 0; i < 8; ++i) { run += lf[((size_t)b * SEQ + tid * 8 + i) * 16 + h]; v[i] = run; }
        float inc = run;
#pragma unroll
        for (int o = 1; o < 64; o <<= 1) { const float t = __shfl_up(inc, o); if (lane >= o) inc += t; }
        if (lane == 63) wtot[wave] = inc;
        __syncthreads();
        float off = inc - run;
        for (int w8 = 0; w8 < wave; ++w8) off += wtot[w8];
        float* fc = (float*)(ws + WS_FC) + (size_t)bh * SEQ; unsigned long long* g3 = (unsigned long long*)(ws + WS_G3) + (size_t)bh * SEQ;
#pragma unroll
        for (int i = 0; i < 8; ++i) { const float Fv = v[i] + off; fc[tid * 8 + i] = Fv;
            const float g = -Fv * LOG2E; const unsigned b1 = f2bf(g); const float r1 = g - __uint_as_float(b1 << 16); const unsigned b2 = f2bf(r1); const float r2 = r1 - __uint_as_float(b2 << 16); const unsigned b3 = f2bf(r2);
            g3[tid * 8 + i] = (unsigned long long)(b1 | (b2 << 16)) | ((unsigned long long)(b3 | (0x3f80u << 16)) << 32); }
        __syncthreads();
    }
}


typedef short s16x4 __attribute__((ext_vector_type(4)));
__device__ __forceinline__ s16x4 ds_tr16(LAS unsigned char* p) { return __builtin_bit_cast(s16x4, __builtin_amdgcn_ds_read_tr16_b64_v4i16((LAS s16x4*)p)); }
__device__ __forceinline__ void ph_spatial(const Frame& F) {
    const InP in = kin(); unsigned char* ws = opq(F.ws);
    LAS unsigned char* L = F.lds;
    constexpr int VN_STRIDE = 544, WC_STRIDE = 272, OFF_VN = 0, OFF_WC = 128 * VN_STRIDE, OFF_ST = OFF_WC + 128 * WC_STRIDE;
    LAS float* st = (LAS float*)(L + OFF_ST);
    const bf16_t* Z = (const bf16_t*)(ws + WS_Z); bf16_t* GT = (bf16_t*)(ws + WS_GATED); const bf16_t* WSB = (const bf16_t*)(ws + WS_WS);
    for (int ch = F.bid; ch < T / 128; ch += F.G) {
        const int t0 = ch * 128;
        __syncthreads();
        { int tid_ = threadIdx.x; asm volatile("" : "+v"(tid_)); const int lane = tid_ & 63, wave = __builtin_amdgcn_readfirstlane(tid_ >> 6);
#pragma unroll 4
        for (int i = 0; i < 16; ++i) {
            const int tl = wave * 16 + i; const bf16_t* vrow = Z + (size_t)(t0 + tl) * 4096 + 2048;
            float v[32]; float s = 0.f;
#pragma unroll
            for (int j = 0; j < 4; ++j) { const u32x4 w = *(const u32x4*)(vrow + (lane + 64 * j) * 8); const unsigned ww[4] = {w.x, w.y, w.z, w.w};
#pragma unroll
                for (int q = 0; q < 4; ++q) { v[j * 8 + 2 * q] = __uint_as_float(ww[q] << 16); v[j * 8 + 2 * q + 1] = __uint_as_float(ww[q] & 0xffff0000u); } }
#pragma unroll
            for (int q = 0; q < 32; ++q) s += v[q];
            const float mean = wave_sum(s) * (1.f / 2048.f); float qq = 0.f;
#pragma unroll
            for (int q = 0; q < 32; ++q) { const float d = v[q] - mean; qq += d * d; }
            const float rstd = 1.f / sqrtf(wave_sum(qq) * (1.f / 2048.f) + EPS);
            if (lane == 0) { st[2 * tl] = mean; st[2 * tl + 1] = rstd; }
        } }
        u32x4 vw[8], wcw[4];
        { int tid_ = threadIdx.x; asm volatile("" : "+v"(tid_)); const int tid = tid_, c8 = tid & 31;
#pragma unroll
            for (int q = 0; q < 8; ++q) vw[q] = *(const u32x4*)(Z + (size_t)(t0 + (tid >> 5) + 16 * q) * 4096 + 2048 + c8 * 8);
#pragma unroll
            for (int q = 0; q < 4; ++q) { const int cidx = tid + 512 * q, r = cidx >> 4, c16 = cidx & 15; wcw[q] = *(const u32x4*)(WSB + r * 128 + c16 * 8); } }
#pragma unroll 1
        for (int g = 0; g < 8; ++g) {
            int tid_ = threadIdx.x; asm volatile("" : "+v"(tid_));
            const int tid = tid_, lane = tid & 63, wave = __builtin_amdgcn_readfirstlane(tid >> 6), fr = lane & 15, fq = lane >> 4;
            __syncthreads();
#pragma unroll
            for (int q = 0; q < 4; ++q) { const int cidx = tid + 512 * q, r = cidx >> 4, c16 = cidx & 15; *(LAS u32x4*)(L + OFF_WC + r * WC_STRIDE + c16 * 16) = wcw[q]; }
            {
                const int c8 = tid & 31; const float* vg = in->v_g + g * 256 + c8 * 8; const float* vb = in->v_b + g * 256 + c8 * 8;
                const f32x4 g0 = *(const f32x4*)vg, g1 = *(const f32x4*)(vg + 4), b0 = *(const f32x4*)vb, b1 = *(const f32x4*)(vb + 4);
#pragma unroll
                for (int q = 0; q < 8; ++q) { const int s = (tid >> 5) + 16 * q;
                    const u32x4 w = vw[q];
                    const float mean = st[2 * s], rstd = st[2 * s + 1];
                    f32x4 x0 = {__uint_as_float(w.x << 16), __uint_as_float(w.x & 0xffff0000u), __uint_as_float(w.y << 16), __uint_as_float(w.y & 0xffff0000u)};
                    f32x4 x1 = {__uint_as_float(w.z << 16), __uint_as_float(w.z & 0xffff0000u), __uint_as_float(w.w << 16), __uint_as_float(w.w & 0xffff0000u)};
                    x0 = (x0 - mean) * rstd * g0 + b0; x1 = (x1 - mean) * rstd * g1 + b1;
                    u32x4 o; o.x = pk2(x0[0], x0[1]); o.y = pk2(x0[2], x0[3]); o.z = pk2(x1[0], x1[1]); o.w = pk2(x1[2], x1[3]);
                    *(LAS u32x4*)(L + OFF_VN + s * VN_STRIDE + c8 * 16) = o; }
            }
            u32x2 uw[8][2]; float bsv[8];
#pragma unroll
            for (int tb = 0; tb < 8; ++tb) { const int t = 16 * tb + fr; bsv[tb] = in->b_s[g * 128 + t];
#pragma unroll
                for (int db = 0; db < 2; ++db) uw[tb][db] = *(const u32x2*)(Z + (size_t)(t0 + t) * 4096 + 256 * g + 32 * wave + 16 * db + 4 * fq); }
            __syncthreads();
            if (g < 7) { const int c8 = tid & 31;
#pragma unroll
                for (int q = 0; q < 8; ++q) vw[q] = *(const u32x4*)(Z + (size_t)(t0 + (tid >> 5) + 16 * q) * 4096 + 2048 + (g + 1) * 256 + c8 * 8);
#pragma unroll
                for (int q = 0; q < 4; ++q) { const int cidx = tid + 512 * q, r = cidx >> 4, c16 = cidx & 15; wcw[q] = *(const u32x4*)(WSB + (size_t)(g + 1) * 16384 + r * 128 + c16 * 8); } }
            f32x4 acc[8][2];
#pragma unroll
            for (int tb = 0; tb < 8; ++tb) { acc[tb][0] = (f32x4){0.f, 0.f, 0.f, 0.f}; acc[tb][1] = (f32x4){0.f, 0.f, 0.f, 0.f}; }
#pragma unroll
            for (int ks = 0; ks < 4; ++ks) {
                const int s0 = 32 * ks; bf16x8 X[2];
#pragma unroll
                for (int db = 0; db < 2; ++db) { LAS unsigned char* p = L + OFF_VN + (s0 + 4 * fq + (fr >> 2)) * VN_STRIDE + (32 * wave + 16 * db + 4 * (fr & 3)) * 2;
                    const s16x4 lo = ds_tr16(p), hi = ds_tr16(p + 16 * VN_STRIDE);
                    X[db] = (bf16x8){lo[0], lo[1], lo[2], lo[3], hi[0], hi[1], hi[2], hi[3]}; }
#pragma unroll
                for (int tb = 0; tb < 8; ++tb) if (2 * ks <= tb) {
                    LAS unsigned char* p = L + OFF_WC + (16 * tb + fr) * WC_STRIDE + (s0 + 4 * fq) * 2;
                    const u32x2 y0 = *(LAS u32x2*)p, y1 = *(LAS u32x2*)(p + 32);
                    const bf16x8 Y = __builtin_bit_cast(bf16x8, (u32x4){y0.x, y0.y, y1.x, y1.y});
                    acc[tb][0] = __builtin_amdgcn_mfma_f32_16x16x32_bf16(X[0], Y, acc[tb][0], 0, 0, 0);
                    acc[tb][1] = __builtin_amdgcn_mfma_f32_16x16x32_bf16(X[1], Y, acc[tb][1], 0, 0, 0); }
            }
#pragma unroll
            for (int tb = 0; tb < 8; ++tb) { const int t = 16 * tb + fr;
#pragma unroll
                for (int db = 0; db < 2; ++db) { const int dd = 256 * g + 32 * wave + 16 * db + 4 * fq;
                    const u32x2 uwv = uw[tb][db];
                    const f32x4 m = acc[tb][db] + bsv[tb];
                    u32x2 o; o.x = pk2(__uint_as_float(uwv.x << 16) * m[0], __uint_as_float(uwv.x & 0xffff0000u) * m[1]); o.y = pk2(__uint_as_float(uwv.y << 16) * m[2], __uint_as_float(uwv.y & 0xffff0000u) * m[3]);
                    *(u32x2*)(GT + (size_t)(t0 + t) * 2048 + dd) = o; } }
        }
    }
}

constexpr int NPH = 18;
struct PA { In in; unsigned char* ws; float* out; int ph_lo, ph_hi, li, pad; };
__global__ void __launch_bounds__(512, 2) fwd(PA args) {
    extern __shared__ __attribute__((aligned(16))) unsigned char lds[];
    Frame F; F.ws = args.ws; F.out = args.out; F.lds = (LAS unsigned char*)lds;
    F.bid = blockIdx.x; F.G = gridDim.x;
    LAS unsigned char* ldsl = (LAS unsigned char*)lds;
    volatile LAS unsigned* MISC = (volatile LAS unsigned*)(ldsl + MISC_OFF);
    for (int u = threadIdx.x; u < (LDS_BYTES - LDSCTL_OFF) / 4; u += 512) ((LAS unsigned*)(ldsl + LDSCTL_OFF))[u] = 0u;
    __syncthreads();
    unsigned char* const ws0 = args.ws;
    XcdBarrier bar = xcd_barrier_post((unsigned*)(ws0 + WS_CTL) + CW_BAR + args.li * XCD_BAR_WORDS, MISC + 8);
    const int lo = args.ph_lo, hi = args.ph_hi;
#ifndef PHMASK
#define PHMASK 0x3ffffu
#endif
#define IN(k) (((PHMASK >> (k)) & 1u) && lo <= (k) && (k) < hi)
#define SEAM(k) do { if (lo <= (k) && (k) + 1 < hi) { if ((k) <= 13) xcd_barrier_bg(bar, ws0, ldsl, MISC + 12); else xcd_barrier(bar); } } while (0)
    const int c = (int)blockIdx.x, G = (int)gridDim.x;

    if (IN(0)) { ph_prologue(F); } SEAM(0);
    if (IN(1)) { ph_norm0(F); } SEAM(1);
    if (IN(2)) {
        unsigned char* ws = opq(ws0);
        pg::StaticOrder S; S.init(T / 256, 4096 / 256, G, c);
        pg::SrcPlain<true> src{(const char*)(ws + WS_WIN), 2048}; pg::EpGeluZ E{(bf16_t*)(ws + WS_Z)};
        pg::gemm_phase<pg::EpGeluZ, pg::StaticOrder, pg::SrcPlain<true>, true>(ldsl, (const char*)(ws + WS_XN), 1024, S, src, E);
    } SEAM(2);
    if (IN(3)) { ph_spatial(F); } SEAM(3);
    if (IN(4)) {
        unsigned char* ws = opq(ws0); const float* mods = (const float*)(ws + WS_MODS);
        pg::StaticOrder S; S.init(T / 256, 1024 / 256, G, c);
        pg::SrcPlain<true> src{(const char*)(ws + WS_WOUT), 4096}; pg::EpResid<true> E{kin()->x, (bf16_t*)(ws + WS_XR), mods + 2048};
        pg::gemm_phase<pg::EpResid<true>, pg::StaticOrder, pg::SrcPlain<true>, true>(ldsl, (const char*)(ws + WS_GATED), 2048, S, src, E);
    } SEAM(4);
#define LAYER_MOE(L, P0) \
    if (IN(P0)) { ph_norm_router(F, L); } SEAM(P0); \
    if (IN(P0 + 1)) { if ((P0) == 13) { TID_LANE_WAVE; if (tid == 0) MISC[12] = 0u; __syncthreads(); bg_cvt(ws0, ldsl, wave, lane, MISC + 12); } ph_list(F); } SEAM(P0 + 1); \
    if (IN(P0 + 2)) {     \
        unsigned char* ws = opq(ws0); const int* blke = (const int*)(ws + WS_BLKE); \
        pg::StaticOrder S; S.init(blke[MAXBLK], 8, G, c); \
        pg::SrcMoeA src{(const char*)(ws + WS_W1) + (size_t)L * 32 * 2048 * 1024 * 2, (const int*)(ws + WS_LIST), blke, 2048}; pg::EpSwiglu E{(bf16_t*)(ws + WS_ACT), kin()->exp_b1 + (size_t)L * 32 * 2048, blke}; \
        pg::gemm_phase<pg::EpSwiglu, pg::StaticOrder, pg::SrcMoeA, true>(ldsl, (const char*)(ws + WS_XN), 1024, S, src, E); \
    } SEAM(P0 + 2); \
    if (IN(P0 + 3)) {     \
        unsigned char* ws = opq(ws0); const int* blke = (const int*)(ws + WS_BLKE); \
        pg::StaticOrder S; S.init(blke[MAXBLK], 4, G, c); \
        pg::SrcMoeB src{(const char*)(ws + WS_W2) + (size_t)L * 32 * 1024 * 1024 * 2, blke, 2048}; pg::EpMoeOut E{(bf16_t*)(ws + WS_YB), kin()->exp_b2 + (size_t)L * 32 * 1024, blke, (const float*)(ws + WS_ROWG)}; \
        pg::gemm_phase<pg::EpMoeOut, pg::StaticOrder, pg::SrcMoeB, true>(ldsl, (const char*)(ws + WS_ACT), 1024, S, src, E); \
    } SEAM(P0 + 3); \
    if (IN(P0 + 4)) { ph_combine(F, L); } SEAM(P0 + 4);

    LAYER_MOE(0, 5)
    if (IN(10)) {
        unsigned char* ws = opq(ws0);
        ph_cumsum(F);
        pg::StaticOrder S; S.init(T / 256, 2048 / 256, G, c);
        { pg::SrcHeads src{(const char*)(ws + WS_WKV), 2048}; pg::EpHeads<0> E{(bf16_t*)(ws + WS_K), (bf16_t*)(ws + WS_V), kin()->k_norm_g};
          pg::gemm_phase<pg::EpHeads<0>, pg::StaticOrder, pg::SrcHeads, true>(ldsl, (const char*)(ws + WS_HKV), 1024, S, src, E); }
        { pg::SrcHeads src{(const char*)(ws + WS_WQG), 2048}; pg::EpHeads<1> E{(bf16_t*)(ws + WS_Q), (bf16_t*)(ws + WS_GS), kin()->q_norm_g};
          pg::gemm_phase<pg::EpHeads<1>, pg::StaticOrder, pg::SrcHeads, true>(ldsl, (const char*)(ws + WS_XN), 1024, S, src, E); }
    } SEAM(10);
    if (IN(11)) {
        unsigned char* ws = opq(ws0);
        static_assert(attn_body::ATTN_LDS_BYTES <= RING_BYTES, "attention LDS");
        const attn_body::AttnTensors AT{(const attn_body::bf16*)(ws + WS_Q), (const attn_body::bf16*)(ws + WS_K), (const attn_body::bf16*)(ws + WS_V), (const attn_body::bf16*)(ws + WS_GS), (attn_body::bf16*)(ws + WS_O), (const unsigned long long*)(ws + WS_G3), kin()->q_norm_g, kin()->k_norm_g};
        attn_body::attn_phase<8>((char*)lds, AT, G, c);
    } SEAM(11);
    if (IN(12)) {
        unsigned char* ws = opq(ws0); const float* mods = (const float*)(ws + WS_MODS);
        pg::StaticOrder S; S.init(T / 256, 1024 / 256, G, c);
        pg::SrcPlain<true> src{(const char*)(ws + WS_WO), 2048}; pg::EpResid<false> E{(const bf16_t*)(ws + WS_XR), (bf16_t*)(ws + WS_XR), mods + 8 * 6144 + 2048};
        pg::gemm_phase<pg::EpResid<false>, pg::StaticOrder, pg::SrcPlain<true>, true>(ldsl, (const char*)(ws + WS_O), 1024, S, src, E);
    } SEAM(12);
    LAYER_MOE(1, 13)
#undef LAYER_MOE
#undef IN
#undef SEAM
}

#include <cstring>
extern "C" void kernel_launch(void* const* d_in, const int* in_sizes, int n_in, void* d_out, int out_size, void* d_ws, size_t ws_size, hipStream_t stream) {
    if (n_in != 28 || ws_size < WS_END || out_size != T * DM) { fprintf(stderr, "kernel_launch: unexpected arguments (n_in %d, ws %zu, out %d)\n", n_in, ws_size, out_size); return; }
    static int grid = 0;
    if (grid == 0) {
        int dev = 0, cus = 0, per_cu = 0;
        if (hipGetDevice(&dev) != hipSuccess || hipDeviceGetAttribute(&cus, hipDeviceAttributeMultiprocessorCount, dev) != hipSuccess) { grid = -1; return; }
        if (hipFuncSetAttribute((const void*)fwd, hipFuncAttributeMaxDynamicSharedMemorySize, LDS_BYTES) != hipSuccess) { fprintf(stderr, "kernel_launch: hipFuncSetAttribute failed\n"); grid = -1; return; }
        if (hipOccupancyMaxActiveBlocksPerMultiprocessor(&per_cu, (const void*)fwd, 512, LDS_BYTES) != hipSuccess || per_cu < 1) fprintf(stderr, "kernel_launch: occupancy query says %d\n", per_cu);
        (void)hipGetLastError();
        grid = cus;
    }
    if (grid < 0) return;
    KA a; memset((void*)&a, 0, sizeof(a));
    { const float** p = (const float**)&a.in; for (int i = 0; i < 28; ++i) p[i] = (const float*)d_in[i]; }
    a.ws = (unsigned char*)d_ws; a.out = (float*)d_out;
    PA pa; memset((void*)&pa, 0, sizeof(pa)); pa.in = a.in; pa.ws = a.ws; pa.out = a.out;
    (void)hipMemsetAsync((unsigned char*)d_ws + WS_CTL, 0, 1 * MiB, stream);
    pa.ph_lo = 0; pa.ph_hi = NPH; pa.li = 0;
    hipLaunchKernelGGL(fwd, dim3(grid), dim3(512), LDS_BYTES, stream, pa);
}
```

```cpp
#include <hip/hip_runtime.h>
#include <cstdio>
#include <cstdint>

#define LAS __attribute__((address_space(3)))
#define GAS __attribute__((address_space(1)))
typedef unsigned short bf16_t;
typedef float f32x4 __attribute__((ext_vector_type(4)));
typedef short bf16x8 __attribute__((ext_vector_type(8)));
typedef unsigned u32x4 __attribute__((ext_vector_type(4)));
typedef unsigned u32x2 __attribute__((ext_vector_type(2)));
typedef int i32x4 __attribute__((ext_vector_type(4)));

constexpr int NB = 8, SEQ = 4096, DM = 1024, T = NB * SEQ;
constexpr int GW = 2048, NG = 8, GD = 256, CH = 128;
constexpr int NH = 16, HD = 64;
constexpr int NE = 32, TOPK = 4;
constexpr int MAXBLK = 544, MAXROWS = MAXBLK * 256;
constexpr float EPS = 1e-6f;
constexpr float LOG2E = 1.4426950408889634f;
constexpr float C2 = 0.125f * LOG2E;

constexpr size_t MiB = 1u << 20;
constexpr size_t WS_CTL = 0;
constexpr size_t WS_MODS = 1 * MiB;
constexpr size_t WS_RB2 = 1 * MiB + 3 * 8 * 6144 * 4;
constexpr size_t WS_FB2 = WS_RB2 + 2 * 8 * 32 * 4;
constexpr size_t WS_HIST = 2 * MiB;
constexpr size_t WS_BLKE = 2 * MiB + 65536;
constexpr size_t WS_TOPE = 3 * MiB;
constexpr size_t WS_TOPG = 4 * MiB;
constexpr size_t WS_DEST = 5 * MiB;
constexpr size_t WS_LIST = 6 * MiB;
constexpr size_t WS_ROWG = 7 * MiB;
constexpr size_t WS_VSTAT = 8 * MiB;
constexpr size_t WS_LOGF = 9 * MiB;
constexpr size_t WS_FC = 11 * MiB;
constexpr size_t WS_G3 = 13 * MiB;
constexpr size_t WS_WIN = 32 * MiB;
constexpr size_t WS_WOUT = 40 * MiB;
constexpr size_t WS_WKV = 44 * MiB;
constexpr size_t WS_WQG = 48 * MiB;
constexpr size_t WS_WO = 52 * MiB;
constexpr size_t WS_WS = 54 * MiB;
constexpr size_t WS_W1 = 64 * MiB;
constexpr size_t WS_W2 = 320 * MiB;
constexpr size_t WS_XN = 448 * MiB;
constexpr size_t WS_HKV = 512 * MiB;
constexpr size_t WS_XR = 576 * MiB;
constexpr size_t WS_Z = 704 * MiB;
constexpr size_t WS_GATED = 960 * MiB;
constexpr size_t WS_ACT = 704 * MiB;
constexpr size_t WS_YB = 976 * MiB;
constexpr size_t WS_PKV = 704 * MiB;
constexpr size_t WS_PQG = 960 * MiB;
constexpr size_t WS_Q = 1248 * MiB;
constexpr size_t WS_K = 1312 * MiB;
constexpr size_t WS_V = 1376 * MiB;
constexpr size_t WS_GS = 1440 * MiB;
constexpr size_t WS_O = 1504 * MiB;
constexpr size_t WS_END = 1568 * MiB;

__device__ __forceinline__ float bf2f(bf16_t v) { return __uint_as_float(((unsigned)v) << 16); }
__device__ __forceinline__ unsigned f2bf(float f) { unsigned u = __float_as_uint(f); return (u + 0x7fffu + ((u >> 16) & 1u)) >> 16; }
__device__ __forceinline__ unsigned pk2(float lo, float hi) { return f2bf(lo) | (f2bf(hi) << 16); }
__device__ __forceinline__ float wave_sum(float v) {
#pragma unroll
    for (int o = 1; o < 64; o <<= 1) v += __shfl_xor(v, o);
    return v;
}
__device__ __forceinline__ float siluf(float x) { return x / (1.f + expf(-x)); }
__device__ __forceinline__ float sigmoidf_(float x) { return 1.f / (1.f + expf(-x)); }

struct In {
    const float *x, *c, *ada_w, *ada_b, *norm_mix_g, *norm_ffn_g, *w_in, *v_g, *v_b, *w_s, *b_s, *w_out, *kv_ada_w, *kv_ada_b, *kv_norm_g, *kv_w, *k_norm_g, *fgate_b,
        *w_qg, *q_norm_g, *w_o, *router_w, *router_b, *exp_w1, *exp_b1, *exp_w2, *exp_b2, *final_g;
};

typedef const In __attribute__((address_space(4)))* InP;
__device__ __forceinline__ InP kin() { auto p = __builtin_amdgcn_kernarg_segment_ptr(); asm volatile("" : "+s"(p)); return (InP)p; }
__device__ __forceinline__ unsigned char* opq(unsigned char* p) { size_t z = 0; asm volatile("" : "+s"(z)); return p + z; }
struct KA { In in; unsigned char* ws; float* out; int L; int pad; };

__device__ __forceinline__ void transpose_item(const float* W, int K, int N, int ldw, bf16_t* WT, LAS float* scr, int item, int lane) {
    const int nblk = N / 32, kb = item / nblk, nb = item % nblk, k0 = 64 * kb, n0 = 32 * nb;
#pragma unroll 32
    for (int i = 0; i < 32; ++i) { const int kk = 2 * i + (lane >> 5); scr[kk * 33 + (lane & 31)] = W[(size_t)(k0 + kk) * ldw + n0 + (lane & 31)]; }
    __builtin_amdgcn_s_waitcnt(0xc07f); asm volatile("" ::: "memory");
    const int c = lane & 7;
#pragma unroll
    for (int j = 0; j < 4; ++j) { const int n = (lane >> 3) + 8 * j; const LAS float* s = scr + (8 * c) * 33 + n;
        u32x4 o; o.x = pk2(s[0 * 33], s[1 * 33]); o.y = pk2(s[2 * 33], s[3 * 33]); o.z = pk2(s[4 * 33], s[5 * 33]); o.w = pk2(s[6 * 33], s[7 * 33]);
        *(u32x4*)(WT + (size_t)(n0 + n) * K + k0 + 8 * c) = o; }
    __builtin_amdgcn_s_waitcnt(0xc07f); asm volatile("" ::: "memory");
}
constexpr int IT_WIN = 16 * 128, IT_WOUT = 32 * 32, IT_WKV = 16 * 64, IT_WQG = 16 * 64, IT_WO = 16 * 32, IT_W1 = 16 * 64  , IT_W2 = 16 * 32;
constexpr int IT_SMALL = IT_WIN + IT_WOUT + IT_WKV + IT_WQG + IT_WO;
constexpr int IT_ALL = IT_SMALL + 64 * IT_W1 + 64 * IT_W2;
constexpr int IT_FG = IT_SMALL + 32 * IT_W1 + 32 * IT_W2, IT_BG = 32 * IT_W1 + 32 * IT_W2;
__host__ __device__ __forceinline__ int fg_item(int i) { return i < IT_SMALL + 32 * IT_W1 ? i : i + 32 * IT_W1; }
__host__ __device__ __forceinline__ int bg_item(int k) { return k < 32 * IT_W1 ? IT_SMALL + 32 * IT_W1 + k : IT_SMALL + 64 * IT_W1 + 32 * IT_W2 + (k - 32 * IT_W1); }
constexpr int CW_CVT = 2048;
__device__ __forceinline__ void cvt_item(InP inp, unsigned char* ws, int it, LAS float* scr, int lane) {
    if (it < IT_WIN) { transpose_item(inp->w_in, 1024, 4096, 4096, (bf16_t*)(ws + WS_WIN), scr, it, lane); return; } it -= IT_WIN;
    if (it < IT_WOUT) { transpose_item(inp->w_out, 2048, 1024, 1024, (bf16_t*)(ws + WS_WOUT), scr, it, lane); return; } it -= IT_WOUT;
    if (it < IT_WKV) { transpose_item(inp->kv_w, 1024, 2048, 2064, (bf16_t*)(ws + WS_WKV), scr, it, lane); return; } it -= IT_WKV;
    if (it < IT_WQG) { transpose_item(inp->w_qg, 1024, 2048, 2048, (bf16_t*)(ws + WS_WQG), scr, it, lane); return; } it -= IT_WQG;
    if (it < IT_WO) { transpose_item(inp->w_o, 1024, 1024, 1024, (bf16_t*)(ws + WS_WO), scr, it, lane); return; } it -= IT_WO;
    if (it < 64 * IT_W1) { const int e = it / IT_W1; transpose_item(inp->exp_w1 + (size_t)e * 1024 * 2048, 1024, 2048, 2048, (bf16_t*)(ws + WS_W1) + (size_t)e * 2048 * 1024, scr, it % IT_W1, lane); return; } it -= 64 * IT_W1;
    { const int e = it / IT_W2; transpose_item(inp->exp_w2 + (size_t)e * 1024 * 1024, 1024, 1024, 1024, (bf16_t*)(ws + WS_W2) + (size_t)e * 1024 * 1024, scr, it % IT_W2, lane); }
}
constexpr int ADA_ITEMS = 96 + 96 + 32;
__device__ __forceinline__ void ada_item(InP inp, float* mods, int item, const LAS float* sc  , LAS float* red  , int tid) {
    const int lane = tid & 63, wave = tid >> 6;
    int which, cg; const float* w; const float* bias; int ldw;
    if (item < 96) { which = 0; cg = item; w = inp->ada_w; bias = inp->ada_b; ldw = 6144; }
    else if (item < 192) { which = 1; cg = item - 96; w = inp->ada_w + (size_t)1024 * 6144; bias = inp->ada_b + 6144; ldw = 6144; }
    else { which = 2; cg = item - 192; w = inp->kv_ada_w; bias = inp->kv_ada_b; ldw = 2048; }
    const int col = cg * 64 + lane;
    float acc[8];
#pragma unroll
    for (int b = 0; b < 8; ++b) acc[b] = 0.f;
    for (int k = wave * 128; k < wave * 128 + 128; ++k) {
        const float wv = w[(size_t)k * ldw + col];
#pragma unroll
        for (int b = 0; b < 8; ++b) acc[b] += sc[b * 1024 + k] * wv;
    }
#pragma unroll
    for (int b = 0; b < 8; ++b) red[(wave * 8 + b) * 64 + lane] = acc[b];
    __syncthreads();
    {
        const int b = tid >> 6; float s = 0.f;
#pragma unroll
        for (int w8 = 0; w8 < 8; ++w8) s += red[(w8 * 8 + b) * 64 + lane];
        mods[((size_t)which * 8 + b) * 6144 + col] = s + bias[col];
    }
    __syncthreads();
}
__device__ __forceinline__ void row_load(const float* xrow, int lane, f32x4 (&v)[4]) {
#pragma unroll
    for (int j = 0; j < 2; ++j) { v[2 * j] = ((const f32x4*)xrow)[2 * lane + 128 * j]; v[2 * j + 1] = ((const f32x4*)xrow)[2 * lane + 128 * j + 1]; }
}
__device__ __forceinline__ void bf8_to_f32(u32x4 w, f32x4& a, f32x4& b) {
    a = (f32x4){__uint_as_float(w.x << 16), __uint_as_float(w.x & 0xffff0000u), __uint_as_float(w.y << 16), __uint_as_float(w.y & 0xffff0000u)};
    b = (f32x4){__uint_as_float(w.z << 16), __uint_as_float(w.z & 0xffff0000u), __uint_as_float(w.w << 16), __uint_as_float(w.w & 0xffff0000u)};
}
__device__ __forceinline__ void row_load_bf(const bf16_t* xrow, int lane, f32x4 (&v)[4]) {
#pragma unroll
    for (int j = 0; j < 2; ++j) bf8_to_f32(((const u32x4*)xrow)[lane + 64 * j], v[2 * j], v[2 * j + 1]);
}
__device__ __forceinline__ float row_rstd(const f32x4 (&v)[4]) {
    float s = 0.f;
#pragma unroll
    for (int j = 0; j < 4; ++j) s += (v[j].x * v[j].x + v[j].y * v[j].y) + (v[j].z * v[j].z + v[j].w * v[j].w);
    return 1.f / sqrtf(wave_sum(s) * (1.f / 1024.f) + EPS);
}
__device__ __forceinline__ f32x4 row_vec(const float* p, int lane, int q) { return ((const f32x4*)p)[2 * lane + 128 * (q >> 1) + (q & 1)]; }
__device__ __forceinline__ void row_modnorm(const f32x4 (&v)[4], float rstd, const float* g, const float* sh, const float* sc, int lane, f32x4 (&h)[4]) {
#pragma unroll
    for (int q = 0; q < 4; ++q) h[q] = (v[q] * rstd * row_vec(g, lane, q)) * (1.f + row_vec(sc, lane, q)) + row_vec(sh, lane, q);
}
__device__ __forceinline__ void row_store_bf16(bf16_t* orow, int lane, const f32x4 (&h)[4]) {
#pragma unroll
    for (int j = 0; j < 2; ++j) { u32x4 w; w.x = pk2(h[2 * j].x, h[2 * j].y); w.y = pk2(h[2 * j].z, h[2 * j].w); w.z = pk2(h[2 * j + 1].x, h[2 * j + 1].y); w.w = pk2(h[2 * j + 1].z, h[2 * j + 1].w);
        ((u32x4*)orow)[lane + 64 * j] = w; }
}

__device__ __forceinline__ void row4_norm_mod_store(const float* xrow, const float* g, const float* sh, const float* sc, bf16_t* orow, int lane) {
    f32x4 v[4]; float s = 0.f;
#pragma unroll
    for (int j = 0; j < 4; ++j) { v[j] = ((const f32x4*)xrow)[lane + 64 * j]; s += (v[j].x * v[j].x + v[j].y * v[j].y) + (v[j].z * v[j].z + v[j].w * v[j].w); }
    const float rstd = 1.f / sqrtf(wave_sum(s) * (1.f / 1024.f) + EPS);
#pragma unroll
    for (int j = 0; j < 4; ++j) { const f32x4 gg = ((const f32x4*)g)[lane + 64 * j], s1 = ((const f32x4*)sc)[lane + 64 * j], s0 = ((const f32x4*)sh)[lane + 64 * j];
        const f32x4 h = (v[j] * rstd * gg) * (1.f + s1) + s0; u32x2 w; w.x = pk2(h.x, h.y); w.y = pk2(h.z, h.w); ((u32x2*)orow)[lane + 64 * j] = w; }
}
__device__ __forceinline__ void row_store_f32(float* orow, int lane, const f32x4 (&h)[4]) {
#pragma unroll
    for (int j = 0; j < 2; ++j)
#pragma unroll
        for (int sq = 0; sq < 2; ++sq) { const int src = 32 * sq + (lane >> 1); f32x4 a, c;
#pragma unroll
            for (int i = 0; i < 4; ++i) { a[i] = __shfl(h[2 * j][i], src); c[i] = __shfl(h[2 * j + 1][i], src); }
            ((f32x4*)orow)[128 * j + 64 * sq + lane] = (lane & 1) ? c : a; }
}

__device__ __forceinline__ void route_row(const LAS float* hs  , const float* rw, const float* rb, int lane, int (&te)[4], float (&tg)[4]) {
    const int e = lane & 31, half = lane >> 5; float acc = 0.f;
    for (int k = half * 512; k < half * 512 + 512; ++k) acc += hs[k] * rw[k * 32 + e];
    acc += __shfl_xor(acc, 32);
    float val = acc + rb[e];
    float tv[4];
#pragma unroll
    for (int q = 0; q < 4; ++q) {
        float bv = val; int bi = e;
#pragma unroll
        for (int o = 1; o < 32; o <<= 1) { const float ov = __shfl_xor(bv, o); const int oi = __shfl_xor(bi, o); if (ov > bv || (ov == bv && oi < bi)) { bv = ov; bi = oi; } }
        te[q] = bi; tv[q] = bv; if (e == bi) val = -INFINITY;
    }
    float s = 0.f;
#pragma unroll
    for (int q = 0; q < 4; ++q) { tg[q] = expf(tv[q] - tv[0]); s += tg[q]; }
#pragma unroll
    for (int q = 0; q < 4; ++q) tg[q] /= s;
}

namespace pg {
constexpr int BM = 256, BK = 64, HALF = 128, HTB = HALF * BK * 2  , STAGE_BYTES = 8 * HTB, NXCD = 8, WGM = 8;
__host__ __device__ __forceinline__ int lds_byte(int r, int c) { const int st = (r >> 4) * 2 + (c >> 5), rr = r & 15, cc = c & 31, ob = rr * 64 + cc * 2; return st * 1024 + (ob ^ (((ob >> 9) & 1) << 5)); }
__host__ __device__ __forceinline__ void stage_rc(int b, int& R, int& C) { const int st = b / 1024, sb = b % 1024, swz = sb ^ (((sb >> 9) & 1) << 5); R = (st >> 1) * 16 + swz / 64; C = (st & 1) * 32 + (swz % 64) / 2; }
__host__ __device__ __forceinline__ int perm32(int rho) { const int n = rho >> 4, i = rho & 15; return 8 * (i >> 2) + 4 * n + (i & 3); }
struct Unit { int pm, pn; };
struct StaticOrder {
    int nM, nN, nwg, G, c;
    __device__ void init(int nM_, int nN_, int G_, int c_) { nM = nM_; nN = nN_; nwg = nM * nN; G = G_; c = c_; }
    __device__ bool next(int i, Unit& u) const {
        const long L = (long)i * G + c; if (L >= nwg) return false;
        int wgid = (int)L; { const int q = nwg / NXCD, r = nwg % NXCD, xcd = wgid % NXCD, off = wgid / NXCD; wgid = (xcd < r ? xcd * (q + 1) : r * (q + 1) + (xcd - r) * q) + off; }
        const int nig = WGM * nN, gid = wgid / nig, fm = gid * WGM, gsz = (nM - fm) < WGM ? (nM - fm) : WGM;
        u.pm = fm + ((wgid % nig) % gsz); u.pn = (wgid % nig) / gsz; return true;
    }
};
__device__ __forceinline__ unsigned cvt_pk_bf16(float lo, float hi) { unsigned r; asm volatile("v_cvt_pk_bf16_f32 %0, %1, %2" : "=v"(r) : "v"(lo), "v"(hi)); return r; }
typedef float f32x2 __attribute__((ext_vector_type(2)));
__device__ __forceinline__ f32x2 gelu_pk(f32x2 v) {
    const f32x2 av = __builtin_elementwise_abs(v), d = av * 0.2316418882f + 1.0f;
    f32x2 t; t.x = __builtin_amdgcn_rcpf(d.x); t.y = __builtin_amdgcn_rcpf(d.y);
    f32x2 q = t * 0.5307027145f + (-0.7265760135f); q = q * t + 0.7107068705f; q = q * t + (-0.142248368f); q = q * t + 0.127414796f; q = q * t;
    const f32x2 s = (v * v) * (-0.72134752044f);
    f32x2 e; e.x = __builtin_amdgcn_exp2f(s.x); e.y = __builtin_amdgcn_exp2f(s.y);
    const f32x2 m = v * (q * e), r = v - m;
    f32x2 o; o.x = v.x < 0.f ? m.x : r.x; o.y = v.y < 0.f ? m.y : r.y; return o;
}
__device__ __forceinline__ float fast_sigmoid(float x) { return __builtin_amdgcn_rcpf(1.f + __builtin_amdgcn_exp2f(-LOG2E * x)); }

template <bool PERM> struct SrcPlain { const char* B; int K2;
    __device__ __forceinline__ unsigned arow_off(const Unit& u, int h, int R) const { return (unsigned)(u.pm * BM + h * HALF + R) * (unsigned)K2; }
    __device__ __forceinline__ const char* bhalf(const Unit& u, int h) const { return B + (size_t)(u.pn * BM + h * HALF) * K2; }
    static __device__ __forceinline__ int brow(int R) { return PERM ? ((R & ~31) + perm32(R & 31)) : R; } };
struct SrcHeads { const char* B; int K2;
    __device__ __forceinline__ unsigned arow_off(const Unit& u, int h, int R) const { return (unsigned)(u.pm * BM + h * HALF + R) * (unsigned)K2; }
    __device__ __forceinline__ const char* bhalf(const Unit& u, int h) const { return B + (size_t)(u.pn * BM + h * 32) * K2; }
    static __device__ __forceinline__ int brow(int R) { return 64 * (R >> 5) + perm32(R & 31); } };
struct SrcMoeA { const char* W1; const int* list; const int* blke; int K2;
    __device__ __forceinline__ unsigned arow_off(const Unit& u, int h, int R) const { int t = list[u.pm * BM + h * HALF + R]; t = t < 0 ? 0 : t; return (unsigned)t * (unsigned)K2; }
    __device__ __forceinline__ const char* bhalf(const Unit& u, int h) const { const int e = blke[u.pm]; return W1 + ((size_t)e * 2048 + h * 1024 + u.pn * 128) * K2; }
    static __device__ __forceinline__ int brow(int R) { return (R & ~31) + perm32(R & 31); } };
struct SrcMoeB { const char* W2; const int* blke; int K2;
    __device__ __forceinline__ unsigned arow_off(const Unit& u, int h, int R) const { return (unsigned)(u.pm * BM + h * HALF + R) * (unsigned)K2; }
    __device__ __forceinline__ const char* bhalf(const Unit& u, int h) const { const int e = blke[u.pm]; return W2 + ((size_t)e * 1024 + u.pn * BM + h * HALF) * K2; }
    static __device__ __forceinline__ int brow(int R) { return (R & ~31) + perm32(R & 31); } };

struct EpGeluZ { bf16_t* Z;
    __device__ __forceinline__ void operator()(const f32x4 (&acc)[2][2][4][2], const Unit& u, int wr, int wc, int fr, int fq) const {
        const int row0 = u.pm * BM + wr * 64 + fr, col0 = u.pn * BM + wc * 32 + 8 * fq;
#pragma unroll
        for (int ai = 0; ai < 2; ++ai)
#pragma unroll
            for (int m = 0; m < 4; ++m) { bf16_t* rowp = Z + (size_t)(row0 + ai * HALF + m * 16) * 4096 + col0;
#pragma unroll
                for (int bj = 0; bj < 2; ++bj) { const f32x4 v0 = acc[ai][bj][m][0], v1 = acc[ai][bj][m][1];
                    const f32x2 a = gelu_pk((f32x2){v0[0], v0[1]}), b = gelu_pk((f32x2){v0[2], v0[3]}), c = gelu_pk((f32x2){v1[0], v1[1]}), d = gelu_pk((f32x2){v1[2], v1[3]});
                    u32x4 w; w.x = cvt_pk_bf16(a.x, a.y); w.y = cvt_pk_bf16(b.x, b.y); w.z = cvt_pk_bf16(c.x, c.y); w.w = cvt_pk_bf16(d.x, d.y);
                    *(u32x4*)(rowp + bj * HALF) = w; } }
    } };
template <bool F32BASE> struct EpResid { const void* base; bf16_t* out; const float* gate;
    __device__ __forceinline__ void operator()(const f32x4 (&acc)[2][2][4][2], const Unit& u, int wr, int wc, int fr, int fq) const {
        const int b = u.pm >> 4; const float* gt = gate + (size_t)b * 6144; const int col0 = u.pn * BM + wc * 32 + 8 * fq;
        f32x4 gv[2][2];
#pragma unroll
        for (int bj = 0; bj < 2; ++bj)
#pragma unroll
            for (int n = 0; n < 2; ++n) gv[bj][n] = *(const f32x4*)(gt + col0 + bj * HALF + 4 * n);
#pragma unroll
        for (int ai = 0; ai < 2; ++ai)
#pragma unroll
            for (int m = 0; m < 4; ++m) { const size_t off = (size_t)(u.pm * BM + ai * HALF + wr * 64 + m * 16 + fr) * DM + col0;
#pragma unroll
                for (int bj = 0; bj < 2; ++bj) { f32x4 b0, b1;
                    if constexpr (F32BASE) { b0 = *(const f32x4*)((const float*)base + off + bj * HALF); b1 = *(const f32x4*)((const float*)base + off + bj * HALF + 4); }
                    else bf8_to_f32(*(const u32x4*)((const bf16_t*)base + off + bj * HALF), b0, b1);
                    const f32x4 r0 = b0 + gv[bj][0] * acc[ai][bj][m][0], r1 = b1 + gv[bj][1] * acc[ai][bj][m][1];
                    u32x4 w; w.x = cvt_pk_bf16(r0[0], r0[1]); w.y = cvt_pk_bf16(r0[2], r0[3]); w.z = cvt_pk_bf16(r1[0], r1[1]); w.w = cvt_pk_bf16(r1[2], r1[3]);
                    *(u32x4*)(out + off + bj * HALF) = w; } }
    } };
struct EpSwiglu { bf16_t* act; const float* b1; const int* blke;
    __device__ __forceinline__ void operator()(const f32x4 (&acc)[2][2][4][2], const Unit& u, int wr, int wc, int fr, int fq) const {
        const int e = blke[u.pm]; const int col0 = u.pn * 128 + wc * 32 + 8 * fq; const float* bb = b1 + (size_t)e * 2048 + col0;
        f32x4 bg[2], bl[2];
#pragma unroll
        for (int n = 0; n < 2; ++n) { bg[n] = *(const f32x4*)(bb + 4 * n); bl[n] = *(const f32x4*)(bb + 1024 + 4 * n); }
#pragma unroll
        for (int ai = 0; ai < 2; ++ai)
#pragma unroll
            for (int m = 0; m < 4; ++m) { const int row = u.pm * BM + ai * HALF + wr * 64 + m * 16 + fr; float a[8];
#pragma unroll
                for (int n = 0; n < 2; ++n) { const f32x4 g4 = acc[ai][0][m][n] + bg[n], l4 = acc[ai][1][m][n] + bl[n];
#pragma unroll
                    for (int j = 0; j < 4; j += 2) {
                        f32x2 g = {fminf(g4[j], 7.f), fminf(g4[j + 1], 7.f)}; f32x2 l = {__builtin_amdgcn_fmed3f(l4[j], -7.f, 7.f), __builtin_amdgcn_fmed3f(l4[j + 1], -7.f, 7.f)};
                        const f32x2 x = g * (-1.702f * LOG2E); f32x2 e; e.x = __builtin_amdgcn_exp2f(x.x); e.y = __builtin_amdgcn_exp2f(x.y);
                        const f32x2 d = e + 1.0f; f32x2 r; r.x = __builtin_amdgcn_rcpf(d.x); r.y = __builtin_amdgcn_rcpf(d.y);
                        const f32x2 o = (l + 1.0f) * (g * r); a[4 * n + j] = o.x; a[4 * n + j + 1] = o.y; } }
                u32x4 w; w.x = cvt_pk_bf16(a[0], a[1]); w.y = cvt_pk_bf16(a[2], a[3]); w.z = cvt_pk_bf16(a[4], a[5]); w.w = cvt_pk_bf16(a[6], a[7]);
                *(u32x4*)(act + (size_t)row * 1024 + col0) = w; }
    } };
struct EpMoeOut { bf16_t* yb; const float* b2; const int* blke; const float* rowg;
    __device__ __forceinline__ void operator()(const f32x4 (&acc)[2][2][4][2], const Unit& u, int wr, int wc, int fr, int fq) const {
        const int e = blke[u.pm]; const int col0 = u.pn * BM + wc * 32 + 8 * fq;
        f32x4 bv[2][2];
#pragma unroll
        for (int bj = 0; bj < 2; ++bj)
#pragma unroll
            for (int n = 0; n < 2; ++n) bv[bj][n] = *(const f32x4*)(b2 + (size_t)e * 1024 + col0 + bj * HALF + 4 * n);
#pragma unroll
        for (int ai = 0; ai < 2; ++ai)
#pragma unroll
            for (int m = 0; m < 4; ++m) { const int row = u.pm * BM + ai * HALF + wr * 64 + m * 16 + fr; const float rg = rowg[row];
#pragma unroll
                for (int bj = 0; bj < 2; ++bj) { const f32x4 v0 = (acc[ai][bj][m][0] + bv[bj][0]) * rg, v1 = (acc[ai][bj][m][1] + bv[bj][1]) * rg;
                    u32x4 w; w.x = cvt_pk_bf16(v0[0], v0[1]); w.y = cvt_pk_bf16(v0[2], v0[3]); w.z = cvt_pk_bf16(v1[0], v1[1]); w.w = cvt_pk_bf16(v1[2], v1[3]);
                    *(u32x4*)(yb + (size_t)row * 1024 + col0 + bj * HALF) = w; } }
    } };
template <int MODE> struct EpHeads { bf16_t* o0; bf16_t* o1; const float* g;
    __device__ __forceinline__ void operator()(const f32x4 (&acc)[2][2][4][2], const Unit& u, int wr, int wc, int fr, int fq) const {
        const bool first = u.pn < 4; bf16_t* O = first ? o0 : o1; const int colbase = (u.pn & 3) * 256 + wc * 64 + 8 * fq;
        f32x4 gv[2][2];
#pragma unroll
        for (int bj = 0; bj < 2; ++bj)
#pragma unroll
            for (int n = 0; n < 2; ++n) gv[bj][n] = *(const f32x4*)(g + 32 * bj + 8 * fq + 4 * n);
#pragma unroll
        for (int ai = 0; ai < 2; ++ai)
#pragma unroll
            for (int m = 0; m < 4; ++m) { const int row = u.pm * BM + ai * HALF + wr * 64 + m * 16 + fr; f32x4 v[2][2];
                if (first) { float ss = 0.f;
#pragma unroll
                    for (int bj = 0; bj < 2; ++bj)
#pragma unroll
                        for (int n = 0; n < 2; ++n) { const f32x4 x = acc[ai][bj][m][n]; ss += (x[0] * x[0] + x[1] * x[1]) + (x[2] * x[2] + x[3] * x[3]); }
                    ss += __shfl_xor(ss, 16); ss += __shfl_xor(ss, 32);
                    float r = 1.f / sqrtf(ss * (1.f / 64.f) + EPS); if (MODE == 1) r *= C2;
#pragma unroll
                    for (int bj = 0; bj < 2; ++bj)
#pragma unroll
                        for (int n = 0; n < 2; ++n) v[bj][n] = acc[ai][bj][m][n] * r * gv[bj][n];
                } else {
#pragma unroll
                    for (int bj = 0; bj < 2; ++bj)
#pragma unroll
                        for (int n = 0; n < 2; ++n) { f32x4 x = acc[ai][bj][m][n]; if (MODE == 1) { x[0] = fast_sigmoid(x[0]); x[1] = fast_sigmoid(x[1]); x[2] = fast_sigmoid(x[2]); x[3] = fast_sigmoid(x[3]); } v[bj][n] = x; }
                }
#pragma unroll
                for (int bj = 0; bj < 2; ++bj) { u32x4 w; w.x = cvt_pk_bf16(v[bj][0][0], v[bj][0][1]); w.y = cvt_pk_bf16(v[bj][0][2], v[bj][0][3]); w.z = cvt_pk_bf16(v[bj][1][0], v[bj][1][1]); w.w = cvt_pk_bf16(v[bj][1][2], v[bj][1][3]);
                    *(u32x4*)(O + (size_t)row * DM + colbase + 32 * bj) = w; } }
    } };

template <class Epi, class Sched, class Src, bool ALIGN_EPI>
__device__ __forceinline__ void gemm_phase(LAS unsigned char* lds, const char* Abase, int K, const Sched& S, const Src& src, const Epi& E) {
    int tid_ = threadIdx.x; asm volatile("" : "+v"(tid_));
    const int tid = tid_, wid = __builtin_amdgcn_readfirstlane(tid >> 6), lane = tid & 63, wr = wid >> 2, wc = wid & 3, fr = lane & 15, fq = lane >> 4;
    const int nt = K / BK;
    int sR[2], sC[2]; unsigned voffB[2];
#pragma unroll
    for (int i = 0; i < 2; ++i) { stage_rc(tid * 16 + i * 8192, sR[i], sC[i]); voffB[i] = (unsigned)(Src::brow(sR[i]) * K + sC[i]) * 2u; }
    const size_t kstep = (size_t)(BK * 2);
    const unsigned ldsw = (unsigned)wid * 1024u;
    const int aoff = lds_byte(wr * 64 + fr, fq * 8), boff = lds_byte(wc * 32 + fr, fq * 8);
#define PG_SA(b, h) (((b) * 2 + (h)) * HTB)
#define PG_SB(b, h) ((4 + (b) * 2 + (h)) * HTB)
#define PG_STAGE(bufoff, gbase, v0, v1) do { \
        __builtin_amdgcn_global_load_lds((const unsigned*)((const char*)(gbase) + (v0)), (LAS unsigned*)(lds + (bufoff) + ldsw), 16, 0, 0); \
        __builtin_amdgcn_global_load_lds((const unsigned*)((const char*)(gbase) + (v1)), (LAS unsigned*)(lds + (bufoff) + ldsw + 8192), 16, 0, 0); } while (0)
#define PG_LDA(dst, b, h) do { _Pragma("unroll") for (int m = 0; m < 4; ++m) _Pragma("unroll") for (int k = 0; k < 2; ++k) dst[m][k] = *(const LAS bf16x8*)(lds + PG_SA(b, h) + aoff + m * 2048 + k * 1024); } while (0)
#define PG_LDB(dst, b, h) do { _Pragma("unroll") for (int n = 0; n < 2; ++n) _Pragma("unroll") for (int k = 0; k < 2; ++k) dst[n][k] = *(const LAS bf16x8*)(lds + PG_SB(b, h) + boff + n * 2048 + k * 1024); } while (0)
#define PG_MMA(ai, bj, At, Bt) do { __builtin_amdgcn_s_setprio(1); _Pragma("unroll") for (int m = 0; m < 4; ++m) _Pragma("unroll") for (int n = 0; n < 2; ++n) _Pragma("unroll") for (int k = 0; k < 2; ++k) \
        acc[ai][bj][m][n] = __builtin_amdgcn_mfma_f32_16x16x32_bf16(Bt[n][k], At[m][k], acc[ai][bj][m][n], 0, 0, 0); __builtin_amdgcn_s_setprio(0); } while (0)
#define PG_WAIT_V(n) asm volatile("s_waitcnt vmcnt(" #n ")" ::: "memory")
#define PG_WAIT_L(n) asm volatile("s_waitcnt lgkmcnt(" #n ")" ::: "memory")
#define PG_BAR __builtin_amdgcn_s_barrier()
#define PG_SCHED __builtin_amdgcn_sched_barrier(0)
    Unit cur, nxt; int ui = 0;
    if (!S.next(0, cur)) return;
    f32x4 acc[2][2][4][2];
#pragma unroll
    for (int a = 0; a < 2; ++a)
#pragma unroll
        for (int b = 0; b < 2; ++b)
#pragma unroll
            for (int m = 0; m < 4; ++m)
#pragma unroll
                for (int n = 0; n < 2; ++n) acc[a][b][m][n] = (f32x4){0.f, 0.f, 0.f, 0.f};
    bf16x8 At[4][2], B0[2][2], B1[2][2];
    unsigned vc[2][2], vn[2][2];
#pragma unroll
    for (int h = 0; h < 2; ++h)
#pragma unroll
        for (int i = 0; i < 2; ++i) vc[h][i] = src.arow_off(cur, h, sR[i]) + (unsigned)sC[i] * 2u;
    const char* cB0 = src.bhalf(cur, 0); const char* cB1 = src.bhalf(cur, 1);
    const char* const cA = Abase;
    PG_STAGE(PG_SB(0, 0), cB0, voffB[0], voffB[1]); PG_STAGE(PG_SB(0, 1), cB1, voffB[0], voffB[1]); PG_STAGE(PG_SA(0, 0), cA, vc[0][0], vc[0][1]); PG_STAGE(PG_SA(0, 1), cA, vc[1][0], vc[1][1]);
    if (wr == 1) PG_BAR;
    PG_WAIT_V(2); PG_BAR;
    PG_STAGE(PG_SB(1, 0), cB0 + kstep, voffB[0], voffB[1]); PG_STAGE(PG_SA(1, 0), cA + kstep, vc[0][0], vc[0][1]); PG_STAGE(PG_SB(1, 1), cB1 + kstep, voffB[0], voffB[1]);
    PG_WAIT_V(6); PG_BAR;
    for (;;) {
        const bool has_next = S.next(ui + 1, nxt);
        const char* nB0 = cB0; const char* nB1 = cB1;
#pragma unroll
        for (int h = 0; h < 2; ++h)
#pragma unroll
            for (int i = 0; i < 2; ++i) vn[h][i] = vc[h][i];
        if (has_next) { nB0 = src.bhalf(nxt, 0); nB1 = src.bhalf(nxt, 1);
#pragma unroll
            for (int h = 0; h < 2; ++h)
#pragma unroll
                for (int i = 0; i < 2; ++i) vn[h][i] = src.arow_off(nxt, h, sR[i]) + (unsigned)sC[i] * 2u; }
        asm volatile("" : "+v"(vn[0][0]), "+v"(vn[0][1]), "+v"(vn[1][0]), "+v"(vn[1][1]));
        for (int t = 0; t < nt; t += 2) {
            const bool last = (t == nt - 2);
            const char* a1 = cA + (size_t)(t + 1) * kstep;
            const char* a2 = last ? cA : cA + (size_t)(t + 2) * kstep; const char* a3 = a2 + kstep;
            const char* b20 = last ? nB0 : cB0 + (size_t)(t + 2) * kstep; const char* b21 = last ? nB1 : cB1 + (size_t)(t + 2) * kstep;
            const char* b30 = b20 + kstep; const char* b31 = b21 + kstep;
            const unsigned w00 = last ? vn[0][0] : vc[0][0], w01 = last ? vn[0][1] : vc[0][1], w10 = last ? vn[1][0] : vc[1][0], w11 = last ? vn[1][1] : vc[1][1];
            PG_LDB(B0, 0, 0); PG_LDB(B1, 0, 1); PG_SCHED; PG_LDA(At, 0, 0); PG_STAGE(PG_SA(1, 1), a1, vc[1][0], vc[1][1]);
            PG_WAIT_V(8); PG_WAIT_L(0); PG_BAR; PG_MMA(0, 0, At, B0); PG_MMA(0, 1, At, B1); PG_BAR; PG_SCHED;
            PG_LDA(At, 0, 1); PG_STAGE(PG_SB(0, 0), b20, voffB[0], voffB[1]); PG_STAGE(PG_SB(0, 1), b21, voffB[0], voffB[1]); PG_STAGE(PG_SA(0, 0), a2, w00, w01);
            PG_WAIT_V(8); PG_WAIT_L(0); PG_BAR; PG_MMA(1, 0, At, B0); PG_MMA(1, 1, At, B1); PG_BAR; PG_SCHED;
            PG_LDB(B0, 1, 0); PG_LDB(B1, 1, 1); PG_SCHED; PG_LDA(At, 1, 0); PG_STAGE(PG_SA(0, 1), a2, w10, w11);
            PG_WAIT_V(8); PG_WAIT_L(0); PG_BAR; PG_MMA(0, 0, At, B0); PG_MMA(0, 1, At, B1); PG_BAR; PG_SCHED;
            PG_LDA(At, 1, 1); PG_STAGE(PG_SB(1, 0), b30, voffB[0], voffB[1]); PG_STAGE(PG_SB(1, 1), b31, voffB[0], voffB[1]); PG_STAGE(PG_SA(1, 0), a3, w00, w01);
            PG_WAIT_V(8); PG_WAIT_L(0); PG_BAR; PG_MMA(1, 0, At, B0); PG_MMA(1, 1, At, B1); PG_BAR; PG_SCHED;
        }
        if constexpr (ALIGN_EPI) { if (wr == 0) PG_BAR; }
        E(acc, cur, wr, wc, fr, fq);
        if (!has_next) break;
#pragma unroll
        for (int a = 0; a < 2; ++a)
#pragma unroll
            for (int b = 0; b < 2; ++b)
#pragma unroll
                for (int m = 0; m < 4; ++m)
#pragma unroll
                    for (int n = 0; n < 2; ++n) acc[a][b][m][n] = (f32x4){0.f, 0.f, 0.f, 0.f};
        cur = nxt; cB0 = nB0; cB1 = nB1; ++ui;
#pragma unroll
        for (int h = 0; h < 2; ++h)
#pragma unroll
            for (int i = 0; i < 2; ++i) vc[h][i] = vn[h][i];
        if constexpr (ALIGN_EPI) { if (wr == 1) PG_BAR; }
    }
    PG_WAIT_V(0);
    if constexpr (!ALIGN_EPI) { if (wr == 0) PG_BAR; }
    PG_BAR;
#undef PG_SA
#undef PG_SB
#undef PG_STAGE
#undef PG_LDA
#undef PG_LDB
#undef PG_MMA
#undef PG_WAIT_V
#undef PG_WAIT_L
#undef PG_BAR
#undef PG_SCHED
}
}
#include <hip/hip_bf16.h>
#include <cmath>
namespace attn_body {
using bf16=__hip_bfloat16;
using bf16x8=__attribute__((ext_vector_type(8)))short;
using s16x4=__attribute__((ext_vector_type(4)))short;
using f32x16=__attribute__((ext_vector_type(16)))float;
using u32x4=__attribute__((ext_vector_type(4)))unsigned;
constexpr int BATCH=8,NHEAD=16,SEQ=4096,D=64,DM=NHEAD*D;
constexpr int NW=8,QBLK=32,QB=QBLK*NW,KVBLK=64,NQB=SEQ/QB;
constexpr int ATTN_PITCH=DM, ATTN_UNIT_ROWS=QB;
__device__ __forceinline__ int crow(int r,int hi){return (r&3)+8*(r>>2)+4*hi;}
#define SBAR() __builtin_amdgcn_sched_barrier(0)
__device__ __forceinline__ void cmask(f32x16&p0,f32x16&p1,int jb,int qrel,int hi){
  const float NEG=-INFINITY; int kb=64*jb+4*hi;
  #pragma unroll
  for(int r=0;r<16;++r){int kv=kb+(r&3)+8*(r>>2); if(kv>qrel)p0[r]=NEG; if(kv+32>qrel)p1[r]=NEG;}
}

constexpr int NSLOT=3, SLOTB=8192;
constexpr int LDS_K=0, LDS_V=NSLOT*SLOTB, LDS_WS=2*NSLOT*SLOTB, LDS_OST=LDS_WS+NW*64*4, LDS_GPAD=LDS_OST+NW*4096, LDS_G3=LDS_GPAD+128*8, LDS_BYTES=LDS_G3+SEQ*8;
constexpr float C2_=0.125f*1.4426950408889634f;
__device__ __forceinline__ void glds16(const void*gsrc,unsigned lds_dst){unsigned keep;
  asm volatile("s_mov_b32 %0, m0\n\ts_mov_b32 m0, %2\n\ts_nop 0\n\tglobal_load_lds_dwordx4 %1, off\n\ts_mov_b32 m0, %0":"=&s"(keep):"v"(gsrc),"s"(lds_dst):"memory");}
__device__ __forceinline__ float max3f(float a,float b,float c){float r;asm("v_max3_f32 %0, %1, %2, %3":"=v"(r):"v"(a),"v"(b),"v"(c));return r;}
__device__ __forceinline__ float max2f(float a,float b){float r;asm("v_max_f32_e32 %0, %1, %2":"=v"(r):"v"(a),"v"(b));return r;}
__device__ __forceinline__ float fadd_s(float a,float b){float r;asm("v_add_f32_e32 %0, %1, %2":"=v"(r):"v"(a),"v"(b));return r;}
__device__ __forceinline__ float fsub_s(float a,float b){float r;asm("v_sub_f32_e32 %0, %1, %2":"=v"(r):"v"(a),"v"(b));return r;}
typedef float f32x2_t __attribute__((ext_vector_type(2))); typedef __bf16 bf16x2_t __attribute__((ext_vector_type(2)));
__device__ __forceinline__ unsigned cvtpk_s(float lo,float hi){f32x2_t v={lo,hi};bf16x2_t b=__builtin_convertvector(v,bf16x2_t);return __builtin_bit_cast(unsigned,b);}
#define WAIT_BAR(N) asm volatile("s_waitcnt vmcnt(" #N ") lgkmcnt(0)\n\ts_barrier":::"memory")

__device__ __forceinline__ void qkt(f32x16&p0,f32x16&p1,const char*Kslot,const bf16x8*qr,bf16x8 ka0,bf16x8 ka1,bf16x8 qa,int r32,int hi){
  const char*kb=Kslot+hi*1024+r32*16;
  { const f32x16 z=f32x16{}; p0=__builtin_amdgcn_mfma_f32_32x32x16_bf16(ka0,qa,z,0,0,0); p1=__builtin_amdgcn_mfma_f32_32x32x16_bf16(ka1,qa,z,0,0,0); }
  #pragma unroll
  for(int d0=0;d0<4;++d0){
    const bf16x8 b0=*reinterpret_cast<const bf16x8*>(kb+d0*2048);
    const bf16x8 b1=*reinterpret_cast<const bf16x8*>(kb+d0*2048+512);
    p0=__builtin_amdgcn_mfma_f32_32x32x16_bf16(b0,qr[d0],p0,0,0,0);p1=__builtin_amdgcn_mfma_f32_32x32x16_bf16(b1,qr[d0],p1,0,0,0);}
}
typedef __attribute__((address_space(3))) const char* lds_cptr;
typedef short v4i16_t __attribute__((ext_vector_type(4)));
__device__ __forceinline__ void kload8(bf16x8*kf,lds_cptr kp){
  kf[0]=*(const __attribute__((address_space(3))) bf16x8*)(kp);      kf[1]=*(const __attribute__((address_space(3))) bf16x8*)(kp+512);
  kf[2]=*(const __attribute__((address_space(3))) bf16x8*)(kp+2048); kf[3]=*(const __attribute__((address_space(3))) bf16x8*)(kp+2560);
  kf[4]=*(const __attribute__((address_space(3))) bf16x8*)(kp+4096); kf[5]=*(const __attribute__((address_space(3))) bf16x8*)(kp+4608);
  kf[6]=*(const __attribute__((address_space(3))) bf16x8*)(kp+6144); kf[7]=*(const __attribute__((address_space(3))) bf16x8*)(kp+6656);
}
__device__ __forceinline__ void kload2(bf16x8*kf,lds_cptr kp,int j){ kf[2*j]=*(const __attribute__((address_space(3))) bf16x8*)(kp+j*2048); kf[2*j+1]=*(const __attribute__((address_space(3))) bf16x8*)(kp+j*2048+512); }
__device__ __forceinline__ s16x4 vtr(lds_cptr p){ return __builtin_bit_cast(s16x4,__builtin_amdgcn_ds_read_tr16_b64_v4i16((__attribute__((address_space(3))) v4i16_t*)p)); }
__device__ __forceinline__ float rowmax(const f32x16&p0,const f32x16&p1){
  float a=max3f(p0[0],p0[1],p1[0]),b=max3f(p0[2],p0[3],p1[1]);a=max3f(a,p1[2],p1[3]);
  #pragma unroll
  for(int r=4;r<16;r+=4){a=max3f(a,p0[r],p0[r+1]);b=max3f(b,p0[r+2],p0[r+3]);a=max3f(a,p1[r],p1[r+1]);b=max3f(b,p1[r+2],p1[r+3]);}
  const float m=max2f(a,b);
  auto rr=__builtin_amdgcn_permlane32_swap(__float_as_uint(m),__float_as_uint(m),false,false);
  return max2f(__uint_as_float(rr[0]),__uint_as_float(rr[1]));
}
__device__ __forceinline__ void pv(f32x16*o,int vb,bf16x8 pa0,bf16x8 pa1,bf16x8 pa2,bf16x8 pa3){
  #pragma unroll
  for(int d0=0;d0<2;++d0){s16x4 lo[4],hi[4];
    #pragma unroll
    for(int ks=0;ks<4;++ks){
      asm volatile("ds_read_b64_tr_b16 %0,%1 offset:%c2":"=&v"(lo[ks]):"v"(vb),"i"(d0*4096+ks*1024):"memory");
      asm volatile("ds_read_b64_tr_b16 %0,%1 offset:%c2":"=&v"(hi[ks]):"v"(vb),"i"(d0*4096+ks*1024+512):"memory");}
    asm volatile("s_waitcnt lgkmcnt(0)":::"memory");SBAR();
    #define PK(k) (bf16x8){lo[k][0],lo[k][1],lo[k][2],lo[k][3],hi[k][0],hi[k][1],hi[k][2],hi[k][3]}
    o[d0]=__builtin_amdgcn_mfma_f32_32x32x16_bf16(pa0,PK(0),o[d0],0,0,0);
    o[d0]=__builtin_amdgcn_mfma_f32_32x32x16_bf16(pa1,PK(1),o[d0],0,0,0);
    o[d0]=__builtin_amdgcn_mfma_f32_32x32x16_bf16(pa2,PK(2),o[d0],0,0,0);
    o[d0]=__builtin_amdgcn_mfma_f32_32x32x16_bf16(pa3,PK(3),o[d0],0,0,0);
    #undef PK
  }
}

#ifndef ATTN_STORE16
#define ATTN_STORE16(p,v) (*(u32x4*)(p)=(v))
#endif
template<int THRL> __device__ __forceinline__ void attn_unit(int b,int h,int qb,const bf16*Q,const bf16*__restrict__ K,const bf16*__restrict__ V,const bf16*__restrict__ GATE,bf16*O,char*shm,float skipthr){
  int tid_=threadIdx.x; asm volatile("":"+v"(tid_));
  const int tid=tid_,lane=tid&63,r32=lane&31,hi=lane>>5; const int wid=__builtin_amdgcn_readfirstlane(tid>>6);
  const long rowbase=(long)b*SEQ; const int q0=qb*QB;
  const bf16*Qw=Q+(rowbase+q0+wid*QBLK)*DM+h*D;
  const unsigned lds0=(unsigned)(uintptr_t)shm;
  int tskip;
  { typedef __attribute__((address_space(3))) const unsigned long long* lds_u64q; const lds_u64q gt_=(lds_u64q)((__attribute__((address_space(3))) const char*)shm+LDS_G3);
    const int NT0=(q0+QB)/KVBLK; const unsigned long long e0=gt_[q0], e1=gt_[lane<NT0?64*lane+63:q0];
    const float G0=(__uint_as_float((unsigned)e0<<16)+__uint_as_float((unsigned)e0&0xffff0000u))+__uint_as_float((unsigned)(e0>>32)<<16);
    const float G1=(__uint_as_float((unsigned)e1<<16)+__uint_as_float((unsigned)e1&0xffff0000u))+__uint_as_float((unsigned)(e1>>32)<<16);
    const int ns=__builtin_popcountll(__ballot(lane<NT0 && (G1-G0)<skipthr)); tskip=__builtin_amdgcn_readfirstlane(min(ns&~1,NT0-6)); }
  const bf16*Kh=K+(rowbase+(long)tskip*KVBLK)*DM+h*D,*Vh=V+(rowbase+(long)tskip*KVBLK)*DM+h*D;
  float*wsf=(float*)(shm+LDS_WS)+wid*64;
  const bf16*ksrc=Kh+(long)lane*DM+wid*8;
  const bf16*vsrc=Vh+(long)(16*(wid&3)+(lane>>2))*DM+(wid>>2)*32+(lane&3)*8;
  const unsigned kdst=lds0+LDS_K+wid*1024, vdst=lds0+LDS_V+wid*1024;
  #define DMA_K(t,slot) glds16(ksrc+(long)(t)*KVBLK*DM,(unsigned)__builtin_amdgcn_readfirstlane(kdst+(slot)))
  #define DMA_V(t,slot) glds16(vsrc+(long)(t)*KVBLK*DM,(unsigned)__builtin_amdgcn_readfirstlane(vdst+(slot)))
  const int vb0=(int)(lds0+LDS_V)+((lane>>4)&1)*32+(lane&3)*8+(4*hi+((lane&15)>>2))*64;
  const char*Kbase=shm+LDS_K; bf16x8 kf[8];
  const lds_cptr shm3=(lds_cptr)shm; const lds_cptr kp0=shm3+LDS_K+hi*1024+r32*16; const lds_cptr vp0=shm3+LDS_V+((lane>>4)&1)*32+(lane&3)*8+(4*hi+((lane&15)>>2))*64;
  const int NT=(q0+QB)/KVBLK-tskip;
  DMA_K(0,0);DMA_V(0,0);DMA_K(1,SLOTB);
  bf16x8 qr[4];
  #pragma unroll
  for(int d0=0;d0<4;++d0)qr[d0]=*reinterpret_cast<const bf16x8*>(&Qw[(long)r32*DM+d0*16+hi*8]);
  float mhat=0.f,l_reg=0.f;f32x16 o[2];o[0]=f32x16{};o[1]=f32x16{};
  typedef __attribute__((address_space(3))) const unsigned long long* lds_u64p;
  const lds_u64p g3p=(lds_u64p)(shm3+LDS_G3)+tskip*KVBLK+r32;
  { const unsigned long long e=((lds_u64p)(shm3+LDS_G3))[q0+wid*QBLK+r32]; const unsigned lo_=(unsigned)e,hi_=(unsigned)(e>>32); mhat=(__uint_as_float(lo_<<16)+__uint_as_float(lo_&0xffff0000u))+__uint_as_float(hi_<<16); }
  u32x4 qa; qa.x=hi?0u:0x3f803f80u; qa.y=0u; qa.z=0u; qa.w=0u;
  #define SETREF() do{ const float x_=-mhat; const unsigned b1_=cvtpk_s(x_,0.f)&0xffffu; const float r1_=x_-__uint_as_float(b1_<<16); const unsigned b2_=cvtpk_s(r1_,0.f)&0xffffu; \
      const float r2_=r1_-__uint_as_float(b2_<<16); const unsigned b3_=cvtpk_s(r2_,0.f)&0xffffu; qa.y=hi?0u:(0x3f80u|(b1_<<16)); qa.z=hi?0u:(b2_|(b3_<<16)); asm volatile("":"+v"(qa)); }while(0)
  SETREF();
  unsigned long long ga0,ga1;
  #define GARD(t) do{ ga0=g3p[(t)*64]; ga1=g3p[(t)*64+32]; }while(0)
  #define KAF(g) __builtin_bit_cast(bf16x8,(u32x4){(unsigned)(g),(unsigned)((g)>>32),0x3f803f80u,0u})
  #define QAF() __builtin_bit_cast(bf16x8,qa)
  const int qrel=wid*QBLK+r32;
  #define CMASK(P0,P1,t) do{int jb_=(t)-(NT-4); if(jb_>=0)cmask(P0,P1,jb_,qrel,hi);}while(0)
  bool resc=false;
  #define START(P0,P1) do{ const float rm=rowmax(P0,P1); resc=false; \
    { const float dl=__builtin_fmaxf(rm,0.f); mhat=fadd_s(mhat,dl);     \
      _Pragma("unroll") for(int r=0;r<16;++r){P0[r]=fsub_s(P0[r],dl);P1[r]=fsub_s(P1[r],dl);} \
      SETREF(); } \
    _Pragma("unroll") for(int r=0;r<16;++r)P0[r]=__builtin_amdgcn_exp2f(P0[r]); }while(0)
  #define RESC() do{ if(resc){ asm volatile("s_waitcnt lgkmcnt(0)":::"memory"); \
      _Pragma("unroll") for(int d_=0;d_<2;++d_) _Pragma("unroll") for(int r=0;r<16;++r)o[d_][r]*=wsf[crow(r,hi)]; } }while(0)
  f32x16 pA0,pA1,pB0,pB1;
  int sl_prev=0,sl_cur=0,sl_next=SLOTB;
  #define ROT() do{sl_prev=sl_cur;sl_cur=sl_next;sl_next=(sl_next==(NSLOT-1)*SLOTB)?0:sl_next+SLOTB;}while(0)
  DMA_K(2,2*SLOTB);
  WAIT_BAR(3);
  GARD(0); qkt(pA0,pA1,Kbase,qr,KAF(ga0),KAF(ga1),QAF(),r32,hi);asm volatile("s_nop 15\n\ts_nop 7":"+v"(pA0),"+v"(pA1));CMASK(pA0,pA1,0);
  START(pA0,pA1);
  _Pragma("unroll") for(int r=0;r<16;++r)pA1[r]=__builtin_amdgcn_exp2f(pA1[r]);
  WAIT_BAR(0);
  DMA_K(3,0);DMA_V(1,SLOTB);
  ROT();
  kload8(kf,kp0+sl_cur); GARD(1);
  WAIT_BAR(2);
  s16x4 vlo[8],vhi[8]; u32x4 pw0,pw1,pw2,pw3;
  #define PKW(P,B) cvtpk_s(P[B],P[B+1])
  #define PAF(k) __builtin_bit_cast(bf16x8,pw##k)
  #define VFR(i) (bf16x8){vlo[i][0],vlo[i][1],vlo[i][2],vlo[i][3],vhi[i][0],vhi[i][1],vhi[i][2],vhi[i][3]}
  #define PIN(x) asm volatile("":"+v"(x))
  #define MX3(a,b,c) __builtin_fmaxf(__builtin_fmaxf((a),(b)),(c))
  #define GAPA(MF,A0,A1,A2,A3,W0,W1,PW) do{ MF; sacc+=A0; sacc+=A1; sacc+=A2; sacc+=A3; PIN(sacc); W0; W1; PIN(PW); SBAR(); }while(0)
  #define EX(v) __builtin_amdgcn_exp2f(v)
  #define GAPB(MF,X,B) do{ MF; X[B]=EX(X[B]); X[B+1]=EX(X[B+1]); X[B+2]=EX(X[B+2]); X[B+3]=EX(X[B+3]); PIN(X); SBAR(); }while(0)
  #define VRD(i) do{ vlo[i]=vtr(vp_+(((i)>>2)*4096+((i)&3)*1024)); vhi[i]=vtr(vp_+(((i)>>2)*4096+((i)&3)*1024+512)); }while(0)
  #define KRD(G,j) do{ if(G){ kload2(kf,kp0+sl_next,j); SBAR(); } }while(0)
  #define STEP(C0,C1,P0,P1,t,GK,GV,GL) do{ SBAR(); \
    const lds_cptr vp_=vp0+sl_prev; \
    { const f32x16 z_=f32x16{}; C0=__builtin_amdgcn_mfma_f32_32x32x16_bf16(KAF(ga0),QAF(),z_,0,0,0); C1=__builtin_amdgcn_mfma_f32_32x32x16_bf16(KAF(ga1),QAF(),z_,0,0,0); } SBAR(); \
    VRD(0); SBAR(); float sacc=(P0[0]+P0[1]); \
    GAPA(C0=__builtin_amdgcn_mfma_f32_32x32x16_bf16(kf[0],qr[0],C0,0,0,0), P0[2],P0[3],P0[4],P0[5],     pw0[0]=PKW(P0,0), pw0[1]=PKW(P0,2), pw0); \
    VRD(4); SBAR(); GAPA(C1=__builtin_amdgcn_mfma_f32_32x32x16_bf16(kf[1],qr[0],C1,0,0,0), P0[6],P0[7],P0[8],P0[9],     pw0[2]=PKW(P0,4), pw0[3]=PKW(P0,6), pw0); \
    VRD(1); SBAR(); GAPA(C0=__builtin_amdgcn_mfma_f32_32x32x16_bf16(kf[2],qr[1],C0,0,0,0),   P0[10],P0[11],P0[12],P0[13], pw1[0]=PKW(P0,8), pw1[1]=PKW(P0,10), pw1); \
    VRD(5); SBAR(); GAPA(C1=__builtin_amdgcn_mfma_f32_32x32x16_bf16(kf[3],qr[1],C1,0,0,0),   P0[14],P0[15],P1[0],P1[1],   pw1[2]=PKW(P0,12),pw1[3]=PKW(P0,14), pw1); \
    VRD(2); SBAR(); GAPA(C0=__builtin_amdgcn_mfma_f32_32x32x16_bf16(kf[4],qr[2],C0,0,0,0),   P1[2],P1[3],P1[4],P1[5],     pw2[0]=PKW(P1,0), pw2[1]=PKW(P1,2), pw2); \
    VRD(6); SBAR(); GAPA(C1=__builtin_amdgcn_mfma_f32_32x32x16_bf16(kf[5],qr[2],C1,0,0,0),   P1[6],P1[7],P1[8],P1[9],     pw2[2]=PKW(P1,4), pw2[3]=PKW(P1,6), pw2); \
    VRD(3); SBAR(); GAPA(C0=__builtin_amdgcn_mfma_f32_32x32x16_bf16(kf[6],qr[3],C0,0,0,0),   P1[10],P1[11],P1[12],P1[13], pw3[0]=PKW(P1,8), pw3[1]=PKW(P1,10), pw3); \
    VRD(7); SBAR(); GAPA(C1=__builtin_amdgcn_mfma_f32_32x32x16_bf16(kf[7],qr[3],C1,0,0,0),   P1[14],P1[15],0.f,0.f,       pw3[2]=PKW(P1,12),pw3[3]=PKW(P1,14), pw3); \
    l_reg+=sacc; \
    if(GK){DMA_K((t)+3,sl_cur);} if(GV){DMA_V((t)+1,sl_next);} \
    CMASK(C0,C1,t); \
    { float a=MX3(C0[0],C0[1],C1[0]),b=MX3(C0[2],C0[3],C1[1]); a=MX3(a,C1[2],C1[3]); \
      _Pragma("unroll") for(int r=4;r<16;r+=4){a=MX3(a,C0[r],C0[r+1]);b=MX3(b,C0[r+2],C0[r+3]);a=MX3(a,C1[r],C1[r+1]);b=MX3(b,C1[r+2],C1[r+3]);} \
      float rm=__builtin_fmaxf(a,b); { auto rr=__builtin_amdgcn_permlane32_swap(__float_as_uint(rm),__float_as_uint(rm),false,false); rm=__builtin_fmaxf(__uint_as_float(rr[0]),__uint_as_float(rr[1])); } \
      resc=false; \
      if(__builtin_expect(__any(rm>(float)THRL),0)){ const float dl=__builtin_fmaxf(rm,0.f); mhat+=dl; \
        _Pragma("unroll") for(int r=0;r<16;++r){C0[r]-=dl;C1[r]-=dl;} \
        SETREF(); \
        const float f=__builtin_amdgcn_exp2f(-dl); l_reg*=f; if(hi==0)wsf[r32]=f; resc=true; } } \
    SBAR(); \
    GAPB(o[0]=__builtin_amdgcn_mfma_f32_32x32x16_bf16(PAF(0),VFR(0),o[0],0,0,0), C0,0); \
    GAPB(o[1]=__builtin_amdgcn_mfma_f32_32x32x16_bf16(PAF(0),VFR(4),o[1],0,0,0), C0,4); \
    KRD(GL,0); GAPB(o[0]=__builtin_amdgcn_mfma_f32_32x32x16_bf16(PAF(1),VFR(1),o[0],0,0,0), C0,8); \
    KRD(GL,1); GAPB(o[1]=__builtin_amdgcn_mfma_f32_32x32x16_bf16(PAF(1),VFR(5),o[1],0,0,0), C0,12); \
    KRD(GL,2); GAPB(o[0]=__builtin_amdgcn_mfma_f32_32x32x16_bf16(PAF(2),VFR(2),o[0],0,0,0), C1,0); \
    KRD(GL,3); GAPB(o[1]=__builtin_amdgcn_mfma_f32_32x32x16_bf16(PAF(2),VFR(6),o[1],0,0,0), C1,4); \
    if(GL){ GARD((t)+1); SBAR(); } GAPB(o[0]=__builtin_amdgcn_mfma_f32_32x32x16_bf16(PAF(3),VFR(3),o[0],0,0,0), C1,8); \
    GAPB(o[1]=__builtin_amdgcn_mfma_f32_32x32x16_bf16(PAF(3),VFR(7),o[1],0,0,0), C1,12); \
    }while(0)
  int t=1;
  #undef CMASK
  #define CMASK(P0,P1,t) do{}while(0)
  for(;t+5<NT;t+=2){
    STEP(pB0,pB1,pA0,pA1,t,true,true,true);     WAIT_BAR(2); RESC(); ROT();
    STEP(pA0,pA1,pB0,pB1,t+1,true,true,true);   WAIT_BAR(2); RESC(); ROT();
  }
  #undef CMASK
  #define CMASK(P0,P1,t) do{int jb_=(t)-(NT-4); if(jb_>=0)cmask(P0,P1,jb_,qrel,hi);}while(0)
  #define ENDW(tt) do{ if((tt)+3<NT){WAIT_BAR(2);} else if((tt)+2<NT){WAIT_BAR(1);} else {WAIT_BAR(0);} }while(0)
  #undef CMASK
  #define CMASK(P0,P1,t) do{}while(0)
  STEP(pB0,pB1,pA0,pA1,NT-5,true,true,true);   WAIT_BAR(2); RESC(); ROT();
  #undef CMASK
  #define CMASK(P0,P1,t) cmask(P0,P1,0,qrel,hi)
  STEP(pA0,pA1,pB0,pB1,NT-4,true,true,true);   WAIT_BAR(2); RESC(); ROT();
  #undef CMASK
  #define CMASK(P0,P1,t) cmask(P0,P1,1,qrel,hi)
  STEP(pB0,pB1,pA0,pA1,NT-3,false,true,true);  WAIT_BAR(1); RESC(); ROT();
  #undef CMASK
  #define CMASK(P0,P1,t) cmask(P0,P1,2,qrel,hi)
  STEP(pA0,pA1,pB0,pB1,NT-2,false,true,true);  WAIT_BAR(0); RESC(); ROT();
  #undef CMASK
  #define CMASK(P0,P1,t) cmask(P0,P1,3,qrel,hi)
  STEP(pB0,pB1,pA0,pA1,NT-1,false,false,false); RESC();
  { float sacc=pB0[0]+pB0[1]; _Pragma("unroll") for(int r=2;r<16;++r)sacc+=pB0[r]; _Pragma("unroll") for(int r=0;r<16;++r)sacc+=pB1[r]; l_reg+=sacc;
    pw0=(u32x4){PKW(pB0,0),PKW(pB0,2),PKW(pB0,4),PKW(pB0,6)};pw1=(u32x4){PKW(pB0,8),PKW(pB0,10),PKW(pB0,12),PKW(pB0,14)};pw2=(u32x4){PKW(pB1,0),PKW(pB1,2),PKW(pB1,4),PKW(pB1,6)};pw3=(u32x4){PKW(pB1,8),PKW(pB1,10),PKW(pB1,12),PKW(pB1,14)};
    SBAR(); pv(o,vb0+sl_cur,PAF(0),PAF(1),PAF(2),PAF(3)); }
  #undef PKW
  #undef PAF
  #undef VFR
  #undef PIN
  #undef MX3
  #undef GAPA
  #undef GAPB
  #undef EX
  #undef VRD
  #undef KRD
  #undef STEP
  #undef ENDW
  {auto rr=__builtin_amdgcn_permlane32_swap(__float_as_uint(l_reg),__float_as_uint(l_reg),false,false);l_reg=__uint_as_float(rr[0])+__uint_as_float(rr[1]);}
  if(hi==0)wsf[32+r32]=l_reg;asm volatile("s_waitcnt lgkmcnt(0)":::"memory");
  float rli[16];
  #pragma unroll
  for(int r=0;r<16;++r)rli[r]=__builtin_amdgcn_rcpf(wsf[32+crow(r,hi)]);
  bf16*Ow=O+(rowbase+q0+wid*QBLK)*DM+h*D; const bf16*Gw=GATE+(rowbase+q0+wid*QBLK)*DM+h*D;
  { bf16*stg=(bf16*)(shm+LDS_OST)+wid*2048;
    #pragma unroll
    for(int r=0;r<16;++r){const int orow=crow(r,hi);
      #pragma unroll
      for(int d0=0;d0<2;++d0)stg[orow*64+d0*32+r32]=__float2bfloat16(o[d0][r]*rli[r]);}
    asm volatile("s_waitcnt lgkmcnt(0)":::"memory");
    #pragma unroll
    for(int i=0;i<4;++i){const int row=i*8+(lane>>3),ch=lane&7; const u32x4 v=*(const u32x4*)(stg+row*64+ch*8); const u32x4 gv=*(const u32x4*)(Gw+(long)row*DM+ch*8); u32x4 w;
      #define GMUL(a,g) cvtpk_s(__uint_as_float((a)<<16)*__uint_as_float((g)<<16),__uint_as_float((a)&0xffff0000u)*__uint_as_float((g)&0xffff0000u))
      w.x=GMUL(v.x,gv.x); w.y=GMUL(v.y,gv.y); w.z=GMUL(v.z,gv.z); w.w=GMUL(v.w,gv.w);
      #undef GMUL
      ATTN_STORE16(Ow+(long)row*DM+ch*8,w);} }
  asm volatile("s_waitcnt lgkmcnt(0)\n\ts_barrier":::"memory");
  #undef DMA_K
  #undef DMA_V
  #undef CMASK
  #undef START
  #undef RESC
  #undef ROT
  #undef SETREF
  #undef GARD
  #undef KAF
  #undef QAF
}
constexpr int ATTN_LDS_BYTES=LDS_BYTES;
struct AttnTensors { const bf16* Q; const bf16* K; const bf16* V; const bf16* GATE; bf16* O; const unsigned long long* G3; const float* qg; const float* kg; };
template<int THRL=8> __device__ __forceinline__ void attn_phase(char*lds,const AttnTensors&T,int grid,int block){
  const int v0=(grid%8==0)?(block%8)*(grid/8)+block/8:block;
  float skipthr; { float a=fabsf(T.qg[threadIdx.x&63]),b=fabsf(T.kg[threadIdx.x&63]);
    #pragma unroll
    for(int o=1;o<64;o<<=1){a=fmaxf(a,__shfl_xor(a,o));b=fmaxf(b,__shfl_xor(b,o));}
    const float qkmax=64.f*a*b*C2_*1.05f; skipthr=-(42.f+3.f*qkmax); }
  for(int v=v0;v<BATCH*NHEAD*2;v+=grid){
    const int bh=v>>1,odd=v&1;
    {
      const u32x4*src=(const u32x4*)(T.G3+(size_t)bh*SEQ); u32x4*dst=(u32x4*)(lds+LDS_G3);
      #pragma unroll
      for(int i=0;i<4;++i)dst[threadIdx.x+512*i]=src[threadIdx.x+512*i];
      if(threadIdx.x<128)((unsigned long long*)(lds+LDS_GPAD))[threadIdx.x]=0x3f80000000000000ull|0xc6eaull;
      asm volatile("s_waitcnt vmcnt(0) lgkmcnt(0)\n\ts_barrier":::"memory"); }
    #pragma unroll 1
    for(int i=0;i<8;++i){ const int j=i>>1; const int qb=(i&1)?(15-2*j-odd):(2*j+odd); attn_unit<THRL>(bh/NHEAD,bh%NHEAD,qb,T.Q,T.K,T.V,T.GATE,T.O,lds,skipthr); }
  }
}
#undef SBAR
#undef WAIT_BAR
}

constexpr int RING_BYTES = 131072;
constexpr int LDS_BYTES = 163840;
constexpr int LDSCTL_OFF = LDS_BYTES - 1024, MISC_OFF = LDSCTL_OFF + 320;
constexpr int CW_BAR = 4096;
typedef GAS unsigned gu32;
#define RLX_AGENT __ATOMIC_RELAXED, __HIP_MEMORY_SCOPE_AGENT
#define XB_TMO      128
#define XB_XCNT(j)  (256  + 64 * (j))
#define XB_XSUB(j)  (1280 + 64 * (j))
#define XB_XGEN(j)  (2304 + 64 * (j))
#define XB_TOP      3328
#define XB_TOPGEN   3392
#define XCD_BAR_WORDS 3456
#define XB_SPIN_CAP (1u << 18)
__device__ __forceinline__ unsigned xb_ld(unsigned* p)              { return __hip_atomic_load(p, __ATOMIC_RELAXED, __HIP_MEMORY_SCOPE_AGENT); }
__device__ __forceinline__ unsigned xb_add(unsigned* p, unsigned v) { return __hip_atomic_fetch_add(p, v, __ATOMIC_RELAXED, __HIP_MEMORY_SCOPE_AGENT); }
__device__ __forceinline__ unsigned xb_xcc_id() { return (unsigned)__builtin_amdgcn_s_getreg((3 << 11) | 20) & 0xFu; }
#define XB_SPIN(cond, bar) do { unsigned _sp = 0; while (cond) { __builtin_amdgcn_s_sleep(1); \
    if ((++_sp & 255u) == 0u) { if (xb_ld(&(bar)[XB_TMO])) break; if (_sp > XB_SPIN_CAP) { atomicAdd(&(bar)[XB_TMO], 1u); break; } } } } while (0)
struct XcdBarrier { unsigned* bar; unsigned x; volatile LAS unsigned* st; };
__device__ __forceinline__ XcdBarrier xcd_barrier_post(unsigned* bar, volatile LAS unsigned* st) {
    XcdBarrier b; b.bar = bar; b.x = xb_xcc_id(); b.st = st;
    if (threadIdx.x == 0) (void)xb_add(&bar[XB_XCNT(b.x)], 1u);
    return b;
}
__device__ __forceinline__ void xcd_barrier_complete(unsigned* bar, unsigned x, unsigned& nloc, unsigned& nx) {
    const unsigned G = gridDim.x * gridDim.y * gridDim.z;
    unsigned sum, cnt, mine, sp = 0u;
    for (;;) {
        sum = 0u; cnt = 0u; mine = 0u;
#pragma unroll
        for (unsigned j = 0; j < 16; ++j) { const unsigned c = xb_ld(&bar[XB_XCNT(j)]); sum += c; cnt += (c > 0u) ? 1u : 0u; mine = (j == x) ? c : mine; }
        if (sum == G) break;
        __builtin_amdgcn_s_sleep(1);
        if ((++sp & 255u) == 0u) { if (xb_ld(&bar[XB_TMO])) break; if (sp > XB_SPIN_CAP) { atomicAdd(&bar[XB_TMO], 1u); break; } }
    }
    nloc = mine > 0u ? mine : 1u; nx = cnt > 0u ? cnt : 1u;
}
__device__ __forceinline__ void xcd_barrier(const XcdBarrier& b) {
    asm volatile("s_waitcnt vmcnt(0)" ::: "memory");
    __syncthreads();
    if (threadIdx.x == 0) {
        unsigned* bar = b.bar; unsigned bx = b.x;
        asm volatile("" : "+s"(bar), "+s"(bx));
        __builtin_amdgcn_s_waitcnt(0);
        unsigned nloc = b.st[0], nx = b.st[1];
        if (nloc == 0u) { xcd_barrier_complete(bar, bx, nloc, nx); b.st[0] = nloc; b.st[1] = nx; }
        const unsigned old = xb_add(&bar[XB_XSUB(bx)], 1u);
        const unsigned gen = old / nloc;
        if (old + 1u == (gen + 1u) * nloc) {
            __builtin_amdgcn_fence(__ATOMIC_RELEASE, "agent");
            asm volatile("s_waitcnt vmcnt(0)" ::: "memory");
            const unsigned og = xb_add(&bar[XB_TOP], 1u);
            const unsigned tg = og / nx;
            if (og + 1u == (tg + 1u) * nx) xb_add(&bar[XB_TOPGEN], 1u);
            else XB_SPIN(xb_ld(&bar[XB_TOPGEN]) == tg, bar);
            __builtin_amdgcn_fence(__ATOMIC_ACQUIRE, "agent");
            xb_add(&bar[XB_XGEN(bx)], 1u);
            asm volatile("s_waitcnt vmcnt(0)" ::: "memory");
        } else {
            XB_SPIN(xb_ld(&bar[XB_XGEN(bx)]) == gen, bar);
            __builtin_amdgcn_fence(__ATOMIC_ACQUIRE, "agent");
            asm volatile("s_waitcnt vmcnt(0)" ::: "memory");
        }
    }
    __syncthreads();
}

__device__ __forceinline__ void bg_cvt(unsigned char* ws, LAS unsigned char* lds, int wave, int lane, volatile LAS unsigned* flag) {
    const InP in = kin(); LAS float* scr = (LAS float*)(lds + wave * 8448); volatile LAS unsigned* cur = flag + 1;
    const unsigned c = blockIdx.x, G = gridDim.x;
    for (;;) {
        if (*flag != 0u) break;
        if (*cur * G + c >= (unsigned)IT_BG) break;
        unsigned k = 0u; if (lane == 0) k = __hip_atomic_fetch_add((LAS unsigned*)cur, 1u, __ATOMIC_RELAXED, __HIP_MEMORY_SCOPE_WORKGROUP); k = (unsigned)__builtin_amdgcn_readfirstlane((int)k);
        const unsigned it = k * G + c; if (it >= (unsigned)IT_BG) break;
        cvt_item(in, ws, bg_item((int)it), scr, lane);
    }
}
__device__ __forceinline__ void xcd_barrier_bg(const XcdBarrier& b, unsigned char* ws, LAS unsigned char* lds, volatile LAS unsigned* flag) {
    asm volatile("s_waitcnt vmcnt(0)" ::: "memory");
    if (threadIdx.x == 0) *flag = 0u;
    __syncthreads();
    const int wave = __builtin_amdgcn_readfirstlane((int)threadIdx.x >> 6), lane = threadIdx.x & 63;
    if (wave != 0) { bg_cvt(ws, lds, wave, lane, flag); asm volatile("s_waitcnt vmcnt(0)" ::: "memory"); }
    else if (threadIdx.x == 0) {
        unsigned* bar = b.bar; unsigned bx = b.x;
        asm volatile("" : "+s"(bar), "+s"(bx));
        __builtin_amdgcn_s_waitcnt(0);
        unsigned nloc = b.st[0], nx = b.st[1];
        if (nloc == 0u) { xcd_barrier_complete(bar, bx, nloc, nx); b.st[0] = nloc; b.st[1] = nx; }
        const unsigned old = xb_add(&bar[XB_XSUB(bx)], 1u);
        const unsigned gen = old / nloc;
        if (old + 1u == (gen + 1u) * nloc) {
            __builtin_amdgcn_fence(__ATOMIC_RELEASE, "agent");
            asm volatile("s_waitcnt vmcnt(0)" ::: "memory");
            const unsigned og = xb_add(&bar[XB_TOP], 1u);
            const unsigned tg = og / nx;
            if (og + 1u == (tg + 1u) * nx) xb_add(&bar[XB_TOPGEN], 1u);
            else XB_SPIN(xb_ld(&bar[XB_TOPGEN]) == tg, bar);
            __builtin_amdgcn_fence(__ATOMIC_ACQUIRE, "agent");
            xb_add(&bar[XB_XGEN(bx)], 1u);
            asm volatile("s_waitcnt vmcnt(0)" ::: "memory");
        } else {
            XB_SPIN(xb_ld(&bar[XB_XGEN(bx)]) == gen, bar);
            __builtin_amdgcn_fence(__ATOMIC_ACQUIRE, "agent");
            asm volatile("s_waitcnt vmcnt(0)" ::: "memory");
        }
        *flag = 1u;
    }
    __syncthreads();
}

struct Frame { unsigned char* ws; float* out; LAS unsigned char* lds; int bid, G; };
#define TID_LANE_WAVE const int tid = threadIdx.x, lane = tid & 63, wave = __builtin_amdgcn_readfirstlane(tid >> 6); (void)tid; (void)lane; (void)wave

__device__ __forceinline__ void ph_prologue(const Frame& F) {
    TID_LANE_WAVE;
    const InP in = kin(); unsigned char* ws = opq(F.ws);
    LAS float* sc = (LAS float*)F.lds; LAS float* red = (LAS float*)(F.lds + 32768);
    __syncthreads();
    if (F.bid < ADA_ITEMS) {
        for (int i = tid; i < 8 * 1024; i += 512) sc[i] = siluf(in->c[i]);
        __syncthreads();
        for (int it = F.bid; it < ADA_ITEMS; it += F.G) ada_item(in, (float*)(ws + WS_MODS), it, sc, red, tid);
    }
    __syncthreads();
    LAS float* scr = (LAS float*)(F.lds + wave * 8448);
    const int gw = F.bid * 8 + wave, ngw = F.G * 8;
    for (int it = gw; it < IT_FG; it += ngw) cvt_item(in, ws, fg_item(it), scr, lane);
    bf16_t* wsb = (bf16_t*)(ws + WS_WS);
    for (int i = F.bid * 512 + tid; i < 8 * 128 * 128; i += F.G * 512) { const int s = i & 127, t = (i >> 7) & 127; wsb[i] = (bf16_t)f2bf(s <= t ? in->w_s[i] : 0.f); }
}
__device__ __forceinline__ void ph_norm0(const Frame& F) {
    TID_LANE_WAVE; const InP in = kin(); unsigned char* ws = opq(F.ws); const int gw = F.bid * 8 + wave, ngw = F.G * 8;
    const float* mods = (const float*)(ws + WS_MODS);
    for (int r = gw; r < T; r += ngw) { const int b = r / SEQ;
        row4_norm_mod_store(in->x + (size_t)r * DM, in->norm_mix_g, mods + (size_t)b * 6144 + 0, mods + (size_t)b * 6144 + 1024, (bf16_t*)(ws + WS_XN) + (size_t)r * DM, lane); }
}
__device__ __forceinline__ void ph_norm_router(const Frame& F, int L) {
    TID_LANE_WAVE; const InP in = kin(); unsigned char* ws = opq(F.ws);
    LAS u32x4* WPB = (LAS u32x4*)F.lds;
    LAS float* lg = (LAS float*)(F.lds + 131072) + wave * 512;
    LAS int* hist = (LAS int*)(F.lds + 131072 + 16384);
    LAS float* rs_s = (LAS float*)(F.lds + 131072 + 16384 + 256) + wave * 16;
    LAS float* pb = (LAS float*)(F.lds + 131072);
    LAS float* rbl = (LAS float*)(F.lds + 131072 + 16384 + 256 + 512);
    const float* mods = (const float*)(ws + WS_MODS) + (size_t)L * 8 * 6144;
    const bf16_t* XR = (const bf16_t*)(ws + WS_XR);
    for (int grp = F.bid; grp < 256; grp += F.G) {
        const int b = grp >> 5; const float* gsc = mods + (size_t)b * 6144 + 4096; const float* gg = in->norm_ffn_g + L * 1024; const float* rw = in->router_w + (size_t)L * 1024 * 32;
        __syncthreads();
        float bpart = 0.f; const float* gsh = mods + (size_t)b * 6144 + 3072;
        for (int cidx = tid; cidx < 32 * 2 * 64; cidx += 512) { const int l = cidx & 63, hh = (cidx >> 6) & 1, s2 = cidx >> 7, e = 16 * hh + (l & 15), k0 = 32 * s2 + 8 * (l >> 4);
            unsigned hi[4], lo[4];
#pragma unroll
            for (int h2 = 0; h2 < 2; ++h2) { const f32x4 g4 = *(const f32x4*)(gg + k0 + 4 * h2), s4 = *(const f32x4*)(gsc + k0 + 4 * h2), h4 = *(const f32x4*)(gsh + k0 + 4 * h2); float wv[4];
#pragma unroll
                for (int q = 0; q < 4; ++q) { const float r_ = rw[(k0 + 4 * h2 + q) * 32 + e]; wv[q] = g4[q] * (1.f + s4[q]) * r_; bpart += h4[q] * r_; }
#pragma unroll
                for (int q = 0; q < 4; q += 2) { const unsigned a0 = f2bf(wv[q]), a1 = f2bf(wv[q + 1]); hi[2 * h2 + (q >> 1)] = a0 | (a1 << 16);
                    lo[2 * h2 + (q >> 1)] = f2bf(wv[q] - __uint_as_float(a0 << 16)) | (f2bf(wv[q + 1] - __uint_as_float(a1 << 16)) << 16); } }
            WPB[((s2 * 2 + 0) * 2 + hh) * 64 + l] = (u32x4){hi[0], hi[1], hi[2], hi[3]}; WPB[((s2 * 2 + 1) * 2 + hh) * 64 + l] = (u32x4){lo[0], lo[1], lo[2], lo[3]}; }
        pb[tid] = bpart;
        if (tid < 32) hist[tid] = 0;
        __syncthreads();
        if (tid < 32) { float t = in->router_b[L * 32 + tid];
#pragma unroll
            for (int p = 0; p < 16; ++p) t += pb[((p >> 2) << 7) | ((tid >> 4) << 6) | ((p & 3) << 4) | (tid & 15)];
            rbl[tid] = t; }
        __syncthreads();
        const int r0 = grp * 128 + wave * 16, j = lane & 15, kq = lane >> 4;
        {
            const bf16_t* xrow = XR + (size_t)(r0 + j) * DM + 8 * kq;
            f32x4 acc0 = {0.f, 0.f, 0.f, 0.f}, acc1 = {0.f, 0.f, 0.f, 0.f}; float ssq = 0.f;
#pragma unroll 16
            for (int s2 = 0; s2 < 32; ++s2) {
                const u32x4 xw = *(const u32x4*)(xrow + 32 * s2); f32x4 xa, xb; bf8_to_f32(xw, xa, xb);
                ssq += ((xa.x * xa.x + xa.y * xa.y) + (xa.z * xa.z + xa.w * xa.w)) + ((xb.x * xb.x + xb.y * xb.y) + (xb.z * xb.z + xb.w * xb.w));
                const bf16x8 xf = __builtin_bit_cast(bf16x8, xw);
#pragma unroll
                for (int pc = 0; pc < 2; ++pc) { const bf16x8 w0 = __builtin_bit_cast(bf16x8, WPB[((s2 * 2 + pc) * 2 + 0) * 64 + lane]), w1 = __builtin_bit_cast(bf16x8, WPB[((s2 * 2 + pc) * 2 + 1) * 64 + lane]);
                    acc0 = __builtin_amdgcn_mfma_f32_16x16x32_bf16(w0, xf, acc0, 0, 0, 0); acc1 = __builtin_amdgcn_mfma_f32_16x16x32_bf16(w1, xf, acc1, 0, 0, 0); }
            }
            ssq += __shfl_xor(ssq, 16); ssq += __shfl_xor(ssq, 32);
            const float rstd = 1.f / sqrtf(ssq * (1.f / 1024.f) + EPS);
            const f32x4 b0 = *(const LAS f32x4*)(rbl + 4 * kq), b1 = *(const LAS f32x4*)(rbl + 16 + 4 * kq);
            *(LAS f32x4*)(lg + j * 32 + 4 * kq) = acc0 * rstd + b0; *(LAS f32x4*)(lg + j * 32 + 16 + 4 * kq) = acc1 * rstd + b1;
            if (kq == 0) rs_s[j] = rstd;
        }
        __builtin_amdgcn_s_waitcnt(0xc07f); asm volatile("" ::: "memory");
        if (lane < 16) {
            float v[32];
#pragma unroll
            for (int q = 0; q < 8; ++q) { const f32x4 t4 = *(const LAS f32x4*)(lg + lane * 32 + 4 * q); v[4 * q] = t4.x; v[4 * q + 1] = t4.y; v[4 * q + 2] = t4.z; v[4 * q + 3] = t4.w; }
            int ti[4]; float tv[4];
#pragma unroll
            for (int p = 0; p < 4; ++p) { float bv = -INFINITY; int bi = 0;
#pragma unroll
                for (int e = 0; e < 32; ++e) { bool ok = v[e] > bv;
#pragma unroll
                    for (int pp = 0; pp < p; ++pp) ok = ok && (ti[pp] != e);
                    if (ok) { bv = v[e]; bi = e; } }
                ti[p] = bi; tv[p] = bv; }
            float tg[4]; float sm = 0.f;
#pragma unroll
            for (int p = 0; p < 4; ++p) { tg[p] = expf(tv[p] - tv[0]); sm += tg[p]; }
            const int r = r0 + lane;
            *(i32x4*)((int*)(ws + WS_TOPE) + r * 4) = (i32x4){ti[0], ti[1], ti[2], ti[3]};
            *(f32x4*)((float*)(ws + WS_TOPG) + r * 4) = (f32x4){tg[0] / sm, tg[1] / sm, tg[2] / sm, tg[3] / sm};
#pragma unroll
            for (int p = 0; p < 4; ++p) __hip_atomic_fetch_add(&hist[ti[p]], 1, __ATOMIC_RELAXED, __HIP_MEMORY_SCOPE_WORKGROUP);
        }
#pragma unroll 4
        for (int i = 0; i < 16; ++i) { const int r = r0 + i; f32x4 v[4], h[4]; row_load_bf(XR + (size_t)r * DM, lane, v);
            row_modnorm(v, rs_s[i], gg, mods + (size_t)b * 6144 + 3072, gsc, lane, h); row_store_bf16((bf16_t*)(ws + WS_XN) + (size_t)r * DM, lane, h); }
        __syncthreads();
        if (tid < 32) ((int*)(ws + WS_HIST))[grp * 32 + tid] = hist[tid];
    }
}
__device__ __forceinline__ void ph_list(const Frame& F) {
    TID_LANE_WAVE; unsigned char* ws = opq(F.ws);
    LAS int* tot = (LAS int*)F.lds; LAS int* before = tot + 32; LAS int* pstart = tot + 64; LAS int* se = tot + 128; LAS int* part = tot + 640;
    const int* hist = (const int*)(ws + WS_HIST); const int* tope = (const int*)(ws + WS_TOPE); const float* topg = (const float*)(ws + WS_TOPG);
    int* dest = (int*)(ws + WS_DEST); int* list = (int*)(ws + WS_LIST); float* rowg = (float*)(ws + WS_ROWG); int* blke = (int*)(ws + WS_BLKE);
    for (int w = F.bid; w < 256; w += F.G) {
        __syncthreads();
        const int mye = tope[w * 512 + tid]; se[tid] = mye;
        { const int e = tid & 31, p = tid >> 5; int a = 0, bf = 0;
#pragma unroll 4
            for (int i = p * 16; i < p * 16 + 16; ++i) { const int h = hist[i * 32 + e]; a += h; bf += (i < w) ? h : 0; }
            part[p * 32 + e] = a; part[512 + p * 32 + e] = bf; }
        __syncthreads();
        if (tid < 32) { int a = 0, bf = 0;
#pragma unroll
            for (int p = 0; p < 16; ++p) { a += part[p * 32 + tid]; bf += part[512 + p * 32 + tid]; }
            tot[tid] = a; before[tid] = bf; }
        __syncthreads();
        if (tid == 0) { int p = 0; for (int e = 0; e < 32; ++e) { pstart[e] = p; p += (tot[e] + 255) / 256 * 256; } pstart[32] = p; }
        __syncthreads();
        { int rank = 0;
            for (int i4 = 0; i4 < 128; ++i4) { const i32x4 q = *(const LAS i32x4*)(se + 4 * i4); const int i0 = 4 * i4;
                rank += (q.x == mye && i0 < tid) + (q.y == mye && i0 + 1 < tid) + (q.z == mye && i0 + 2 < tid) + (q.w == mye && i0 + 3 < tid); }
            const int slot = w * 512 + tid, d = pstart[mye] + before[mye] + rank;
            dest[slot] = d; list[d] = slot >> 2; rowg[d] = topg[slot]; }
        if (w < 32) { const int e = w; for (int r = pstart[e] + tot[e] + tid; r < pstart[e + 1]; r += 512) { list[r] = -1; rowg[r] = 0.f; }
            for (int bk = pstart[e] / 256 + tid; bk < pstart[e + 1] / 256; bk += 512) blke[bk] = e; }
        if (w == 32 && tid == 0) blke[MAXBLK] = pstart[32] / 256;
    }
}
__device__ __forceinline__ void ph_combine(const Frame& F, int L) {
    TID_LANE_WAVE; const InP in = kin(); unsigned char* ws = opq(F.ws); float* out = F.out;
    LAS u32x4* WFB = (LAS u32x4*)F.lds;
    LAS float* rs_s = (LAS float*)(F.lds + 65536) + wave * 16;
    LAS float* pb = (LAS float*)(F.lds + 65536 + 1024);
    LAS float* fbl = (LAS float*)(F.lds + 65536 + 1024 + 2048);
    const float* mods = (const float*)(ws + WS_MODS);
    bf16_t* XR = (bf16_t*)(ws + WS_XR); const bf16_t* YB = (const bf16_t*)(ws + WS_YB); const int* dest = (const int*)(ws + WS_DEST);
    for (int grp = F.bid; grp < 256; grp += F.G) {
        const int b = grp >> 5, r0 = grp * 128 + wave * 16;
        if (L == 0) {
            __syncthreads();
            const float* ksc = mods + ((size_t)16 + b) * 6144 + 1024; const float* ksh = mods + ((size_t)16 + b) * 6144; float bpart = 0.f;
            for (int cidx = tid; cidx < 32 * 64; cidx += 512) { const int l = cidx & 63, s2 = cidx >> 6, e = l & 15, k0 = 32 * s2 + 8 * (l >> 4);
                unsigned hi[4], lo[4];
#pragma unroll
                for (int h2 = 0; h2 < 2; ++h2) { const f32x4 g4 = *(const f32x4*)(in->kv_norm_g + k0 + 4 * h2), s4 = *(const f32x4*)(ksc + k0 + 4 * h2), h4 = *(const f32x4*)(ksh + k0 + 4 * h2); float wv[4];
#pragma unroll
                    for (int q = 0; q < 4; ++q) { const float r_ = in->kv_w[(size_t)(k0 + 4 * h2 + q) * 2064 + 2048 + e]; wv[q] = g4[q] * (1.f + s4[q]) * r_; bpart += h4[q] * r_; }
#pragma unroll
                    for (int q = 0; q < 4; q += 2) { const unsigned a0 = f2bf(wv[q]), a1 = f2bf(wv[q + 1]); hi[2 * h2 + (q >> 1)] = a0 | (a1 << 16);
                        lo[2 * h2 + (q >> 1)] = f2bf(wv[q] - __uint_as_float(a0 << 16)) | (f2bf(wv[q + 1] - __uint_as_float(a1 << 16)) << 16); } }
                WFB[(s2 * 2 + 0) * 64 + l] = (u32x4){hi[0], hi[1], hi[2], hi[3]}; WFB[(s2 * 2 + 1) * 64 + l] = (u32x4){lo[0], lo[1], lo[2], lo[3]}; }
            pb[tid] = bpart;
            __syncthreads();
            if (tid < 16) { float t = in->fgate_b[tid];
#pragma unroll
                for (int p = 0; p < 32; ++p) t += pb[(p << 4) | tid];
                fbl[tid] = t; }
            __syncthreads();
        }
        const float* gt = mods + ((size_t)L * 8 + b) * 6144 + 5120;
#pragma unroll 1
        for (int i = 0; i < 16; ++i) {
            const int r = r0 + i; f32x4 v[4]; row_load_bf(XR + (size_t)r * DM, lane, v);
            f32x4 y[4];
#pragma unroll
            for (int j = 0; j < 4; ++j) y[j] = (f32x4){0.f, 0.f, 0.f, 0.f};
            const i32x4 d4 = *(const i32x4*)(dest + r * 4); const int dd[4] = {d4.x, d4.y, d4.z, d4.w};
#pragma unroll
            for (int q = 0; q < 4; ++q) { const bf16_t* yr = YB + (size_t)dd[q] * 1024;
#pragma unroll
                for (int j = 0; j < 2; ++j) { f32x4 a, c; bf8_to_f32(((const u32x4*)yr)[lane + 64 * j], a, c); y[2 * j] += a; y[2 * j + 1] += c; } }
#pragma unroll
            for (int j = 0; j < 4; ++j) v[j] = v[j] + row_vec(gt, lane, j) * y[j];
            const float rs = row_rstd(v);
            if (L == 1) { f32x4 o4[4];
#pragma unroll
                for (int j = 0; j < 4; ++j) o4[j] = v[j] * rs * row_vec(in->final_g, lane, j);
                row_store_f32(out + (size_t)r * DM, lane, o4);
                continue;
            }
            row_store_bf16(XR + (size_t)r * DM, lane, v);
            f32x4 h[4];
            row_modnorm(v, rs, in->norm_mix_g + 1024, mods + ((size_t)8 + b) * 6144 + 0, mods + ((size_t)8 + b) * 6144 + 1024, lane, h);
            row_store_bf16((bf16_t*)(ws + WS_XN) + (size_t)r * DM, lane, h);
            row_modnorm(v, rs, in->kv_norm_g, mods + ((size_t)16 + b) * 6144 + 0, mods + ((size_t)16 + b) * 6144 + 1024, lane, h);
            row_store_bf16((bf16_t*)(ws + WS_HKV) + (size_t)r * DM, lane, h);
            if (lane == 0) rs_s[i] = rs;
        }
        if (L == 0) {
            __builtin_amdgcn_fence(__ATOMIC_RELEASE, "workgroup"); asm volatile("s_waitcnt vmcnt(0) lgkmcnt(0)" ::: "memory"); __builtin_amdgcn_fence(__ATOMIC_ACQUIRE, "workgroup");
            const int j = lane & 15, kq = lane >> 4; const bf16_t* xrow = XR + (size_t)(r0 + j) * DM + 8 * kq;
            f32x4 acc = {0.f, 0.f, 0.f, 0.f};
#pragma unroll 16
            for (int s2 = 0; s2 < 32; ++s2) { const bf16x8 xf = __builtin_bit_cast(bf16x8, __builtin_nontemporal_load((const u32x4*)(xrow + 32 * s2)));
#pragma unroll
                for (int pc = 0; pc < 2; ++pc) acc = __builtin_amdgcn_mfma_f32_16x16x32_bf16(__builtin_bit_cast(bf16x8, WFB[(s2 * 2 + pc) * 64 + lane]), xf, acc, 0, 0, 0); }
            const float rstd = rs_s[j]; const f32x4 fb = *(const LAS f32x4*)(fbl + 4 * kq);
            f32x4 lf;
#pragma unroll
            for (int q = 0; q < 4; ++q) { const float xg = acc[q] * rstd + fb[q]; lf[q] = fminf(xg, 0.f) - log1pf(expf(-fabsf(xg))); }
            *(f32x4*)((float*)(ws + WS_LOGF) + (size_t)(r0 + j) * 16 + 4 * kq) = lf;
        }
    }
}
__device__ __forceinline__ void ph_cumsum(const Frame& F) {
    TID_LANE_WAVE; unsigned char* ws = opq(F.ws); LAS float* wtot = (LAS float*)F.lds;
    for (int bh = F.bid; bh < NB * NH; bh += F.G) {
        const int b = bh >> 4, h = bh & 15;
        const float* lf = (const float*)(ws + WS_LOGF); float v[8]; float run = 0.f;
#pragma unroll
        for (int i = 0; i < 8; ++i) { run += lf[((size_t)b * SEQ + tid * 8 + i) * 16 + h]; v[i] = run; }
        float inc = run;
#pragma unroll
        for (int o = 1; o < 64; o <<= 1) { const float t = __shfl_up(inc, o); if (lane >= o) inc += t; }
        if (lane == 63) wtot[wave] = inc;
        __syncthreads();
        float off = inc - run;
        for (int w8 = 0; w8 < wave; ++w8) off += wtot[w8];
        float* fc = (float*)(ws + WS_FC) + (size_t)bh * SEQ; unsigned long long* g3 = (unsigned long long*)(ws + WS_G3) + (size_t)bh * SEQ;
#pragma unroll
        for (int i = 0; i < 8; ++i) { const float Fv = v[i] + off; fc[tid * 8 + i] = Fv;
            const float g = -Fv * LOG2E; const unsigned b1 = f2bf(g); const float r1 = g - __uint_as_float(b1 << 16); const unsigned b2 = f2bf(r1); const float r2 = r1 - __uint_as_float(b2 << 16); const unsigned b3 = f2bf(r2);
            g3[tid * 8 + i] = (unsigned long long)(b1 | (b2 << 16)) | ((unsigned long long)(b3 | (0x3f80u << 16)) << 32); }
        __syncthreads();
    }
}


typedef short s16x4 __attribute__((ext_vector_type(4)));
__device__ __forceinline__ s16x4 ds_tr16(LAS unsigned char* p) { return __builtin_bit_cast(s16x4, __builtin_amdgcn_ds_read_tr16_b64_v4i16((LAS s16x4*)p)); }
__device__ __forceinline__ void ph_spatial(const Frame& F) {
    const InP in = kin(); unsigned char* ws = opq(F.ws);
    LAS unsigned char* L = F.lds;
    constexpr int VN_STRIDE = 544, WC_STRIDE = 272, OFF_VN = 0, OFF_WC = 128 * VN_STRIDE, OFF_ST = OFF_WC + 128 * WC_STRIDE;
    LAS float* st = (LAS float*)(L + OFF_ST);
    const bf16_t* Z = (const bf16_t*)(ws + WS_Z); bf16_t* GT = (bf16_t*)(ws + WS_GATED); const bf16_t* WSB = (const bf16_t*)(ws + WS_WS);
    for (int ch = F.bid; ch < T / 128; ch += F.G) {
        const int t0 = ch * 128;
        __syncthreads();
        { int tid_ = threadIdx.x; asm volatile("" : "+v"(tid_)); const int lane = tid_ & 63, wave = __builtin_amdgcn_readfirstlane(tid_ >> 6);
#pragma unroll 4
        for (int i = 0; i < 16; ++i) {
            const int tl = wave * 16 + i; const bf16_t* vrow = Z + (size_t)(t0 + tl) * 4096 + 2048;
            float v[32]; float s = 0.f;
#pragma unroll
            for (int j = 0; j < 4; ++j) { const u32x4 w = *(const u32x4*)(vrow + (lane + 64 * j) * 8); const unsigned ww[4] = {w.x, w.y, w.z, w.w};
#pragma unroll
                for (int q = 0; q < 4; ++q) { v[j * 8 + 2 * q] = __uint_as_float(ww[q] << 16); v[j * 8 + 2 * q + 1] = __uint_as_float(ww[q] & 0xffff0000u); } }
#pragma unroll
            for (int q = 0; q < 32; ++q) s += v[q];
            const float mean = wave_sum(s) * (1.f / 2048.f); float qq = 0.f;
#pragma unroll
            for (int q = 0; q < 32; ++q) { const float d = v[q] - mean; qq += d * d; }
            const float rstd = 1.f / sqrtf(wave_sum(qq) * (1.f / 2048.f) + EPS);
            if (lane == 0) { st[2 * tl] = mean; st[2 * tl + 1] = rstd; }
        } }
        u32x4 vw[8], wcw[4];
        { int tid_ = threadIdx.x; asm volatile("" : "+v"(tid_)); const int tid = tid_, c8 = tid & 31;
#pragma unroll
            for (int q = 0; q < 8; ++q) vw[q] = *(const u32x4*)(Z + (size_t)(t0 + (tid >> 5) + 16 * q) * 4096 + 2048 + c8 * 8);
#pragma unroll
            for (int q = 0; q < 4; ++q) { const int cidx = tid + 512 * q, r = cidx >> 4, c16 = cidx & 15; wcw[q] = *(const u32x4*)(WSB + r * 128 + c16 * 8); } }
#pragma unroll 1
        for (int g = 0; g < 8; ++g) {
            int tid_ = threadIdx.x; asm volatile("" : "+v"(tid_));
            const int tid = tid_, lane = tid & 63, wave = __builtin_amdgcn_readfirstlane(tid >> 6), fr = lane & 15, fq = lane >> 4;
            __syncthreads();
#pragma unroll
            for (int q = 0; q < 4; ++q) { const int cidx = tid + 512 * q, r = cidx >> 4, c16 = cidx & 15; *(LAS u32x4*)(L + OFF_WC + r * WC_STRIDE + c16 * 16) = wcw[q]; }
            {
                const int c8 = tid & 31; const float* vg = in->v_g + g * 256 + c8 * 8; const float* vb = in->v_b + g * 256 + c8 * 8;
                const f32x4 g0 = *(const f32x4*)vg, g1 = *(const f32x4*)(vg + 4), b0 = *(const f32x4*)vb, b1 = *(const f32x4*)(vb + 4);
#pragma unroll
                for (int q = 0; q < 8; ++q) { const int s = (tid >> 5) + 16 * q;
                    const u32x4 w = vw[q];
                    const float mean = st[2 * s], rstd = st[2 * s + 1];
                    f32x4 x0 = {__uint_as_float(w.x << 16), __uint_as_float(w.x & 0xffff0000u), __uint_as_float(w.y << 16), __uint_as_float(w.y & 0xffff0000u)};
                    f32x4 x1 = {__uint_as_float(w.z << 16), __uint_as_float(w.z & 0xffff0000u), __uint_as_float(w.w << 16), __uint_as_float(w.w & 0xffff0000u)};
                    x0 = (x0 - mean) * rstd * g0 + b0; x1 = (x1 - mean) * rstd * g1 + b1;
                    u32x4 o; o.x = pk2(x0[0], x0[1]); o.y = pk2(x0[2], x0[3]); o.z = pk2(x1[0], x1[1]); o.w = pk2(x1[2], x1[3]);
                    *(LAS u32x4*)(L + OFF_VN + s * VN_STRIDE + c8 * 16) = o; }
            }
            u32x2 uw[8][2]; float bsv[8];
#pragma unroll
            for (int tb = 0; tb < 8; ++tb) { const int t = 16 * tb + fr; bsv[tb] = in->b_s[g * 128 + t];
#pragma unroll
                for (int db = 0; db < 2; ++db) uw[tb][db] = *(const u32x2*)(Z + (size_t)(t0 + t) * 4096 + 256 * g + 32 * wave + 16 * db + 4 * fq); }
            __syncthreads();
            if (g < 7) { const int c8 = tid & 31;
#pragma unroll
                for (int q = 0; q < 8; ++q) vw[q] = *(const u32x4*)(Z + (size_t)(t0 + (tid >> 5) + 16 * q) * 4096 + 2048 + (g + 1) * 256 + c8 * 8);
#pragma unroll
                for (int q = 0; q < 4; ++q) { const int cidx = tid + 512 * q, r = cidx >> 4, c16 = cidx & 15; wcw[q] = *(const u32x4*)(WSB + (size_t)(g + 1) * 16384 + r * 128 + c16 * 8); } }
            f32x4 acc[8][2];
#pragma unroll
            for (int tb = 0; tb < 8; ++tb) { acc[tb][0] = (f32x4){0.f, 0.f, 0.f, 0.f}; acc[tb][1] = (f32x4){0.f, 0.f, 0.f, 0.f}; }
#pragma unroll
            for (int ks = 0; ks < 4; ++ks) {
                const int s0 = 32 * ks; bf16x8 X[2];
#pragma unroll
                for (int db = 0; db < 2; ++db) { LAS unsigned char* p = L + OFF_VN + (s0 + 4 * fq + (fr >> 2)) * VN_STRIDE + (32 * wave + 16 * db + 4 * (fr & 3)) * 2;
                    const s16x4 lo = ds_tr16(p), hi = ds_tr16(p + 16 * VN_STRIDE);
                    X[db] = (bf16x8){lo[0], lo[1], lo[2], lo[3], hi[0], hi[1], hi[2], hi[3]}; }
#pragma unroll
                for (int tb = 0; tb < 8; ++tb) if (2 * ks <= tb) {
                    LAS unsigned char* p = L + OFF_WC + (16 * tb + fr) * WC_STRIDE + (s0 + 4 * fq) * 2;
                    const u32x2 y0 = *(LAS u32x2*)p, y1 = *(LAS u32x2*)(p + 32);
                    const bf16x8 Y = __builtin_bit_cast(bf16x8, (u32x4){y0.x, y0.y, y1.x, y1.y});
                    acc[tb][0] = __builtin_amdgcn_mfma_f32_16x16x32_bf16(X[0], Y, acc[tb][0], 0, 0, 0);
                    acc[tb][1] = __builtin_amdgcn_mfma_f32_16x16x32_bf16(X[1], Y, acc[tb][1], 0, 0, 0); }
            }
#pragma unroll
            for (int tb = 0; tb < 8; ++tb) { const int t = 16 * tb + fr;
#pragma unroll
                for (int db = 0; db < 2; ++db) { const int dd = 256 * g + 32 * wave + 16 * db + 4 * fq;
                    const u32x2 uwv = uw[tb][db];
                    const f32x4 m = acc[tb][db] + bsv[tb];
                    u32x2 o; o.x = pk2(__uint_as_float(uwv.x << 16) * m[0], __uint_as_float(uwv.x & 0xffff0000u) * m[1]); o.y = pk2(__uint_as_float(uwv.y << 16) * m[2], __uint_as_float(uwv.y & 0xffff0000u) * m[3]);
                    *(u32x2*)(GT + (size_t)(t0 + t) * 2048 + dd) = o; } }
        }
    }
}

constexpr int NPH = 18;
struct PA { In in; unsigned char* ws; float* out; int ph_lo, ph_hi, li, pad; };
__global__ void __launch_bounds__(512, 2) fwd(PA args) {
    extern __shared__ __attribute__((aligned(16))) unsigned char lds[];
    Frame F; F.ws = args.ws; F.out = args.out; F.lds = (LAS unsigned char*)lds;
    F.bid = blockIdx.x; F.G = gridDim.x;
    LAS unsigned char* ldsl = (LAS unsigned char*)lds;
    volatile LAS unsigned* MISC = (volatile LAS unsigned*)(ldsl + MISC_OFF);
    for (int u = threadIdx.x; u < (LDS_BYTES - LDSCTL_OFF) / 4; u += 512) ((LAS unsigned*)(ldsl + LDSCTL_OFF))[u] = 0u;
    __syncthreads();
    unsigned char* const ws0 = args.ws;
    XcdBarrier bar = xcd_barrier_post((unsigned*)(ws0 + WS_CTL) + CW_BAR + args.li * XCD_BAR_WORDS, MISC + 8);
    const int lo = args.ph_lo, hi = args.ph_hi;
#ifndef PHMASK
#define PHMASK 0x3ffffu
#endif
#define IN(k) (((PHMASK >> (k)) & 1u) && lo <= (k) && (k) < hi)
#define SEAM(k) do { if (lo <= (k) && (k) + 1 < hi) { if ((k) <= 13) xcd_barrier_bg(bar, ws0, ldsl, MISC + 12); else xcd_barrier(bar); } } while (0)
    const int c = (int)blockIdx.x, G = (int)gridDim.x;

    if (IN(0)) { ph_prologue(F); } SEAM(0);
    if (IN(1)) { ph_norm0(F); } SEAM(1);
    if (IN(2)) {
        unsigned char* ws = opq(ws0);
        pg::StaticOrder S; S.init(T / 256, 4096 / 256, G, c);
        pg::SrcPlain<true> src{(const char*)(ws + WS_WIN), 2048}; pg::EpGeluZ E{(bf16_t*)(ws + WS_Z)};
        pg::gemm_phase<pg::EpGeluZ, pg::StaticOrder, pg::SrcPlain<true>, true>(ldsl, (const char*)(ws + WS_XN), 1024, S, src, E);
    } SEAM(2);
    if (IN(3)) { ph_spatial(F); } SEAM(3);
    if (IN(4)) {
        unsigned char* ws = opq(ws0); const float* mods = (const float*)(ws + WS_MODS);
        pg::StaticOrder S; S.init(T / 256, 1024 / 256, G, c);
        pg::SrcPlain<true> src{(const char*)(ws + WS_WOUT), 4096}; pg::EpResid<true> E{kin()->x, (bf16_t*)(ws + WS_XR), mods + 2048};
        pg::gemm_phase<pg::EpResid<true>, pg::StaticOrder, pg::SrcPlain<true>, true>(ldsl, (const char*)(ws + WS_GATED), 2048, S, src, E);
    } SEAM(4);
#define LAYER_MOE(L, P0) \
    if (IN(P0)) { ph_norm_router(F, L); } SEAM(P0); \
    if (IN(P0 + 1)) { if ((P0) == 13) { TID_LANE_WAVE; if (tid == 0) MISC[12] = 0u; __syncthreads(); bg_cvt(ws0, ldsl, wave, lane, MISC + 12); } ph_list(F); } SEAM(P0 + 1); \
    if (IN(P0 + 2)) {     \
        unsigned char* ws = opq(ws0); const int* blke = (const int*)(ws + WS_BLKE); \
        pg::StaticOrder S; S.init(blke[MAXBLK], 8, G, c); \
        pg::SrcMoeA src{(const char*)(ws + WS_W1) + (size_t)L * 32 * 2048 * 1024 * 2, (const int*)(ws + WS_LIST), blke, 2048}; pg::EpSwiglu E{(bf16_t*)(ws + WS_ACT), kin()->exp_b1 + (size_t)L * 32 * 2048, blke}; \
        pg::gemm_phase<pg::EpSwiglu, pg::StaticOrder, pg::SrcMoeA, true>(ldsl, (const char*)(ws + WS_XN), 1024, S, src, E); \
    } SEAM(P0 + 2); \
    if (IN(P0 + 3)) {     \
        unsigned char* ws = opq(ws0); const int* blke = (const int*)(ws + WS_BLKE); \
        pg::StaticOrder S; S.init(blke[MAXBLK], 4, G, c); \
        pg::SrcMoeB src{(const char*)(ws + WS_W2) + (size_t)L * 32 * 1024 * 1024 * 2, blke, 2048}; pg::EpMoeOut E{(bf16_t*)(ws + WS_YB), kin()->exp_b2 + (size_t)L * 32 * 1024, blke, (const float*)(ws + WS_ROWG)}; \
        pg::gemm_phase<pg::EpMoeOut, pg::StaticOrder, pg::SrcMoeB, true>(ldsl, (const char*)(ws + WS_ACT), 1024, S, src, E); \
    } SEAM(P0 + 3); \
    if (IN(P0 + 4)) { ph_combine(F, L); } SEAM(P0 + 4);

    LAYER_MOE(0, 5)
    if (IN(10)) {
        unsigned char* ws = opq(ws0);
        ph_cumsum(F);
        pg::StaticOrder S; S.init(T / 256, 2048 / 256, G, c);
        { pg::SrcHeads src{(const char*)(ws + WS_WKV), 2048}; pg::EpHeads<0> E{(bf16_t*)(ws + WS_K), (bf16_t*)(ws + WS_V), kin()->k_norm_g};
          pg::gemm_phase<pg::EpHeads<0>, pg::StaticOrder, pg::SrcHeads, true>(ldsl, (const char*)(ws + WS_HKV), 1024, S, src, E); }
        { pg::SrcHeads src{(const char*)(ws + WS_WQG), 2048}; pg::EpHeads<1> E{(bf16_t*)(ws + WS_Q), (bf16_t*)(ws + WS_GS), kin()->q_norm_g};
          pg::gemm_phase<pg::EpHeads<1>, pg::StaticOrder, pg::SrcHeads, true>(ldsl, (const char*)(ws + WS_XN), 1024, S, src, E); }
    } SEAM(10);
    if (IN(11)) {
        unsigned char* ws = opq(ws0);
        static_assert(attn_body::ATTN_LDS_BYTES <= RING_BYTES, "attention LDS");
        const attn_body::AttnTensors AT{(const attn_body::bf16*)(ws + WS_Q), (const attn_body::bf16*)(ws + WS_K), (const attn_body::bf16*)(ws + WS_V), (const attn_body::bf16*)(ws + WS_GS), (attn_body::bf16*)(ws + WS_O), (const unsigned long long*)(ws + WS_G3), kin()->q_norm_g, kin()->k_norm_g};
        attn_body::attn_phase<8>((char*)lds, AT, G, c);
    } SEAM(11);
    if (IN(12)) {
        unsigned char* ws = opq(ws0); const float* mods = (const float*)(ws + WS_MODS);
        pg::StaticOrder S; S.init(T / 256, 1024 / 256, G, c);
        pg::SrcPlain<true> src{(const char*)(ws + WS_WO), 2048}; pg::EpResid<false> E{(const bf16_t*)(ws + WS_XR), (bf16_t*)(ws + WS_XR), mods + 8 * 6144 + 2048};
        pg::gemm_phase<pg::EpResid<false>, pg::StaticOrder, pg::SrcPlain<true>, true>(ldsl, (const char*)(ws + WS_O), 1024, S, src, E);
    } SEAM(12);
    LAYER_MOE(1, 13)
#undef LAYER_MOE
#undef IN
#undef SEAM
}

#include <cstring>
extern "C" void kernel_launch(void* const* d_in, const int* in_sizes, int n_in, void* d_out, int out_size, void* d_ws, size_t ws_size, hipStream_t stream) {
    if (n_in != 28 || ws_size < WS_END || out_size != T * DM) { fprintf(stderr, "kernel_launch: unexpected arguments (n_in %d, ws %zu, out %d)\n", n_in, ws_size, out_size); return; }
    static int grid = 0;
    if (grid == 0) {
        int dev = 0, cus = 0, per_cu = 0;
        if (hipGetDevice(&dev) != hipSuccess || hipDeviceGetAttribute(&cus, hipDeviceAttributeMultiprocessorCount, dev) != hipSuccess) { grid = -1; return; }
        if (hipFuncSetAttribute((const void*)fwd, hipFuncAttributeMaxDynamicSharedMemorySize, LDS_BYTES) != hipSuccess) { fprintf(stderr, "kernel_launch: hipFuncSetAttribute failed\n"); grid = -1; return; }
        if (hipOccupancyMaxActiveBlocksPerMultiprocessor(&per_cu, (const void*)fwd, 512, LDS_BYTES) != hipSuccess || per_cu < 1) fprintf(stderr, "kernel_launch: occupancy query says %d\n", per_cu);
        (void)hipGetLastError();
        grid = cus;
    }
    if (grid < 0) return;
    KA a; memset((void*)&a, 0, sizeof(a));
    { const float** p = (const float**)&a.in; for (int i = 0; i < 28; ++i) p[i] = (const float*)d_in[i]; }
    a.ws = (unsigned char*)d_ws; a.out = (float*)d_out;
    PA pa; memset((void*)&pa, 0, sizeof(pa)); pa.in = a.in; pa.ws = a.ws; pa.out = a.out;
    (void)hipMemsetAsync((unsigned char*)d_ws + WS_CTL, 0, 1 * MiB, stream);
    pa.ph_lo = 0; pa.ph_hi = NPH; pa.li = 0;
    hipLaunchKernelGGL(fwd, dim3(grid), dim3(512), LDS_BYTES, stream, pa);
}
```

```cpp
#include <hip/hip_runtime.h>
#include <cstdio>
#include <cstdint>

#define LAS __attribute__((address_space(3)))
#define GAS __attribute__((address_space(1)))
typedef unsigned short bf16_t;
typedef float f32x4 __attribute__((ext_vector_type(4)));
typedef short bf16x8 __attribute__((ext_vector_type(8)));
typedef unsigned u32x4 __attribute__((ext_vector_type(4)));
typedef unsigned u32x2 __attribute__((ext_vector_type(2)));
typedef int i32x4 __attribute__((ext_vector_type(4)));

constexpr int NB = 8, SEQ = 4096, DM = 1024, T = NB * SEQ;
constexpr int GW = 2048, NG = 8, GD = 256, CH = 128;
constexpr int NH = 16, HD = 64;
constexpr int NE = 32, TOPK = 4;
constexpr int MAXBLK = 544, MAXROWS = MAXBLK * 256;
constexpr float EPS = 1e-6f;
constexpr float LOG2E = 1.4426950408889634f;
constexpr float C2 = 0.125f * LOG2E;

constexpr size_t MiB = 1u << 20;
constexpr size_t WS_CTL = 0;
constexpr size_t WS_MODS = 1 * MiB;
constexpr size_t WS_RB2 = 1 * MiB + 3 * 8 * 6144 * 4;
constexpr size_t WS_FB2 = WS_RB2 + 2 * 8 * 32 * 4;
constexpr size_t WS_HIST = 2 * MiB;
constexpr size_t WS_BLKE = 2 * MiB + 65536;
constexpr size_t WS_TOPE = 3 * MiB;
constexpr size_t WS_TOPG = 4 * MiB;
constexpr size_t WS_DEST = 5 * MiB;
constexpr size_t WS_LIST = 6 * MiB;
constexpr size_t WS_ROWG = 7 * MiB;
constexpr size_t WS_VSTAT = 8 * MiB;
constexpr size_t WS_LOGF = 9 * MiB;
constexpr size_t WS_FC = 11 * MiB;
constexpr size_t WS_G3 = 13 * MiB;
constexpr size_t WS_WIN = 32 * MiB;
constexpr size_t WS_WOUT = 40 * MiB;
constexpr size_t WS_WKV = 44 * MiB;
constexpr size_t WS_WQG = 48 * MiB;
constexpr size_t WS_WO = 52 * MiB;
constexpr size_t WS_WS = 54 * MiB;
constexpr size_t WS_W1 = 64 * MiB;
constexpr size_t WS_W2 = 320 * MiB;
constexpr size_t WS_XN = 448 * MiB;
constexpr size_t WS_HKV = 512 * MiB;
constexpr size_t WS_XN8 = 640 * MiB;
constexpr size_t WS_XR = 576 * MiB;
constexpr size_t WS_Z = 704 * MiB;
constexpr size_t WS_GATED = 960 * MiB;
constexpr size_t WS_ACT = 704 * MiB;
constexpr size_t WS_YB = 976 * MiB;
constexpr size_t WS_PKV = 704 * MiB;
constexpr size_t WS_PQG = 960 * MiB;
constexpr size_t WS_Q = 1248 * MiB;
constexpr size_t WS_K = 1312 * MiB;
constexpr size_t WS_V = 1376 * MiB;
constexpr size_t WS_GS = 1440 * MiB;
constexpr size_t WS_O = 1504 * MiB;
constexpr size_t WS_END = 1568 * MiB;

__device__ __forceinline__ float bf2f(bf16_t v) { return __uint_as_float(((unsigned)v) << 16); }
__device__ __forceinline__ unsigned f2bf(float f) { unsigned u = __float_as_uint(f); return (u + 0x7fffu + ((u >> 16) & 1u)) >> 16; }
__device__ __forceinline__ unsigned pk2(float lo, float hi) { return f2bf(lo) | (f2bf(hi) << 16); }
__device__ __forceinline__ float wave_sum(float v) {
#pragma unroll
    for (int o = 1; o < 64; o <<= 1) v += __shfl_xor(v, o);
    return v;
}
__device__ __forceinline__ float siluf(float x) { return x / (1.f + expf(-x)); }
__device__ __forceinline__ float sigmoidf_(float x) { return 1.f / (1.f + expf(-x)); }

struct In {
    const float *x, *c, *ada_w, *ada_b, *norm_mix_g, *norm_ffn_g, *w_in, *v_g, *v_b, *w_s, *b_s, *w_out, *kv_ada_w, *kv_ada_b, *kv_norm_g, *kv_w, *k_norm_g, *fgate_b,
        *w_qg, *q_norm_g, *w_o, *router_w, *router_b, *exp_w1, *exp_b1, *exp_w2, *exp_b2, *final_g;
};

typedef const In __attribute__((address_space(4)))* InP;
__device__ __forceinline__ InP kin() { auto p = __builtin_amdgcn_kernarg_segment_ptr(); asm volatile("" : "+s"(p)); return (InP)p; }
__device__ __forceinline__ unsigned char* opq(unsigned char* p) { size_t z = 0; asm volatile("" : "+s"(z)); return p + z; }
struct KA { In in; unsigned char* ws; float* out; int L; int pad; };

__device__ __forceinline__ void transpose_item(const float* W, int K, int N, int ldw, bf16_t* WT, LAS float* scr, int item, int lane) {
    const int nblk = N / 32, kb = item / nblk, nb = item % nblk, k0 = 64 * kb, n0 = 32 * nb;
#pragma unroll 32
    for (int i = 0; i < 32; ++i) { const int kk = 2 * i + (lane >> 5); scr[kk * 33 + (lane & 31)] = W[(size_t)(k0 + kk) * ldw + n0 + (lane & 31)]; }
    __builtin_amdgcn_s_waitcnt(0xc07f); asm volatile("" ::: "memory");
    const int c = lane & 7;
#pragma unroll
    for (int j = 0; j < 4; ++j) { const int n = (lane >> 3) + 8 * j; const LAS float* s = scr + (8 * c) * 33 + n;
        u32x4 o; o.x = pk2(s[0 * 33], s[1 * 33]); o.y = pk2(s[2 * 33], s[3 * 33]); o.z = pk2(s[4 * 33], s[5 * 33]); o.w = pk2(s[6 * 33], s[7 * 33]);
        *(u32x4*)(WT + (size_t)(n0 + n) * K + k0 + 8 * c) = o; }
    __builtin_amdgcn_s_waitcnt(0xc07f); asm volatile("" ::: "memory");
}
__device__ __forceinline__ unsigned pk4_fp8(float a, float b, float c, float d) { int w = 0; w = __builtin_amdgcn_cvt_pk_fp8_f32(a, b, w, false); w = __builtin_amdgcn_cvt_pk_fp8_f32(c, d, w, true); return (unsigned)w; }
constexpr float W8_SCALE = 32.f, A8_SCALE = 4.f, MOE_DESCALE = 1.f / (32.f * 4.f);
__device__ __forceinline__ void transpose_item_fp8(const float* W, int K, int N, int ldw, unsigned char* WT, LAS float* scr, int item, int lane) {
    const int nblk = N / 32, kb = item / nblk, nb = item % nblk, k0 = 64 * kb, n0 = 32 * nb;
#pragma unroll 32
    for (int i = 0; i < 32; ++i) { const int kk = 2 * i + (lane >> 5); scr[kk * 33 + (lane & 31)] = W[(size_t)(k0 + kk) * ldw + n0 + (lane & 31)]; }
    __builtin_amdgcn_s_waitcnt(0xc07f); asm volatile("" ::: "memory");
    const int n = lane >> 1, hf = lane & 1; const LAS float* sp = scr + (32 * hf) * 33 + n;
#pragma unroll
    for (int q = 0; q < 2; ++q) { u32x4 o;
        o.x = pk4_fp8(sp[(16 * q + 0) * 33] * W8_SCALE, sp[(16 * q + 1) * 33] * W8_SCALE, sp[(16 * q + 2) * 33] * W8_SCALE, sp[(16 * q + 3) * 33] * W8_SCALE);
        o.y = pk4_fp8(sp[(16 * q + 4) * 33] * W8_SCALE, sp[(16 * q + 5) * 33] * W8_SCALE, sp[(16 * q + 6) * 33] * W8_SCALE, sp[(16 * q + 7) * 33] * W8_SCALE);
        o.z = pk4_fp8(sp[(16 * q + 8) * 33] * W8_SCALE, sp[(16 * q + 9) * 33] * W8_SCALE, sp[(16 * q + 10) * 33] * W8_SCALE, sp[(16 * q + 11) * 33] * W8_SCALE);
        o.w = pk4_fp8(sp[(16 * q + 12) * 33] * W8_SCALE, sp[(16 * q + 13) * 33] * W8_SCALE, sp[(16 * q + 14) * 33] * W8_SCALE, sp[(16 * q + 15) * 33] * W8_SCALE);
        *(u32x4*)(WT + (size_t)(n0 + n) * K + k0 + 32 * hf + 16 * q) = o; }
    __builtin_amdgcn_s_waitcnt(0xc07f); asm volatile("" ::: "memory");
}
constexpr int IT_WIN = 16 * 128, IT_WOUT = 32 * 32, IT_WKV = 16 * 64, IT_WQG = 16 * 64, IT_WO = 16 * 32, IT_W1 = 16 * 64  , IT_W2 = 16 * 32;
constexpr int IT_SMALL = IT_WIN + IT_WOUT + IT_WKV + IT_WQG + IT_WO;
constexpr int IT_ALL = IT_SMALL + 64 * IT_W1 + 64 * IT_W2;
constexpr int IT_FG = IT_SMALL + 32 * IT_W1 + 32 * IT_W2, IT_BG = 32 * IT_W1 + 32 * IT_W2;
__host__ __device__ __forceinline__ int fg_item(int i) { return i < IT_SMALL + 32 * IT_W1 ? i : i + 32 * IT_W1; }
__host__ __device__ __forceinline__ int bg_item(int k) { return k < 32 * IT_W1 ? IT_SMALL + 32 * IT_W1 + k : IT_SMALL + 64 * IT_W1 + 32 * IT_W2 + (k - 32 * IT_W1); }
constexpr int CW_CVT = 2048;
__device__ __forceinline__ void cvt_item(InP inp, unsigned char* ws, int it, LAS float* scr, int lane) {
    if (it < IT_WIN) { transpose_item(inp->w_in, 1024, 4096, 4096, (bf16_t*)(ws + WS_WIN), scr, it, lane); return; } it -= IT_WIN;
    if (it < IT_WOUT) { transpose_item(inp->w_out, 2048, 1024, 1024, (bf16_t*)(ws + WS_WOUT), scr, it, lane); return; } it -= IT_WOUT;
    if (it < IT_WKV) { transpose_item(inp->kv_w, 1024, 2048, 2064, (bf16_t*)(ws + WS_WKV), scr, it, lane); return; } it -= IT_WKV;
    if (it < IT_WQG) { transpose_item(inp->w_qg, 1024, 2048, 2048, (bf16_t*)(ws + WS_WQG), scr, it, lane); return; } it -= IT_WQG;
    if (it < IT_WO) { transpose_item(inp->w_o, 1024, 1024, 1024, (bf16_t*)(ws + WS_WO), scr, it, lane); return; } it -= IT_WO;
    if (it < 64 * IT_W1) { const int e = it / IT_W1; transpose_item_fp8(inp->exp_w1 + (size_t)e * 1024 * 2048, 1024, 2048, 2048, ws + WS_W1 + (size_t)e * 2048 * 1024, scr, it % IT_W1, lane); return; } it -= 64 * IT_W1;
    { const int e = it / IT_W2; transpose_item_fp8(inp->exp_w2 + (size_t)e * 1024 * 1024, 1024, 1024, 1024, ws + WS_W2 + (size_t)e * 1024 * 1024, scr, it % IT_W2, lane); }
}
constexpr int ADA_ITEMS = 96 + 96 + 32;
__device__ __forceinline__ void ada_item(InP inp, float* mods, int item, const LAS float* sc  , LAS float* red  , int tid) {
    const int lane = tid & 63, wave = tid >> 6;
    int which, cg; const float* w; const float* bias; int ldw;
    if (item < 96) { which = 0; cg = item; w = inp->ada_w; bias = inp->ada_b; ldw = 6144; }
    else if (item < 192) { which = 1; cg = item - 96; w = inp->ada_w + (size_t)1024 * 6144; bias = inp->ada_b + 6144; ldw = 6144; }
    else { which = 2; cg = item - 192; w = inp->kv_ada_w; bias = inp->kv_ada_b; ldw = 2048; }
    const int col = cg * 64 + lane;
    float acc[8];
#pragma unroll
    for (int b = 0; b < 8; ++b) acc[b] = 0.f;
    for (int k = wave * 128; k < wave * 128 + 128; ++k) {
        const float wv = w[(size_t)k * ldw + col];
#pragma unroll
        for (int b = 0; b < 8; ++b) acc[b] += sc[b * 1024 + k] * wv;
    }
#pragma unroll
    for (int b = 0; b < 8; ++b) red[(wave * 8 + b) * 64 + lane] = acc[b];
    __syncthreads();
    {
        const int b = tid >> 6; float s = 0.f;
#pragma unroll
        for (int w8 = 0; w8 < 8; ++w8) s += red[(w8 * 8 + b) * 64 + lane];
        mods[((size_t)which * 8 + b) * 6144 + col] = s + bias[col];
    }
    __syncthreads();
}
__device__ __forceinline__ void row_load(const float* xrow, int lane, f32x4 (&v)[4]) {
#pragma unroll
    for (int j = 0; j < 2; ++j) { v[2 * j] = ((const f32x4*)xrow)[2 * lane + 128 * j]; v[2 * j + 1] = ((const f32x4*)xrow)[2 * lane + 128 * j + 1]; }
}
__device__ __forceinline__ void bf8_to_f32(u32x4 w, f32x4& a, f32x4& b) {
    a = (f32x4){__uint_as_float(w.x << 16), __uint_as_float(w.x & 0xffff0000u), __uint_as_float(w.y << 16), __uint_as_float(w.y & 0xffff0000u)};
    b = (f32x4){__uint_as_float(w.z << 16), __uint_as_float(w.z & 0xffff0000u), __uint_as_float(w.w << 16), __uint_as_float(w.w & 0xffff0000u)};
}
__device__ __forceinline__ void row_load_bf(const bf16_t* xrow, int lane, f32x4 (&v)[4]) {
#pragma unroll
    for (int j = 0; j < 2; ++j) bf8_to_f32(((const u32x4*)xrow)[lane + 64 * j], v[2 * j], v[2 * j + 1]);
}
__device__ __forceinline__ float row_rstd(const f32x4 (&v)[4]) {
    float s = 0.f;
#pragma unroll
    for (int j = 0; j < 4; ++j) s += (v[j].x * v[j].x + v[j].y * v[j].y) + (v[j].z * v[j].z + v[j].w * v[j].w);
    return 1.f / sqrtf(wave_sum(s) * (1.f / 1024.f) + EPS);
}
__device__ __forceinline__ f32x4 row_vec(const float* p, int lane, int q) { return ((const f32x4*)p)[2 * lane + 128 * (q >> 1) + (q & 1)]; }
__device__ __forceinline__ void row_modnorm(const f32x4 (&v)[4], float rstd, const float* g, const float* sh, const float* sc, int lane, f32x4 (&h)[4]) {
#pragma unroll
    for (int q = 0; q < 4; ++q) h[q] = (v[q] * rstd * row_vec(g, lane, q)) * (1.f + row_vec(sc, lane, q)) + row_vec(sh, lane, q);
}
__device__ __forceinline__ void row_store_bf16(bf16_t* orow, int lane, const f32x4 (&h)[4]) {
#pragma unroll
    for (int j = 0; j < 2; ++j) { u32x4 w; w.x = pk2(h[2 * j].x, h[2 * j].y); w.y = pk2(h[2 * j].z, h[2 * j].w); w.z = pk2(h[2 * j + 1].x, h[2 * j + 1].y); w.w = pk2(h[2 * j + 1].z, h[2 * j + 1].w);
        ((u32x4*)orow)[lane + 64 * j] = w; }
}

__device__ __forceinline__ void row_store_fp8(unsigned char* orow, int lane, const f32x4 (&h)[4]) {
#pragma unroll
    for (int j = 0; j < 2; ++j) { u32x2 w; w.x = pk4_fp8(h[2 * j].x * A8_SCALE, h[2 * j].y * A8_SCALE, h[2 * j].z * A8_SCALE, h[2 * j].w * A8_SCALE);
        w.y = pk4_fp8(h[2 * j + 1].x * A8_SCALE, h[2 * j + 1].y * A8_SCALE, h[2 * j + 1].z * A8_SCALE, h[2 * j + 1].w * A8_SCALE); ((u32x2*)orow)[lane + 64 * j] = w; }
}
__device__ __forceinline__ void row4_norm_mod_store(const float* xrow, const float* g, const float* sh, const float* sc, bf16_t* orow, int lane) {
    f32x4 v[4]; float s = 0.f;
#pragma unroll
    for (int j = 0; j < 4; ++j) { v[j] = ((const f32x4*)xrow)[lane + 64 * j]; s += (v[j].x * v[j].x + v[j].y * v[j].y) + (v[j].z * v[j].z + v[j].w * v[j].w); }
    const float rstd = 1.f / sqrtf(wave_sum(s) * (1.f / 1024.f) + EPS);
#pragma unroll
    for (int j = 0; j < 4; ++j) { const f32x4 gg = ((const f32x4*)g)[lane + 64 * j], s1 = ((const f32x4*)sc)[lane + 64 * j], s0 = ((const f32x4*)sh)[lane + 64 * j];
        const f32x4 h = (v[j] * rstd * gg) * (1.f + s1) + s0; u32x2 w; w.x = pk2(h.x, h.y); w.y = pk2(h.z, h.w); ((u32x2*)orow)[lane + 64 * j] = w; }
}
__device__ __forceinline__ void row_store_f32(float* orow, int lane, const f32x4 (&h)[4]) {
#pragma unroll
    for (int j = 0; j < 2; ++j)
#pragma unroll
        for (int sq = 0; sq < 2; ++sq) { const int src = 32 * sq + (lane >> 1); f32x4 a, c;
#pragma unroll
            for (int i = 0; i < 4; ++i) { a[i] = __shfl(h[2 * j][i], src); c[i] = __shfl(h[2 * j + 1][i], src); }
            ((f32x4*)orow)[128 * j + 64 * sq + lane] = (lane & 1) ? c : a; }
}

__device__ __forceinline__ void route_row(const LAS float* hs  , const float* rw, const float* rb, int lane, int (&te)[4], float (&tg)[4]) {
    const int e = lane & 31, half = lane >> 5; float acc = 0.f;
    for (int k = half * 512; k < half * 512 + 512; ++k) acc += hs[k] * rw[k * 32 + e];
    acc += __shfl_xor(acc, 32);
    float val = acc + rb[e];
    float tv[4];
#pragma unroll
    for (int q = 0; q < 4; ++q) {
        float bv = val; int bi = e;
#pragma unroll
        for (int o = 1; o < 32; o <<= 1) { const float ov = __shfl_xor(bv, o); const int oi = __shfl_xor(bi, o); if (ov > bv || (ov == bv && oi < bi)) { bv = ov; bi = oi; } }
        te[q] = bi; tv[q] = bv; if (e == bi) val = -INFINITY;
    }
    float s = 0.f;
#pragma unroll
    for (int q = 0; q < 4; ++q) { tg[q] = expf(tv[q] - tv[0]); s += tg[q]; }
#pragma unroll
    for (int q = 0; q < 4; ++q) tg[q] /= s;
}

namespace pg {
constexpr int BM = 256, BK = 64, HALF = 128, HTB = HALF * BK * 2  , STAGE_BYTES = 8 * HTB, NXCD = 8, WGM = 8;
__host__ __device__ __forceinline__ int lds_byte(int r, int c) { const int st = (r >> 4) * 2 + (c >> 5), rr = r & 15, cc = c & 31, ob = rr * 64 + cc * 2; return st * 1024 + (ob ^ (((ob >> 9) & 1) << 5)); }
__host__ __device__ __forceinline__ void stage_rc(int b, int& R, int& C) { const int st = b / 1024, sb = b % 1024, swz = sb ^ (((sb >> 9) & 1) << 5); R = (st >> 1) * 16 + swz / 64; C = (st & 1) * 32 + (swz % 64) / 2; }
__host__ __device__ __forceinline__ int perm32(int rho) { const int n = rho >> 4, i = rho & 15; return 8 * (i >> 2) + 4 * n + (i & 3); }
struct Unit { int pm, pn; };
struct StaticOrder {
    int nM, nN, nwg, G, c;
    __device__ void init(int nM_, int nN_, int G_, int c_) { nM = nM_; nN = nN_; nwg = nM * nN; G = G_; c = c_; }
    __device__ bool next(int i, Unit& u) const {
        const long L = (long)i * G + c; if (L >= nwg) return false;
        int wgid = (int)L; { const int q = nwg / NXCD, r = nwg % NXCD, xcd = wgid % NXCD, off = wgid / NXCD; wgid = (xcd < r ? xcd * (q + 1) : r * (q + 1) + (xcd - r) * q) + off; }
        const int nig = WGM * nN, gid = wgid / nig, fm = gid * WGM, gsz = (nM - fm) < WGM ? (nM - fm) : WGM;
        u.pm = fm + ((wgid % nig) % gsz); u.pn = (wgid % nig) / gsz; return true;
    }
};
__device__ __forceinline__ unsigned cvt_pk_bf16(float lo, float hi) { unsigned r; asm volatile("v_cvt_pk_bf16_f32 %0, %1, %2" : "=v"(r) : "v"(lo), "v"(hi)); return r; }
typedef float f32x2 __attribute__((ext_vector_type(2)));
typedef int v8i32 __attribute__((ext_vector_type(8)));
typedef int v4i32 __attribute__((ext_vector_type(4)));
__device__ __forceinline__ f32x2 gelu_pk(f32x2 v) {
    const f32x2 av = __builtin_elementwise_abs(v), d = av * 0.2316418882f + 1.0f;
    f32x2 t; t.x = __builtin_amdgcn_rcpf(d.x); t.y = __builtin_amdgcn_rcpf(d.y);
    f32x2 q = t * 0.5307027145f + (-0.7265760135f); q = q * t + 0.7107068705f; q = q * t + (-0.142248368f); q = q * t + 0.127414796f; q = q * t;
    const f32x2 s = (v * v) * (-0.72134752044f);
    f32x2 e; e.x = __builtin_amdgcn_exp2f(s.x); e.y = __builtin_amdgcn_exp2f(s.y);
    const f32x2 m = v * (q * e), r = v - m;
    f32x2 o; o.x = v.x < 0.f ? m.x : r.x; o.y = v.y < 0.f ? m.y : r.y; return o;
}
__device__ __forceinline__ float fast_sigmoid(float x) { return __builtin_amdgcn_rcpf(1.f + __builtin_amdgcn_exp2f(-LOG2E * x)); }

template <bool PERM> struct SrcPlain { const char* B; int K2; static constexpr bool FP8 = false;
    __device__ __forceinline__ unsigned arow_off(const Unit& u, int h, int R) const { return (unsigned)(u.pm * BM + h * HALF + R) * (unsigned)K2; }
    __device__ __forceinline__ const char* bhalf(const Unit& u, int h) const { return B + (size_t)(u.pn * BM + h * HALF) * K2; }
    static __device__ __forceinline__ int brow(int R) { return PERM ? ((R & ~31) + perm32(R & 31)) : R; } };
struct SrcHeads { const char* B; int K2; static constexpr bool FP8 = false;
    __device__ __forceinline__ unsigned arow_off(const Unit& u, int h, int R) const { return (unsigned)(u.pm * BM + h * HALF + R) * (unsigned)K2; }
    __device__ __forceinline__ const char* bhalf(const Unit& u, int h) const { return B + (size_t)(u.pn * BM + h * 32) * K2; }
    static __device__ __forceinline__ int brow(int R) { return 64 * (R >> 5) + perm32(R & 31); } };
struct SrcMoeA { const char* W1; const int* list; const int* blke; int K2; static constexpr bool FP8 = true;
    __device__ __forceinline__ unsigned arow_off(const Unit& u, int h, int R) const { int t = list[u.pm * BM + h * HALF + R]; t = t < 0 ? 0 : t; return (unsigned)t * (unsigned)K2; }
    __device__ __forceinline__ const char* bhalf(const Unit& u, int h) const { const int e = blke[u.pm]; return W1 + ((size_t)e * 2048 + h * 1024 + u.pn * 128) * K2; }
    static __device__ __forceinline__ int brow(int R) { return (R & ~31) + perm32(R & 31); } };
struct SrcMoeB { const char* W2; const int* blke; int K2; static constexpr bool FP8 = true;
    __device__ __forceinline__ unsigned arow_off(const Unit& u, int h, int R) const { return (unsigned)(u.pm * BM + h * HALF + R) * (unsigned)K2; }
    __device__ __forceinline__ const char* bhalf(const Unit& u, int h) const { const int e = blke[u.pm]; return W2 + ((size_t)e * 1024 + u.pn * BM + h * HALF) * K2; }
    static __device__ __forceinline__ int brow(int R) { return (R & ~31) + perm32(R & 31); } };

struct EpGeluZ { bf16_t* Z;
    __device__ __forceinline__ void operator()(const f32x4 (&acc)[2][2][4][2], const Unit& u, int wr, int wc, int fr, int fq) const {
        const int row0 = u.pm * BM + wr * 64 + fr, col0 = u.pn * BM + wc * 32 + 8 * fq;
#pragma unroll
        for (int ai = 0; ai < 2; ++ai)
#pragma unroll
            for (int m = 0; m < 4; ++m) { bf16_t* rowp = Z + (size_t)(row0 + ai * HALF + m * 16) * 4096 + col0;
#pragma unroll
                for (int bj = 0; bj < 2; ++bj) { const f32x4 v0 = acc[ai][bj][m][0], v1 = acc[ai][bj][m][1];
                    const f32x2 a = gelu_pk((f32x2){v0[0], v0[1]}), b = gelu_pk((f32x2){v0[2], v0[3]}), c = gelu_pk((f32x2){v1[0], v1[1]}), d = gelu_pk((f32x2){v1[2], v1[3]});
                    u32x4 w; w.x = cvt_pk_bf16(a.x, a.y); w.y = cvt_pk_bf16(b.x, b.y); w.z = cvt_pk_bf16(c.x, c.y); w.w = cvt_pk_bf16(d.x, d.y);
                    *(u32x4*)(rowp + bj * HALF) = w; } }
    } };
template <bool F32BASE> struct EpResid { const void* base; bf16_t* out; const float* gate;
    __device__ __forceinline__ void operator()(const f32x4 (&acc)[2][2][4][2], const Unit& u, int wr, int wc, int fr, int fq) const {
        const int b = u.pm >> 4; const float* gt = gate + (size_t)b * 6144; const int col0 = u.pn * BM + wc * 32 + 8 * fq;
        f32x4 gv[2][2];
#pragma unroll
        for (int bj = 0; bj < 2; ++bj)
#pragma unroll
            for (int n = 0; n < 2; ++n) gv[bj][n] = *(const f32x4*)(gt + col0 + bj * HALF + 4 * n);
#pragma unroll
        for (int ai = 0; ai < 2; ++ai)
#pragma unroll
            for (int m = 0; m < 4; ++m) { const size_t off = (size_t)(u.pm * BM + ai * HALF + wr * 64 + m * 16 + fr) * DM + col0;
#pragma unroll
                for (int bj = 0; bj < 2; ++bj) { f32x4 b0, b1;
                    if constexpr (F32BASE) { b0 = *(const f32x4*)((const float*)base + off + bj * HALF); b1 = *(const f32x4*)((const float*)base + off + bj * HALF + 4); }
                    else bf8_to_f32(*(const u32x4*)((const bf16_t*)base + off + bj * HALF), b0, b1);
                    const f32x4 r0 = b0 + gv[bj][0] * acc[ai][bj][m][0], r1 = b1 + gv[bj][1] * acc[ai][bj][m][1];
                    u32x4 w; w.x = cvt_pk_bf16(r0[0], r0[1]); w.y = cvt_pk_bf16(r0[2], r0[3]); w.z = cvt_pk_bf16(r1[0], r1[1]); w.w = cvt_pk_bf16(r1[2], r1[3]);
                    *(u32x4*)(out + off + bj * HALF) = w; } }
    } };
struct EpSwiglu { unsigned char* act; const float* b1; const int* blke;
    __device__ __forceinline__ void operator()(const f32x4 (&acc)[2][2][4][2], const Unit& u, int wr, int wc, int fr, int fq) const {
        const int e = blke[u.pm]; const int col0 = u.pn * 128 + wc * 32 + 8 * fq; const float* bb = b1 + (size_t)e * 2048 + col0;
        f32x4 bg[2], bl[2];
#pragma unroll
        for (int n = 0; n < 2; ++n) { bg[n] = *(const f32x4*)(bb + 4 * n); bl[n] = *(const f32x4*)(bb + 1024 + 4 * n); }
#pragma unroll
        for (int ai = 0; ai < 2; ++ai)
#pragma unroll
            for (int m = 0; m < 4; ++m) { const int row = u.pm * BM + ai * HALF + wr * 64 + m * 16 + fr; float a[8];
#pragma unroll
                for (int n = 0; n < 2; ++n) { const f32x4 g4 = acc[ai][0][m][n] * MOE_DESCALE + bg[n], l4 = acc[ai][1][m][n] * MOE_DESCALE + bl[n];
#pragma unroll
                    for (int j = 0; j < 4; j += 2) {
                        f32x2 g = {fminf(g4[j], 7.f), fminf(g4[j + 1], 7.f)}; f32x2 l = {__builtin_amdgcn_fmed3f(l4[j], -7.f, 7.f), __builtin_amdgcn_fmed3f(l4[j + 1], -7.f, 7.f)};
                        const f32x2 x = g * (-1.702f * LOG2E); f32x2 e; e.x = __builtin_amdgcn_exp2f(x.x); e.y = __builtin_amdgcn_exp2f(x.y);
                        const f32x2 d = e + 1.0f; f32x2 r; r.x = __builtin_amdgcn_rcpf(d.x); r.y = __builtin_amdgcn_rcpf(d.y);
                        const f32x2 o = (l + 1.0f) * (g * r); a[4 * n + j] = o.x; a[4 * n + j + 1] = o.y; } }
                u32x2 w; w.x = pk4_fp8(a[0] * A8_SCALE, a[1] * A8_SCALE, a[2] * A8_SCALE, a[3] * A8_SCALE); w.y = pk4_fp8(a[4] * A8_SCALE, a[5] * A8_SCALE, a[6] * A8_SCALE, a[7] * A8_SCALE);
                *(u32x2*)(act + (size_t)row * 1024 + col0) = w; }
    } };
struct EpMoeOut { bf16_t* yb; const float* b2; const int* blke; const float* rowg;
    __device__ __forceinline__ void operator()(const f32x4 (&acc)[2][2][4][2], const Unit& u, int wr, int wc, int fr, int fq) const {
        const int e = blke[u.pm]; const int col0 = u.pn * BM + wc * 32 + 8 * fq;
        f32x4 bv[2][2];
#pragma unroll
        for (int bj = 0; bj < 2; ++bj)
#pragma unroll
            for (int n = 0; n < 2; ++n) bv[bj][n] = *(const f32x4*)(b2 + (size_t)e * 1024 + col0 + bj * HALF + 4 * n);
#pragma unroll
        for (int ai = 0; ai < 2; ++ai)
#pragma unroll
            for (int m = 0; m < 4; ++m) { const int row = u.pm * BM + ai * HALF + wr * 64 + m * 16 + fr; const float rg = rowg[row];
#pragma unroll
                for (int bj = 0; bj < 2; ++bj) { const f32x4 v0 = (acc[ai][bj][m][0] * MOE_DESCALE + bv[bj][0]) * rg, v1 = (acc[ai][bj][m][1] * MOE_DESCALE + bv[bj][1]) * rg;
                    u32x4 w; w.x = cvt_pk_bf16(v0[0], v0[1]); w.y = cvt_pk_bf16(v0[2], v0[3]); w.z = cvt_pk_bf16(v1[0], v1[1]); w.w = cvt_pk_bf16(v1[2], v1[3]);
                    *(u32x4*)(yb + (size_t)row * 1024 + col0 + bj * HALF) = w; } }
    } };
template <int MODE> struct EpHeads { bf16_t* o0; bf16_t* o1; const float* g;
    __device__ __forceinline__ void operator()(const f32x4 (&acc)[2][2][4][2], const Unit& u, int wr, int wc, int fr, int fq) const {
        const bool first = u.pn < 4; bf16_t* O = first ? o0 : o1; const int colbase = (u.pn & 3) * 256 + wc * 64 + 8 * fq;
        f32x4 gv[2][2];
#pragma unroll
        for (int bj = 0; bj < 2; ++bj)
#pragma unroll
            for (int n = 0; n < 2; ++n) gv[bj][n] = *(const f32x4*)(g + 32 * bj + 8 * fq + 4 * n);
#pragma unroll
        for (int ai = 0; ai < 2; ++ai)
#pragma unroll
            for (int m = 0; m < 4; ++m) { const int row = u.pm * BM + ai * HALF + wr * 64 + m * 16 + fr; f32x4 v[2][2];
                if (first) { float ss = 0.f;
#pragma unroll
                    for (int bj = 0; bj < 2; ++bj)
#pragma unroll
                        for (int n = 0; n < 2; ++n) { const f32x4 x = acc[ai][bj][m][n]; ss += (x[0] * x[0] + x[1] * x[1]) + (x[2] * x[2] + x[3] * x[3]); }
                    ss += __shfl_xor(ss, 16); ss += __shfl_xor(ss, 32);
                    float r = 1.f / sqrtf(ss * (1.f / 64.f) + EPS); if (MODE == 1) r *= C2;
#pragma unroll
                    for (int bj = 0; bj < 2; ++bj)
#pragma unroll
                        for (int n = 0; n < 2; ++n) v[bj][n] = acc[ai][bj][m][n] * r * gv[bj][n];
                } else {
#pragma unroll
                    for (int bj = 0; bj < 2; ++bj)
#pragma unroll
                        for (int n = 0; n < 2; ++n) { f32x4 x = acc[ai][bj][m][n]; if (MODE == 1) { x[0] = fast_sigmoid(x[0]); x[1] = fast_sigmoid(x[1]); x[2] = fast_sigmoid(x[2]); x[3] = fast_sigmoid(x[3]); } v[bj][n] = x; }
                }
#pragma unroll
                for (int bj = 0; bj < 2; ++bj) { u32x4 w; w.x = cvt_pk_bf16(v[bj][0][0], v[bj][0][1]); w.y = cvt_pk_bf16(v[bj][0][2], v[bj][0][3]); w.z = cvt_pk_bf16(v[bj][1][0], v[bj][1][1]); w.w = cvt_pk_bf16(v[bj][1][2], v[bj][1][3]);
                    *(u32x4*)(O + (size_t)row * DM + colbase + 32 * bj) = w; } }
    } };

template <class Epi, class Sched, class Src, bool ALIGN_EPI>
__device__ __forceinline__ void gemm_phase(LAS unsigned char* lds, const char* Abase, int K, const Sched& S, const Src& src, const Epi& E) {
    int tid_ = threadIdx.x; asm volatile("" : "+v"(tid_));
    const int tid = tid_, wid = __builtin_amdgcn_readfirstlane(tid >> 6), lane = tid & 63, wr = wid >> 2, wc = wid & 3, fr = lane & 15, fq = lane >> 4;
    const int nt = K / BK; constexpr bool PARK = Src::FP8;
    int sR[2], sC[2]; unsigned voffB[2];
#pragma unroll
    for (int i = 0; i < 2; ++i) { stage_rc(tid * 16 + i * 8192, sR[i], sC[i]); voffB[i] = (unsigned)(Src::brow(sR[i]) * K + sC[i]) * 2u; }
    const size_t kstep = (size_t)(BK * 2);
    const unsigned ldsw = (unsigned)wid * 1024u;
    const int aoff = lds_byte(wr * 64 + fr, fq * 8), boff = lds_byte(wc * 32 + fr, fq * 8);
#define PG_SA(b, h) (((b) * 2 + (h)) * HTB)
#define PG_SB(b, h) ((4 + (b) * 2 + (h)) * HTB)
#define PG_STAGE(bufoff, gbase, v0, v1) do { \
        __builtin_amdgcn_global_load_lds((const unsigned*)((const char*)(gbase) + (v0)), (LAS unsigned*)(lds + (bufoff) + ldsw), 16, 0, 0); \
        __builtin_amdgcn_global_load_lds((const unsigned*)((const char*)(gbase) + (v1)), (LAS unsigned*)(lds + (bufoff) + ldsw + 8192), 16, 0, 0); } while (0)
#define PG_LD16(p) (*(const LAS v4i32*)(p))
#define PG_LDA(dst, b, h) do { if constexpr (Src::FP8) { _Pragma("unroll") for (int m = 0; m < 4; ++m) { const v4i32 x0_ = PG_LD16(lds + PG_SA(b, h) + aoff + m * 2048), x1_ = PG_LD16(lds + PG_SA(b, h) + aoff + m * 2048 + 1024); \
            dst##8[m] = __builtin_shufflevector(x0_, x1_, 0, 1, 2, 3, 4, 5, 6, 7); } } else { \
        _Pragma("unroll") for (int m = 0; m < 4; ++m) _Pragma("unroll") for (int k = 0; k < 2; ++k) dst[m][k] = *(const LAS bf16x8*)(lds + PG_SA(b, h) + aoff + m * 2048 + k * 1024); } } while (0)
#define PG_LDB(dst, b, h) do { if constexpr (Src::FP8) { _Pragma("unroll") for (int n = 0; n < 2; ++n) { const v4i32 x0_ = PG_LD16(lds + PG_SB(b, h) + boff + n * 2048), x1_ = PG_LD16(lds + PG_SB(b, h) + boff + n * 2048 + 1024); \
            dst##8[n] = __builtin_shufflevector(x0_, x1_, 0, 1, 2, 3, 4, 5, 6, 7); } } else { \
        _Pragma("unroll") for (int n = 0; n < 2; ++n) _Pragma("unroll") for (int k = 0; k < 2; ++k) dst[n][k] = *(const LAS bf16x8*)(lds + PG_SB(b, h) + boff + n * 2048 + k * 1024); } } while (0)
#define PG_MMA(ai, bj, At, Bt) do { __builtin_amdgcn_s_setprio(1); if constexpr (Src::FP8) { _Pragma("unroll") for (int m = 0; m < 4; ++m) _Pragma("unroll") for (int n = 0; n < 2; ++n) \
        acc[ai][bj][m][n] = __builtin_amdgcn_mfma_scale_f32_16x16x128_f8f6f4(Bt##8[n], At##8[m], acc[ai][bj][m][n], 0, 0, 0, 0x7f7f7f7f, 0, 0x7f7f7f7f); } else { \
        _Pragma("unroll") for (int m = 0; m < 4; ++m) _Pragma("unroll") for (int n = 0; n < 2; ++n) _Pragma("unroll") for (int k = 0; k < 2; ++k) \
        acc[ai][bj][m][n] = __builtin_amdgcn_mfma_f32_16x16x32_bf16(Bt[n][k], At[m][k], acc[ai][bj][m][n], 0, 0, 0); } __builtin_amdgcn_s_setprio(0); } while (0)
#define PG_WAIT_V(n) asm volatile("s_waitcnt vmcnt(" #n ")" ::: "memory")
#define PG_WAIT_L(n) asm volatile("s_waitcnt lgkmcnt(" #n ")" ::: "memory")
#define PG_BAR __builtin_amdgcn_s_barrier()
#define PG_SCHED __builtin_amdgcn_sched_barrier(0)
    Unit cur, nxt; int ui = 0;
    if (!S.next(0, cur)) return;
    f32x4 acc[2][2][4][2];
#pragma unroll
    for (int a = 0; a < 2; ++a)
#pragma unroll
        for (int b = 0; b < 2; ++b)
#pragma unroll
            for (int m = 0; m < 4; ++m)
#pragma unroll
                for (int n = 0; n < 2; ++n) acc[a][b][m][n] = (f32x4){0.f, 0.f, 0.f, 0.f};
    bf16x8 At[4][2], B0[2][2], B1[2][2]; v8i32 At8[4], B08[2], B18[2];
    unsigned vc[2][2], vn[2][2];
#pragma unroll
    for (int h = 0; h < 2; ++h)
#pragma unroll
        for (int i = 0; i < 2; ++i) vc[h][i] = src.arow_off(cur, h, sR[i]) + (unsigned)sC[i] * 2u;
    const char* cB0 = src.bhalf(cur, 0); const char* cB1 = src.bhalf(cur, 1);
    const char* const cA = Abase;
    PG_STAGE(PG_SB(0, 0), cB0, voffB[0], voffB[1]); PG_STAGE(PG_SB(0, 1), cB1, voffB[0], voffB[1]); PG_STAGE(PG_SA(0, 0), cA, vc[0][0], vc[0][1]); PG_STAGE(PG_SA(0, 1), cA, vc[1][0], vc[1][1]);
    if (wr == 1) PG_BAR;
    PG_WAIT_V(2); PG_BAR;
    PG_STAGE(PG_SB(1, 0), cB0 + kstep, voffB[0], voffB[1]); PG_STAGE(PG_SA(1, 0), cA + kstep, vc[0][0], vc[0][1]); PG_STAGE(PG_SB(1, 1), cB1 + kstep, voffB[0], voffB[1]);
    PG_WAIT_V(6); PG_BAR;
    for (;;) {
        const bool has_next = S.next(ui + 1, nxt);
        const char* nB0 = cB0; const char* nB1 = cB1;
#pragma unroll
        for (int h = 0; h < 2; ++h)
#pragma unroll
            for (int i = 0; i < 2; ++i) vn[h][i] = vc[h][i];
        if (has_next) { nB0 = src.bhalf(nxt, 0); nB1 = src.bhalf(nxt, 1);
#pragma unroll
            for (int h = 0; h < 2; ++h)
#pragma unroll
                for (int i = 0; i < 2; ++i) vn[h][i] = src.arow_off(nxt, h, sR[i]) + (unsigned)sC[i] * 2u; }
        asm volatile("" : "+v"(vn[0][0]), "+v"(vn[0][1]), "+v"(vn[1][0]), "+v"(vn[1][1]));
        if constexpr (PARK) { u32x4 pv; pv.x = vn[0][0]; pv.y = vn[0][1]; pv.z = vn[1][0]; pv.w = vn[1][1]; *(LAS u32x4*)(lds + STAGE_BYTES + tid * 16) = pv; }
#pragma unroll 1
        for (int t = 0; t < nt; t += 2) {
            const bool last = (t == nt - 2);
            const char* a1 = cA + (size_t)(t + 1) * kstep;
            const char* a2 = last ? cA : cA + (size_t)(t + 2) * kstep; const char* a3 = a2 + kstep;
            const char* b20 = last ? nB0 : cB0 + (size_t)(t + 2) * kstep; const char* b21 = last ? nB1 : cB1 + (size_t)(t + 2) * kstep;
            const char* b30 = b20 + kstep; const char* b31 = b21 + kstep;
            unsigned w00, w01, w10, w11;
            if constexpr (!PARK) { w00 = last ? vn[0][0] : vc[0][0]; w01 = last ? vn[0][1] : vc[0][1]; w10 = last ? vn[1][0] : vc[1][0]; w11 = last ? vn[1][1] : vc[1][1]; }
            if constexpr (Src::FP8) asm volatile("" : "+s"(a1), "+s"(a2), "+s"(a3), "+s"(b20), "+s"(b21), "+s"(b30), "+s"(b31));
            PG_LDB(B0, 0, 0); PG_LDB(B1, 0, 1); PG_SCHED; PG_LDA(At, 0, 0); PG_STAGE(PG_SA(1, 1), a1, vc[1][0], vc[1][1]);
            if constexpr (PARK) { if (last) { const u32x4 pv = *(const LAS u32x4*)(lds + STAGE_BYTES + tid * 16); vc[0][0] = pv.x; vc[0][1] = pv.y; vc[1][0] = pv.z; vc[1][1] = pv.w; }
                w00 = vc[0][0]; w01 = vc[0][1]; w10 = vc[1][0]; w11 = vc[1][1]; }
            PG_WAIT_V(8); PG_WAIT_L(0); PG_BAR; PG_MMA(0, 0, At, B0); PG_MMA(0, 1, At, B1); PG_BAR; PG_SCHED;
            PG_LDA(At, 0, 1); PG_STAGE(PG_SB(0, 0), b20, voffB[0], voffB[1]); PG_STAGE(PG_SB(0, 1), b21, voffB[0], voffB[1]); PG_STAGE(PG_SA(0, 0), a2, w00, w01);
            PG_WAIT_V(8); PG_WAIT_L(0); PG_BAR; PG_MMA(1, 0, At, B0); PG_MMA(1, 1, At, B1); PG_BAR; PG_SCHED;
            PG_LDB(B0, 1, 0); PG_LDB(B1, 1, 1); PG_SCHED; PG_LDA(At, 1, 0); PG_STAGE(PG_SA(0, 1), a2, w10, w11);
            PG_WAIT_V(8); PG_WAIT_L(0); PG_BAR; PG_MMA(0, 0, At, B0); PG_MMA(0, 1, At, B1); PG_BAR; PG_SCHED;
            PG_LDA(At, 1, 1); PG_STAGE(PG_SB(1, 0), b30, voffB[0], voffB[1]); PG_STAGE(PG_SB(1, 1), b31, voffB[0], voffB[1]); PG_STAGE(PG_SA(1, 0), a3, w00, w01);
            PG_WAIT_V(8); PG_WAIT_L(0); PG_BAR; PG_MMA(1, 0, At, B0); PG_MMA(1, 1, At, B1); PG_BAR; PG_SCHED;
        }
        if constexpr (ALIGN_EPI) { if (wr == 0) PG_BAR; }
        if constexpr (PARK) { int t2 = threadIdx.x; asm volatile("" : "+v"(t2)); E(acc, cur, wr, wc, t2 & 15, (t2 & 63) >> 4); }
        else E(acc, cur, wr, wc, fr, fq);
        if (!has_next) break;
#pragma unroll
        for (int a = 0; a < 2; ++a)
#pragma unroll
            for (int b = 0; b < 2; ++b)
#pragma unroll
                for (int m = 0; m < 4; ++m)
#pragma unroll
                    for (int n = 0; n < 2; ++n) acc[a][b][m][n] = (f32x4){0.f, 0.f, 0.f, 0.f};
        cur = nxt; cB0 = nB0; cB1 = nB1; ++ui;
        if constexpr (!PARK) {
#pragma unroll
        for (int h = 0; h < 2; ++h)
#pragma unroll
            for (int i = 0; i < 2; ++i) vc[h][i] = vn[h][i]; }
        if constexpr (ALIGN_EPI) { if (wr == 1) PG_BAR; }
    }
    PG_WAIT_V(0);
    if constexpr (!ALIGN_EPI) { if (wr == 0) PG_BAR; }
    PG_BAR;
#undef PG_SA
#undef PG_SB
#undef PG_STAGE
#undef PG_LDA
#undef PG_LDB
#undef PG_MMA
#undef PG_LD16
#undef PG_WAIT_V
#undef PG_WAIT_L
#undef PG_BAR
#undef PG_SCHED
}
}
#include <hip/hip_bf16.h>
#include <cmath>
namespace attn_body {
using bf16=__hip_bfloat16;
using bf16x8=__attribute__((ext_vector_type(8)))short;
using s16x4=__attribute__((ext_vector_type(4)))short;
using f32x16=__attribute__((ext_vector_type(16)))float;
using u32x4=__attribute__((ext_vector_type(4)))unsigned;
constexpr int BATCH=8,NHEAD=16,SEQ=4096,D=64,DM=NHEAD*D;
constexpr int NW=8,QBLK=32,QB=QBLK*NW,KVBLK=64,NQB=SEQ/QB;
constexpr int ATTN_PITCH=DM, ATTN_UNIT_ROWS=QB;
__device__ __forceinline__ int crow(int r,int hi){return (r&3)+8*(r>>2)+4*hi;}
#define SBAR() __builtin_amdgcn_sched_barrier(0)
__device__ __forceinline__ void cmask(f32x16&p0,f32x16&p1,int jb,int qrel,int hi){
  const float NEG=-INFINITY; int kb=64*jb+4*hi;
  #pragma unroll
  for(int r=0;r<16;++r){int kv=kb+(r&3)+8*(r>>2); if(kv>qrel)p0[r]=NEG; if(kv+32>qrel)p1[r]=NEG;}
}

constexpr int NSLOT=3, SLOTB=8192;
constexpr int LDS_K=0, LDS_V=NSLOT*SLOTB, LDS_WS=2*NSLOT*SLOTB, LDS_OST=LDS_WS+NW*64*4, LDS_GPAD=LDS_OST+NW*4096, LDS_G3=LDS_GPAD+128*8, LDS_BYTES=LDS_G3+SEQ*8;
constexpr float C2_=0.125f*1.4426950408889634f;
__device__ __forceinline__ void glds16(const void*gsrc,unsigned lds_dst){unsigned keep;
  asm volatile("s_mov_b32 %0, m0\n\ts_mov_b32 m0, %2\n\ts_nop 0\n\tglobal_load_lds_dwordx4 %1, off\n\ts_mov_b32 m0, %0":"=&s"(keep):"v"(gsrc),"s"(lds_dst):"memory");}
__device__ __forceinline__ float max3f(float a,float b,float c){float r;asm("v_max3_f32 %0, %1, %2, %3":"=v"(r):"v"(a),"v"(b),"v"(c));return r;}
__device__ __forceinline__ float max2f(float a,float b){float r;asm("v_max_f32_e32 %0, %1, %2":"=v"(r):"v"(a),"v"(b));return r;}
__device__ __forceinline__ float fadd_s(float a,float b){float r;asm("v_add_f32_e32 %0, %1, %2":"=v"(r):"v"(a),"v"(b));return r;}
__device__ __forceinline__ float fsub_s(float a,float b){float r;asm("v_sub_f32_e32 %0, %1, %2":"=v"(r):"v"(a),"v"(b));return r;}
typedef float f32x2_t __attribute__((ext_vector_type(2))); typedef __bf16 bf16x2_t __attribute__((ext_vector_type(2)));
__device__ __forceinline__ unsigned cvtpk_s(float lo,float hi){f32x2_t v={lo,hi};bf16x2_t b=__builtin_convertvector(v,bf16x2_t);return __builtin_bit_cast(unsigned,b);}
#define WAIT_BAR(N) asm volatile("s_waitcnt vmcnt(" #N ") lgkmcnt(0)\n\ts_barrier":::"memory")

__device__ __forceinline__ void qkt(f32x16&p0,f32x16&p1,const char*Kslot,const bf16x8*qr,bf16x8 ka0,bf16x8 ka1,bf16x8 qa,int r32,int hi){
  const char*kb=Kslot+hi*1024+r32*16;
  { const f32x16 z=f32x16{}; p0=__builtin_amdgcn_mfma_f32_32x32x16_bf16(ka0,qa,z,0,0,0); p1=__builtin_amdgcn_mfma_f32_32x32x16_bf16(ka1,qa,z,0,0,0); }
  #pragma unroll
  for(int d0=0;d0<4;++d0){
    const bf16x8 b0=*reinterpret_cast<const bf16x8*>(kb+d0*2048);
    const bf16x8 b1=*reinterpret_cast<const bf16x8*>(kb+d0*2048+512);
    p0=__builtin_amdgcn_mfma_f32_32x32x16_bf16(b0,qr[d0],p0,0,0,0);p1=__builtin_amdgcn_mfma_f32_32x32x16_bf16(b1,qr[d0],p1,0,0,0);}
}
typedef __attribute__((address_space(3))) const char* lds_cptr;
typedef short v4i16_t __attribute__((ext_vector_type(4)));
__device__ __forceinline__ void kload8(bf16x8*kf,lds_cptr kp){
  kf[0]=*(const __attribute__((address_space(3))) bf16x8*)(kp);      kf[1]=*(const __attribute__((address_space(3))) bf16x8*)(kp+512);
  kf[2]=*(const __attribute__((address_space(3))) bf16x8*)(kp+2048); kf[3]=*(const __attribute__((address_space(3))) bf16x8*)(kp+2560);
  kf[4]=*(const __attribute__((address_space(3))) bf16x8*)(kp+4096); kf[5]=*(const __attribute__((address_space(3))) bf16x8*)(kp+4608);
  kf[6]=*(const __attribute__((address_space(3))) bf16x8*)(kp+6144); kf[7]=*(const __attribute__((address_space(3))) bf16x8*)(kp+6656);
}
__device__ __forceinline__ void kload2(bf16x8*kf,lds_cptr kp,int j){ kf[2*j]=*(const __attribute__((address_space(3))) bf16x8*)(kp+j*2048); kf[2*j+1]=*(const __attribute__((address_space(3))) bf16x8*)(kp+j*2048+512); }
__device__ __forceinline__ s16x4 vtr(lds_cptr p){ return __builtin_bit_cast(s16x4,__builtin_amdgcn_ds_read_tr16_b64_v4i16((__attribute__((address_space(3))) v4i16_t*)p)); }
__device__ __forceinline__ float rowmax(const f32x16&p0,const f32x16&p1){
  float a=max3f(p0[0],p0[1],p1[0]),b=max3f(p0[2],p0[3],p1[1]);a=max3f(a,p1[2],p1[3]);
  #pragma unroll
  for(int r=4;r<16;r+=4){a=max3f(a,p0[r],p0[r+1]);b=max3f(b,p0[r+2],p0[r+3]);a=max3f(a,p1[r],p1[r+1]);b=max3f(b,p1[r+2],p1[r+3]);}
  const float m=max2f(a,b);
  auto rr=__builtin_amdgcn_permlane32_swap(__float_as_uint(m),__float_as_uint(m),false,false);
  return max2f(__uint_as_float(rr[0]),__uint_as_float(rr[1]));
}
__device__ __forceinline__ void pv(f32x16*o,int vb,bf16x8 pa0,bf16x8 pa1,bf16x8 pa2,bf16x8 pa3){
  #pragma unroll
  for(int d0=0;d0<2;++d0){s16x4 lo[4],hi[4];
    #pragma unroll
    for(int ks=0;ks<4;++ks){
      asm volatile("ds_read_b64_tr_b16 %0,%1 offset:%c2":"=&v"(lo[ks]):"v"(vb),"i"(d0*4096+ks*1024):"memory");
      asm volatile("ds_read_b64_tr_b16 %0,%1 offset:%c2":"=&v"(hi[ks]):"v"(vb),"i"(d0*4096+ks*1024+512):"memory");}
    asm volatile("s_waitcnt lgkmcnt(0)":::"memory");SBAR();
    #define PK(k) (bf16x8){lo[k][0],lo[k][1],lo[k][2],lo[k][3],hi[k][0],hi[k][1],hi[k][2],hi[k][3]}
    o[d0]=__builtin_amdgcn_mfma_f32_32x32x16_bf16(pa0,PK(0),o[d0],0,0,0);
    o[d0]=__builtin_amdgcn_mfma_f32_32x32x16_bf16(pa1,PK(1),o[d0],0,0,0);
    o[d0]=__builtin_amdgcn_mfma_f32_32x32x16_bf16(pa2,PK(2),o[d0],0,0,0);
    o[d0]=__builtin_amdgcn_mfma_f32_32x32x16_bf16(pa3,PK(3),o[d0],0,0,0);
    #undef PK
  }
}

#ifndef ATTN_STORE16
#define ATTN_STORE16(p,v) (*(u32x4*)(p)=(v))
#endif
template<int THRL> __device__ __forceinline__ void attn_unit(int b,int h,int qb,const bf16*Q,const bf16*__restrict__ K,const bf16*__restrict__ V,const bf16*__restrict__ GATE,bf16*O,char*shm,float skipthr){
  int tid_=threadIdx.x; asm volatile("":"+v"(tid_));
  const int tid=tid_,lane=tid&63,r32=lane&31,hi=lane>>5; const int wid=__builtin_amdgcn_readfirstlane(tid>>6);
  const long rowbase=(long)b*SEQ; const int q0=qb*QB;
  const bf16*Qw=Q+(rowbase+q0+wid*QBLK)*DM+h*D;
  const unsigned lds0=(unsigned)(uintptr_t)shm;
  int tskip;
  { typedef __attribute__((address_space(3))) const unsigned long long* lds_u64q; const lds_u64q gt_=(lds_u64q)((__attribute__((address_space(3))) const char*)shm+LDS_G3);
    const int NT0=(q0+QB)/KVBLK; const unsigned long long e0=gt_[q0], e1=gt_[lane<NT0?64*lane+63:q0];
    const float G0=(__uint_as_float((unsigned)e0<<16)+__uint_as_float((unsigned)e0&0xffff0000u))+__uint_as_float((unsigned)(e0>>32)<<16);
    const float G1=(__uint_as_float((unsigned)e1<<16)+__uint_as_float((unsigned)e1&0xffff0000u))+__uint_as_float((unsigned)(e1>>32)<<16);
    const int ns=__builtin_popcountll(__ballot(lane<NT0 && (G1-G0)<skipthr)); tskip=__builtin_amdgcn_readfirstlane(min(ns&~1,NT0-6)); }
  const bf16*Kh=K+(rowbase+(long)tskip*KVBLK)*DM+h*D,*Vh=V+(rowbase+(long)tskip*KVBLK)*DM+h*D;
  float*wsf=(float*)(shm+LDS_WS)+wid*64;
  const bf16*ksrc=Kh+(long)lane*DM+wid*8;
  const bf16*vsrc=Vh+(long)(16*(wid&3)+(lane>>2))*DM+(wid>>2)*32+(lane&3)*8;
  const unsigned kdst=lds0+LDS_K+wid*1024, vdst=lds0+LDS_V+wid*1024;
  #define DMA_K(t,slot) glds16(ksrc+(long)(t)*KVBLK*DM,(unsigned)__builtin_amdgcn_readfirstlane(kdst+(slot)))
  #define DMA_V(t,slot) glds16(vsrc+(long)(t)*KVBLK*DM,(unsigned)__builtin_amdgcn_readfirstlane(vdst+(slot)))
  const int vb0=(int)(lds0+LDS_V)+((lane>>4)&1)*32+(lane&3)*8+(4*hi+((lane&15)>>2))*64;
  const char*Kbase=shm+LDS_K; bf16x8 kf[8];
  const lds_cptr shm3=(lds_cptr)shm; const lds_cptr kp0=shm3+LDS_K+hi*1024+r32*16; const lds_cptr vp0=shm3+LDS_V+((lane>>4)&1)*32+(lane&3)*8+(4*hi+((lane&15)>>2))*64;
  const int NT=(q0+QB)/KVBLK-tskip;
  DMA_K(0,0);DMA_V(0,0);DMA_K(1,SLOTB);
  bf16x8 qr[4];
  #pragma unroll
  for(int d0=0;d0<4;++d0)qr[d0]=*reinterpret_cast<const bf16x8*>(&Qw[(long)r32*DM+d0*16+hi*8]);
  float mhat=0.f,l_reg=0.f;f32x16 o[2];o[0]=f32x16{};o[1]=f32x16{};
  typedef __attribute__((address_space(3))) const unsigned long long* lds_u64p;
  const lds_u64p g3p=(lds_u64p)(shm3+LDS_G3)+tskip*KVBLK+r32;
  { const unsigned long long e=((lds_u64p)(shm3+LDS_G3))[q0+wid*QBLK+r32]; const unsigned lo_=(unsigned)e,hi_=(unsigned)(e>>32); mhat=(__uint_as_float(lo_<<16)+__uint_as_float(lo_&0xffff0000u))+__uint_as_float(hi_<<16); }
  u32x4 qa; qa.x=hi?0u:0x3f803f80u; qa.y=0u; qa.z=0u; qa.w=0u;
  #define SETREF() do{ const float x_=-mhat; const unsigned b1_=cvtpk_s(x_,0.f)&0xffffu; const float r1_=x_-__uint_as_float(b1_<<16); const unsigned b2_=cvtpk_s(r1_,0.f)&0xffffu; \
      const float r2_=r1_-__uint_as_float(b2_<<16); const unsigned b3_=cvtpk_s(r2_,0.f)&0xffffu; qa.y=hi?0u:(0x3f80u|(b1_<<16)); qa.z=hi?0u:(b2_|(b3_<<16)); asm volatile("":"+v"(qa)); }while(0)
  SETREF();
  unsigned long long ga0,ga1;
  #define GARD(t) do{ ga0=g3p[(t)*64]; ga1=g3p[(t)*64+32]; }while(0)
  #define KAF(g) __builtin_bit_cast(bf16x8,(u32x4){(unsigned)(g),(unsigned)((g)>>32),0x3f803f80u,0u})
  #define QAF() __builtin_bit_cast(bf16x8,qa)
  const int qrel=wid*QBLK+r32;
  #define CMASK(P0,P1,t) do{int jb_=(t)-(NT-4); if(jb_>=0)cmask(P0,P1,jb_,qrel,hi);}while(0)
  bool resc=false;
  #define START(P0,P1) do{ const float rm=rowmax(P0,P1); resc=false; \
    { const float dl=__builtin_fmaxf(rm,0.f); mhat=fadd_s(mhat,dl);     \
      _Pragma("unroll") for(int r=0;r<16;++r){P0[r]=fsub_s(P0[r],dl);P1[r]=fsub_s(P1[r],dl);} \
      SETREF(); } \
    _Pragma("unroll") for(int r=0;r<16;++r)P0[r]=__builtin_amdgcn_exp2f(P0[r]); }while(0)
  #define RESC() do{ if(resc){ asm volatile("s_waitcnt lgkmcnt(0)":::"memory"); \
      _Pragma("unroll") for(int d_=0;d_<2;++d_) _Pragma("unroll") for(int r=0;r<16;++r)o[d_][r]*=wsf[crow(r,hi)]; } }while(0)
  f32x16 pA0,pA1,pB0,pB1;
  int sl_prev=0,sl_cur=0,sl_next=SLOTB;
  #define ROT() do{sl_prev=sl_cur;sl_cur=sl_next;sl_next=(sl_next==(NSLOT-1)*SLOTB)?0:sl_next+SLOTB;}while(0)
  DMA_K(2,2*SLOTB);
  WAIT_BAR(3);
  GARD(0); qkt(pA0,pA1,Kbase,qr,KAF(ga0),KAF(ga1),QAF(),r32,hi);asm volatile("s_nop 15\n\ts_nop 7":"+v"(pA0),"+v"(pA1));CMASK(pA0,pA1,0);
  START(pA0,pA1);
  _Pragma("unroll") for(int r=0;r<16;++r)pA1[r]=__builtin_amdgcn_exp2f(pA1[r]);
  WAIT_BAR(0);
  DMA_K(3,0);DMA_V(1,SLOTB);
  ROT();
  kload8(kf,kp0+sl_cur); GARD(1);
  WAIT_BAR(2);
  s16x4 vlo[8],vhi[8]; u32x4 pw0,pw1,pw2,pw3;
  #define PKW(P,B) cvtpk_s(P[B],P[B+1])
  #define PAF(k) __builtin_bit_cast(bf16x8,pw##k)
  #define VFR(i) (bf16x8){vlo[i][0],vlo[i][1],vlo[i][2],vlo[i][3],vhi[i][0],vhi[i][1],vhi[i][2],vhi[i][3]}
  #define PIN(x) asm volatile("":"+v"(x))
  #define MX3(a,b,c) __builtin_fmaxf(__builtin_fmaxf((a),(b)),(c))
  #define GAPA(MF,A0,A1,A2,A3,W0,W1,PW) do{ MF; sacc+=A0; sacc+=A1; sacc+=A2; sacc+=A3; PIN(sacc); W0; W1; PIN(PW); SBAR(); }while(0)
  #define EX(v) __builtin_amdgcn_exp2f(v)
  #define GAPB(MF,X,B) do{ MF; X[B]=EX(X[B]); X[B+1]=EX(X[B+1]); X[B+2]=EX(X[B+2]); X[B+3]=EX(X[B+3]); PIN(X); SBAR(); }while(0)
  #define VRD(i) do{ vlo[i]=vtr(vp_+(((i)>>2)*4096+((i)&3)*1024)); vhi[i]=vtr(vp_+(((i)>>2)*4096+((i)&3)*1024+512)); }while(0)
  #define KRD(G,j) do{ if(G){ kload2(kf,kp0+sl_next,j); SBAR(); } }while(0)
  #define STEP(C0,C1,P0,P1,t,GK,GV,GL) do{ SBAR(); \
    const lds_cptr vp_=vp0+sl_prev; \
    { const f32x16 z_=f32x16{}; C0=__builtin_amdgcn_mfma_f32_32x32x16_bf16(KAF(ga0),QAF(),z_,0,0,0); C1=__builtin_amdgcn_mfma_f32_32x32x16_bf16(KAF(ga1),QAF(),z_,0,0,0); } SBAR(); \
    VRD(0); SBAR(); float sacc=(P0[0]+P0[1]); \
    GAPA(C0=__builtin_amdgcn_mfma_f32_32x32x16_bf16(kf[0],qr[0],C0,0,0,0), P0[2],P0[3],P0[4],P0[5],     pw0[0]=PKW(P0,0), pw0[1]=PKW(P0,2), pw0); \
    VRD(4); SBAR(); GAPA(C1=__builtin_amdgcn_mfma_f32_32x32x16_bf16(kf[1],qr[0],C1,0,0,0), P0[6],P0[7],P0[8],P0[9],     pw0[2]=PKW(P0,4), pw0[3]=PKW(P0,6), pw0); \
    VRD(1); SBAR(); GAPA(C0=__builtin_amdgcn_mfma_f32_32x32x16_bf16(kf[2],qr[1],C0,0,0,0),   P0[10],P0[11],P0[12],P0[13], pw1[0]=PKW(P0,8), pw1[1]=PKW(P0,10), pw1); \
    VRD(5); SBAR(); GAPA(C1=__builtin_amdgcn_mfma_f32_32x32x16_bf16(kf[3],qr[1],C1,0,0,0),   P0[14],P0[15],P1[0],P1[1],   pw1[2]=PKW(P0,12),pw1[3]=PKW(P0,14), pw1); \
    VRD(2); SBAR(); GAPA(C0=__builtin_amdgcn_mfma_f32_32x32x16_bf16(kf[4],qr[2],C0,0,0,0),   P1[2],P1[3],P1[4],P1[5],     pw2[0]=PKW(P1,0), pw2[1]=PKW(P1,2), pw2); \
    VRD(6); SBAR(); GAPA(C1=__builtin_amdgcn_mfma_f32_32x32x16_bf16(kf[5],qr[2],C1,0,0,0),   P1[6],P1[7],P1[8],P1[9],     pw2[2]=PKW(P1,4), pw2[3]=PKW(P1,6), pw2); \
    VRD(3); SBAR(); GAPA(C0=__builtin_amdgcn_mfma_f32_32x32x16_bf16(kf[6],qr[3],C0,0,0,0),   P1[10],P1[11],P1[12],P1[13], pw3[0]=PKW(P1,8), pw3[1]=PKW(P1,10), pw3); \
    VRD(7); SBAR(); GAPA(C1=__builtin_amdgcn_mfma_f32_32x32x16_bf16(kf[7],qr[3],C1,0,0,0),   P1[14],P1[15],0.f,0.f,       pw3[2]=PKW(P1,12),pw3[3]=PKW(P1,14), pw3); \
    l_reg+=sacc; \
    if(GK){DMA_K((t)+3,sl_cur);} if(GV){DMA_V((t)+1,sl_next);} \
    CMASK(C0,C1,t); \
    { float a=MX3(C0[0],C0[1],C1[0]),b=MX3(C0[2],C0[3],C1[1]); a=MX3(a,C1[2],C1[3]); \
      _Pragma("unroll") for(int r=4;r<16;r+=4){a=MX3(a,C0[r],C0[r+1]);b=MX3(b,C0[r+2],C0[r+3]);a=MX3(a,C1[r],C1[r+1]);b=MX3(b,C1[r+2],C1[r+3]);} \
      float rm=__builtin_fmaxf(a,b); { auto rr=__builtin_amdgcn_permlane32_swap(__float_as_uint(rm),__float_as_uint(rm),false,false); rm=__builtin_fmaxf(__uint_as_float(rr[0]),__uint_as_float(rr[1])); } \
      resc=false; \
      if(__builtin_expect(__any(rm>(float)THRL),0)){ const float dl=__builtin_fmaxf(rm,0.f); mhat+=dl; \
        _Pragma("unroll") for(int r=0;r<16;++r){C0[r]-=dl;C1[r]-=dl;} \
        SETREF(); \
        const float f=__builtin_amdgcn_exp2f(-dl); l_reg*=f; if(hi==0)wsf[r32]=f; resc=true; } } \
    SBAR(); \
    GAPB(o[0]=__builtin_amdgcn_mfma_f32_32x32x16_bf16(PAF(0),VFR(0),o[0],0,0,0), C0,0); \
    GAPB(o[1]=__builtin_amdgcn_mfma_f32_32x32x16_bf16(PAF(0),VFR(4),o[1],0,0,0), C0,4); \
    KRD(GL,0); GAPB(o[0]=__builtin_amdgcn_mfma_f32_32x32x16_bf16(PAF(1),VFR(1),o[0],0,0,0), C0,8); \
    KRD(GL,1); GAPB(o[1]=__builtin_amdgcn_mfma_f32_32x32x16_bf16(PAF(1),VFR(5),o[1],0,0,0), C0,12); \
    KRD(GL,2); GAPB(o[0]=__builtin_amdgcn_mfma_f32_32x32x16_bf16(PAF(2),VFR(2),o[0],0,0,0), C1,0); \
    KRD(GL,3); GAPB(o[1]=__builtin_amdgcn_mfma_f32_32x32x16_bf16(PAF(2),VFR(6),o[1],0,0,0), C1,4); \
    if(GL){ GARD((t)+1); SBAR(); } GAPB(o[0]=__builtin_amdgcn_mfma_f32_32x32x16_bf16(PAF(3),VFR(3),o[0],0,0,0), C1,8); \
    GAPB(o[1]=__builtin_amdgcn_mfma_f32_32x32x16_bf16(PAF(3),VFR(7),o[1],0,0,0), C1,12); \
    }while(0)
  int t=1;
  #undef CMASK
  #define CMASK(P0,P1,t) do{}while(0)
  for(;t+5<NT;t+=2){
    STEP(pB0,pB1,pA0,pA1,t,true,true,true);     WAIT_BAR(2); RESC(); ROT();
    STEP(pA0,pA1,pB0,pB1,t+1,true,true,true);   WAIT_BAR(2); RESC(); ROT();
  }
  #undef CMASK
  #define CMASK(P0,P1,t) do{int jb_=(t)-(NT-4); if(jb_>=0)cmask(P0,P1,jb_,qrel,hi);}while(0)
  #define ENDW(tt) do{ if((tt)+3<NT){WAIT_BAR(2);} else if((tt)+2<NT){WAIT_BAR(1);} else {WAIT_BAR(0);} }while(0)
  #undef CMASK
  #define CMASK(P0,P1,t) do{}while(0)
  STEP(pB0,pB1,pA0,pA1,NT-5,true,true,true);   WAIT_BAR(2); RESC(); ROT();
  #undef CMASK
  #define CMASK(P0,P1,t) cmask(P0,P1,0,qrel,hi)
  STEP(pA0,pA1,pB0,pB1,NT-4,true,true,true);   WAIT_BAR(2); RESC(); ROT();
  #undef CMASK
  #define CMASK(P0,P1,t) cmask(P0,P1,1,qrel,hi)
  STEP(pB0,pB1,pA0,pA1,NT-3,false,true,true);  WAIT_BAR(1); RESC(); ROT();
  #undef CMASK
  #define CMASK(P0,P1,t) cmask(P0,P1,2,qrel,hi)
  STEP(pA0,pA1,pB0,pB1,NT-2,false,true,true);  WAIT_BAR(0); RESC(); ROT();
  #undef CMASK
  #define CMASK(P0,P1,t) cmask(P0,P1,3,qrel,hi)
  STEP(pB0,pB1,pA0,pA1,NT-1,false,false,false); RESC();
  { float sacc=pB0[0]+pB0[1]; _Pragma("unroll") for(int r=2;r<16;++r)sacc+=pB0[r]; _Pragma("unroll") for(int r=0;r<16;++r)sacc+=pB1[r]; l_reg+=sacc;
    pw0=(u32x4){PKW(pB0,0),PKW(pB0,2),PKW(pB0,4),PKW(pB0,6)};pw1=(u32x4){PKW(pB0,8),PKW(pB0,10),PKW(pB0,12),PKW(pB0,14)};pw2=(u32x4){PKW(pB1,0),PKW(pB1,2),PKW(pB1,4),PKW(pB1,6)};pw3=(u32x4){PKW(pB1,8),PKW(pB1,10),PKW(pB1,12),PKW(pB1,14)};
    SBAR(); pv(o,vb0+sl_cur,PAF(0),PAF(1),PAF(2),PAF(3)); }
  #undef PKW
  #undef PAF
  #undef VFR
  #undef PIN
  #undef MX3
  #undef GAPA
  #undef GAPB
  #undef EX
  #undef VRD
  #undef KRD
  #undef STEP
  #undef ENDW
  {auto rr=__builtin_amdgcn_permlane32_swap(__float_as_uint(l_reg),__float_as_uint(l_reg),false,false);l_reg=__uint_as_float(rr[0])+__uint_as_float(rr[1]);}
  if(hi==0)wsf[32+r32]=l_reg;asm volatile("s_waitcnt lgkmcnt(0)":::"memory");
  float rli[16];
  #pragma unroll
  for(int r=0;r<16;++r)rli[r]=__builtin_amdgcn_rcpf(wsf[32+crow(r,hi)]);
  bf16*Ow=O+(rowbase+q0+wid*QBLK)*DM+h*D; const bf16*Gw=GATE+(rowbase+q0+wid*QBLK)*DM+h*D;
  { bf16*stg=(bf16*)(shm+LDS_OST)+wid*2048;
    #pragma unroll
    for(int r=0;r<16;++r){const int orow=crow(r,hi);
      #pragma unroll
      for(int d0=0;d0<2;++d0)stg[orow*64+d0*32+r32]=__float2bfloat16(o[d0][r]*rli[r]);}
    asm volatile("s_waitcnt lgkmcnt(0)":::"memory");
    #pragma unroll
    for(int i=0;i<4;++i){const int row=i*8+(lane>>3),ch=lane&7; const u32x4 v=*(const u32x4*)(stg+row*64+ch*8); const u32x4 gv=*(const u32x4*)(Gw+(long)row*DM+ch*8); u32x4 w;
      #define GMUL(a,g) cvtpk_s(__uint_as_float((a)<<16)*__uint_as_float((g)<<16),__uint_as_float((a)&0xffff0000u)*__uint_as_float((g)&0xffff0000u))
      w.x=GMUL(v.x,gv.x); w.y=GMUL(v.y,gv.y); w.z=GMUL(v.z,gv.z); w.w=GMUL(v.w,gv.w);
      #undef GMUL
      ATTN_STORE16(Ow+(long)row*DM+ch*8,w);} }
  asm volatile("s_waitcnt lgkmcnt(0)\n\ts_barrier":::"memory");
  #undef DMA_K
  #undef DMA_V
  #undef CMASK
  #undef START
  #undef RESC
  #undef ROT
  #undef SETREF
  #undef GARD
  #undef KAF
  #undef QAF
}
constexpr int ATTN_LDS_BYTES=LDS_BYTES;
struct AttnTensors { const bf16* Q; const bf16* K; const bf16* V; const bf16* GATE; bf16* O; const unsigned long long* G3; const float* qg; const float* kg; };
template<int THRL=8> __device__ __forceinline__ void attn_phase(char*lds,const AttnTensors&T,int grid,int block){
  const int v0=(grid%8==0)?(block%8)*(grid/8)+block/8:block;
  float skipthr; { float a=fabsf(T.qg[threadIdx.x&63]),b=fabsf(T.kg[threadIdx.x&63]);
    #pragma unroll
    for(int o=1;o<64;o<<=1){a=fmaxf(a,__shfl_xor(a,o));b=fmaxf(b,__shfl_xor(b,o));}
    const float qkmax=64.f*a*b*C2_*1.05f; skipthr=-(42.f+3.f*qkmax); }
  for(int v=v0;v<BATCH*NHEAD*2;v+=grid){
    const int bh=v>>1,odd=v&1;
    {
      const u32x4*src=(const u32x4*)(T.G3+(size_t)bh*SEQ); u32x4*dst=(u32x4*)(lds+LDS_G3);
      #pragma unroll
      for(int i=0;i<4;++i)dst[threadIdx.x+512*i]=src[threadIdx.x+512*i];
      if(threadIdx.x<128)((unsigned long long*)(lds+LDS_GPAD))[threadIdx.x]=0x3f80000000000000ull|0xc6eaull;
      asm volatile("s_waitcnt vmcnt(0) lgkmcnt(0)\n\ts_barrier":::"memory"); }
    #pragma unroll 1
    for(int i=0;i<8;++i){ const int j=i>>1; const int qb=(i&1)?(15-2*j-odd):(2*j+odd); attn_unit<THRL>(bh/NHEAD,bh%NHEAD,qb,T.Q,T.K,T.V,T.GATE,T.O,lds,skipthr); }
  }
}
#undef SBAR
#undef WAIT_BAR
}

constexpr int RING_BYTES = 131072;
constexpr int LDS_BYTES = 163840;
constexpr int LDSCTL_OFF = LDS_BYTES - 1024, MISC_OFF = LDSCTL_OFF + 320;
constexpr int CW_BAR = 4096;
typedef GAS unsigned gu32;
#define RLX_AGENT __ATOMIC_RELAXED, __HIP_MEMORY_SCOPE_AGENT
#define XB_TMO      128
#define XB_XCNT(j)  (256  + 64 * (j))
#define XB_XSUB(j)  (1280 + 64 * (j))
#define XB_XGEN(j)  (2304 + 64 * (j))
#define XB_TOP      3328
#define XB_TOPGEN   3392
#define XCD_BAR_WORDS 3456
#define XB_SPIN_CAP (1u << 18)
__device__ __forceinline__ unsigned xb_ld(unsigned* p)              { return __hip_atomic_load(p, __ATOMIC_RELAXED, __HIP_MEMORY_SCOPE_AGENT); }
__device__ __forceinline__ unsigned xb_add(unsigned* p, unsigned v) { return __hip_atomic_fetch_add(p, v, __ATOMIC_RELAXED, __HIP_MEMORY_SCOPE_AGENT); }
__device__ __forceinline__ unsigned xb_xcc_id() { return (unsigned)__builtin_amdgcn_s_getreg((3 << 11) | 20) & 0xFu; }
#define XB_SPIN(cond, bar) do { unsigned _sp = 0; while (cond) { __builtin_amdgcn_s_sleep(1); \
    if ((++_sp & 255u) == 0u) { if (xb_ld(&(bar)[XB_TMO])) break; if (_sp > XB_SPIN_CAP) { atomicAdd(&(bar)[XB_TMO], 1u); break; } } } } while (0)
struct XcdBarrier { unsigned* bar; unsigned x; volatile LAS unsigned* st; };
__device__ __forceinline__ XcdBarrier xcd_barrier_post(unsigned* bar, volatile LAS unsigned* st) {
    XcdBarrier b; b.bar = bar; b.x = xb_xcc_id(); b.st = st;
    if (threadIdx.x == 0) (void)xb_add(&bar[XB_XCNT(b.x)], 1u);
    return b;
}
__device__ __forceinline__ void xcd_barrier_complete(unsigned* bar, unsigned x, unsigned& nloc, unsigned& nx) {
    const unsigned G = gridDim.x * gridDim.y * gridDim.z;
    unsigned sum, cnt, mine, sp = 0u;
    for (;;) {
        sum = 0u; cnt = 0u; mine = 0u;
#pragma unroll
        for (unsigned j = 0; j < 16; ++j) { const unsigned c = xb_ld(&bar[XB_XCNT(j)]); sum += c; cnt += (c > 0u) ? 1u : 0u; mine = (j == x) ? c : mine; }
        if (sum == G) break;
        __builtin_amdgcn_s_sleep(1);
        if ((++sp & 255u) == 0u) { if (xb_ld(&bar[XB_TMO])) break; if (sp > XB_SPIN_CAP) { atomicAdd(&bar[XB_TMO], 1u); break; } }
    }
    nloc = mine > 0u ? mine : 1u; nx = cnt > 0u ? cnt : 1u;
}
__device__ __forceinline__ void xcd_barrier(const XcdBarrier& b) {
    asm volatile("s_waitcnt vmcnt(0)" ::: "memory");
    __syncthreads();
    if (threadIdx.x == 0) {
        unsigned* bar = b.bar; unsigned bx = b.x;
        asm volatile("" : "+s"(bar), "+s"(bx));
        __builtin_amdgcn_s_waitcnt(0);
        unsigned nloc = b.st[0], nx = b.st[1];
        if (nloc == 0u) { xcd_barrier_complete(bar, bx, nloc, nx); b.st[0] = nloc; b.st[1] = nx; }
        const unsigned old = xb_add(&bar[XB_XSUB(bx)], 1u);
        const unsigned gen = old / nloc;
        if (old + 1u == (gen + 1u) * nloc) {
            __builtin_amdgcn_fence(__ATOMIC_RELEASE, "agent");
            asm volatile("s_waitcnt vmcnt(0)" ::: "memory");
            const unsigned og = xb_add(&bar[XB_TOP], 1u);
            const unsigned tg = og / nx;
            if (og + 1u == (tg + 1u) * nx) xb_add(&bar[XB_TOPGEN], 1u);
            else XB_SPIN(xb_ld(&bar[XB_TOPGEN]) == tg, bar);
            __builtin_amdgcn_fence(__ATOMIC_ACQUIRE, "agent");
            xb_add(&bar[XB_XGEN(bx)], 1u);
            asm volatile("s_waitcnt vmcnt(0)" ::: "memory");
        } else {
            XB_SPIN(xb_ld(&bar[XB_XGEN(bx)]) == gen, bar);
            __builtin_amdgcn_fence(__ATOMIC_ACQUIRE, "agent");
            asm volatile("s_waitcnt vmcnt(0)" ::: "memory");
        }
    }
    __syncthreads();
}

__device__ __forceinline__ void bg_cvt(unsigned char* ws, LAS unsigned char* lds, int wave, int lane, volatile LAS unsigned* flag) {
    const InP in = kin(); LAS float* scr = (LAS float*)(lds + wave * 8448); volatile LAS unsigned* cur = flag + 1;
    const unsigned c = blockIdx.x, G = gridDim.x;
    for (;;) {
        if (*flag != 0u) break;
        if (*cur * G + c >= (unsigned)IT_BG) break;
        unsigned k = 0u; if (lane == 0) k = __hip_atomic_fetch_add((LAS unsigned*)cur, 1u, __ATOMIC_RELAXED, __HIP_MEMORY_SCOPE_WORKGROUP); k = (unsigned)__builtin_amdgcn_readfirstlane((int)k);
        const unsigned it = k * G + c; if (it >= (unsigned)IT_BG) break;
        cvt_item(in, ws, bg_item((int)it), scr, lane);
    }
}
__device__ __forceinline__ void xcd_barrier_bg(const XcdBarrier& b, unsigned char* ws, LAS unsigned char* lds, volatile LAS unsigned* flag) {
    asm volatile("s_waitcnt vmcnt(0)" ::: "memory");
    if (threadIdx.x == 0) *flag = 0u;
    __syncthreads();
    const int wave = __builtin_amdgcn_readfirstlane((int)threadIdx.x >> 6), lane = threadIdx.x & 63;
    if (wave != 0) { bg_cvt(ws, lds, wave, lane, flag); asm volatile("s_waitcnt vmcnt(0)" ::: "memory"); }
    else if (threadIdx.x == 0) {
        unsigned* bar = b.bar; unsigned bx = b.x;
        asm volatile("" : "+s"(bar), "+s"(bx));
        __builtin_amdgcn_s_waitcnt(0);
        unsigned nloc = b.st[0], nx = b.st[1];
        if (nloc == 0u) { xcd_barrier_complete(bar, bx, nloc, nx); b.st[0] = nloc; b.st[1] = nx; }
        const unsigned old = xb_add(&bar[XB_XSUB(bx)], 1u);
        const unsigned gen = old / nloc;
        if (old + 1u == (gen + 1u) * nloc) {
            __builtin_amdgcn_fence(__ATOMIC_RELEASE, "agent");
            asm volatile("s_waitcnt vmcnt(0)" ::: "memory");
            const unsigned og = xb_add(&bar[XB_TOP], 1u);
            const unsigned tg = og / nx;
            if (og + 1u == (tg + 1u) * nx) xb_add(&bar[XB_TOPGEN], 1u);
            else XB_SPIN(xb_ld(&bar[XB_TOPGEN]) == tg, bar);
            __builtin_amdgcn_fence(__ATOMIC_ACQUIRE, "agent");
            xb_add(&bar[XB_XGEN(bx)], 1u);
            asm volatile("s_waitcnt vmcnt(0)" ::: "memory");
        } else {
            XB_SPIN(xb_ld(&bar[XB_XGEN(bx)]) == gen, bar);
            __builtin_amdgcn_fence(__ATOMIC_ACQUIRE, "agent");
            asm volatile("s_waitcnt vmcnt(0)" ::: "memory");
        }
        *flag = 1u;
    }
    __syncthreads();
}

struct Frame { unsigned char* ws; float* out; LAS unsigned char* lds; int bid, G; };
#define TID_LANE_WAVE const int tid = threadIdx.x, lane = tid & 63, wave = __builtin_amdgcn_readfirstlane(tid >> 6); (void)tid; (void)lane; (void)wave

__device__ __forceinline__ void ph_prologue(const Frame& F) {
    TID_LANE_WAVE;
    const InP in = kin(); unsigned char* ws = opq(F.ws);
    LAS float* sc = (LAS float*)F.lds; LAS float* red = (LAS float*)(F.lds + 32768);
    __syncthreads();
    if (F.bid < ADA_ITEMS) {
        for (int i = tid; i < 8 * 1024; i += 512) sc[i] = siluf(in->c[i]);
        __syncthreads();
        for (int it = F.bid; it < ADA_ITEMS; it += F.G) ada_item(in, (float*)(ws + WS_MODS), it, sc, red, tid);
    }
    __syncthreads();
    LAS float* scr = (LAS float*)(F.lds + wave * 8448);
    const int gw = F.bid * 8 + wave, ngw = F.G * 8;
    for (int it = gw; it < IT_FG; it += ngw) cvt_item(in, ws, fg_item(it), scr, lane);
    bf16_t* wsb = (bf16_t*)(ws + WS_WS);
    for (int i = F.bid * 512 + tid; i < 8 * 128 * 128; i += F.G * 512) { const int s = i & 127, t = (i >> 7) & 127; wsb[i] = (bf16_t)f2bf(s <= t ? in->w_s[i] : 0.f); }
}
__device__ __forceinline__ void ph_norm0(const Frame& F) {
    TID_LANE_WAVE; const InP in = kin(); unsigned char* ws = opq(F.ws); const int gw = F.bid * 8 + wave, ngw = F.G * 8;
    const float* mods = (const float*)(ws + WS_MODS);
    for (int r = gw; r < T; r += ngw) { const int b = r / SEQ;
        row4_norm_mod_store(in->x + (size_t)r * DM, in->norm_mix_g, mods + (size_t)b * 6144 + 0, mods + (size_t)b * 6144 + 1024, (bf16_t*)(ws + WS_XN) + (size_t)r * DM, lane); }
}
__device__ __forceinline__ void ph_norm_router(const Frame& F, int L) {
    TID_LANE_WAVE; const InP in = kin(); unsigned char* ws = opq(F.ws);
    LAS u32x4* WPB = (LAS u32x4*)F.lds;
    LAS float* lg = (LAS float*)(F.lds + 131072) + wave * 512;
    LAS int* hist = (LAS int*)(F.lds + 131072 + 16384);
    LAS float* rs_s = (LAS float*)(F.lds + 131072 + 16384 + 256) + wave * 16;
    LAS float* pb = (LAS float*)(F.lds + 131072);
    LAS float* rbl = (LAS float*)(F.lds + 131072 + 16384 + 256 + 512);
    const float* mods = (const float*)(ws + WS_MODS) + (size_t)L * 8 * 6144;
    const bf16_t* XR = (const bf16_t*)(ws + WS_XR);
    for (int grp = F.bid; grp < 256; grp += F.G) {
        const int b = grp >> 5; const float* gsc = mods + (size_t)b * 6144 + 4096; const float* gg = in->norm_ffn_g + L * 1024; const float* rw = in->router_w + (size_t)L * 1024 * 32;
        __syncthreads();
        float bpart = 0.f; const float* gsh = mods + (size_t)b * 6144 + 3072;
        for (int cidx = tid; cidx < 32 * 2 * 64; cidx += 512) { const int l = cidx & 63, hh = (cidx >> 6) & 1, s2 = cidx >> 7, e = 16 * hh + (l & 15), k0 = 32 * s2 + 8 * (l >> 4);
            unsigned hi[4], lo[4];
#pragma unroll
            for (int h2 = 0; h2 < 2; ++h2) { const f32x4 g4 = *(const f32x4*)(gg + k0 + 4 * h2), s4 = *(const f32x4*)(gsc + k0 + 4 * h2), h4 = *(const f32x4*)(gsh + k0 + 4 * h2); float wv[4];
#pragma unroll
                for (int q = 0; q < 4; ++q) { const float r_ = rw[(k0 + 4 * h2 + q) * 32 + e]; wv[q] = g4[q] * (1.f + s4[q]) * r_; bpart += h4[q] * r_; }
#pragma unroll
                for (int q = 0; q < 4; q += 2) { const unsigned a0 = f2bf(wv[q]), a1 = f2bf(wv[q + 1]); hi[2 * h2 + (q >> 1)] = a0 | (a1 << 16);
                    lo[2 * h2 + (q >> 1)] = f2bf(wv[q] - __uint_as_float(a0 << 16)) | (f2bf(wv[q + 1] - __uint_as_float(a1 << 16)) << 16); } }
            WPB[((s2 * 2 + 0) * 2 + hh) * 64 + l] = (u32x4){hi[0], hi[1], hi[2], hi[3]}; WPB[((s2 * 2 + 1) * 2 + hh) * 64 + l] = (u32x4){lo[0], lo[1], lo[2], lo[3]}; }
        pb[tid] = bpart;
        if (tid < 32) hist[tid] = 0;
        __syncthreads();
        if (tid < 32) { float t = in->router_b[L * 32 + tid];
#pragma unroll
            for (int p = 0; p < 16; ++p) t += pb[((p >> 2) << 7) | ((tid >> 4) << 6) | ((p & 3) << 4) | (tid & 15)];
            rbl[tid] = t; }
        __syncthreads();
        const int r0 = grp * 128 + wave * 16, j = lane & 15, kq = lane >> 4;
        {
            const bf16_t* xrow = XR + (size_t)(r0 + j) * DM + 8 * kq;
            f32x4 acc0 = {0.f, 0.f, 0.f, 0.f}, acc1 = {0.f, 0.f, 0.f, 0.f}; float ssq = 0.f;
#pragma unroll 16
            for (int s2 = 0; s2 < 32; ++s2) {
                const u32x4 xw = *(const u32x4*)(xrow + 32 * s2); f32x4 xa, xb; bf8_to_f32(xw, xa, xb);
                ssq += ((xa.x * xa.x + xa.y * xa.y) + (xa.z * xa.z + xa.w * xa.w)) + ((xb.x * xb.x + xb.y * xb.y) + (xb.z * xb.z + xb.w * xb.w));
                const bf16x8 xf = __builtin_bit_cast(bf16x8, xw);
#pragma unroll
                for (int pc = 0; pc < 2; ++pc) { const bf16x8 w0 = __builtin_bit_cast(bf16x8, WPB[((s2 * 2 + pc) * 2 + 0) * 64 + lane]), w1 = __builtin_bit_cast(bf16x8, WPB[((s2 * 2 + pc) * 2 + 1) * 64 + lane]);
                    acc0 = __builtin_amdgcn_mfma_f32_16x16x32_bf16(w0, xf, acc0, 0, 0, 0); acc1 = __builtin_amdgcn_mfma_f32_16x16x32_bf16(w1, xf, acc1, 0, 0, 0); }
            }
            ssq += __shfl_xor(ssq, 16); ssq += __shfl_xor(ssq, 32);
            const float rstd = 1.f / sqrtf(ssq * (1.f / 1024.f) + EPS);
            const f32x4 b0 = *(const LAS f32x4*)(rbl + 4 * kq), b1 = *(const LAS f32x4*)(rbl + 16 + 4 * kq);
            *(LAS f32x4*)(lg + j * 32 + 4 * kq) = acc0 * rstd + b0; *(LAS f32x4*)(lg + j * 32 + 16 + 4 * kq) = acc1 * rstd + b1;
            if (kq == 0) rs_s[j] = rstd;
        }
        __builtin_amdgcn_s_waitcnt(0xc07f); asm volatile("" ::: "memory");
        if (lane < 16) {
            float v[32];
#pragma unroll
            for (int q = 0; q < 8; ++q) { const f32x4 t4 = *(const LAS f32x4*)(lg + lane * 32 + 4 * q); v[4 * q] = t4.x; v[4 * q + 1] = t4.y; v[4 * q + 2] = t4.z; v[4 * q + 3] = t4.w; }
            int ti[4]; float tv[4];
#pragma unroll
            for (int p = 0; p < 4; ++p) { float bv = -INFINITY; int bi = 0;
#pragma unroll
                for (int e = 0; e < 32; ++e) { bool ok = v[e] > bv;
#pragma unroll
                    for (int pp = 0; pp < p; ++pp) ok = ok && (ti[pp] != e);
                    if (ok) { bv = v[e]; bi = e; } }
                ti[p] = bi; tv[p] = bv; }
            float tg[4]; float sm = 0.f;
#pragma unroll
            for (int p = 0; p < 4; ++p) { tg[p] = expf(tv[p] - tv[0]); sm += tg[p]; }
            const int r = r0 + lane;
            *(i32x4*)((int*)(ws + WS_TOPE) + r * 4) = (i32x4){ti[0], ti[1], ti[2], ti[3]};
            *(f32x4*)((float*)(ws + WS_TOPG) + r * 4) = (f32x4){tg[0] / sm, tg[1] / sm, tg[2] / sm, tg[3] / sm};
#pragma unroll
            for (int p = 0; p < 4; ++p) __hip_atomic_fetch_add(&hist[ti[p]], 1, __ATOMIC_RELAXED, __HIP_MEMORY_SCOPE_WORKGROUP);
        }
#pragma unroll 4
        for (int i = 0; i < 16; ++i) { const int r = r0 + i; f32x4 v[4], h[4]; row_load_bf(XR + (size_t)r * DM, lane, v);
            row_modnorm(v, rs_s[i], gg, mods + (size_t)b * 6144 + 3072, gsc, lane, h); row_store_fp8(ws + WS_XN8 + (size_t)r * DM, lane, h); }
        __syncthreads();
        if (tid < 32) ((int*)(ws + WS_HIST))[grp * 32 + tid] = hist[tid];
    }
}
__device__ __forceinline__ void ph_list(const Frame& F) {
    TID_LANE_WAVE; unsigned char* ws = opq(F.ws);
    LAS int* tot = (LAS int*)F.lds; LAS int* before = tot + 32; LAS int* pstart = tot + 64; LAS int* se = tot + 128; LAS int* part = tot + 640;
    const int* hist = (const int*)(ws + WS_HIST); const int* tope = (const int*)(ws + WS_TOPE); const float* topg = (const float*)(ws + WS_TOPG);
    int* dest = (int*)(ws + WS_DEST); int* list = (int*)(ws + WS_LIST); float* rowg = (float*)(ws + WS_ROWG); int* blke = (int*)(ws + WS_BLKE);
    for (int w = F.bid; w < 256; w += F.G) {
        __syncthreads();
        const int mye = tope[w * 512 + tid]; se[tid] = mye;
        { const int e = tid & 31, p = tid >> 5; int a = 0, bf = 0;
#pragma unroll 4
            for (int i = p * 16; i < p * 16 + 16; ++i) { const int h = hist[i * 32 + e]; a += h; bf += (i < w) ? h : 0; }
            part[p * 32 + e] = a; part[512 + p * 32 + e] = bf; }
        __syncthreads();
        if (tid < 32) { int a = 0, bf = 0;
#pragma unroll
            for (int p = 0; p < 16; ++p) { a += part[p * 32 + tid]; bf += part[512 + p * 32 + tid]; }
            tot[tid] = a; before[tid] = bf; }
        __syncthreads();
        if (tid == 0) { int p = 0; for (int e = 0; e < 32; ++e) { pstart[e] = p; p += (tot[e] + 255) / 256 * 256; } pstart[32] = p; }
        __syncthreads();
        { int rank = 0;
            for (int i4 = 0; i4 < 128; ++i4) { const i32x4 q = *(const LAS i32x4*)(se + 4 * i4); const int i0 = 4 * i4;
                rank += (q.x == mye && i0 < tid) + (q.y == mye && i0 + 1 < tid) + (q.z == mye && i0 + 2 < tid) + (q.w == mye && i0 + 3 < tid); }
            const int slot = w * 512 + tid, d = pstart[mye] + before[mye] + rank;
            dest[slot] = d; list[d] = slot >> 2; rowg[d] = topg[slot]; }
        if (w < 32) { const int e = w; for (int r = pstart[e] + tot[e] + tid; r < pstart[e + 1]; r += 512) { list[r] = -1; rowg[r] = 0.f; }
            for (int bk = pstart[e] / 256 + tid; bk < pstart[e + 1] / 256; bk += 512) blke[bk] = e; }
        if (w == 32 && tid == 0) blke[MAXBLK] = pstart[32] / 256;
    }
}
__device__ __forceinline__ void ph_combine(const Frame& F, int L) {
    TID_LANE_WAVE; const InP in = kin(); unsigned char* ws = opq(F.ws); float* out = F.out;
    LAS u32x4* WFB = (LAS u32x4*)F.lds;
    LAS float* rs_s = (LAS float*)(F.lds + 65536) + wave * 16;
    LAS float* pb = (LAS float*)(F.lds + 65536 + 1024);
    LAS float* fbl = (LAS float*)(F.lds + 65536 + 1024 + 2048);
    const float* mods = (const float*)(ws + WS_MODS);
    bf16_t* XR = (bf16_t*)(ws + WS_XR); const bf16_t* YB = (const bf16_t*)(ws + WS_YB); const int* dest = (const int*)(ws + WS_DEST);
    for (int grp = F.bid; grp < 256; grp += F.G) {
        const int b = grp >> 5, r0 = grp * 128 + wave * 16;
        if (L == 0) {
            __syncthreads();
            const float* ksc = mods + ((size_t)16 + b) * 6144 + 1024; const float* ksh = mods + ((size_t)16 + b) * 6144; float bpart = 0.f;
            for (int cidx = tid; cidx < 32 * 64; cidx += 512) { const int l = cidx & 63, s2 = cidx >> 6, e = l & 15, k0 = 32 * s2 + 8 * (l >> 4);
                unsigned hi[4], lo[4];
#pragma unroll
                for (int h2 = 0; h2 < 2; ++h2) { const f32x4 g4 = *(const f32x4*)(in->kv_norm_g + k0 + 4 * h2), s4 = *(const f32x4*)(ksc + k0 + 4 * h2), h4 = *(const f32x4*)(ksh + k0 + 4 * h2); float wv[4];
#pragma unroll
                    for (int q = 0; q < 4; ++q) { const float r_ = in->kv_w[(size_t)(k0 + 4 * h2 + q) * 2064 + 2048 + e]; wv[q] = g4[q] * (1.f + s4[q]) * r_; bpart += h4[q] * r_; }
#pragma unroll
                    for (int q = 0; q < 4; q += 2) { const unsigned a0 = f2bf(wv[q]), a1 = f2bf(wv[q + 1]); hi[2 * h2 + (q >> 1)] = a0 | (a1 << 16);
                        lo[2 * h2 + (q >> 1)] = f2bf(wv[q] - __uint_as_float(a0 << 16)) | (f2bf(wv[q + 1] - __uint_as_float(a1 << 16)) << 16); } }
                WFB[(s2 * 2 + 0) * 64 + l] = (u32x4){hi[0], hi[1], hi[2], hi[3]}; WFB[(s2 * 2 + 1) * 64 + l] = (u32x4){lo[0], lo[1], lo[2], lo[3]}; }
            pb[tid] = bpart;
            __syncthreads();
            if (tid < 16) { float t = in->fgate_b[tid];
#pragma unroll
                for (int p = 0; p < 32; ++p) t += pb[(p << 4) | tid];
                fbl[tid] = t; }
            __syncthreads();
        }
        const float* gt = mods + ((size_t)L * 8 + b) * 6144 + 5120;
#pragma unroll 1
        for (int i = 0; i < 16; ++i) {
            const int r = r0 + i; f32x4 v[4]; row_load_bf(XR + (size_t)r * DM, lane, v);
            f32x4 y[4];
#pragma unroll
            for (int j = 0; j < 4; ++j) y[j] = (f32x4){0.f, 0.f, 0.f, 0.f};
            const i32x4 d4 = *(const i32x4*)(dest + r * 4); const int dd[4] = {d4.x, d4.y, d4.z, d4.w};
#pragma unroll
            for (int q = 0; q < 4; ++q) { const bf16_t* yr = YB + (size_t)dd[q] * 1024;
#pragma unroll
                for (int j = 0; j < 2; ++j) { f32x4 a, c; bf8_to_f32(((const u32x4*)yr)[lane + 64 * j], a, c); y[2 * j] += a; y[2 * j + 1] += c; } }
#pragma unroll
            for (int j = 0; j < 4; ++j) v[j] = v[j] + row_vec(gt, lane, j) * y[j];
            const float rs = row_rstd(v);
            if (L == 1) { f32x4 o4[4];
#pragma unroll
                for (int j = 0; j < 4; ++j) o4[j] = v[j] * rs * row_vec(in->final_g, lane, j);
                row_store_f32(out + (size_t)r * DM, lane, o4);
                continue;
            }
            row_store_bf16(XR + (size_t)r * DM, lane, v);
            f32x4 h[4];
            row_modnorm(v, rs, in->norm_mix_g + 1024, mods + ((size_t)8 + b) * 6144 + 0, mods + ((size_t)8 + b) * 6144 + 1024, lane, h);
            row_store_bf16((bf16_t*)(ws + WS_XN) + (size_t)r * DM, lane, h);
            row_modnorm(v, rs, in->kv_norm_g, mods + ((size_t)16 + b) * 6144 + 0, mods + ((size_t)16 + b) * 6144 + 1024, lane, h);
            row_store_bf16((bf16_t*)(ws + WS_HKV) + (size_t)r * DM, lane, h);
            if (lane == 0) rs_s[i] = rs;
        }
        if (L == 0) {
            __builtin_amdgcn_fence(__ATOMIC_RELEASE, "workgroup"); asm volatile("s_waitcnt vmcnt(0) lgkmcnt(0)" ::: "memory"); __builtin_amdgcn_fence(__ATOMIC_ACQUIRE, "workgroup");
            const int j = lane & 15, kq = lane >> 4; const bf16_t* xrow = XR + (size_t)(r0 + j) * DM + 8 * kq;
            f32x4 acc = {0.f, 0.f, 0.f, 0.f};
#pragma unroll 16
            for (int s2 = 0; s2 < 32; ++s2) { const bf16x8 xf = __builtin_bit_cast(bf16x8, __builtin_nontemporal_load((const u32x4*)(xrow + 32 * s2)));
#pragma unroll
                for (int pc = 0; pc < 2; ++pc) acc = __builtin_amdgcn_mfma_f32_16x16x32_bf16(__builtin_bit_cast(bf16x8, WFB[(s2 * 2 + pc) * 64 + lane]), xf, acc, 0, 0, 0); }
            const float rstd = rs_s[j]; const f32x4 fb = *(const LAS f32x4*)(fbl + 4 * kq);
            f32x4 lf;
#pragma unroll
            for (int q = 0; q < 4; ++q) { const float xg = acc[q] * rstd + fb[q]; lf[q] = fminf(xg, 0.f) - log1pf(expf(-fabsf(xg))); }
            *(f32x4*)((float*)(ws + WS_LOGF) + (size_t)(r0 + j) * 16 + 4 * kq) = lf;
        }
    }
}
__device__ __forceinline__ void ph_cumsum(const Frame& F) {
    TID_LANE_WAVE; unsigned char* ws = opq(F.ws); LAS float* wtot = (LAS float*)F.lds;
    for (int bh = F.bid; bh < NB * NH; bh += F.G) {
        const int b = bh >> 4, h = bh & 15;
        const float* lf = (const float*)(ws + WS_LOGF); float v[8]; float run = 0.f;
#pragma unroll
        for (int i = 0; i < 8; ++i) { run += lf[((size_t)b * SEQ + tid * 8 + i) * 16 + h]; v[i] = run; }
        float inc = run;
#pragma unroll
        for (int o = 1; o < 64; o <<= 1) { const float t = __shfl_up(inc, o); if (lane >= o) inc += t; }
        if (lane == 63) wtot[wave] = inc;
        __syncthreads();
        float off = inc - run;
        for (int w8 = 0; w8 < wave; ++w8) off += wtot[w8];
        float* fc = (float*)(ws + WS_FC) + (size_t)bh * SEQ; unsigned long long* g3 = (unsigned long long*)(ws + WS_G3) + (size_t)bh * SEQ;
#pragma unroll
        for (int i = 0; i < 8; ++i) { const float Fv = v[i] + off; fc[tid * 8 + i] = Fv;
            const float g = -Fv * LOG2E; const unsigned b1 = f2bf(g); const float r1 = g - __uint_as_float(b1 << 16); const unsigned b2 = f2bf(r1); const float r2 = r1 - __uint_as_float(b2 << 16); const unsigned b3 = f2bf(r2);
            g3[tid * 8 + i] = (unsigned long long)(b1 | (b2 << 16)) | ((unsigned long long)(b3 | (0x3f80u << 16)) << 32); }
        __syncthreads();
    }
}


typedef short s16x4 __attribute__((ext_vector_type(4)));
__device__ __forceinline__ s16x4 ds_tr16(LAS unsigned char* p) { return __builtin_bit_cast(s16x4, __builtin_amdgcn_ds_read_tr16_b64_v4i16((LAS s16x4*)p)); }
__device__ __forceinline__ void ph_spatial(const Frame& F) {
    const InP in = kin(); unsigned char* ws = opq(F.ws);
    LAS unsigned char* L = F.lds;
    constexpr int VN_STRIDE = 544, WC_STRIDE = 272, OFF_VN = 0, OFF_WC = 128 * VN_STRIDE, OFF_ST = OFF_WC + 128 * WC_STRIDE;
    LAS float* st = (LAS float*)(L + OFF_ST);
    const bf16_t* Z = (const bf16_t*)(ws + WS_Z); bf16_t* GT = (bf16_t*)(ws + WS_GATED); const bf16_t* WSB = (const bf16_t*)(ws + WS_WS);
    for (int ch = F.bid; ch < T / 128; ch += F.G) {
        const int t0 = ch * 128;
        __syncthreads();
        { int tid_ = threadIdx.x; asm volatile("" : "+v"(tid_)); const int lane = tid_ & 63, wave = __builtin_amdgcn_readfirstlane(tid_ >> 6);
#pragma unroll 4
        for (int i = 0; i < 16; ++i) {
            const int tl = wave * 16 + i; const bf16_t* vrow = Z + (size_t)(t0 + tl) * 4096 + 2048;
            float v[32]; float s = 0.f;
#pragma unroll
            for (int j = 0; j < 4; ++j) { const u32x4 w = *(const u32x4*)(vrow + (lane + 64 * j) * 8); const unsigned ww[4] = {w.x, w.y, w.z, w.w};
#pragma unroll
                for (int q = 0; q < 4; ++q) { v[j * 8 + 2 * q] = __uint_as_float(ww[q] << 16); v[j * 8 + 2 * q + 1] = __uint_as_float(ww[q] & 0xffff0000u); } }
#pragma unroll
            for (int q = 0; q < 32; ++q) s += v[q];
            const float mean = wave_sum(s) * (1.f / 2048.f); float qq = 0.f;
#pragma unroll
            for (int q = 0; q < 32; ++q) { const float d = v[q] - mean; qq += d * d; }
            const float rstd = 1.f / sqrtf(wave_sum(qq) * (1.f / 2048.f) + EPS);
            if (lane == 0) { st[2 * tl] = mean; st[2 * tl + 1] = rstd; }
        } }
        u32x4 vw[8], wcw[4];
        { int tid_ = threadIdx.x; asm volatile("" : "+v"(tid_)); const int tid = tid_, c8 = tid & 31;
#pragma unroll
            for (int q = 0; q < 8; ++q) vw[q] = *(const u32x4*)(Z + (size_t)(t0 + (tid >> 5) + 16 * q) * 4096 + 2048 + c8 * 8);
#pragma unroll
            for (int q = 0; q < 4; ++q) { const int cidx = tid + 512 * q, r = cidx >> 4, c16 = cidx & 15; wcw[q] = *(const u32x4*)(WSB + r * 128 + c16 * 8); } }
#pragma unroll 1
        for (int g = 0; g < 8; ++g) {
            int tid_ = threadIdx.x; asm volatile("" : "+v"(tid_));
            const int tid = tid_, lane = tid & 63, wave = __builtin_amdgcn_readfirstlane(tid >> 6), fr = lane & 15, fq = lane >> 4;
            __syncthreads();
#pragma unroll
            for (int q = 0; q < 4; ++q) { const int cidx = tid + 512 * q, r = cidx >> 4, c16 = cidx & 15; *(LAS u32x4*)(L + OFF_WC + r * WC_STRIDE + c16 * 16) = wcw[q]; }
            {
                const int c8 = tid & 31; const float* vg = in->v_g + g * 256 + c8 * 8; const float* vb = in->v_b + g * 256 + c8 * 8;
                const f32x4 g0 = *(const f32x4*)vg, g1 = *(const f32x4*)(vg + 4), b0 = *(const f32x4*)vb, b1 = *(const f32x4*)(vb + 4);
#pragma unroll
                for (int q = 0; q < 8; ++q) { const int s = (tid >> 5) + 16 * q;
                    const u32x4 w = vw[q];
                    const float mean = st[2 * s], rstd = st[2 * s + 1];
                    f32x4 x0 = {__uint_as_float(w.x << 16), __uint_as_float(w.x & 0xffff0000u), __uint_as_float(w.y << 16), __uint_as_float(w.y & 0xffff0000u)};
                    f32x4 x1 = {__uint_as_float(w.z << 16), __uint_as_float(w.z & 0xffff0000u), __uint_as_float(w.w << 16), __uint_as_float(w.w & 0xffff0000u)};
                    x0 = (x0 - mean) * rstd * g0 + b0; x1 = (x1 - mean) * rstd * g1 + b1;
                    u32x4 o; o.x = pk2(x0[0], x0[1]); o.y = pk2(x0[2], x0[3]); o.z = pk2(x1[0], x1[1]); o.w = pk2(x1[2], x1[3]);
                    *(LAS u32x4*)(L + OFF_VN + s * VN_STRIDE + c8 * 16) = o; }
            }
            u32x2 uw[8][2]; float bsv[8];
#pragma unroll
            for (int tb = 0; tb < 8; ++tb) { const int t = 16 * tb + fr; bsv[tb] = in->b_s[g * 128 + t];
#pragma unroll
                for (int db = 0; db < 2; ++db) uw[tb][db] = *(const u32x2*)(Z + (size_t)(t0 + t) * 4096 + 256 * g + 32 * wave + 16 * db + 4 * fq); }
            __syncthreads();
            if (g < 7) { const int c8 = tid & 31;
#pragma unroll
                for (int q = 0; q < 8; ++q) vw[q] = *(const u32x4*)(Z + (size_t)(t0 + (tid >> 5) + 16 * q) * 4096 + 2048 + (g + 1) * 256 + c8 * 8);
#pragma unroll
                for (int q = 0; q < 4; ++q) { const int cidx = tid + 512 * q, r = cidx >> 4, c16 = cidx & 15; wcw[q] = *(const u32x4*)(WSB + (size_t)(g + 1) * 16384 + r * 128 + c16 * 8); } }
            f32x4 acc[8][2];
#pragma unroll
            for (int tb = 0; tb < 8; ++tb) { acc[tb][0] = (f32x4){0.f, 0.f, 0.f, 0.f}; acc[tb][1] = (f32x4){0.f, 0.f, 0.f, 0.f}; }
#pragma unroll
            for (int ks = 0; ks < 4; ++ks) {
                const int s0 = 32 * ks; bf16x8 X[2];
#pragma unroll
                for (int db = 0; db < 2; ++db) { LAS unsigned char* p = L + OFF_VN + (s0 + 4 * fq + (fr >> 2)) * VN_STRIDE + (32 * wave + 16 * db + 4 * (fr & 3)) * 2;
                    const s16x4 lo = ds_tr16(p), hi = ds_tr16(p + 16 * VN_STRIDE);
                    X[db] = (bf16x8){lo[0], lo[1], lo[2], lo[3], hi[0], hi[1], hi[2], hi[3]}; }
#pragma unroll
                for (int tb = 0; tb < 8; ++tb) if (2 * ks <= tb) {
                    LAS unsigned char* p = L + OFF_WC + (16 * tb + fr) * WC_STRIDE + (s0 + 4 * fq) * 2;
                    const u32x2 y0 = *(LAS u32x2*)p, y1 = *(LAS u32x2*)(p + 32);
                    const bf16x8 Y = __builtin_bit_cast(bf16x8, (u32x4){y0.x, y0.y, y1.x, y1.y});
                    acc[tb][0] = __builtin_amdgcn_mfma_f32_16x16x32_bf16(X[0], Y, acc[tb][0], 0, 0, 0);
                    acc[tb][1] = __builtin_amdgcn_mfma_f32_16x16x32_bf16(X[1], Y, acc[tb][1], 0, 0, 0); }
            }
#pragma unroll
            for (int tb = 0; tb < 8; ++tb) { const int t = 16 * tb + fr;
#pragma unroll
                for (int db = 0; db < 2; ++db) { const int dd = 256 * g + 32 * wave + 16 * db + 4 * fq;
                    const u32x2 uwv = uw[tb][db];
                    const f32x4 m = acc[tb][db] + bsv[tb];
                    u32x2 o; o.x = pk2(__uint_as_float(uwv.x << 16) * m[0], __uint_as_float(uwv.x & 0xffff0000u) * m[1]); o.y = pk2(__uint_as_float(uwv.y << 16) * m[2], __uint_as_float(uwv.y & 0xffff0000u) * m[3]);
                    *(u32x2*)(GT + (size_t)(t0 + t) * 2048 + dd) = o; } }
        }
    }
}

constexpr int NPH = 18;
struct PA { In in; unsigned char* ws; float* out; int ph_lo, ph_hi, li, pad; };
__global__ void __launch_bounds__(512, 2) fwd(PA args) {
    extern __shared__ __attribute__((aligned(16))) unsigned char lds[];
    Frame F; F.ws = args.ws; F.out = args.out; F.lds = (LAS unsigned char*)lds;
    F.bid = blockIdx.x; F.G = gridDim.x;
    LAS unsigned char* ldsl = (LAS unsigned char*)lds;
    volatile LAS unsigned* MISC = (volatile LAS unsigned*)(ldsl + MISC_OFF);
    for (int u = threadIdx.x; u < (LDS_BYTES - LDSCTL_OFF) / 4; u += 512) ((LAS unsigned*)(ldsl + LDSCTL_OFF))[u] = 0u;
    __syncthreads();
    unsigned char* const ws0 = args.ws;
    XcdBarrier bar = xcd_barrier_post((unsigned*)(ws0 + WS_CTL) + CW_BAR + args.li * XCD_BAR_WORDS, MISC + 8);
    const int lo = args.ph_lo, hi = args.ph_hi;
#ifndef PHMASK
#define PHMASK 0x3ffffu
#endif
#define IN(k) (((PHMASK >> (k)) & 1u) && lo <= (k) && (k) < hi)
#define SEAM(k) do { if (lo <= (k) && (k) + 1 < hi) { if ((k) <= 13) xcd_barrier_bg(bar, ws0, ldsl, MISC + 12); else xcd_barrier(bar); } } while (0)
    const int c = (int)blockIdx.x, G = (int)gridDim.x;

    if (IN(0)) { ph_prologue(F); } SEAM(0);
    if (IN(1)) { ph_norm0(F); } SEAM(1);
    if (IN(2)) {
        unsigned char* ws = opq(ws0);
        pg::StaticOrder S; S.init(T / 256, 4096 / 256, G, c);
        pg::SrcPlain<true> src{(const char*)(ws + WS_WIN), 2048}; pg::EpGeluZ E{(bf16_t*)(ws + WS_Z)};
        pg::gemm_phase<pg::EpGeluZ, pg::StaticOrder, pg::SrcPlain<true>, true>(ldsl, (const char*)(ws + WS_XN), 1024, S, src, E);
    } SEAM(2);
    if (IN(3)) { ph_spatial(F); } SEAM(3);
    if (IN(4)) {
        unsigned char* ws = opq(ws0); const float* mods = (const float*)(ws + WS_MODS);
        pg::StaticOrder S; S.init(T / 256, 1024 / 256, G, c);
        pg::SrcPlain<true> src{(const char*)(ws + WS_WOUT), 4096}; pg::EpResid<true> E{kin()->x, (bf16_t*)(ws + WS_XR), mods + 2048};
        pg::gemm_phase<pg::EpResid<true>, pg::StaticOrder, pg::SrcPlain<true>, true>(ldsl, (const char*)(ws + WS_GATED), 2048, S, src, E);
    } SEAM(4);
#define LAYER_MOE(L, P0) \
    if (IN(P0)) { ph_norm_router(F, L); } SEAM(P0); \
    if (IN(P0 + 1)) { if ((P0) == 13) { TID_LANE_WAVE; if (tid == 0) MISC[12] = 0u; __syncthreads(); bg_cvt(ws0, ldsl, wave, lane, MISC + 12); } ph_list(F); } SEAM(P0 + 1); \
    if (IN(P0 + 2)) {     \
        unsigned char* ws = opq(ws0); const int* blke = (const int*)(ws + WS_BLKE); \
        pg::StaticOrder S; S.init(blke[MAXBLK], 8, G, c); \
        pg::SrcMoeA src{(const char*)(ws + WS_W1) + (size_t)L * 32 * 2048 * 1024, (const int*)(ws + WS_LIST), blke, 1024}; pg::EpSwiglu E{ws + WS_ACT, kin()->exp_b1 + (size_t)L * 32 * 2048, blke}; \
        pg::gemm_phase<pg::EpSwiglu, pg::StaticOrder, pg::SrcMoeA, true>(ldsl, (const char*)(ws + WS_XN8), 512, S, src, E);     \
    } SEAM(P0 + 2); \
    if (IN(P0 + 3)) {     \
        unsigned char* ws = opq(ws0); const int* blke = (const int*)(ws + WS_BLKE); \
        pg::StaticOrder S; S.init(blke[MAXBLK], 4, G, c); \
        pg::SrcMoeB src{(const char*)(ws + WS_W2) + (size_t)L * 32 * 1024 * 1024, blke, 1024}; pg::EpMoeOut E{(bf16_t*)(ws + WS_YB), kin()->exp_b2 + (size_t)L * 32 * 1024, blke, (const float*)(ws + WS_ROWG)}; \
        pg::gemm_phase<pg::EpMoeOut, pg::StaticOrder, pg::SrcMoeB, true>(ldsl, (const char*)(ws + WS_ACT), 512, S, src, E); \
    } SEAM(P0 + 3); \
    if (IN(P0 + 4)) { ph_combine(F, L); } SEAM(P0 + 4);

    LAYER_MOE(0, 5)
    if (IN(10)) {
        unsigned char* ws = opq(ws0);
        ph_cumsum(F);
        pg::StaticOrder S; S.init(T / 256, 2048 / 256, G, c);
        { pg::SrcHeads src{(const char*)(ws + WS_WKV), 2048}; pg::EpHeads<0> E{(bf16_t*)(ws + WS_K), (bf16_t*)(ws + WS_V), kin()->k_norm_g};
          pg::gemm_phase<pg::EpHeads<0>, pg::StaticOrder, pg::SrcHeads, true>(ldsl, (const char*)(ws + WS_HKV), 1024, S, src, E); }
        { pg::SrcHeads src{(const char*)(ws + WS_WQG), 2048}; pg::EpHeads<1> E{(bf16_t*)(ws + WS_Q), (bf16_t*)(ws + WS_GS), kin()->q_norm_g};
          pg::gemm_phase<pg::EpHeads<1>, pg::StaticOrder, pg::SrcHeads, true>(ldsl, (const char*)(ws + WS_XN), 1024, S, src, E); }
    } SEAM(10);
    if (IN(11)) {
        unsigned char* ws = opq(ws0);
        static_assert(attn_body::ATTN_LDS_BYTES <= RING_BYTES, "attention LDS");
        const attn_body::AttnTensors AT{(const attn_body::bf16*)(ws + WS_Q), (const attn_body::bf16*)(ws + WS_K), (const attn_body::bf16*)(ws + WS_V), (const attn_body::bf16*)(ws + WS_GS), (attn_body::bf16*)(ws + WS_O), (const unsigned long long*)(ws + WS_G3), kin()->q_norm_g, kin()->k_norm_g};
        attn_body::attn_phase<8>((char*)lds, AT, G, c);
    } SEAM(11);
    if (IN(12)) {
        unsigned char* ws = opq(ws0); const float* mods = (const float*)(ws + WS_MODS);
        pg::StaticOrder S; S.init(T / 256, 1024 / 256, G, c);
        pg::SrcPlain<true> src{(const char*)(ws + WS_WO), 2048}; pg::EpResid<false> E{(const bf16_t*)(ws + WS_XR), (bf16_t*)(ws + WS_XR), mods + 8 * 6144 + 2048};
        pg::gemm_phase<pg::EpResid<false>, pg::StaticOrder, pg::SrcPlain<true>, true>(ldsl, (const char*)(ws + WS_O), 1024, S, src, E);
    } SEAM(12);
    LAYER_MOE(1, 13)
#undef LAYER_MOE
#undef IN
#undef SEAM
}

#include <cstring>
extern "C" void kernel_launch(void* const* d_in, const int* in_sizes, int n_in, void* d_out, int out_size, void* d_ws, size_t ws_size, hipStream_t stream) {
    if (n_in != 28 || ws_size < WS_END || out_size != T * DM) { fprintf(stderr, "kernel_launch: unexpected arguments (n_in %d, ws %zu, out %d)\n", n_in, ws_size, out_size); return; }
    static int grid = 0;
    if (grid == 0) {
        int dev = 0, cus = 0, per_cu = 0;
        if (hipGetDevice(&dev) != hipSuccess || hipDeviceGetAttribute(&cus, hipDeviceAttributeMultiprocessorCount, dev) != hipSuccess) { grid = -1; return; }
        if (hipFuncSetAttribute((const void*)fwd, hipFuncAttributeMaxDynamicSharedMemorySize, LDS_BYTES) != hipSuccess) { fprintf(stderr, "kernel_launch: hipFuncSetAttribute failed\n"); grid = -1; return; }
        if (hipOccupancyMaxActiveBlocksPerMultiprocessor(&per_cu, (const void*)fwd, 512, LDS_BYTES) != hipSuccess || per_cu < 1) fprintf(stderr, "kernel_launch: occupancy query says %d\n", per_cu);
        (void)hipGetLastError();
        grid = cus;
    }
    if (grid < 0) return;
    KA a; memset((void*)&a, 0, sizeof(a));
    { const float** p = (const float**)&a.in; for (int i = 0; i < 28; ++i) p[i] = (const float*)d_in[i]; }
    a.ws = (unsigned char*)d_ws; a.out = (float*)d_out;
    PA pa; memset((void*)&pa, 0, sizeof(pa)); pa.in = a.in; pa.ws = a.ws; pa.out = a.out;
    (void)hipMemsetAsync((unsigned char*)d_ws + WS_CTL, 0, 1 * MiB, stream);
    pa.ph_lo = 0; pa.ph_hi = NPH; pa.li = 0;
    hipLaunchKernelGGL(fwd, dim3(grid), dim3(512), LDS_BYTES, stream, pa);
}
```

```cpp
#include <hip/hip_runtime.h>
#include <cstdio>
#include <cstdint>

#define LAS __attribute__((address_space(3)))
#define GAS __attribute__((address_space(1)))
typedef unsigned short bf16_t;
typedef float f32x4 __attribute__((ext_vector_type(4)));
typedef short bf16x8 __attribute__((ext_vector_type(8)));
typedef unsigned u32x4 __attribute__((ext_vector_type(4)));
typedef unsigned u32x2 __attribute__((ext_vector_type(2)));
typedef int i32x4 __attribute__((ext_vector_type(4)));

constexpr int NB = 8, SEQ = 4096, DM = 1024, T = NB * SEQ;
constexpr int GW = 2048, NG = 8, GD = 256, CH = 128;
constexpr int NH = 16, HD = 64;
constexpr int NE = 32, TOPK = 4;
constexpr int MAXBLK = 544, MAXROWS = MAXBLK * 256;
constexpr float EPS = 1e-6f;
constexpr float LOG2E = 1.4426950408889634f;
constexpr float C2 = 0.125f * LOG2E;

constexpr size_t MiB = 1u << 20;
constexpr size_t WS_CTL = 0;
constexpr size_t WS_MODS = 1 * MiB;
constexpr size_t WS_RB2 = 1 * MiB + 3 * 8 * 6144 * 4;
constexpr size_t WS_FB2 = WS_RB2 + 2 * 8 * 32 * 4;
constexpr size_t WS_HIST = 2 * MiB;
constexpr size_t WS_BLKE = 2 * MiB + 65536;
constexpr size_t WS_TOPE = 3 * MiB;
constexpr size_t WS_TOPG = 4 * MiB;
constexpr size_t WS_DEST = 5 * MiB;
constexpr size_t WS_LIST = 6 * MiB;
constexpr size_t WS_ROWG = 7 * MiB;
constexpr size_t WS_VSTAT = 8 * MiB;
constexpr size_t WS_LOGF = 9 * MiB;
constexpr size_t WS_FC = 11 * MiB;
constexpr size_t WS_G3 = 13 * MiB;
constexpr size_t WS_WIN = 32 * MiB;
constexpr size_t WS_WOUT = 40 * MiB;
constexpr size_t WS_WKV = 44 * MiB;
constexpr size_t WS_WQG = 48 * MiB;
constexpr size_t WS_WO = 52 * MiB;
constexpr size_t WS_WS = 54 * MiB;
constexpr size_t WS_W1 = 64 * MiB;
constexpr size_t WS_W2 = 320 * MiB;
constexpr size_t WS_XN = 448 * MiB;
constexpr size_t WS_HKV = 512 * MiB;
constexpr size_t WS_XN8 = 640 * MiB;
constexpr size_t WS_XR = 576 * MiB;
constexpr size_t WS_Z = 704 * MiB;
constexpr size_t WS_GATED = 960 * MiB;
constexpr size_t WS_ACT = 704 * MiB;
constexpr size_t WS_YB = 976 * MiB;
constexpr size_t WS_PKV = 704 * MiB;
constexpr size_t WS_PQG = 960 * MiB;
constexpr size_t WS_Q = 1248 * MiB;
constexpr size_t WS_K = 1312 * MiB;
constexpr size_t WS_V = 1376 * MiB;
constexpr size_t WS_GS = 1440 * MiB;
constexpr size_t WS_O = 1504 * MiB;
constexpr size_t WS_END = 1568 * MiB;

__device__ __forceinline__ float bf2f(bf16_t v) { return __uint_as_float(((unsigned)v) << 16); }
__device__ __forceinline__ unsigned f2bf(float f) { unsigned u = __float_as_uint(f); return (u + 0x7fffu + ((u >> 16) & 1u)) >> 16; }
__device__ __forceinline__ unsigned pk2(float lo, float hi) { return f2bf(lo) | (f2bf(hi) << 16); }
__device__ __forceinline__ float wave_sum(float v) {
#pragma unroll
    for (int o = 1; o < 64; o <<= 1) v += __shfl_xor(v, o);
    return v;
}
__device__ __forceinline__ float siluf(float x) { return x / (1.f + expf(-x)); }
__device__ __forceinline__ float sigmoidf_(float x) { return 1.f / (1.f + expf(-x)); }

struct In {
    const float *x, *c, *ada_w, *ada_b, *norm_mix_g, *norm_ffn_g, *w_in, *v_g, *v_b, *w_s, *b_s, *w_out, *kv_ada_w, *kv_ada_b, *kv_norm_g, *kv_w, *k_norm_g, *fgate_b,
        *w_qg, *q_norm_g, *w_o, *router_w, *router_b, *exp_w1, *exp_b1, *exp_w2, *exp_b2, *final_g;
};

typedef const In __attribute__((address_space(4)))* InP;
__device__ __forceinline__ InP kin() { auto p = __builtin_amdgcn_kernarg_segment_ptr(); asm volatile("" : "+s"(p)); return (InP)p; }
__device__ __forceinline__ unsigned char* opq(unsigned char* p) { size_t z = 0; asm volatile("" : "+s"(z)); return p + z; }
struct KA { In in; unsigned char* ws; float* out; int L; int pad; };

__device__ __forceinline__ void transpose_item(const float* W, int K, int N, int ldw, bf16_t* WT, LAS float* scr, int item, int lane) {
    const int nblk = N / 32, kb = item / nblk, nb = item % nblk, k0 = 64 * kb, n0 = 32 * nb;
#pragma unroll 32
    for (int i = 0; i < 32; ++i) { const int kk = 2 * i + (lane >> 5); scr[kk * 33 + (lane & 31)] = W[(size_t)(k0 + kk) * ldw + n0 + (lane & 31)]; }
    __builtin_amdgcn_s_waitcnt(0xc07f); asm volatile("" ::: "memory");
    const int c = lane & 7;
#pragma unroll
    for (int j = 0; j < 4; ++j) { const int n = (lane >> 3) + 8 * j; const LAS float* s = scr + (8 * c) * 33 + n;
        u32x4 o; o.x = pk2(s[0 * 33], s[1 * 33]); o.y = pk2(s[2 * 33], s[3 * 33]); o.z = pk2(s[4 * 33], s[5 * 33]); o.w = pk2(s[6 * 33], s[7 * 33]);
        *(u32x4*)(WT + (size_t)(n0 + n) * K + k0 + 8 * c) = o; }
    __builtin_amdgcn_s_waitcnt(0xc07f); asm volatile("" ::: "memory");
}
__device__ __forceinline__ unsigned pk4_fp8(float a, float b, float c, float d) { int w = 0; w = __builtin_amdgcn_cvt_pk_fp8_f32(a, b, w, false); w = __builtin_amdgcn_cvt_pk_fp8_f32(c, d, w, true); return (unsigned)w; }
constexpr float W8_SCALE = 32.f, A8_SCALE = 4.f, MOE_DESCALE = 1.f / (32.f * 4.f);
__device__ __forceinline__ float a8(float x) { return __builtin_amdgcn_fmed3f(x * A8_SCALE, -448.f, 448.f); }
__device__ __forceinline__ unsigned pk4_fp8s(float a, float b, float c, float d) { return pk4_fp8(a8(a), a8(b), a8(c), a8(d)); }
__device__ __forceinline__ void transpose_item_fp8(const float* W, int K, int N, int ldw, unsigned char* WT, LAS float* scr, int item, int lane) {
    const int nblk = N / 32, kb = item / nblk, nb = item % nblk, k0 = 64 * kb, n0 = 32 * nb;
#pragma unroll 32
    for (int i = 0; i < 32; ++i) { const int kk = 2 * i + (lane >> 5); scr[kk * 33 + (lane & 31)] = W[(size_t)(k0 + kk) * ldw + n0 + (lane & 31)]; }
    __builtin_amdgcn_s_waitcnt(0xc07f); asm volatile("" ::: "memory");
    const int n = lane >> 1, hf = lane & 1; const LAS float* sp = scr + (32 * hf) * 33 + n;
#pragma unroll
    for (int q = 0; q < 2; ++q) { u32x4 o;
        o.x = pk4_fp8(sp[(16 * q + 0) * 33] * W8_SCALE, sp[(16 * q + 1) * 33] * W8_SCALE, sp[(16 * q + 2) * 33] * W8_SCALE, sp[(16 * q + 3) * 33] * W8_SCALE);
        o.y = pk4_fp8(sp[(16 * q + 4) * 33] * W8_SCALE, sp[(16 * q + 5) * 33] * W8_SCALE, sp[(16 * q + 6) * 33] * W8_SCALE, sp[(16 * q + 7) * 33] * W8_SCALE);
        o.z = pk4_fp8(sp[(16 * q + 8) * 33] * W8_SCALE, sp[(16 * q + 9) * 33] * W8_SCALE, sp[(16 * q + 10) * 33] * W8_SCALE, sp[(16 * q + 11) * 33] * W8_SCALE);
        o.w = pk4_fp8(sp[(16 * q + 12) * 33] * W8_SCALE, sp[(16 * q + 13) * 33] * W8_SCALE, sp[(16 * q + 14) * 33] * W8_SCALE, sp[(16 * q + 15) * 33] * W8_SCALE);
        *(u32x4*)(WT + (size_t)(n0 + n) * K + k0 + 32 * hf + 16 * q) = o; }
    __builtin_amdgcn_s_waitcnt(0xc07f); asm volatile("" ::: "memory");
}
constexpr int IT_WIN = 16 * 128, IT_WOUT = 32 * 32, IT_WKV = 16 * 64, IT_WQG = 16 * 64, IT_WO = 16 * 32, IT_W1 = 16 * 64  , IT_W2 = 16 * 32;
constexpr int IT_SMALL = IT_WIN + IT_WOUT + IT_WKV + IT_WQG + IT_WO;
constexpr int IT_ALL = IT_SMALL + 64 * IT_W1 + 64 * IT_W2;
constexpr int IT_FG = IT_SMALL + 32 * IT_W1 + 32 * IT_W2, IT_BG = 32 * IT_W1 + 32 * IT_W2;
__host__ __device__ __forceinline__ int fg_item(int i) { return i < IT_SMALL + 32 * IT_W1 ? i : i + 32 * IT_W1; }
__host__ __device__ __forceinline__ int bg_item(int k) { return k < 32 * IT_W1 ? IT_SMALL + 32 * IT_W1 + k : IT_SMALL + 64 * IT_W1 + 32 * IT_W2 + (k - 32 * IT_W1); }
constexpr int CW_CVT = 2048;
__device__ __forceinline__ void cvt_item(InP inp, unsigned char* ws, int it, LAS float* scr, int lane) {
    if (it < IT_WIN) { transpose_item_fp8(inp->w_in, 1024, 4096, 4096, ws + WS_WIN, scr, it, lane); return; } it -= IT_WIN;
    if (it < IT_WOUT) { transpose_item_fp8(inp->w_out, 2048, 1024, 1024, ws + WS_WOUT, scr, it, lane); return; } it -= IT_WOUT;
    if (it < IT_WKV) { transpose_item(inp->kv_w, 1024, 2048, 2064, (bf16_t*)(ws + WS_WKV), scr, it, lane); return; } it -= IT_WKV;
    if (it < IT_WQG) { transpose_item(inp->w_qg, 1024, 2048, 2048, (bf16_t*)(ws + WS_WQG), scr, it, lane); return; } it -= IT_WQG;
    if (it < IT_WO) { transpose_item(inp->w_o, 1024, 1024, 1024, (bf16_t*)(ws + WS_WO), scr, it, lane); return; } it -= IT_WO;
    if (it < 64 * IT_W1) { const int e = it / IT_W1; transpose_item_fp8(inp->exp_w1 + (size_t)e * 1024 * 2048, 1024, 2048, 2048, ws + WS_W1 + (size_t)e * 2048 * 1024, scr, it % IT_W1, lane); return; } it -= 64 * IT_W1;
    { const int e = it / IT_W2; transpose_item_fp8(inp->exp_w2 + (size_t)e * 1024 * 1024, 1024, 1024, 1024, ws + WS_W2 + (size_t)e * 1024 * 1024, scr, it % IT_W2, lane); }
}
constexpr int ADA_ITEMS = 96 + 96 + 32;
__device__ __forceinline__ void ada_item(InP inp, float* mods, int item, const LAS float* sc  , LAS float* red  , int tid) {
    const int lane = tid & 63, wave = tid >> 6;
    int which, cg; const float* w; const float* bias; int ldw;
    if (item < 96) { which = 0; cg = item; w = inp->ada_w; bias = inp->ada_b; ldw = 6144; }
    else if (item < 192) { which = 1; cg = item - 96; w = inp->ada_w + (size_t)1024 * 6144; bias = inp->ada_b + 6144; ldw = 6144; }
    else { which = 2; cg = item - 192; w = inp->kv_ada_w; bias = inp->kv_ada_b; ldw = 2048; }
    const int col = cg * 64 + lane;
    float acc[8];
#pragma unroll
    for (int b = 0; b < 8; ++b) acc[b] = 0.f;
    for (int k = wave * 128; k < wave * 128 + 128; ++k) {
        const float wv = w[(size_t)k * ldw + col];
#pragma unroll
        for (int b = 0; b < 8; ++b) acc[b] += sc[b * 1024 + k] * wv;
    }
#pragma unroll
    for (int b = 0; b < 8; ++b) red[(wave * 8 + b) * 64 + lane] = acc[b];
    __syncthreads();
    {
        const int b = tid >> 6; float s = 0.f;
#pragma unroll
        for (int w8 = 0; w8 < 8; ++w8) s += red[(w8 * 8 + b) * 64 + lane];
        mods[((size_t)which * 8 + b) * 6144 + col] = s + bias[col];
    }
    __syncthreads();
}
__device__ __forceinline__ void row_load(const float* xrow, int lane, f32x4 (&v)[4]) {
#pragma unroll
    for (int j = 0; j < 2; ++j) { v[2 * j] = ((const f32x4*)xrow)[2 * lane + 128 * j]; v[2 * j + 1] = ((const f32x4*)xrow)[2 * lane + 128 * j + 1]; }
}
__device__ __forceinline__ void bf8_to_f32(u32x4 w, f32x4& a, f32x4& b) {
    a = (f32x4){__uint_as_float(w.x << 16), __uint_as_float(w.x & 0xffff0000u), __uint_as_float(w.y << 16), __uint_as_float(w.y & 0xffff0000u)};
    b = (f32x4){__uint_as_float(w.z << 16), __uint_as_float(w.z & 0xffff0000u), __uint_as_float(w.w << 16), __uint_as_float(w.w & 0xffff0000u)};
}
__device__ __forceinline__ void row_load_bf(const bf16_t* xrow, int lane, f32x4 (&v)[4]) {
#pragma unroll
    for (int j = 0; j < 2; ++j) bf8_to_f32(((const u32x4*)xrow)[lane + 64 * j], v[2 * j], v[2 * j + 1]);
}
__device__ __forceinline__ float row_rstd(const f32x4 (&v)[4]) {
    float s = 0.f;
#pragma unroll
    for (int j = 0; j < 4; ++j) s += (v[j].x * v[j].x + v[j].y * v[j].y) + (v[j].z * v[j].z + v[j].w * v[j].w);
    return 1.f / sqrtf(wave_sum(s) * (1.f / 1024.f) + EPS);
}
__device__ __forceinline__ f32x4 row_vec(const float* p, int lane, int q) { return ((const f32x4*)p)[2 * lane + 128 * (q >> 1) + (q & 1)]; }
__device__ __forceinline__ void row_modnorm(const f32x4 (&v)[4], float rstd, const float* g, const float* sh, const float* sc, int lane, f32x4 (&h)[4]) {
#pragma unroll
    for (int q = 0; q < 4; ++q) h[q] = (v[q] * rstd * row_vec(g, lane, q)) * (1.f + row_vec(sc, lane, q)) + row_vec(sh, lane, q);
}
__device__ __forceinline__ void row_store_bf16(bf16_t* orow, int lane, const f32x4 (&h)[4]) {
#pragma unroll
    for (int j = 0; j < 2; ++j) { u32x4 w; w.x = pk2(h[2 * j].x, h[2 * j].y); w.y = pk2(h[2 * j].z, h[2 * j].w); w.z = pk2(h[2 * j + 1].x, h[2 * j + 1].y); w.w = pk2(h[2 * j + 1].z, h[2 * j + 1].w);
        ((u32x4*)orow)[lane + 64 * j] = w; }
}

__device__ __forceinline__ void row_store_fp8(unsigned char* orow, int lane, const f32x4 (&h)[4]) {
#pragma unroll
    for (int j = 0; j < 2; ++j) { u32x2 w; w.x = pk4_fp8(h[2 * j].x * A8_SCALE, h[2 * j].y * A8_SCALE, h[2 * j].z * A8_SCALE, h[2 * j].w * A8_SCALE);
        w.y = pk4_fp8(h[2 * j + 1].x * A8_SCALE, h[2 * j + 1].y * A8_SCALE, h[2 * j + 1].z * A8_SCALE, h[2 * j + 1].w * A8_SCALE); ((u32x2*)orow)[lane + 64 * j] = w; }
}
__device__ __forceinline__ void row4_norm_mod_store(const float* xrow, const float* g, const float* sh, const float* sc, unsigned char* orow, int lane) {
    f32x4 v[4]; float s = 0.f;
#pragma unroll
    for (int j = 0; j < 4; ++j) { v[j] = ((const f32x4*)xrow)[lane + 64 * j]; s += (v[j].x * v[j].x + v[j].y * v[j].y) + (v[j].z * v[j].z + v[j].w * v[j].w); }
    const float rstd = 1.f / sqrtf(wave_sum(s) * (1.f / 1024.f) + EPS);
#pragma unroll
    for (int j = 0; j < 4; ++j) { const f32x4 gg = ((const f32x4*)g)[lane + 64 * j], s1 = ((const f32x4*)sc)[lane + 64 * j], s0 = ((const f32x4*)sh)[lane + 64 * j];
        const f32x4 h = (v[j] * rstd * gg) * (1.f + s1) + s0; ((unsigned*)orow)[lane + 64 * j] = pk4_fp8s(h.x, h.y, h.z, h.w); }
}
__device__ __forceinline__ void row_store_f32(float* orow, int lane, const f32x4 (&h)[4]) {
#pragma unroll
    for (int j = 0; j < 2; ++j)
#pragma unroll
        for (int sq = 0; sq < 2; ++sq) { const int src = 32 * sq + (lane >> 1); f32x4 a, c;
#pragma unroll
            for (int i = 0; i < 4; ++i) { a[i] = __shfl(h[2 * j][i], src); c[i] = __shfl(h[2 * j + 1][i], src); }
            ((f32x4*)orow)[128 * j + 64 * sq + lane] = (lane & 1) ? c : a; }
}

__device__ __forceinline__ void route_row(const LAS float* hs  , const float* rw, const float* rb, int lane, int (&te)[4], float (&tg)[4]) {
    const int e = lane & 31, half = lane >> 5; float acc = 0.f;
    for (int k = half * 512; k < half * 512 + 512; ++k) acc += hs[k] * rw[k * 32 + e];
    acc += __shfl_xor(acc, 32);
    float val = acc + rb[e];
    float tv[4];
#pragma unroll
    for (int q = 0; q < 4; ++q) {
        float bv = val; int bi = e;
#pragma unroll
        for (int o = 1; o < 32; o <<= 1) { const float ov = __shfl_xor(bv, o); const int oi = __shfl_xor(bi, o); if (ov > bv || (ov == bv && oi < bi)) { bv = ov; bi = oi; } }
        te[q] = bi; tv[q] = bv; if (e == bi) val = -INFINITY;
    }
    float s = 0.f;
#pragma unroll
    for (int q = 0; q < 4; ++q) { tg[q] = expf(tv[q] - tv[0]); s += tg[q]; }
#pragma unroll
    for (int q = 0; q < 4; ++q) tg[q] /= s;
}

namespace pg {
constexpr int BM = 256, BK = 64, HALF = 128, HTB = HALF * BK * 2  , STAGE_BYTES = 8 * HTB, NXCD = 8, WGM = 8;
__host__ __device__ __forceinline__ int lds_byte(int r, int c) { const int st = (r >> 4) * 2 + (c >> 5), rr = r & 15, cc = c & 31, ob = rr * 64 + cc * 2; return st * 1024 + (ob ^ (((ob >> 9) & 1) << 5)); }
__host__ __device__ __forceinline__ void stage_rc(int b, int& R, int& C) { const int st = b / 1024, sb = b % 1024, swz = sb ^ (((sb >> 9) & 1) << 5); R = (st >> 1) * 16 + swz / 64; C = (st & 1) * 32 + (swz % 64) / 2; }
__host__ __device__ __forceinline__ int perm32(int rho) { const int n = rho >> 4, i = rho & 15; return 8 * (i >> 2) + 4 * n + (i & 3); }
struct Unit { int pm, pn; };
struct StaticOrder {
    int nM, nN, nwg, G, c;
    __device__ void init(int nM_, int nN_, int G_, int c_) { nM = nM_; nN = nN_; nwg = nM * nN; G = G_; c = c_; }
    __device__ bool next(int i, Unit& u) const {
        const long L = (long)i * G + c; if (L >= nwg) return false;
        int wgid = (int)L; { const int q = nwg / NXCD, r = nwg % NXCD, xcd = wgid % NXCD, off = wgid / NXCD; wgid = (xcd < r ? xcd * (q + 1) : r * (q + 1) + (xcd - r) * q) + off; }
        const int nig = WGM * nN, gid = wgid / nig, fm = gid * WGM, gsz = (nM - fm) < WGM ? (nM - fm) : WGM;
        u.pm = fm + ((wgid % nig) % gsz); u.pn = (wgid % nig) / gsz; return true;
    }
};
__device__ __forceinline__ unsigned cvt_pk_bf16(float lo, float hi) { unsigned r; asm volatile("v_cvt_pk_bf16_f32 %0, %1, %2" : "=v"(r) : "v"(lo), "v"(hi)); return r; }
typedef float f32x2 __attribute__((ext_vector_type(2)));
typedef int v8i32 __attribute__((ext_vector_type(8)));
typedef int v4i32 __attribute__((ext_vector_type(4)));
__device__ __forceinline__ f32x2 gelu_pk(f32x2 v) {
    const f32x2 av = __builtin_elementwise_abs(v), d = av * 0.2316418882f + 1.0f;
    f32x2 t; t.x = __builtin_amdgcn_rcpf(d.x); t.y = __builtin_amdgcn_rcpf(d.y);
    f32x2 q = t * 0.5307027145f + (-0.7265760135f); q = q * t + 0.7107068705f; q = q * t + (-0.142248368f); q = q * t + 0.127414796f; q = q * t;
    const f32x2 s = (v * v) * (-0.72134752044f);
    f32x2 e; e.x = __builtin_amdgcn_exp2f(s.x); e.y = __builtin_amdgcn_exp2f(s.y);
    const f32x2 m = v * (q * e), r = v - m;
    f32x2 o; o.x = v.x < 0.f ? m.x : r.x; o.y = v.y < 0.f ? m.y : r.y; return o;
}
__device__ __forceinline__ float fast_sigmoid(float x) { return __builtin_amdgcn_rcpf(1.f + __builtin_amdgcn_exp2f(-LOG2E * x)); }

template <bool PERM, bool F8 = false> struct SrcPlain { const char* B; int K2; static constexpr bool FP8 = F8;
    __device__ __forceinline__ unsigned arow_off(const Unit& u, int h, int R) const { return (unsigned)(u.pm * BM + h * HALF + R) * (unsigned)K2; }
    __device__ __forceinline__ const char* bhalf(const Unit& u, int h) const { return B + (size_t)(u.pn * BM + h * HALF) * K2; }
    static __device__ __forceinline__ int brow(int R) { return PERM ? ((R & ~31) + perm32(R & 31)) : R; } };
struct SrcHeads { const char* B; int K2; static constexpr bool FP8 = false;
    __device__ __forceinline__ unsigned arow_off(const Unit& u, int h, int R) const { return (unsigned)(u.pm * BM + h * HALF + R) * (unsigned)K2; }
    __device__ __forceinline__ const char* bhalf(const Unit& u, int h) const { return B + (size_t)(u.pn * BM + h * 32) * K2; }
    static __device__ __forceinline__ int brow(int R) { return 64 * (R >> 5) + perm32(R & 31); } };
struct SrcMoeA { const char* W1; const int* list; const int* blke; int K2; static constexpr bool FP8 = true;
    __device__ __forceinline__ unsigned arow_off(const Unit& u, int h, int R) const { int t = list[u.pm * BM + h * HALF + R]; t = t < 0 ? 0 : t; return (unsigned)t * (unsigned)K2; }
    __device__ __forceinline__ const char* bhalf(const Unit& u, int h) const { const int e = blke[u.pm]; return W1 + ((size_t)e * 2048 + h * 1024 + u.pn * 128) * K2; }
    static __device__ __forceinline__ int brow(int R) { return (R & ~31) + perm32(R & 31); } };
struct SrcMoeB { const char* W2; const int* blke; int K2; static constexpr bool FP8 = true;
    __device__ __forceinline__ unsigned arow_off(const Unit& u, int h, int R) const { return (unsigned)(u.pm * BM + h * HALF + R) * (unsigned)K2; }
    __device__ __forceinline__ const char* bhalf(const Unit& u, int h) const { const int e = blke[u.pm]; return W2 + ((size_t)e * 1024 + u.pn * BM + h * HALF) * K2; }
    static __device__ __forceinline__ int brow(int R) { return (R & ~31) + perm32(R & 31); } };

struct EpGeluZ { bf16_t* Z; float ds;
    __device__ __forceinline__ void operator()(const f32x4 (&acc)[2][2][4][2], const Unit& u, int wr, int wc, int fr, int fq) const {
        const int row0 = u.pm * BM + wr * 64 + fr, col0 = u.pn * BM + wc * 32 + 8 * fq;
#pragma unroll
        for (int ai = 0; ai < 2; ++ai)
#pragma unroll
            for (int m = 0; m < 4; ++m) { bf16_t* rowp = Z + (size_t)(row0 + ai * HALF + m * 16) * 4096 + col0;
#pragma unroll
                for (int bj = 0; bj < 2; ++bj) { const f32x4 v0 = acc[ai][bj][m][0] * ds, v1 = acc[ai][bj][m][1] * ds;
                    const f32x2 a = gelu_pk((f32x2){v0[0], v0[1]}), b = gelu_pk((f32x2){v0[2], v0[3]}), c = gelu_pk((f32x2){v1[0], v1[1]}), d = gelu_pk((f32x2){v1[2], v1[3]});
                    u32x4 w; w.x = cvt_pk_bf16(a.x, a.y); w.y = cvt_pk_bf16(b.x, b.y); w.z = cvt_pk_bf16(c.x, c.y); w.w = cvt_pk_bf16(d.x, d.y);
                    *(u32x4*)(rowp + bj * HALF) = w; } }
    } };
template <bool F32BASE> struct EpResid { const void* base; bf16_t* out; const float* gate; float ds;
    __device__ __forceinline__ void operator()(const f32x4 (&acc)[2][2][4][2], const Unit& u, int wr, int wc, int fr, int fq) const {
        const int b = u.pm >> 4; const float* gt = gate + (size_t)b * 6144; const int col0 = u.pn * BM + wc * 32 + 8 * fq;
        f32x4 gv[2][2];
#pragma unroll
        for (int bj = 0; bj < 2; ++bj)
#pragma unroll
            for (int n = 0; n < 2; ++n) gv[bj][n] = *(const f32x4*)(gt + col0 + bj * HALF + 4 * n) * ds;
#pragma unroll
        for (int ai = 0; ai < 2; ++ai)
#pragma unroll
            for (int m = 0; m < 4; ++m) { const size_t off = (size_t)(u.pm * BM + ai * HALF + wr * 64 + m * 16 + fr) * DM + col0;
#pragma unroll
                for (int bj = 0; bj < 2; ++bj) { f32x4 b0, b1;
                    if constexpr (F32BASE) { b0 = *(const f32x4*)((const float*)base + off + bj * HALF); b1 = *(const f32x4*)((const float*)base + off + bj * HALF + 4); }
                    else bf8_to_f32(*(const u32x4*)((const bf16_t*)base + off + bj * HALF), b0, b1);
                    const f32x4 r0 = b0 + gv[bj][0] * acc[ai][bj][m][0], r1 = b1 + gv[bj][1] * acc[ai][bj][m][1];
                    u32x4 w; w.x = cvt_pk_bf16(r0[0], r0[1]); w.y = cvt_pk_bf16(r0[2], r0[3]); w.z = cvt_pk_bf16(r1[0], r1[1]); w.w = cvt_pk_bf16(r1[2], r1[3]);
                    *(u32x4*)(out + off + bj * HALF) = w; } }
    } };
struct EpSwiglu { unsigned char* act; const float* b1; const int* blke;
    __device__ __forceinline__ void operator()(const f32x4 (&acc)[2][2][4][2], const Unit& u, int wr, int wc, int fr, int fq) const {
        const int e = blke[u.pm]; const int col0 = u.pn * 128 + wc * 32 + 8 * fq; const float* bb = b1 + (size_t)e * 2048 + col0;
        f32x4 bg[2], bl[2];
#pragma unroll
        for (int n = 0; n < 2; ++n) { bg[n] = *(const f32x4*)(bb + 4 * n); bl[n] = *(const f32x4*)(bb + 1024 + 4 * n); }
#pragma unroll
        for (int ai = 0; ai < 2; ++ai)
#pragma unroll
            for (int m = 0; m < 4; ++m) { const int row = u.pm * BM + ai * HALF + wr * 64 + m * 16 + fr; float a[8];
#pragma unroll
                for (int n = 0; n < 2; ++n) { const f32x4 g4 = acc[ai][0][m][n] * MOE_DESCALE + bg[n], l4 = acc[ai][1][m][n] * MOE_DESCALE + bl[n];
#pragma unroll
                    for (int j = 0; j < 4; j += 2) {
                        f32x2 g = {fminf(g4[j], 7.f), fminf(g4[j + 1], 7.f)}; f32x2 l = {__builtin_amdgcn_fmed3f(l4[j], -7.f, 7.f), __builtin_amdgcn_fmed3f(l4[j + 1], -7.f, 7.f)};
                        const f32x2 x = g * (-1.702f * LOG2E); f32x2 e; e.x = __builtin_amdgcn_exp2f(x.x); e.y = __builtin_amdgcn_exp2f(x.y);
                        const f32x2 d = e + 1.0f; f32x2 r; r.x = __builtin_amdgcn_rcpf(d.x); r.y = __builtin_amdgcn_rcpf(d.y);
                        const f32x2 o = (l + 1.0f) * (g * r); a[4 * n + j] = o.x; a[4 * n + j + 1] = o.y; } }
                u32x2 w; w.x = pk4_fp8(a[0] * A8_SCALE, a[1] * A8_SCALE, a[2] * A8_SCALE, a[3] * A8_SCALE); w.y = pk4_fp8(a[4] * A8_SCALE, a[5] * A8_SCALE, a[6] * A8_SCALE, a[7] * A8_SCALE);
                *(u32x2*)(act + (size_t)row * 1024 + col0) = w; }
    } };
struct EpMoeOut { bf16_t* yb; const float* b2; const int* blke; const float* rowg;
    __device__ __forceinline__ void operator()(const f32x4 (&acc)[2][2][4][2], const Unit& u, int wr, int wc, int fr, int fq) const {
        const int e = blke[u.pm]; const int col0 = u.pn * BM + wc * 32 + 8 * fq;
        f32x4 bv[2][2];
#pragma unroll
        for (int bj = 0; bj < 2; ++bj)
#pragma unroll
            for (int n = 0; n < 2; ++n) bv[bj][n] = *(const f32x4*)(b2 + (size_t)e * 1024 + col0 + bj * HALF + 4 * n);
#pragma unroll
        for (int ai = 0; ai < 2; ++ai)
#pragma unroll
            for (int m = 0; m < 4; ++m) { const int row = u.pm * BM + ai * HALF + wr * 64 + m * 16 + fr; const float rg = rowg[row];
#pragma unroll
                for (int bj = 0; bj < 2; ++bj) { const f32x4 v0 = (acc[ai][bj][m][0] * MOE_DESCALE + bv[bj][0]) * rg, v1 = (acc[ai][bj][m][1] * MOE_DESCALE + bv[bj][1]) * rg;
                    u32x4 w; w.x = cvt_pk_bf16(v0[0], v0[1]); w.y = cvt_pk_bf16(v0[2], v0[3]); w.z = cvt_pk_bf16(v1[0], v1[1]); w.w = cvt_pk_bf16(v1[2], v1[3]);
                    *(u32x4*)(yb + (size_t)row * 1024 + col0 + bj * HALF) = w; } }
    } };
template <int MODE> struct EpHeads { bf16_t* o0; bf16_t* o1; const float* g;
    __device__ __forceinline__ void operator()(const f32x4 (&acc)[2][2][4][2], const Unit& u, int wr, int wc, int fr, int fq) const {
        const bool first = u.pn < 4; bf16_t* O = first ? o0 : o1; const int colbase = (u.pn & 3) * 256 + wc * 64 + 8 * fq;
        f32x4 gv[2][2];
#pragma unroll
        for (int bj = 0; bj < 2; ++bj)
#pragma unroll
            for (int n = 0; n < 2; ++n) gv[bj][n] = *(const f32x4*)(g + 32 * bj + 8 * fq + 4 * n);
#pragma unroll
        for (int ai = 0; ai < 2; ++ai)
#pragma unroll
            for (int m = 0; m < 4; ++m) { const int row = u.pm * BM + ai * HALF + wr * 64 + m * 16 + fr; f32x4 v[2][2];
                if (first) { float ss = 0.f;
#pragma unroll
                    for (int bj = 0; bj < 2; ++bj)
#pragma unroll
                        for (int n = 0; n < 2; ++n) { const f32x4 x = acc[ai][bj][m][n]; ss += (x[0] * x[0] + x[1] * x[1]) + (x[2] * x[2] + x[3] * x[3]); }
                    ss += __shfl_xor(ss, 16); ss += __shfl_xor(ss, 32);
                    float r = 1.f / sqrtf(ss * (1.f / 64.f) + EPS); if (MODE == 1) r *= C2;
#pragma unroll
                    for (int bj = 0; bj < 2; ++bj)
#pragma unroll
                        for (int n = 0; n < 2; ++n) v[bj][n] = acc[ai][bj][m][n] * r * gv[bj][n];
                } else {
#pragma unroll
                    for (int bj = 0; bj < 2; ++bj)
#pragma unroll
                        for (int n = 0; n < 2; ++n) { f32x4 x = acc[ai][bj][m][n]; if (MODE == 1) { x[0] = fast_sigmoid(x[0]); x[1] = fast_sigmoid(x[1]); x[2] = fast_sigmoid(x[2]); x[3] = fast_sigmoid(x[3]); } v[bj][n] = x; }
                }
#pragma unroll
                for (int bj = 0; bj < 2; ++bj) { u32x4 w; w.x = cvt_pk_bf16(v[bj][0][0], v[bj][0][1]); w.y = cvt_pk_bf16(v[bj][0][2], v[bj][0][3]); w.z = cvt_pk_bf16(v[bj][1][0], v[bj][1][1]); w.w = cvt_pk_bf16(v[bj][1][2], v[bj][1][3]);
                    *(u32x4*)(O + (size_t)row * DM + colbase + 32 * bj) = w; } }
    } };

template <class Epi, class Sched, class Src, bool ALIGN_EPI>
__device__ __forceinline__ void gemm_phase(LAS unsigned char* lds, const char* Abase, int K, const Sched& S, const Src& src, const Epi& E) {
    int tid_ = threadIdx.x; asm volatile("" : "+v"(tid_));
    const int tid = tid_, wid = __builtin_amdgcn_readfirstlane(tid >> 6), lane = tid & 63, wr = wid >> 2, wc = wid & 3, fr = lane & 15, fq = lane >> 4;
    const int nt = K / BK; constexpr bool PARK = Src::FP8;
    int sR[2], sC[2]; unsigned voffB[2];
#pragma unroll
    for (int i = 0; i < 2; ++i) { stage_rc(tid * 16 + i * 8192, sR[i], sC[i]); voffB[i] = (unsigned)(Src::brow(sR[i]) * K + sC[i]) * 2u; }
    const size_t kstep = (size_t)(BK * 2);
    const unsigned ldsw = (unsigned)wid * 1024u;
    const int aoff = lds_byte(wr * 64 + fr, fq * 8), boff = lds_byte(wc * 32 + fr, fq * 8);
#define PG_SA(b, h) (((b) * 2 + (h)) * HTB)
#define PG_SB(b, h) ((4 + (b) * 2 + (h)) * HTB)
#define PG_STAGE(bufoff, gbase, v0, v1) do { \
        __builtin_amdgcn_global_load_lds((const unsigned*)((const char*)(gbase) + (v0)), (LAS unsigned*)(lds + (bufoff) + ldsw), 16, 0, 0); \
        __builtin_amdgcn_global_load_lds((const unsigned*)((const char*)(gbase) + (v1)), (LAS unsigned*)(lds + (bufoff) + ldsw + 8192), 16, 0, 0); } while (0)
#define PG_LD16(p) (*(const LAS v4i32*)(p))
#define PG_LDA(dst, b, h) do { if constexpr (Src::FP8) { _Pragma("unroll") for (int m = 0; m < 4; ++m) { const v4i32 x0_ = PG_LD16(lds + PG_SA(b, h) + aoff + m * 2048), x1_ = PG_LD16(lds + PG_SA(b, h) + aoff + m * 2048 + 1024); \
            dst##8[m] = __builtin_shufflevector(x0_, x1_, 0, 1, 2, 3, 4, 5, 6, 7); } } else { \
        _Pragma("unroll") for (int m = 0; m < 4; ++m) _Pragma("unroll") for (int k = 0; k < 2; ++k) dst[m][k] = *(const LAS bf16x8*)(lds + PG_SA(b, h) + aoff + m * 2048 + k * 1024); } } while (0)
#define PG_LDB(dst, b, h) do { if constexpr (Src::FP8) { _Pragma("unroll") for (int n = 0; n < 2; ++n) { const v4i32 x0_ = PG_LD16(lds + PG_SB(b, h) + boff + n * 2048), x1_ = PG_LD16(lds + PG_SB(b, h) + boff + n * 2048 + 1024); \
            dst##8[n] = __builtin_shufflevector(x0_, x1_, 0, 1, 2, 3, 4, 5, 6, 7); } } else { \
        _Pragma("unroll") for (int n = 0; n < 2; ++n) _Pragma("unroll") for (int k = 0; k < 2; ++k) dst[n][k] = *(const LAS bf16x8*)(lds + PG_SB(b, h) + boff + n * 2048 + k * 1024); } } while (0)
#define PG_MMA(ai, bj, At, Bt) do { __builtin_amdgcn_s_setprio(1); if constexpr (Src::FP8) { _Pragma("unroll") for (int m = 0; m < 4; ++m) _Pragma("unroll") for (int n = 0; n < 2; ++n) \
        acc[ai][bj][m][n] = __builtin_amdgcn_mfma_scale_f32_16x16x128_f8f6f4(Bt##8[n], At##8[m], acc[ai][bj][m][n], 0, 0, 0, 0x7f7f7f7f, 0, 0x7f7f7f7f); } else { \
        _Pragma("unroll") for (int m = 0; m < 4; ++m) _Pragma("unroll") for (int n = 0; n < 2; ++n) _Pragma("unroll") for (int k = 0; k < 2; ++k) \
        acc[ai][bj][m][n] = __builtin_amdgcn_mfma_f32_16x16x32_bf16(Bt[n][k], At[m][k], acc[ai][bj][m][n], 0, 0, 0); } __builtin_amdgcn_s_setprio(0); } while (0)
#define PG_WAIT_V(n) asm volatile("s_waitcnt vmcnt(" #n ")" ::: "memory")
#define PG_WAIT_L(n) asm volatile("s_waitcnt lgkmcnt(" #n ")" ::: "memory")
#define PG_BAR __builtin_amdgcn_s_barrier()
#define PG_SCHED __builtin_amdgcn_sched_barrier(0)
    Unit cur, nxt; int ui = 0;
    if (!S.next(0, cur)) return;
    f32x4 acc[2][2][4][2];
#pragma unroll
    for (int a = 0; a < 2; ++a)
#pragma unroll
        for (int b = 0; b < 2; ++b)
#pragma unroll
            for (int m = 0; m < 4; ++m)
#pragma unroll
                for (int n = 0; n < 2; ++n) acc[a][b][m][n] = (f32x4){0.f, 0.f, 0.f, 0.f};
    bf16x8 At[4][2], B0[2][2], B1[2][2]; v8i32 At8[4], B08[2], B18[2];
    unsigned vc[2][2], vn[2][2];
#pragma unroll
    for (int h = 0; h < 2; ++h)
#pragma unroll
        for (int i = 0; i < 2; ++i) vc[h][i] = src.arow_off(cur, h, sR[i]) + (unsigned)sC[i] * 2u;
    const char* cB0 = src.bhalf(cur, 0); const char* cB1 = src.bhalf(cur, 1);
    const char* const cA = Abase;
    PG_STAGE(PG_SB(0, 0), cB0, voffB[0], voffB[1]); PG_STAGE(PG_SB(0, 1), cB1, voffB[0], voffB[1]); PG_STAGE(PG_SA(0, 0), cA, vc[0][0], vc[0][1]); PG_STAGE(PG_SA(0, 1), cA, vc[1][0], vc[1][1]);
    if (wr == 1) PG_BAR;
    PG_WAIT_V(2); PG_BAR;
    PG_STAGE(PG_SB(1, 0), cB0 + kstep, voffB[0], voffB[1]); PG_STAGE(PG_SA(1, 0), cA + kstep, vc[0][0], vc[0][1]); PG_STAGE(PG_SB(1, 1), cB1 + kstep, voffB[0], voffB[1]);
    PG_WAIT_V(6); PG_BAR;
    for (;;) {
        const bool has_next = S.next(ui + 1, nxt);
        const char* nB0 = cB0; const char* nB1 = cB1;
#pragma unroll
        for (int h = 0; h < 2; ++h)
#pragma unroll
            for (int i = 0; i < 2; ++i) vn[h][i] = vc[h][i];
        if (has_next) { nB0 = src.bhalf(nxt, 0); nB1 = src.bhalf(nxt, 1);
#pragma unroll
            for (int h = 0; h < 2; ++h)
#pragma unroll
                for (int i = 0; i < 2; ++i) vn[h][i] = src.arow_off(nxt, h, sR[i]) + (unsigned)sC[i] * 2u; }
        asm volatile("" : "+v"(vn[0][0]), "+v"(vn[0][1]), "+v"(vn[1][0]), "+v"(vn[1][1]));
        if constexpr (PARK) { u32x4 pv; pv.x = vn[0][0]; pv.y = vn[0][1]; pv.z = vn[1][0]; pv.w = vn[1][1]; *(LAS u32x4*)(lds + STAGE_BYTES + tid * 16) = pv; }
#pragma unroll 1
        for (int t = 0; t < nt; t += 2) {
            const bool last = (t == nt - 2);
            const char* a1 = cA + (size_t)(t + 1) * kstep;
            const char* a2 = last ? cA : cA + (size_t)(t + 2) * kstep; const char* a3 = a2 + kstep;
            const char* b20 = last ? nB0 : cB0 + (size_t)(t + 2) * kstep; const char* b21 = last ? nB1 : cB1 + (size_t)(t + 2) * kstep;
            const char* b30 = b20 + kstep; const char* b31 = b21 + kstep;
            unsigned w00, w01, w10, w11;
            if constexpr (!PARK) { w00 = last ? vn[0][0] : vc[0][0]; w01 = last ? vn[0][1] : vc[0][1]; w10 = last ? vn[1][0] : vc[1][0]; w11 = last ? vn[1][1] : vc[1][1]; }
            if constexpr (Src::FP8) asm volatile("" : "+s"(a1), "+s"(a2), "+s"(a3), "+s"(b20), "+s"(b21), "+s"(b30), "+s"(b31));
            PG_LDB(B0, 0, 0); PG_LDB(B1, 0, 1); PG_SCHED; PG_LDA(At, 0, 0); PG_STAGE(PG_SA(1, 1), a1, vc[1][0], vc[1][1]);
            if constexpr (PARK) { if (last) { const u32x4 pv = *(const LAS u32x4*)(lds + STAGE_BYTES + tid * 16); vc[0][0] = pv.x; vc[0][1] = pv.y; vc[1][0] = pv.z; vc[1][1] = pv.w; }
                w00 = vc[0][0]; w01 = vc[0][1]; w10 = vc[1][0]; w11 = vc[1][1]; }
            PG_WAIT_V(8); PG_WAIT_L(0); PG_BAR; PG_MMA(0, 0, At, B0); PG_MMA(0, 1, At, B1); PG_BAR; PG_SCHED;
            PG_LDA(At, 0, 1); PG_STAGE(PG_SB(0, 0), b20, voffB[0], voffB[1]); PG_STAGE(PG_SB(0, 1), b21, voffB[0], voffB[1]); PG_STAGE(PG_SA(0, 0), a2, w00, w01);
            PG_WAIT_V(8); PG_WAIT_L(0); PG_BAR; PG_MMA(1, 0, At, B0); PG_MMA(1, 1, At, B1); PG_BAR; PG_SCHED;
            PG_LDB(B0, 1, 0); PG_LDB(B1, 1, 1); PG_SCHED; PG_LDA(At, 1, 0); PG_STAGE(PG_SA(0, 1), a2, w10, w11);
            PG_WAIT_V(8); PG_WAIT_L(0); PG_BAR; PG_MMA(0, 0, At, B0); PG_MMA(0, 1, At, B1); PG_BAR; PG_SCHED;
            PG_LDA(At, 1, 1); PG_STAGE(PG_SB(1, 0), b30, voffB[0], voffB[1]); PG_STAGE(PG_SB(1, 1), b31, voffB[0], voffB[1]); PG_STAGE(PG_SA(1, 0), a3, w00, w01);
            PG_WAIT_V(8); PG_WAIT_L(0); PG_BAR; PG_MMA(1, 0, At, B0); PG_MMA(1, 1, At, B1); PG_BAR; PG_SCHED;
        }
        if constexpr (ALIGN_EPI) { if (wr == 0) PG_BAR; }
        if constexpr (PARK) { int t2 = threadIdx.x; asm volatile("" : "+v"(t2)); E(acc, cur, wr, wc, t2 & 15, (t2 & 63) >> 4); }
        else E(acc, cur, wr, wc, fr, fq);
        if (!has_next) break;
#pragma unroll
        for (int a = 0; a < 2; ++a)
#pragma unroll
            for (int b = 0; b < 2; ++b)
#pragma unroll
                for (int m = 0; m < 4; ++m)
#pragma unroll
                    for (int n = 0; n < 2; ++n) acc[a][b][m][n] = (f32x4){0.f, 0.f, 0.f, 0.f};
        cur = nxt; cB0 = nB0; cB1 = nB1; ++ui;
        if constexpr (!PARK) {
#pragma unroll
        for (int h = 0; h < 2; ++h)
#pragma unroll
            for (int i = 0; i < 2; ++i) vc[h][i] = vn[h][i]; }
        if constexpr (ALIGN_EPI) { if (wr == 1) PG_BAR; }
    }
    PG_WAIT_V(0);
    if constexpr (!ALIGN_EPI) { if (wr == 0) PG_BAR; }
    PG_BAR;
#undef PG_SA
#undef PG_SB
#undef PG_STAGE
#undef PG_LDA
#undef PG_LDB
#undef PG_MMA
#undef PG_LD16
#undef PG_WAIT_V
#undef PG_WAIT_L
#undef PG_BAR
#undef PG_SCHED
}
}
#include <hip/hip_bf16.h>
#include <cmath>
namespace attn_body {
using bf16=__hip_bfloat16;
using bf16x8=__attribute__((ext_vector_type(8)))short;
using s16x4=__attribute__((ext_vector_type(4)))short;
using f32x16=__attribute__((ext_vector_type(16)))float;
using u32x4=__attribute__((ext_vector_type(4)))unsigned;
constexpr int BATCH=8,NHEAD=16,SEQ=4096,D=64,DM=NHEAD*D;
constexpr int NW=8,QBLK=32,QB=QBLK*NW,KVBLK=64,NQB=SEQ/QB;
constexpr int ATTN_PITCH=DM, ATTN_UNIT_ROWS=QB;
__device__ __forceinline__ int crow(int r,int hi){return (r&3)+8*(r>>2)+4*hi;}
#define SBAR() __builtin_amdgcn_sched_barrier(0)
__device__ __forceinline__ void cmask(f32x16&p0,f32x16&p1,int jb,int qrel,int hi){
  const float NEG=-INFINITY; int kb=64*jb+4*hi;
  #pragma unroll
  for(int r=0;r<16;++r){int kv=kb+(r&3)+8*(r>>2); if(kv>qrel)p0[r]=NEG; if(kv+32>qrel)p1[r]=NEG;}
}

constexpr int NSLOT=3, SLOTB=8192;
constexpr int LDS_K=0, LDS_V=NSLOT*SLOTB, LDS_WS=2*NSLOT*SLOTB, LDS_OST=LDS_WS+NW*64*4, LDS_GPAD=LDS_OST+NW*4096, LDS_G3=LDS_GPAD+128*8, LDS_BYTES=LDS_G3+SEQ*8;
constexpr float C2_=0.125f*1.4426950408889634f;
__device__ __forceinline__ void glds16(const void*gsrc,unsigned lds_dst){unsigned keep;
  asm volatile("s_mov_b32 %0, m0\n\ts_mov_b32 m0, %2\n\ts_nop 0\n\tglobal_load_lds_dwordx4 %1, off\n\ts_mov_b32 m0, %0":"=&s"(keep):"v"(gsrc),"s"(lds_dst):"memory");}
__device__ __forceinline__ float max3f(float a,float b,float c){float r;asm("v_max3_f32 %0, %1, %2, %3":"=v"(r):"v"(a),"v"(b),"v"(c));return r;}
__device__ __forceinline__ float max2f(float a,float b){float r;asm("v_max_f32_e32 %0, %1, %2":"=v"(r):"v"(a),"v"(b));return r;}
__device__ __forceinline__ float fadd_s(float a,float b){float r;asm("v_add_f32_e32 %0, %1, %2":"=v"(r):"v"(a),"v"(b));return r;}
__device__ __forceinline__ float fsub_s(float a,float b){float r;asm("v_sub_f32_e32 %0, %1, %2":"=v"(r):"v"(a),"v"(b));return r;}
typedef float f32x2_t __attribute__((ext_vector_type(2))); typedef __bf16 bf16x2_t __attribute__((ext_vector_type(2)));
__device__ __forceinline__ unsigned cvtpk_s(float lo,float hi){f32x2_t v={lo,hi};bf16x2_t b=__builtin_convertvector(v,bf16x2_t);return __builtin_bit_cast(unsigned,b);}
#define WAIT_BAR(N) asm volatile("s_waitcnt vmcnt(" #N ") lgkmcnt(0)\n\ts_barrier":::"memory")

__device__ __forceinline__ void qkt(f32x16&p0,f32x16&p1,const char*Kslot,const bf16x8*qr,bf16x8 ka0,bf16x8 ka1,bf16x8 qa,int r32,int hi){
  const char*kb=Kslot+hi*1024+r32*16;
  { const f32x16 z=f32x16{}; p0=__builtin_amdgcn_mfma_f32_32x32x16_bf16(ka0,qa,z,0,0,0); p1=__builtin_amdgcn_mfma_f32_32x32x16_bf16(ka1,qa,z,0,0,0); }
  #pragma unroll
  for(int d0=0;d0<4;++d0){
    const bf16x8 b0=*reinterpret_cast<const bf16x8*>(kb+d0*2048);
    const bf16x8 b1=*reinterpret_cast<const bf16x8*>(kb+d0*2048+512);
    p0=__builtin_amdgcn_mfma_f32_32x32x16_bf16(b0,qr[d0],p0,0,0,0);p1=__builtin_amdgcn_mfma_f32_32x32x16_bf16(b1,qr[d0],p1,0,0,0);}
}
typedef __attribute__((address_space(3))) const char* lds_cptr;
typedef short v4i16_t __attribute__((ext_vector_type(4)));
__device__ __forceinline__ void kload8(bf16x8*kf,lds_cptr kp){
  kf[0]=*(const __attribute__((address_space(3))) bf16x8*)(kp);      kf[1]=*(const __attribute__((address_space(3))) bf16x8*)(kp+512);
  kf[2]=*(const __attribute__((address_space(3))) bf16x8*)(kp+2048); kf[3]=*(const __attribute__((address_space(3))) bf16x8*)(kp+2560);
  kf[4]=*(const __attribute__((address_space(3))) bf16x8*)(kp+4096); kf[5]=*(const __attribute__((address_space(3))) bf16x8*)(kp+4608);
  kf[6]=*(const __attribute__((address_space(3))) bf16x8*)(kp+6144); kf[7]=*(const __attribute__((address_space(3))) bf16x8*)(kp+6656);
}
__device__ __forceinline__ void kload2(bf16x8*kf,lds_cptr kp,int j){ kf[2*j]=*(const __attribute__((address_space(3))) bf16x8*)(kp+j*2048); kf[2*j+1]=*(const __attribute__((address_space(3))) bf16x8*)(kp+j*2048+512); }
__device__ __forceinline__ s16x4 vtr(lds_cptr p){ return __builtin_bit_cast(s16x4,__builtin_amdgcn_ds_read_tr16_b64_v4i16((__attribute__((address_space(3))) v4i16_t*)p)); }
__device__ __forceinline__ float rowmax(const f32x16&p0,const f32x16&p1){
  float a=max3f(p0[0],p0[1],p1[0]),b=max3f(p0[2],p0[3],p1[1]);a=max3f(a,p1[2],p1[3]);
  #pragma unroll
  for(int r=4;r<16;r+=4){a=max3f(a,p0[r],p0[r+1]);b=max3f(b,p0[r+2],p0[r+3]);a=max3f(a,p1[r],p1[r+1]);b=max3f(b,p1[r+2],p1[r+3]);}
  const float m=max2f(a,b);
  auto rr=__builtin_amdgcn_permlane32_swap(__float_as_uint(m),__float_as_uint(m),false,false);
  return max2f(__uint_as_float(rr[0]),__uint_as_float(rr[1]));
}
__device__ __forceinline__ void pv(f32x16*o,int vb,bf16x8 pa0,bf16x8 pa1,bf16x8 pa2,bf16x8 pa3){
  #pragma unroll
  for(int d0=0;d0<2;++d0){s16x4 lo[4],hi[4];
    #pragma unroll
    for(int ks=0;ks<4;++ks){
      asm volatile("ds_read_b64_tr_b16 %0,%1 offset:%c2":"=&v"(lo[ks]):"v"(vb),"i"(d0*4096+ks*1024):"memory");
      asm volatile("ds_read_b64_tr_b16 %0,%1 offset:%c2":"=&v"(hi[ks]):"v"(vb),"i"(d0*4096+ks*1024+512):"memory");}
    asm volatile("s_waitcnt lgkmcnt(0)":::"memory");SBAR();
    #define PK(k) (bf16x8){lo[k][0],lo[k][1],lo[k][2],lo[k][3],hi[k][0],hi[k][1],hi[k][2],hi[k][3]}
    o[d0]=__builtin_amdgcn_mfma_f32_32x32x16_bf16(pa0,PK(0),o[d0],0,0,0);
    o[d0]=__builtin_amdgcn_mfma_f32_32x32x16_bf16(pa1,PK(1),o[d0],0,0,0);
    o[d0]=__builtin_amdgcn_mfma_f32_32x32x16_bf16(pa2,PK(2),o[d0],0,0,0);
    o[d0]=__builtin_amdgcn_mfma_f32_32x32x16_bf16(pa3,PK(3),o[d0],0,0,0);
    #undef PK
  }
}

#ifndef ATTN_STORE16
#define ATTN_STORE16(p,v) (*(u32x4*)(p)=(v))
#endif
template<int THRL> __device__ __forceinline__ void attn_unit(int b,int h,int qb,const bf16*Q,const bf16*__restrict__ K,const bf16*__restrict__ V,const bf16*__restrict__ GATE,bf16*O,char*shm,float skipthr){
  int tid_=threadIdx.x; asm volatile("":"+v"(tid_));
  const int tid=tid_,lane=tid&63,r32=lane&31,hi=lane>>5; const int wid=__builtin_amdgcn_readfirstlane(tid>>6);
  const long rowbase=(long)b*SEQ; const int q0=qb*QB;
  const bf16*Qw=Q+(rowbase+q0+wid*QBLK)*DM+h*D;
  const unsigned lds0=(unsigned)(uintptr_t)shm;
  int tskip;
  { typedef __attribute__((address_space(3))) const unsigned long long* lds_u64q; const lds_u64q gt_=(lds_u64q)((__attribute__((address_space(3))) const char*)shm+LDS_G3);
    const int NT0=(q0+QB)/KVBLK; const unsigned long long e0=gt_[q0], e1=gt_[lane<NT0?64*lane+63:q0];
    const float G0=(__uint_as_float((unsigned)e0<<16)+__uint_as_float((unsigned)e0&0xffff0000u))+__uint_as_float((unsigned)(e0>>32)<<16);
    const float G1=(__uint_as_float((unsigned)e1<<16)+__uint_as_float((unsigned)e1&0xffff0000u))+__uint_as_float((unsigned)(e1>>32)<<16);
    const int ns=__builtin_popcountll(__ballot(lane<NT0 && (G1-G0)<skipthr)); tskip=__builtin_amdgcn_readfirstlane(min(ns&~1,NT0-6)); }
  const bf16*Kh=K+(rowbase+(long)tskip*KVBLK)*DM+h*D,*Vh=V+(rowbase+(long)tskip*KVBLK)*DM+h*D;
  float*wsf=(float*)(shm+LDS_WS)+wid*64;
  const bf16*ksrc=Kh+(long)lane*DM+wid*8;
  const bf16*vsrc=Vh+(long)(16*(wid&3)+(lane>>2))*DM+(wid>>2)*32+(lane&3)*8;
  const unsigned kdst=lds0+LDS_K+wid*1024, vdst=lds0+LDS_V+wid*1024;
  #define DMA_K(t,slot) glds16(ksrc+(long)(t)*KVBLK*DM,(unsigned)__builtin_amdgcn_readfirstlane(kdst+(slot)))
  #define DMA_V(t,slot) glds16(vsrc+(long)(t)*KVBLK*DM,(unsigned)__builtin_amdgcn_readfirstlane(vdst+(slot)))
  const int vb0=(int)(lds0+LDS_V)+((lane>>4)&1)*32+(lane&3)*8+(4*hi+((lane&15)>>2))*64;
  const char*Kbase=shm+LDS_K; bf16x8 kf[8];
  const lds_cptr shm3=(lds_cptr)shm; const lds_cptr kp0=shm3+LDS_K+hi*1024+r32*16; const lds_cptr vp0=shm3+LDS_V+((lane>>4)&1)*32+(lane&3)*8+(4*hi+((lane&15)>>2))*64;
  const int NT=(q0+QB)/KVBLK-tskip;
  DMA_K(0,0);DMA_V(0,0);DMA_K(1,SLOTB);
  bf16x8 qr[4];
  #pragma unroll
  for(int d0=0;d0<4;++d0)qr[d0]=*reinterpret_cast<const bf16x8*>(&Qw[(long)r32*DM+d0*16+hi*8]);
  float mhat=0.f,l_reg=0.f;f32x16 o[2];o[0]=f32x16{};o[1]=f32x16{};
  typedef __attribute__((address_space(3))) const unsigned long long* lds_u64p;
  const lds_u64p g3p=(lds_u64p)(shm3+LDS_G3)+tskip*KVBLK+r32;
  { const unsigned long long e=((lds_u64p)(shm3+LDS_G3))[q0+wid*QBLK+r32]; const unsigned lo_=(unsigned)e,hi_=(unsigned)(e>>32); mhat=(__uint_as_float(lo_<<16)+__uint_as_float(lo_&0xffff0000u))+__uint_as_float(hi_<<16); }
  u32x4 qa; qa.x=hi?0u:0x3f803f80u; qa.y=0u; qa.z=0u; qa.w=0u;
  #define SETREF() do{ const float x_=-mhat; const unsigned b1_=cvtpk_s(x_,0.f)&0xffffu; const float r1_=x_-__uint_as_float(b1_<<16); const unsigned b2_=cvtpk_s(r1_,0.f)&0xffffu; \
      const float r2_=r1_-__uint_as_float(b2_<<16); const unsigned b3_=cvtpk_s(r2_,0.f)&0xffffu; qa.y=hi?0u:(0x3f80u|(b1_<<16)); qa.z=hi?0u:(b2_|(b3_<<16)); asm volatile("":"+v"(qa)); }while(0)
  SETREF();
  unsigned long long ga0,ga1;
  #define GARD(t) do{ ga0=g3p[(t)*64]; ga1=g3p[(t)*64+32]; }while(0)
  #define KAF(g) __builtin_bit_cast(bf16x8,(u32x4){(unsigned)(g),(unsigned)((g)>>32),0x3f803f80u,0u})
  #define QAF() __builtin_bit_cast(bf16x8,qa)
  const int qrel=wid*QBLK+r32;
  #define CMASK(P0,P1,t) do{int jb_=(t)-(NT-4); if(jb_>=0)cmask(P0,P1,jb_,qrel,hi);}while(0)
  bool resc=false;
  #define START(P0,P1) do{ const float rm=rowmax(P0,P1); resc=false; \
    { const float dl=__builtin_fmaxf(rm,0.f); mhat=fadd_s(mhat,dl);     \
      _Pragma("unroll") for(int r=0;r<16;++r){P0[r]=fsub_s(P0[r],dl);P1[r]=fsub_s(P1[r],dl);} \
      SETREF(); } \
    _Pragma("unroll") for(int r=0;r<16;++r)P0[r]=__builtin_amdgcn_exp2f(P0[r]); }while(0)
  #define RESC() do{ if(resc){ asm volatile("s_waitcnt lgkmcnt(0)":::"memory"); \
      _Pragma("unroll") for(int d_=0;d_<2;++d_) _Pragma("unroll") for(int r=0;r<16;++r)o[d_][r]*=wsf[crow(r,hi)]; } }while(0)
  f32x16 pA0,pA1,pB0,pB1;
  int sl_prev=0,sl_cur=0,sl_next=SLOTB;
  #define ROT() do{sl_prev=sl_cur;sl_cur=sl_next;sl_next=(sl_next==(NSLOT-1)*SLOTB)?0:sl_next+SLOTB;}while(0)
  DMA_K(2,2*SLOTB);
  WAIT_BAR(3);
  GARD(0); qkt(pA0,pA1,Kbase,qr,KAF(ga0),KAF(ga1),QAF(),r32,hi);asm volatile("s_nop 15\n\ts_nop 7":"+v"(pA0),"+v"(pA1));CMASK(pA0,pA1,0);
  START(pA0,pA1);
  _Pragma("unroll") for(int r=0;r<16;++r)pA1[r]=__builtin_amdgcn_exp2f(pA1[r]);
  WAIT_BAR(0);
  DMA_K(3,0);DMA_V(1,SLOTB);
  ROT();
  kload8(kf,kp0+sl_cur); GARD(1);
  WAIT_BAR(2);
  s16x4 vlo[8],vhi[8]; u32x4 pw0,pw1,pw2,pw3;
  #define PKW(P,B) cvtpk_s(P[B],P[B+1])
  #define PAF(k) __builtin_bit_cast(bf16x8,pw##k)
  #define VFR(i) (bf16x8){vlo[i][0],vlo[i][1],vlo[i][2],vlo[i][3],vhi[i][0],vhi[i][1],vhi[i][2],vhi[i][3]}
  #define PIN(x) asm volatile("":"+v"(x))
  #define MX3(a,b,c) __builtin_fmaxf(__builtin_fmaxf((a),(b)),(c))
  #define GAPA(MF,A0,A1,A2,A3,W0,W1,PW) do{ MF; sacc+=A0; sacc+=A1; sacc+=A2; sacc+=A3; PIN(sacc); W0; W1; PIN(PW); SBAR(); }while(0)
  #define EX(v) __builtin_amdgcn_exp2f(v)
  #define GAPB(MF,X,B) do{ MF; X[B]=EX(X[B]); X[B+1]=EX(X[B+1]); X[B+2]=EX(X[B+2]); X[B+3]=EX(X[B+3]); PIN(X); SBAR(); }while(0)
  #define VRD(i) do{ vlo[i]=vtr(vp_+(((i)>>2)*4096+((i)&3)*1024)); vhi[i]=vtr(vp_+(((i)>>2)*4096+((i)&3)*1024+512)); }while(0)
  #define KRD(G,j) do{ if(G){ kload2(kf,kp0+sl_next,j); SBAR(); } }while(0)
  #define STEP(C0,C1,P0,P1,t,GK,GV,GL) do{ SBAR(); \
    const lds_cptr vp_=vp0+sl_prev; \
    { const f32x16 z_=f32x16{}; C0=__builtin_amdgcn_mfma_f32_32x32x16_bf16(KAF(ga0),QAF(),z_,0,0,0); C1=__builtin_amdgcn_mfma_f32_32x32x16_bf16(KAF(ga1),QAF(),z_,0,0,0); } SBAR(); \
    VRD(0); SBAR(); float sacc=(P0[0]+P0[1]); \
    GAPA(C0=__builtin_amdgcn_mfma_f32_32x32x16_bf16(kf[0],qr[0],C0,0,0,0), P0[2],P0[3],P0[4],P0[5],     pw0[0]=PKW(P0,0), pw0[1]=PKW(P0,2), pw0); \
    VRD(4); SBAR(); GAPA(C1=__builtin_amdgcn_mfma_f32_32x32x16_bf16(kf[1],qr[0],C1,0,0,0), P0[6],P0[7],P0[8],P0[9],     pw0[2]=PKW(P0,4), pw0[3]=PKW(P0,6), pw0); \
    VRD(1); SBAR(); GAPA(C0=__builtin_amdgcn_mfma_f32_32x32x16_bf16(kf[2],qr[1],C0,0,0,0),   P0[10],P0[11],P0[12],P0[13], pw1[0]=PKW(P0,8), pw1[1]=PKW(P0,10), pw1); \
    VRD(5); SBAR(); GAPA(C1=__builtin_amdgcn_mfma_f32_32x32x16_bf16(kf[3],qr[1],C1,0,0,0),   P0[14],P0[15],P1[0],P1[1],   pw1[2]=PKW(P0,12),pw1[3]=PKW(P0,14), pw1); \
    VRD(2); SBAR(); GAPA(C0=__builtin_amdgcn_mfma_f32_32x32x16_bf16(kf[4],qr[2],C0,0,0,0),   P1[2],P1[3],P1[4],P1[5],     pw2[0]=PKW(P1,0), pw2[1]=PKW(P1,2), pw2); \
    VRD(6); SBAR(); GAPA(C1=__builtin_amdgcn_mfma_f32_32x32x16_bf16(kf[5],qr[2],C1,0,0,0),   P1[6],P1[7],P1[8],P1[9],     pw2[2]=PKW(P1,4), pw2[3]=PKW(P1,6), pw2); \
    VRD(3); SBAR(); GAPA(C0=__builtin_amdgcn_mfma_f32_32x32x16_bf16(kf[6],qr[3],C0,0,0,0),   P1[10],P1[11],P1[12],P1[13], pw3[0]=PKW(P1,8), pw3[1]=PKW(P1,10), pw3); \
    VRD(7); SBAR(); GAPA(C1=__builtin_amdgcn_mfma_f32_32x32x16_bf16(kf[7],qr[3],C1,0,0,0),   P1[14],P1[15],0.f,0.f,       pw3[2]=PKW(P1,12),pw3[3]=PKW(P1,14), pw3); \
    l_reg+=sacc; \
    if(GK){DMA_K((t)+3,sl_cur);} if(GV){DMA_V((t)+1,sl_next);} \
    CMASK(C0,C1,t); \
    { float a=MX3(C0[0],C0[1],C1[0]),b=MX3(C0[2],C0[3],C1[1]); a=MX3(a,C1[2],C1[3]); \
      _Pragma("unroll") for(int r=4;r<16;r+=4){a=MX3(a,C0[r],C0[r+1]);b=MX3(b,C0[r+2],C0[r+3]);a=MX3(a,C1[r],C1[r+1]);b=MX3(b,C1[r+2],C1[r+3]);} \
      float rm=__builtin_fmaxf(a,b); { auto rr=__builtin_amdgcn_permlane32_swap(__float_as_uint(rm),__float_as_uint(rm),false,false); rm=__builtin_fmaxf(__uint_as_float(rr[0]),__uint_as_float(rr[1])); } \
      resc=false; \
      if(__builtin_expect(__any(rm>(float)THRL),0)){ const float dl=__builtin_fmaxf(rm,0.f); mhat+=dl; \
        _Pragma("unroll") for(int r=0;r<16;++r){C0[r]-=dl;C1[r]-=dl;} \
        SETREF(); \
        const float f=__builtin_amdgcn_exp2f(-dl); l_reg*=f; if(hi==0)wsf[r32]=f; resc=true; } } \
    SBAR(); \
    GAPB(o[0]=__builtin_amdgcn_mfma_f32_32x32x16_bf16(PAF(0),VFR(0),o[0],0,0,0), C0,0); \
    GAPB(o[1]=__builtin_amdgcn_mfma_f32_32x32x16_bf16(PAF(0),VFR(4),o[1],0,0,0), C0,4); \
    KRD(GL,0); GAPB(o[0]=__builtin_amdgcn_mfma_f32_32x32x16_bf16(PAF(1),VFR(1),o[0],0,0,0), C0,8); \
    KRD(GL,1); GAPB(o[1]=__builtin_amdgcn_mfma_f32_32x32x16_bf16(PAF(1),VFR(5),o[1],0,0,0), C0,12); \
    KRD(GL,2); GAPB(o[0]=__builtin_amdgcn_mfma_f32_32x32x16_bf16(PAF(2),VFR(2),o[0],0,0,0), C1,0); \
    KRD(GL,3); GAPB(o[1]=__builtin_amdgcn_mfma_f32_32x32x16_bf16(PAF(2),VFR(6),o[1],0,0,0), C1,4); \
    if(GL){ GARD((t)+1); SBAR(); } GAPB(o[0]=__builtin_amdgcn_mfma_f32_32x32x16_bf16(PAF(3),VFR(3),o[0],0,0,0), C1,8); \
    GAPB(o[1]=__builtin_amdgcn_mfma_f32_32x32x16_bf16(PAF(3),VFR(7),o[1],0,0,0), C1,12); \
    }while(0)
  int t=1;
  #undef CMASK
  #define CMASK(P0,P1,t) do{}while(0)
  for(;t+5<NT;t+=2){
    STEP(pB0,pB1,pA0,pA1,t,true,true,true);     WAIT_BAR(2); RESC(); ROT();
    STEP(pA0,pA1,pB0,pB1,t+1,true,true,true);   WAIT_BAR(2); RESC(); ROT();
  }
  #undef CMASK
  #define CMASK(P0,P1,t) do{int jb_=(t)-(NT-4); if(jb_>=0)cmask(P0,P1,jb_,qrel,hi);}while(0)
  #define ENDW(tt) do{ if((tt)+3<NT){WAIT_BAR(2);} else if((tt)+2<NT){WAIT_BAR(1);} else {WAIT_BAR(0);} }while(0)
  #undef CMASK
  #define CMASK(P0,P1,t) do{}while(0)
  STEP(pB0,pB1,pA0,pA1,NT-5,true,true,true);   WAIT_BAR(2); RESC(); ROT();
  #undef CMASK
  #define CMASK(P0,P1,t) cmask(P0,P1,0,qrel,hi)
  STEP(pA0,pA1,pB0,pB1,NT-4,true,true,true);   WAIT_BAR(2); RESC(); ROT();
  #undef CMASK
  #define CMASK(P0,P1,t) cmask(P0,P1,1,qrel,hi)
  STEP(pB0,pB1,pA0,pA1,NT-3,false,true,true);  WAIT_BAR(1); RESC(); ROT();
  #undef CMASK
  #define CMASK(P0,P1,t) cmask(P0,P1,2,qrel,hi)
  STEP(pA0,pA1,pB0,pB1,NT-2,false,true,true);  WAIT_BAR(0); RESC(); ROT();
  #undef CMASK
  #define CMASK(P0,P1,t) cmask(P0,P1,3,qrel,hi)
  STEP(pB0,pB1,pA0,pA1,NT-1,false,false,false); RESC();
  { float sacc=pB0[0]+pB0[1]; _Pragma("unroll") for(int r=2;r<16;++r)sacc+=pB0[r]; _Pragma("unroll") for(int r=0;r<16;++r)sacc+=pB1[r]; l_reg+=sacc;
    pw0=(u32x4){PKW(pB0,0),PKW(pB0,2),PKW(pB0,4),PKW(pB0,6)};pw1=(u32x4){PKW(pB0,8),PKW(pB0,10),PKW(pB0,12),PKW(pB0,14)};pw2=(u32x4){PKW(pB1,0),PKW(pB1,2),PKW(pB1,4),PKW(pB1,6)};pw3=(u32x4){PKW(pB1,8),PKW(pB1,10),PKW(pB1,12),PKW(pB1,14)};
    SBAR(); pv(o,vb0+sl_cur,PAF(0),PAF(1),PAF(2),PAF(3)); }
  #undef PKW
  #undef PAF
  #undef VFR
  #undef PIN
  #undef MX3
  #undef GAPA
  #undef GAPB
  #undef EX
  #undef VRD
  #undef KRD
  #undef STEP
  #undef ENDW
  {auto rr=__builtin_amdgcn_permlane32_swap(__float_as_uint(l_reg),__float_as_uint(l_reg),false,false);l_reg=__uint_as_float(rr[0])+__uint_as_float(rr[1]);}
  if(hi==0)wsf[32+r32]=l_reg;asm volatile("s_waitcnt lgkmcnt(0)":::"memory");
  float rli[16];
  #pragma unroll
  for(int r=0;r<16;++r)rli[r]=__builtin_amdgcn_rcpf(wsf[32+crow(r,hi)]);
  bf16*Ow=O+(rowbase+q0+wid*QBLK)*DM+h*D; const bf16*Gw=GATE+(rowbase+q0+wid*QBLK)*DM+h*D;
  { bf16*stg=(bf16*)(shm+LDS_OST)+wid*2048;
    #pragma unroll
    for(int r=0;r<16;++r){const int orow=crow(r,hi);
      #pragma unroll
      for(int d0=0;d0<2;++d0)stg[orow*64+d0*32+r32]=__float2bfloat16(o[d0][r]*rli[r]);}
    asm volatile("s_waitcnt lgkmcnt(0)":::"memory");
    #pragma unroll
    for(int i=0;i<4;++i){const int row=i*8+(lane>>3),ch=lane&7; const u32x4 v=*(const u32x4*)(stg+row*64+ch*8); const u32x4 gv=*(const u32x4*)(Gw+(long)row*DM+ch*8); u32x4 w;
      #define GMUL(a,g) cvtpk_s(__uint_as_float((a)<<16)*__uint_as_float((g)<<16),__uint_as_float((a)&0xffff0000u)*__uint_as_float((g)&0xffff0000u))
      w.x=GMUL(v.x,gv.x); w.y=GMUL(v.y,gv.y); w.z=GMUL(v.z,gv.z); w.w=GMUL(v.w,gv.w);
      #undef GMUL
      ATTN_STORE16(Ow+(long)row*DM+ch*8,w);} }
  asm volatile("s_waitcnt lgkmcnt(0)\n\ts_barrier":::"memory");
  #undef DMA_K
  #undef DMA_V
  #undef CMASK
  #undef START
  #undef RESC
  #undef ROT
  #undef SETREF
  #undef GARD
  #undef KAF
  #undef QAF
}
constexpr int ATTN_LDS_BYTES=LDS_BYTES;
struct AttnTensors { const bf16* Q; const bf16* K; const bf16* V; const bf16* GATE; bf16* O; const unsigned long long* G3; const float* qg; const float* kg; };
template<int THRL=8> __device__ __forceinline__ void attn_phase(char*lds,const AttnTensors&T,int grid,int block){
  const int v0=(grid%8==0)?(block%8)*(grid/8)+block/8:block;
  float skipthr; { float a=fabsf(T.qg[threadIdx.x&63]),b=fabsf(T.kg[threadIdx.x&63]);
    #pragma unroll
    for(int o=1;o<64;o<<=1){a=fmaxf(a,__shfl_xor(a,o));b=fmaxf(b,__shfl_xor(b,o));}
    const float qkmax=64.f*a*b*C2_*1.05f; skipthr=-(42.f+3.f*qkmax); }
  for(int v=v0;v<BATCH*NHEAD*2;v+=grid){
    const int bh=v>>1,odd=v&1;
    {
      const u32x4*src=(const u32x4*)(T.G3+(size_t)bh*SEQ); u32x4*dst=(u32x4*)(lds+LDS_G3);
      #pragma unroll
      for(int i=0;i<4;++i)dst[threadIdx.x+512*i]=src[threadIdx.x+512*i];
      if(threadIdx.x<128)((unsigned long long*)(lds+LDS_GPAD))[threadIdx.x]=0x3f80000000000000ull|0xc6eaull;
      asm volatile("s_waitcnt vmcnt(0) lgkmcnt(0)\n\ts_barrier":::"memory"); }
    #pragma unroll 1
    for(int i=0;i<8;++i){ const int j=i>>1; const int qb=(i&1)?(15-2*j-odd):(2*j+odd); attn_unit<THRL>(bh/NHEAD,bh%NHEAD,qb,T.Q,T.K,T.V,T.GATE,T.O,lds,skipthr); }
  }
}
#undef SBAR
#undef WAIT_BAR
}

constexpr int RING_BYTES = 131072;
constexpr int LDS_BYTES = 163840;
constexpr int LDSCTL_OFF = LDS_BYTES - 1024, MISC_OFF = LDSCTL_OFF + 320;
constexpr int CW_BAR = 4096;
typedef GAS unsigned gu32;
#define RLX_AGENT __ATOMIC_RELAXED, __HIP_MEMORY_SCOPE_AGENT
#define XB_TMO      128
#define XB_XCNT(j)  (256  + 64 * (j))
#define XB_XSUB(j)  (1280 + 64 * (j))
#define XB_XGEN(j)  (2304 + 64 * (j))
#define XB_TOP      3328
#define XB_TOPGEN   3392
#define XCD_BAR_WORDS 3456
#define XB_SPIN_CAP (1u << 18)
__device__ __forceinline__ unsigned xb_ld(unsigned* p)              { return __hip_atomic_load(p, __ATOMIC_RELAXED, __HIP_MEMORY_SCOPE_AGENT); }
__device__ __forceinline__ unsigned xb_add(unsigned* p, unsigned v) { return __hip_atomic_fetch_add(p, v, __ATOMIC_RELAXED, __HIP_MEMORY_SCOPE_AGENT); }
__device__ __forceinline__ unsigned xb_xcc_id() { return (unsigned)__builtin_amdgcn_s_getreg((3 << 11) | 20) & 0xFu; }
#define XB_SPIN(cond, bar) do { unsigned _sp = 0; while (cond) { __builtin_amdgcn_s_sleep(1); \
    if ((++_sp & 255u) == 0u) { if (xb_ld(&(bar)[XB_TMO])) break; if (_sp > XB_SPIN_CAP) { atomicAdd(&(bar)[XB_TMO], 1u); break; } } } } while (0)
struct XcdBarrier { unsigned* bar; unsigned x; volatile LAS unsigned* st; };
__device__ __forceinline__ XcdBarrier xcd_barrier_post(unsigned* bar, volatile LAS unsigned* st) {
    XcdBarrier b; b.bar = bar; b.x = xb_xcc_id(); b.st = st;
    if (threadIdx.x == 0) (void)xb_add(&bar[XB_XCNT(b.x)], 1u);
    return b;
}
__device__ __forceinline__ void xcd_barrier_complete(unsigned* bar, unsigned x, unsigned& nloc, unsigned& nx) {
    const unsigned G = gridDim.x * gridDim.y * gridDim.z;
    unsigned sum, cnt, mine, sp = 0u;
    for (;;) {
        sum = 0u; cnt = 0u; mine = 0u;
#pragma unroll
        for (unsigned j = 0; j < 16; ++j) { const unsigned c = xb_ld(&bar[XB_XCNT(j)]); sum += c; cnt += (c > 0u) ? 1u : 0u; mine = (j == x) ? c : mine; }
        if (sum == G) break;
        __builtin_amdgcn_s_sleep(1);
        if ((++sp & 255u) == 0u) { if (xb_ld(&bar[XB_TMO])) break; if (sp > XB_SPIN_CAP) { atomicAdd(&bar[XB_TMO], 1u); break; } }
    }
    nloc = mine > 0u ? mine : 1u; nx = cnt > 0u ? cnt : 1u;
}
__device__ __forceinline__ void xcd_barrier(const XcdBarrier& b) {
    asm volatile("s_waitcnt vmcnt(0)" ::: "memory");
    __syncthreads();
    if (threadIdx.x == 0) {
        unsigned* bar = b.bar; unsigned bx = b.x;
        asm volatile("" : "+s"(bar), "+s"(bx));
        __builtin_amdgcn_s_waitcnt(0);
        unsigned nloc = b.st[0], nx = b.st[1];
        if (nloc == 0u) { xcd_barrier_complete(bar, bx, nloc, nx); b.st[0] = nloc; b.st[1] = nx; }
        const unsigned old = xb_add(&bar[XB_XSUB(bx)], 1u);
        const unsigned gen = old / nloc;
        if (old + 1u == (gen + 1u) * nloc) {
            __builtin_amdgcn_fence(__ATOMIC_RELEASE, "agent");
            asm volatile("s_waitcnt vmcnt(0)" ::: "memory");
            const unsigned og = xb_add(&bar[XB_TOP], 1u);
            const unsigned tg = og / nx;
            if (og + 1u == (tg + 1u) * nx) xb_add(&bar[XB_TOPGEN], 1u);
            else XB_SPIN(xb_ld(&bar[XB_TOPGEN]) == tg, bar);
            __builtin_amdgcn_fence(__ATOMIC_ACQUIRE, "agent");
            xb_add(&bar[XB_XGEN(bx)], 1u);
            asm volatile("s_waitcnt vmcnt(0)" ::: "memory");
        } else {
            XB_SPIN(xb_ld(&bar[XB_XGEN(bx)]) == gen, bar);
            __builtin_amdgcn_fence(__ATOMIC_ACQUIRE, "agent");
            asm volatile("s_waitcnt vmcnt(0)" ::: "memory");
        }
    }
    __syncthreads();
}

__device__ __forceinline__ void bg_cvt(unsigned char* ws, LAS unsigned char* lds, int wave, int lane, volatile LAS unsigned* flag) {
    const InP in = kin(); LAS float* scr = (LAS float*)(lds + wave * 8448); volatile LAS unsigned* cur = flag + 1;
    const unsigned c = blockIdx.x, G = gridDim.x;
    for (;;) {
        if (*flag != 0u) break;
        if (*cur * G + c >= (unsigned)IT_BG) break;
        unsigned k = 0u; if (lane == 0) k = __hip_atomic_fetch_add((LAS unsigned*)cur, 1u, __ATOMIC_RELAXED, __HIP_MEMORY_SCOPE_WORKGROUP); k = (unsigned)__builtin_amdgcn_readfirstlane((int)k);
        const unsigned it = k * G + c; if (it >= (unsigned)IT_BG) break;
        cvt_item(in, ws, bg_item((int)it), scr, lane);
    }
}
__device__ __forceinline__ void xcd_barrier_bg(const XcdBarrier& b, unsigned char* ws, LAS unsigned char* lds, volatile LAS unsigned* flag) {
    asm volatile("s_waitcnt vmcnt(0)" ::: "memory");
    if (threadIdx.x == 0) *flag = 0u;
    __syncthreads();
    const int wave = __builtin_amdgcn_readfirstlane((int)threadIdx.x >> 6), lane = threadIdx.x & 63;
    if (wave != 0) { bg_cvt(ws, lds, wave, lane, flag); asm volatile("s_waitcnt vmcnt(0)" ::: "memory"); }
    else if (threadIdx.x == 0) {
        unsigned* bar = b.bar; unsigned bx = b.x;
        asm volatile("" : "+s"(bar), "+s"(bx));
        __builtin_amdgcn_s_waitcnt(0);
        unsigned nloc = b.st[0], nx = b.st[1];
        if (nloc == 0u) { xcd_barrier_complete(bar, bx, nloc, nx); b.st[0] = nloc; b.st[1] = nx; }
        const unsigned old = xb_add(&bar[XB_XSUB(bx)], 1u);
        const unsigned gen = old / nloc;
        if (old + 1u == (gen + 1u) * nloc) {
            __builtin_amdgcn_fence(__ATOMIC_RELEASE, "agent");
            asm volatile("s_waitcnt vmcnt(0)" ::: "memory");
            const unsigned og = xb_add(&bar[XB_TOP], 1u);
            const unsigned tg = og / nx;
            if (og + 1u == (tg + 1u) * nx) xb_add(&bar[XB_TOPGEN], 1u);
            else XB_SPIN(xb_ld(&bar[XB_TOPGEN]) == tg, bar);
            __builtin_amdgcn_fence(__ATOMIC_ACQUIRE, "agent");
            xb_add(&bar[XB_XGEN(bx)], 1u);
            asm volatile("s_waitcnt vmcnt(0)" ::: "memory");
        } else {
            XB_SPIN(xb_ld(&bar[XB_XGEN(bx)]) == gen, bar);
            __builtin_amdgcn_fence(__ATOMIC_ACQUIRE, "agent");
            asm volatile("s_waitcnt vmcnt(0)" ::: "memory");
        }
        *flag = 1u;
    }
    __syncthreads();
}

struct Frame { unsigned char* ws; float* out; LAS unsigned char* lds; int bid, G; };
#define TID_LANE_WAVE const int tid = threadIdx.x, lane = tid & 63, wave = __builtin_amdgcn_readfirstlane(tid >> 6); (void)tid; (void)lane; (void)wave

__device__ __forceinline__ void ph_prologue(const Frame& F) {
    TID_LANE_WAVE;
    const InP in = kin(); unsigned char* ws = opq(F.ws);
    LAS float* sc = (LAS float*)F.lds; LAS float* red = (LAS float*)(F.lds + 32768);
    __syncthreads();
    if (F.bid < ADA_ITEMS) {
        for (int i = tid; i < 8 * 1024; i += 512) sc[i] = siluf(in->c[i]);
        __syncthreads();
        for (int it = F.bid; it < ADA_ITEMS; it += F.G) ada_item(in, (float*)(ws + WS_MODS), it, sc, red, tid);
    }
    __syncthreads();
    LAS float* scr = (LAS float*)(F.lds + wave * 8448);
    const int gw = F.bid * 8 + wave, ngw = F.G * 8;
    for (int it = gw; it < IT_FG; it += ngw) cvt_item(in, ws, fg_item(it), scr, lane);
    bf16_t* wsb = (bf16_t*)(ws + WS_WS);
    for (int i = F.bid * 512 + tid; i < 8 * 128 * 128; i += F.G * 512) { const int s = i & 127, t = (i >> 7) & 127; wsb[i] = (bf16_t)f2bf(s <= t ? in->w_s[i] : 0.f); }
}
__device__ __forceinline__ void ph_norm0(const Frame& F) {
    TID_LANE_WAVE; const InP in = kin(); unsigned char* ws = opq(F.ws); const int gw = F.bid * 8 + wave, ngw = F.G * 8;
    const float* mods = (const float*)(ws + WS_MODS);
    for (int r = gw; r < T; r += ngw) { const int b = r / SEQ;
        row4_norm_mod_store(in->x + (size_t)r * DM, in->norm_mix_g, mods + (size_t)b * 6144 + 0, mods + (size_t)b * 6144 + 1024, ws + WS_XN8 + (size_t)r * DM, lane); }
}
__device__ __forceinline__ void ph_norm_router(const Frame& F, int L) {
    TID_LANE_WAVE; const InP in = kin(); unsigned char* ws = opq(F.ws);
    LAS u32x4* WPB = (LAS u32x4*)F.lds;
    LAS float* lg = (LAS float*)(F.lds + 131072) + wave * 512;
    LAS int* hist = (LAS int*)(F.lds + 131072 + 16384);
    LAS float* rs_s = (LAS float*)(F.lds + 131072 + 16384 + 256) + wave * 16;
    LAS float* pb = (LAS float*)(F.lds + 131072);
    LAS float* rbl = (LAS float*)(F.lds + 131072 + 16384 + 256 + 512);
    const float* mods = (const float*)(ws + WS_MODS) + (size_t)L * 8 * 6144;
    const bf16_t* XR = (const bf16_t*)(ws + WS_XR);
    for (int grp = F.bid; grp < 256; grp += F.G) {
        const int b = grp >> 5; const float* gsc = mods + (size_t)b * 6144 + 4096; const float* gg = in->norm_ffn_g + L * 1024; const float* rw = in->router_w + (size_t)L * 1024 * 32;
        __syncthreads();
        float bpart = 0.f; const float* gsh = mods + (size_t)b * 6144 + 3072;
        for (int cidx = tid; cidx < 32 * 2 * 64; cidx += 512) { const int l = cidx & 63, hh = (cidx >> 6) & 1, s2 = cidx >> 7, e = 16 * hh + (l & 15), k0 = 32 * s2 + 8 * (l >> 4);
            unsigned hi[4], lo[4];
#pragma unroll
            for (int h2 = 0; h2 < 2; ++h2) { const f32x4 g4 = *(const f32x4*)(gg + k0 + 4 * h2), s4 = *(const f32x4*)(gsc + k0 + 4 * h2), h4 = *(const f32x4*)(gsh + k0 + 4 * h2); float wv[4];
#pragma unroll
                for (int q = 0; q < 4; ++q) { const float r_ = rw[(k0 + 4 * h2 + q) * 32 + e]; wv[q] = g4[q] * (1.f + s4[q]) * r_; bpart += h4[q] * r_; }
#pragma unroll
                for (int q = 0; q < 4; q += 2) { const unsigned a0 = f2bf(wv[q]), a1 = f2bf(wv[q + 1]); hi[2 * h2 + (q >> 1)] = a0 | (a1 << 16);
                    lo[2 * h2 + (q >> 1)] = f2bf(wv[q] - __uint_as_float(a0 << 16)) | (f2bf(wv[q + 1] - __uint_as_float(a1 << 16)) << 16); } }
            WPB[((s2 * 2 + 0) * 2 + hh) * 64 + l] = (u32x4){hi[0], hi[1], hi[2], hi[3]}; WPB[((s2 * 2 + 1) * 2 + hh) * 64 + l] = (u32x4){lo[0], lo[1], lo[2], lo[3]}; }
        pb[tid] = bpart;
        if (tid < 32) hist[tid] = 0;
        __syncthreads();
        if (tid < 32) { float t = in->router_b[L * 32 + tid];
#pragma unroll
            for (int p = 0; p < 16; ++p) t += pb[((p >> 2) << 7) | ((tid >> 4) << 6) | ((p & 3) << 4) | (tid & 15)];
            rbl[tid] = t; }
        __syncthreads();
        const int r0 = grp * 128 + wave * 16, j = lane & 15, kq = lane >> 4;
        {
            const bf16_t* xrow = XR + (size_t)(r0 + j) * DM + 8 * kq;
            f32x4 acc0 = {0.f, 0.f, 0.f, 0.f}, acc1 = {0.f, 0.f, 0.f, 0.f}; float ssq = 0.f;
#pragma unroll 16
            for (int s2 = 0; s2 < 32; ++s2) {
                const u32x4 xw = *(const u32x4*)(xrow + 32 * s2); f32x4 xa, xb; bf8_to_f32(xw, xa, xb);
                ssq += ((xa.x * xa.x + xa.y * xa.y) + (xa.z * xa.z + xa.w * xa.w)) + ((xb.x * xb.x + xb.y * xb.y) + (xb.z * xb.z + xb.w * xb.w));
                const bf16x8 xf = __builtin_bit_cast(bf16x8, xw);
#pragma unroll
                for (int pc = 0; pc < 2; ++pc) { const bf16x8 w0 = __builtin_bit_cast(bf16x8, WPB[((s2 * 2 + pc) * 2 + 0) * 64 + lane]), w1 = __builtin_bit_cast(bf16x8, WPB[((s2 * 2 + pc) * 2 + 1) * 64 + lane]);
                    acc0 = __builtin_amdgcn_mfma_f32_16x16x32_bf16(w0, xf, acc0, 0, 0, 0); acc1 = __builtin_amdgcn_mfma_f32_16x16x32_bf16(w1, xf, acc1, 0, 0, 0); }
            }
            ssq += __shfl_xor(ssq, 16); ssq += __shfl_xor(ssq, 32);
            const float rstd = 1.f / sqrtf(ssq * (1.f / 1024.f) + EPS);
            const f32x4 b0 = *(const LAS f32x4*)(rbl + 4 * kq), b1 = *(const LAS f32x4*)(rbl + 16 + 4 * kq);
            *(LAS f32x4*)(lg + j * 32 + 4 * kq) = acc0 * rstd + b0; *(LAS f32x4*)(lg + j * 32 + 16 + 4 * kq) = acc1 * rstd + b1;
            if (kq == 0) rs_s[j] = rstd;
        }
        __builtin_amdgcn_s_waitcnt(0xc07f); asm volatile("" ::: "memory");
        if (lane < 16) {
            float v[32];
#pragma unroll
            for (int q = 0; q < 8; ++q) { const f32x4 t4 = *(const LAS f32x4*)(lg + lane * 32 + 4 * q); v[4 * q] = t4.x; v[4 * q + 1] = t4.y; v[4 * q + 2] = t4.z; v[4 * q + 3] = t4.w; }
            int ti[4]; float tv[4];
#pragma unroll
            for (int p = 0; p < 4; ++p) { float bv = -INFINITY; int bi = 0;
#pragma unroll
                for (int e = 0; e < 32; ++e) { bool ok = v[e] > bv;
#pragma unroll
                    for (int pp = 0; pp < p; ++pp) ok = ok && (ti[pp] != e);
                    if (ok) { bv = v[e]; bi = e; } }
                ti[p] = bi; tv[p] = bv; }
            float tg[4]; float sm = 0.f;
#pragma unroll
            for (int p = 0; p < 4; ++p) { tg[p] = expf(tv[p] - tv[0]); sm += tg[p]; }
            const int r = r0 + lane;
            *(i32x4*)((int*)(ws + WS_TOPE) + r * 4) = (i32x4){ti[0], ti[1], ti[2], ti[3]};
            *(f32x4*)((float*)(ws + WS_TOPG) + r * 4) = (f32x4){tg[0] / sm, tg[1] / sm, tg[2] / sm, tg[3] / sm};
#pragma unroll
            for (int p = 0; p < 4; ++p) __hip_atomic_fetch_add(&hist[ti[p]], 1, __ATOMIC_RELAXED, __HIP_MEMORY_SCOPE_WORKGROUP);
        }
#pragma unroll 4
        for (int i = 0; i < 16; ++i) { const int r = r0 + i; f32x4 v[4], h[4]; row_load_bf(XR + (size_t)r * DM, lane, v);
            row_modnorm(v, rs_s[i], gg, mods + (size_t)b * 6144 + 3072, gsc, lane, h); row_store_fp8(ws + WS_XN8 + (size_t)r * DM, lane, h); }
        __syncthreads();
        if (tid < 32) ((int*)(ws + WS_HIST))[grp * 32 + tid] = hist[tid];
    }
}
__device__ __forceinline__ void ph_list(const Frame& F) {
    TID_LANE_WAVE; unsigned char* ws = opq(F.ws);
    LAS int* tot = (LAS int*)F.lds; LAS int* before = tot + 32; LAS int* pstart = tot + 64; LAS int* se = tot + 128; LAS int* part = tot + 640;
    const int* hist = (const int*)(ws + WS_HIST); const int* tope = (const int*)(ws + WS_TOPE); const float* topg = (const float*)(ws + WS_TOPG);
    int* dest = (int*)(ws + WS_DEST); int* list = (int*)(ws + WS_LIST); float* rowg = (float*)(ws + WS_ROWG); int* blke = (int*)(ws + WS_BLKE);
    for (int w = F.bid; w < 256; w += F.G) {
        __syncthreads();
        const int mye = tope[w * 512 + tid]; se[tid] = mye;
        { const int e = tid & 31, p = tid >> 5; int a = 0, bf = 0;
#pragma unroll 4
            for (int i = p * 16; i < p * 16 + 16; ++i) { const int h = hist[i * 32 + e]; a += h; bf += (i < w) ? h : 0; }
            part[p * 32 + e] = a; part[512 + p * 32 + e] = bf; }
        __syncthreads();
        if (tid < 32) { int a = 0, bf = 0;
#pragma unroll
            for (int p = 0; p < 16; ++p) { a += part[p * 32 + tid]; bf += part[512 + p * 32 + tid]; }
            tot[tid] = a; before[tid] = bf; }
        __syncthreads();
        if (tid == 0) { int p = 0; for (int e = 0; e < 32; ++e) { pstart[e] = p; p += (tot[e] + 255) / 256 * 256; } pstart[32] = p; }
        __syncthreads();
        { int rank = 0;
            for (int i4 = 0; i4 < 128; ++i4) { const i32x4 q = *(const LAS i32x4*)(se + 4 * i4); const int i0 = 4 * i4;
                rank += (q.x == mye && i0 < tid) + (q.y == mye && i0 + 1 < tid) + (q.z == mye && i0 + 2 < tid) + (q.w == mye && i0 + 3 < tid); }
            const int slot = w * 512 + tid, d = pstart[mye] + before[mye] + rank;
            dest[slot] = d; list[d] = slot >> 2; rowg[d] = topg[slot]; }
        if (w < 32) { const int e = w; for (int r = pstart[e] + tot[e] + tid; r < pstart[e + 1]; r += 512) { list[r] = -1; rowg[r] = 0.f; }
            for (int bk = pstart[e] / 256 + tid; bk < pstart[e + 1] / 256; bk += 512) blke[bk] = e; }
        if (w == 32 && tid == 0) blke[MAXBLK] = pstart[32] / 256;
    }
}
__device__ __forceinline__ void ph_combine(const Frame& F, int L) {
    TID_LANE_WAVE; const InP in = kin(); unsigned char* ws = opq(F.ws); float* out = F.out;
    LAS u32x4* WFB = (LAS u32x4*)F.lds;
    LAS float* rs_s = (LAS float*)(F.lds + 65536) + wave * 16;
    LAS float* pb = (LAS float*)(F.lds + 65536 + 1024);
    LAS float* fbl = (LAS float*)(F.lds + 65536 + 1024 + 2048);
    const float* mods = (const float*)(ws + WS_MODS);
    bf16_t* XR = (bf16_t*)(ws + WS_XR); const bf16_t* YB = (const bf16_t*)(ws + WS_YB); const int* dest = (const int*)(ws + WS_DEST);
    for (int grp = F.bid; grp < 256; grp += F.G) {
        const int b = grp >> 5, r0 = grp * 128 + wave * 16;
        if (L == 0) {
            __syncthreads();
            const float* ksc = mods + ((size_t)16 + b) * 6144 + 1024; const float* ksh = mods + ((size_t)16 + b) * 6144; float bpart = 0.f;
            for (int cidx = tid; cidx < 32 * 64; cidx += 512) { const int l = cidx & 63, s2 = cidx >> 6, e = l & 15, k0 = 32 * s2 + 8 * (l >> 4);
                unsigned hi[4], lo[4];
#pragma unroll
                for (int h2 = 0; h2 < 2; ++h2) { const f32x4 g4 = *(const f32x4*)(in->kv_norm_g + k0 + 4 * h2), s4 = *(const f32x4*)(ksc + k0 + 4 * h2), h4 = *(const f32x4*)(ksh + k0 + 4 * h2); float wv[4];
#pragma unroll
                    for (int q = 0; q < 4; ++q) { const float r_ = in->kv_w[(size_t)(k0 + 4 * h2 + q) * 2064 + 2048 + e]; wv[q] = g4[q] * (1.f + s4[q]) * r_; bpart += h4[q] * r_; }
#pragma unroll
                    for (int q = 0; q < 4; q += 2) { const unsigned a0 = f2bf(wv[q]), a1 = f2bf(wv[q + 1]); hi[2 * h2 + (q >> 1)] = a0 | (a1 << 16);
                        lo[2 * h2 + (q >> 1)] = f2bf(wv[q] - __uint_as_float(a0 << 16)) | (f2bf(wv[q + 1] - __uint_as_float(a1 << 16)) << 16); } }
                WFB[(s2 * 2 + 0) * 64 + l] = (u32x4){hi[0], hi[1], hi[2], hi[3]}; WFB[(s2 * 2 + 1) * 64 + l] = (u32x4){lo[0], lo[1], lo[2], lo[3]}; }
            pb[tid] = bpart;
            __syncthreads();
            if (tid < 16) { float t = in->fgate_b[tid];
#pragma unroll
                for (int p = 0; p < 32; ++p) t += pb[(p << 4) | tid];
                fbl[tid] = t; }
            __syncthreads();
        }
        const float* gt = mods + ((size_t)L * 8 + b) * 6144 + 5120;
#pragma unroll 1
        for (int i = 0; i < 16; ++i) {
            const int r = r0 + i; f32x4 v[4]; row_load_bf(XR + (size_t)r * DM, lane, v);
            f32x4 y[4];
#pragma unroll
            for (int j = 0; j < 4; ++j) y[j] = (f32x4){0.f, 0.f, 0.f, 0.f};
            const i32x4 d4 = *(const i32x4*)(dest + r * 4); const int dd[4] = {d4.x, d4.y, d4.z, d4.w};
#pragma unroll
            for (int q = 0; q < 4; ++q) { const bf16_t* yr = YB + (size_t)dd[q] * 1024;
#pragma unroll
                for (int j = 0; j < 2; ++j) { f32x4 a, c; bf8_to_f32(((const u32x4*)yr)[lane + 64 * j], a, c); y[2 * j] += a; y[2 * j + 1] += c; } }
#pragma unroll
            for (int j = 0; j < 4; ++j) v[j] = v[j] + row_vec(gt, lane, j) * y[j];
            const float rs = row_rstd(v);
            if (L == 1) { f32x4 o4[4];
#pragma unroll
                for (int j = 0; j < 4; ++j) o4[j] = v[j] * rs * row_vec(in->final_g, lane, j);
                row_store_f32(out + (size_t)r * DM, lane, o4);
                continue;
            }
            row_store_bf16(XR + (size_t)r * DM, lane, v);
            f32x4 h[4];
            row_modnorm(v, rs, in->norm_mix_g + 1024, mods + ((size_t)8 + b) * 6144 + 0, mods + ((size_t)8 + b) * 6144 + 1024, lane, h);
            row_store_bf16((bf16_t*)(ws + WS_XN) + (size_t)r * DM, lane, h);
            row_modnorm(v, rs, in->kv_norm_g, mods + ((size_t)16 + b) * 6144 + 0, mods + ((size_t)16 + b) * 6144 + 1024, lane, h);
            row_store_bf16((bf16_t*)(ws + WS_HKV) + (size_t)r * DM, lane, h);
            if (lane == 0) rs_s[i] = rs;
        }
        if (L == 0) {
            __builtin_amdgcn_fence(__ATOMIC_RELEASE, "workgroup"); asm volatile("s_waitcnt vmcnt(0) lgkmcnt(0)" ::: "memory"); __builtin_amdgcn_fence(__ATOMIC_ACQUIRE, "workgroup");
            const int j = lane & 15, kq = lane >> 4; const bf16_t* xrow = XR + (size_t)(r0 + j) * DM + 8 * kq;
            f32x4 acc = {0.f, 0.f, 0.f, 0.f};
#pragma unroll 16
            for (int s2 = 0; s2 < 32; ++s2) { const bf16x8 xf = __builtin_bit_cast(bf16x8, __builtin_nontemporal_load((const u32x4*)(xrow + 32 * s2)));
#pragma unroll
                for (int pc = 0; pc < 2; ++pc) acc = __builtin_amdgcn_mfma_f32_16x16x32_bf16(__builtin_bit_cast(bf16x8, WFB[(s2 * 2 + pc) * 64 + lane]), xf, acc, 0, 0, 0); }
            const float rstd = rs_s[j]; const f32x4 fb = *(const LAS f32x4*)(fbl + 4 * kq);
            f32x4 lf;
#pragma unroll
            for (int q = 0; q < 4; ++q) { const float xg = acc[q] * rstd + fb[q]; lf[q] = fminf(xg, 0.f) - log1pf(expf(-fabsf(xg))); }
            *(f32x4*)((float*)(ws + WS_LOGF) + (size_t)(r0 + j) * 16 + 4 * kq) = lf;
        }
    }
}
__device__ __forceinline__ void ph_cumsum(const Frame& F) {
    TID_LANE_WAVE; unsigned char* ws = opq(F.ws); LAS float* wtot = (LAS float*)F.lds;
    for (int bh = F.bid; bh < NB * NH; bh += F.G) {
        const int b = bh >> 4, h = bh & 15;
        const float* lf = (const float*)(ws + WS_LOGF); float v[8]; float run = 0.f;
#pragma unroll
        for (int i = 0; i < 8; ++i) { run += lf[((size_t)b * SEQ + tid * 8 + i) * 16 + h]; v[i] = run; }
        float inc = run;
#pragma unroll
        for (int o = 1; o < 64; o <<= 1) { const float t = __shfl_up(inc, o); if (lane >= o) inc += t; }
        if (lane == 63) wtot[wave] = inc;
        __syncthreads();
        float off = inc - run;
        for (int w8 = 0; w8 < wave; ++w8) off += wtot[w8];
        float* fc = (float*)(ws + WS_FC) + (size_t)bh * SEQ; unsigned long long* g3 = (unsigned long long*)(ws + WS_G3) + (size_t)bh * SEQ;
#pragma unroll
        for (int i = 0; i < 8; ++i) { const float Fv = v[i] + off; fc[tid * 8 + i] = Fv;
            const float g = -Fv * LOG2E; const unsigned b1 = f2bf(g); const float r1 = g - __uint_as_float(b1 << 16); const unsigned b2 = f2bf(r1); const float r2 = r1 - __uint_as_float(b2 << 16); const unsigned b3 = f2bf(r2);
            g3[tid * 8 + i] = (unsigned long long)(b1 | (b2 << 16)) | ((unsigned long long)(b3 | (0x3f80u << 16)) << 32); }
        __syncthreads();
    }
}


typedef short s16x4 __attribute__((ext_vector_type(4)));
__device__ __forceinline__ s16x4 ds_tr16(LAS unsigned char* p) { return __builtin_bit_cast(s16x4, __builtin_amdgcn_ds_read_tr16_b64_v4i16((LAS s16x4*)p)); }
__device__ __forceinline__ void ph_spatial(const Frame& F) {
    const InP in = kin(); unsigned char* ws = opq(F.ws);
    LAS unsigned char* L = F.lds;
    constexpr int VN_STRIDE = 544, WC_STRIDE = 272, OFF_VN = 0, OFF_WC = 128 * VN_STRIDE, OFF_ST = OFF_WC + 128 * WC_STRIDE;
    LAS float* st = (LAS float*)(L + OFF_ST);
    const bf16_t* Z = (const bf16_t*)(ws + WS_Z); unsigned char* GT = ws + WS_GATED; const bf16_t* WSB = (const bf16_t*)(ws + WS_WS);
    for (int ch = F.bid; ch < T / 128; ch += F.G) {
        const int t0 = ch * 128;
        __syncthreads();
        { int tid_ = threadIdx.x; asm volatile("" : "+v"(tid_)); const int lane = tid_ & 63, wave = __builtin_amdgcn_readfirstlane(tid_ >> 6);
#pragma unroll 4
        for (int i = 0; i < 16; ++i) {
            const int tl = wave * 16 + i; const bf16_t* vrow = Z + (size_t)(t0 + tl) * 4096 + 2048;
            float v[32]; float s = 0.f;
#pragma unroll
            for (int j = 0; j < 4; ++j) { const u32x4 w = *(const u32x4*)(vrow + (lane + 64 * j) * 8); const unsigned ww[4] = {w.x, w.y, w.z, w.w};
#pragma unroll
                for (int q = 0; q < 4; ++q) { v[j * 8 + 2 * q] = __uint_as_float(ww[q] << 16); v[j * 8 + 2 * q + 1] = __uint_as_float(ww[q] & 0xffff0000u); } }
#pragma unroll
            for (int q = 0; q < 32; ++q) s += v[q];
            const float mean = wave_sum(s) * (1.f / 2048.f); float qq = 0.f;
#pragma unroll
            for (int q = 0; q < 32; ++q) { const float d = v[q] - mean; qq += d * d; }
            const float rstd = 1.f / sqrtf(wave_sum(qq) * (1.f / 2048.f) + EPS);
            if (lane == 0) { st[2 * tl] = mean; st[2 * tl + 1] = rstd; }
        } }
        u32x4 vw[8], wcw[4];
        { int tid_ = threadIdx.x; asm volatile("" : "+v"(tid_)); const int tid = tid_, c8 = tid & 31;
#pragma unroll
            for (int q = 0; q < 8; ++q) vw[q] = *(const u32x4*)(Z + (size_t)(t0 + (tid >> 5) + 16 * q) * 4096 + 2048 + c8 * 8);
#pragma unroll
            for (int q = 0; q < 4; ++q) { const int cidx = tid + 512 * q, r = cidx >> 4, c16 = cidx & 15; wcw[q] = *(const u32x4*)(WSB + r * 128 + c16 * 8); } }
#pragma unroll 1
        for (int g = 0; g < 8; ++g) {
            int tid_ = threadIdx.x; asm volatile("" : "+v"(tid_));
            const int tid = tid_, lane = tid & 63, wave = __builtin_amdgcn_readfirstlane(tid >> 6), fr = lane & 15, fq = lane >> 4;
            __syncthreads();
#pragma unroll
            for (int q = 0; q < 4; ++q) { const int cidx = tid + 512 * q, r = cidx >> 4, c16 = cidx & 15; *(LAS u32x4*)(L + OFF_WC + r * WC_STRIDE + c16 * 16) = wcw[q]; }
            {
                const int c8 = tid & 31; const float* vg = in->v_g + g * 256 + c8 * 8; const float* vb = in->v_b + g * 256 + c8 * 8;
                const f32x4 g0 = *(const f32x4*)vg, g1 = *(const f32x4*)(vg + 4), b0 = *(const f32x4*)vb, b1 = *(const f32x4*)(vb + 4);
#pragma unroll
                for (int q = 0; q < 8; ++q) { const int s = (tid >> 5) + 16 * q;
                    const u32x4 w = vw[q];
                    const float mean = st[2 * s], rstd = st[2 * s + 1];
                    f32x4 x0 = {__uint_as_float(w.x << 16), __uint_as_float(w.x & 0xffff0000u), __uint_as_float(w.y << 16), __uint_as_float(w.y & 0xffff0000u)};
                    f32x4 x1 = {__uint_as_float(w.z << 16), __uint_as_float(w.z & 0xffff0000u), __uint_as_float(w.w << 16), __uint_as_float(w.w & 0xffff0000u)};
                    x0 = (x0 - mean) * rstd * g0 + b0; x1 = (x1 - mean) * rstd * g1 + b1;
                    u32x4 o; o.x = pk2(x0[0], x0[1]); o.y = pk2(x0[2], x0[3]); o.z = pk2(x1[0], x1[1]); o.w = pk2(x1[2], x1[3]);
                    *(LAS u32x4*)(L + OFF_VN + s * VN_STRIDE + c8 * 16) = o; }
            }
            u32x2 uw[8][2]; float bsv[8];
#pragma unroll
            for (int tb = 0; tb < 8; ++tb) { const int t = 16 * tb + fr; bsv[tb] = in->b_s[g * 128 + t];
#pragma unroll
                for (int db = 0; db < 2; ++db) uw[tb][db] = *(const u32x2*)(Z + (size_t)(t0 + t) * 4096 + 256 * g + 32 * wave + 16 * db + 4 * fq); }
            __syncthreads();
            if (g < 7) { const int c8 = tid & 31;
#pragma unroll
                for (int q = 0; q < 8; ++q) vw[q] = *(const u32x4*)(Z + (size_t)(t0 + (tid >> 5) + 16 * q) * 4096 + 2048 + (g + 1) * 256 + c8 * 8);
#pragma unroll
                for (int q = 0; q < 4; ++q) { const int cidx = tid + 512 * q, r = cidx >> 4, c16 = cidx & 15; wcw[q] = *(const u32x4*)(WSB + (size_t)(g + 1) * 16384 + r * 128 + c16 * 8); } }
            f32x4 acc[8][2];
#pragma unroll
            for (int tb = 0; tb < 8; ++tb) { acc[tb][0] = (f32x4){0.f, 0.f, 0.f, 0.f}; acc[tb][1] = (f32x4){0.f, 0.f, 0.f, 0.f}; }
#pragma unroll
            for (int ks = 0; ks < 4; ++ks) {
                const int s0 = 32 * ks; bf16x8 X[2];
#pragma unroll
                for (int db = 0; db < 2; ++db) { LAS unsigned char* p = L + OFF_VN + (s0 + 4 * fq + (fr >> 2)) * VN_STRIDE + (32 * wave + 16 * db + 4 * (fr & 3)) * 2;
                    const s16x4 lo = ds_tr16(p), hi = ds_tr16(p + 16 * VN_STRIDE);
                    X[db] = (bf16x8){lo[0], lo[1], lo[2], lo[3], hi[0], hi[1], hi[2], hi[3]}; }
#pragma unroll
                for (int tb = 0; tb < 8; ++tb) if (2 * ks <= tb) {
                    LAS unsigned char* p = L + OFF_WC + (16 * tb + fr) * WC_STRIDE + (s0 + 4 * fq) * 2;
                    const u32x2 y0 = *(LAS u32x2*)p, y1 = *(LAS u32x2*)(p + 32);
                    const bf16x8 Y = __builtin_bit_cast(bf16x8, (u32x4){y0.x, y0.y, y1.x, y1.y});
                    acc[tb][0] = __builtin_amdgcn_mfma_f32_16x16x32_bf16(X[0], Y, acc[tb][0], 0, 0, 0);
                    acc[tb][1] = __builtin_amdgcn_mfma_f32_16x16x32_bf16(X[1], Y, acc[tb][1], 0, 0, 0); }
            }
#pragma unroll
            for (int tb = 0; tb < 8; ++tb) { const int t = 16 * tb + fr;
#pragma unroll
                for (int db = 0; db < 2; ++db) { const int dd = 256 * g + 32 * wave + 16 * db + 4 * fq;
                    const u32x2 uwv = uw[tb][db];
                    const f32x4 m = acc[tb][db] + bsv[tb];
                    *(unsigned*)(GT + (size_t)(t0 + t) * 2048 + dd) = pk4_fp8s(__uint_as_float(uwv.x << 16) * m[0], __uint_as_float(uwv.x & 0xffff0000u) * m[1], __uint_as_float(uwv.y << 16) * m[2], __uint_as_float(uwv.y & 0xffff0000u) * m[3]); } }
        }
    }
}

constexpr int NPH = 18;
struct PA { In in; unsigned char* ws; float* out; int ph_lo, ph_hi, li, pad; };
__global__ void __launch_bounds__(512, 2) fwd(PA args) {
    extern __shared__ __attribute__((aligned(16))) unsigned char lds[];
    Frame F; F.ws = args.ws; F.out = args.out; F.lds = (LAS unsigned char*)lds;
    F.bid = blockIdx.x; F.G = gridDim.x;
    LAS unsigned char* ldsl = (LAS unsigned char*)lds;
    volatile LAS unsigned* MISC = (volatile LAS unsigned*)(ldsl + MISC_OFF);
    for (int u = threadIdx.x; u < (LDS_BYTES - LDSCTL_OFF) / 4; u += 512) ((LAS unsigned*)(ldsl + LDSCTL_OFF))[u] = 0u;
    __syncthreads();
    unsigned char* const ws0 = args.ws;
    XcdBarrier bar = xcd_barrier_post((unsigned*)(ws0 + WS_CTL) + CW_BAR + args.li * XCD_BAR_WORDS, MISC + 8);
    const int lo = args.ph_lo, hi = args.ph_hi;
#ifndef PHMASK
#define PHMASK 0x3ffffu
#endif
#define IN(k) (((PHMASK >> (k)) & 1u) && lo <= (k) && (k) < hi)
#define SEAM(k) do { if (lo <= (k) && (k) + 1 < hi) { if ((k) <= 13) xcd_barrier_bg(bar, ws0, ldsl, MISC + 12); else xcd_barrier(bar); } } while (0)
    const int c = (int)blockIdx.x, G = (int)gridDim.x;

    if (IN(0)) { ph_prologue(F); } SEAM(0);
    if (IN(1)) { ph_norm0(F); } SEAM(1);
    if (IN(2)) {
        unsigned char* ws = opq(ws0);
        pg::StaticOrder S; S.init(T / 256, 4096 / 256, G, c);
        pg::SrcPlain<true, true> src{(const char*)(ws + WS_WIN), 1024}; pg::EpGeluZ E{(bf16_t*)(ws + WS_Z), MOE_DESCALE};
        pg::gemm_phase<pg::EpGeluZ, pg::StaticOrder, pg::SrcPlain<true, true>, true>(ldsl, (const char*)(ws + WS_XN8), 512, S, src, E);
    } SEAM(2);
    if (IN(3)) { ph_spatial(F); } SEAM(3);
    if (IN(4)) {
        unsigned char* ws = opq(ws0); const float* mods = (const float*)(ws + WS_MODS);
        pg::StaticOrder S; S.init(T / 256, 1024 / 256, G, c);
        pg::SrcPlain<true, true> src{(const char*)(ws + WS_WOUT), 2048}; pg::EpResid<true> E{kin()->x, (bf16_t*)(ws + WS_XR), mods + 2048, MOE_DESCALE};
        pg::gemm_phase<pg::EpResid<true>, pg::StaticOrder, pg::SrcPlain<true, true>, true>(ldsl, (const char*)(ws + WS_GATED), 1024, S, src, E);
    } SEAM(4);
#define LAYER_MOE(L, P0) \
    if (IN(P0)) { ph_norm_router(F, L); } SEAM(P0); \
    if (IN(P0 + 1)) { if ((P0) == 13) { TID_LANE_WAVE; if (tid == 0) MISC[12] = 0u; __syncthreads(); bg_cvt(ws0, ldsl, wave, lane, MISC + 12); } ph_list(F); } SEAM(P0 + 1); \
    if (IN(P0 + 2)) {     \
        unsigned char* ws = opq(ws0); const int* blke = (const int*)(ws + WS_BLKE); \
        pg::StaticOrder S; S.init(blke[MAXBLK], 8, G, c); \
        pg::SrcMoeA src{(const char*)(ws + WS_W1) + (size_t)L * 32 * 2048 * 1024, (const int*)(ws + WS_LIST), blke, 1024}; pg::EpSwiglu E{ws + WS_ACT, kin()->exp_b1 + (size_t)L * 32 * 2048, blke}; \
        pg::gemm_phase<pg::EpSwiglu, pg::StaticOrder, pg::SrcMoeA, true>(ldsl, (const char*)(ws + WS_XN8), 512, S, src, E);     \
    } SEAM(P0 + 2); \
    if (IN(P0 + 3)) {     \
        unsigned char* ws = opq(ws0); const int* blke = (const int*)(ws + WS_BLKE); \
        pg::StaticOrder S; S.init(blke[MAXBLK], 4, G, c); \
        pg::SrcMoeB src{(const char*)(ws + WS_W2) + (size_t)L * 32 * 1024 * 1024, blke, 1024}; pg::EpMoeOut E{(bf16_t*)(ws + WS_YB), kin()->exp_b2 + (size_t)L * 32 * 1024, blke, (const float*)(ws + WS_ROWG)}; \
        pg::gemm_phase<pg::EpMoeOut, pg::StaticOrder, pg::SrcMoeB, true>(ldsl, (const char*)(ws + WS_ACT), 512, S, src, E); \
    } SEAM(P0 + 3); \
    if (IN(P0 + 4)) { ph_combine(F, L); } SEAM(P0 + 4);

    LAYER_MOE(0, 5)
    if (IN(10)) {
        unsigned char* ws = opq(ws0);
        ph_cumsum(F);
        pg::StaticOrder S; S.init(T / 256, 2048 / 256, G, c);
        { pg::SrcHeads src{(const char*)(ws + WS_WKV), 2048}; pg::EpHeads<0> E{(bf16_t*)(ws + WS_K), (bf16_t*)(ws + WS_V), kin()->k_norm_g};
          pg::gemm_phase<pg::EpHeads<0>, pg::StaticOrder, pg::SrcHeads, true>(ldsl, (const char*)(ws + WS_HKV), 1024, S, src, E); }
        { pg::SrcHeads src{(const char*)(ws + WS_WQG), 2048}; pg::EpHeads<1> E{(bf16_t*)(ws + WS_Q), (bf16_t*)(ws + WS_GS), kin()->q_norm_g};
          pg::gemm_phase<pg::EpHeads<1>, pg::StaticOrder, pg::SrcHeads, true>(ldsl, (const char*)(ws + WS_XN), 1024, S, src, E); }
    } SEAM(10);
    if (IN(11)) {
        unsigned char* ws = opq(ws0);
        static_assert(attn_body::ATTN_LDS_BYTES <= RING_BYTES, "attention LDS");
        const attn_body::AttnTensors AT{(const attn_body::bf16*)(ws + WS_Q), (const attn_body::bf16*)(ws + WS_K), (const attn_body::bf16*)(ws + WS_V), (const attn_body::bf16*)(ws + WS_GS), (attn_body::bf16*)(ws + WS_O), (const unsigned long long*)(ws + WS_G3), kin()->q_norm_g, kin()->k_norm_g};
        attn_body::attn_phase<8>((char*)lds, AT, G, c);
    } SEAM(11);
    if (IN(12)) {
        unsigned char* ws = opq(ws0); const float* mods = (const float*)(ws + WS_MODS);
        pg::StaticOrder S; S.init(T / 256, 1024 / 256, G, c);
        pg::SrcPlain<true> src{(const char*)(ws + WS_WO), 2048}; pg::EpResid<false> E{(const bf16_t*)(ws + WS_XR), (bf16_t*)(ws + WS_XR), mods + 8 * 6144 + 2048, 1.f};
        pg::gemm_phase<pg::EpResid<false>, pg::StaticOrder, pg::SrcPlain<true>, true>(ldsl, (const char*)(ws + WS_O), 1024, S, src, E);
    } SEAM(12);
    LAYER_MOE(1, 13)
#undef LAYER_MOE
#undef IN
#undef SEAM
}

#include <cstring>
extern "C" void kernel_launch(void* const* d_in, const int* in_sizes, int n_in, void* d_out, int out_size, void* d_ws, size_t ws_size, hipStream_t stream) {
    if (n_in != 28 || ws_size < WS_END || out_size != T * DM) { fprintf(stderr, "kernel_launch: unexpected arguments (n_in %d, ws %zu, out %d)\n", n_in, ws_size, out_size); return; }
    static int grid = 0;
    if (grid == 0) {
        int dev = 0, cus = 0, per_cu = 0;
        if (hipGetDevice(&dev) != hipSuccess || hipDeviceGetAttribute(&cus, hipDeviceAttributeMultiprocessorCount, dev) != hipSuccess) { grid = -1; return; }
        if (hipFuncSetAttribute((const void*)fwd, hipFuncAttributeMaxDynamicSharedMemorySize, LDS_BYTES) != hipSuccess) { fprintf(stderr, "kernel_launch: hipFuncSetAttribute failed\n"); grid = -1; return; }
        if (hipOccupancyMaxActiveBlocksPerMultiprocessor(&per_cu, (const void*)fwd, 512, LDS_BYTES) != hipSuccess || per_cu < 1) fprintf(stderr, "kernel_launch: occupancy query says %d\n", per_cu);
        (void)hipGetLastError();
        grid = cus;
    }
    if (grid < 0) return;
    KA a; memset((void*)&a, 0, sizeof(a));
    { const float** p = (const float**)&a.in; for (int i = 0; i < 28; ++i) p[i] = (const float*)d_in[i]; }
    a.ws = (unsigned char*)d_ws; a.out = (float*)d_out;
    PA pa; memset((void*)&pa, 0, sizeof(pa)); pa.in = a.in; pa.ws = a.ws; pa.out = a.out;
    (void)hipMemsetAsync((unsigned char*)d_ws + WS_CTL, 0, 1 * MiB, stream);
    pa.ph_lo = 0; pa.ph_hi = NPH; pa.li = 0;
    hipLaunchKernelGGL(fwd, dim3(grid), dim3(512), LDS_BYTES, stream, pa);
}
```

```cpp
#include <hip/hip_runtime.h>
#include <cstdio>
#include <cstdint>

#define LAS __attribute__((address_space(3)))
#define GAS __attribute__((address_space(1)))
typedef unsigned short bf16_t;
typedef float f32x4 __attribute__((ext_vector_type(4)));
typedef short bf16x8 __attribute__((ext_vector_type(8)));
typedef unsigned u32x4 __attribute__((ext_vector_type(4)));
typedef unsigned u32x2 __attribute__((ext_vector_type(2)));
typedef int i32x4 __attribute__((ext_vector_type(4)));

constexpr int NB = 8, SEQ = 4096, DM = 1024, T = NB * SEQ;
constexpr int GW = 2048, NG = 8, GD = 256, CH = 128;
constexpr int NH = 16, HD = 64;
constexpr int NE = 32, TOPK = 4;
constexpr int MAXBLK = 544, MAXROWS = MAXBLK * 256;
constexpr float EPS = 1e-6f;
constexpr float LOG2E = 1.4426950408889634f;
constexpr float C2 = 0.125f * LOG2E;

constexpr size_t MiB = 1u << 20;
constexpr size_t WS_CTL = 0;
constexpr size_t WS_MODS = 1 * MiB;
constexpr size_t WS_RB2 = 1 * MiB + 3 * 8 * 6144 * 4;
constexpr size_t WS_FB2 = WS_RB2 + 2 * 8 * 32 * 4;
constexpr size_t WS_HIST = 2 * MiB;
constexpr size_t WS_BLKE = 2 * MiB + 65536;
constexpr size_t WS_TOPE = 3 * MiB;
constexpr size_t WS_TOPG = 4 * MiB;
constexpr size_t WS_DEST = 5 * MiB;
constexpr size_t WS_LIST = 6 * MiB;
constexpr size_t WS_ROWG = 7 * MiB;
constexpr size_t WS_VSTAT = 8 * MiB;
constexpr size_t WS_LOGF = 9 * MiB;
constexpr size_t WS_FC = 11 * MiB;
constexpr size_t WS_G3 = 13 * MiB;
constexpr size_t WS_WIN = 32 * MiB;
constexpr size_t WS_WOUT = 40 * MiB;
constexpr size_t WS_WKV = 44 * MiB;
constexpr size_t WS_WQG = 48 * MiB;
constexpr size_t WS_WO = 52 * MiB;
constexpr size_t WS_WS = 54 * MiB;
constexpr size_t WS_W1 = 64 * MiB;
constexpr size_t WS_W2 = 320 * MiB;
constexpr size_t WS_XN = 448 * MiB;
constexpr size_t WS_HKV = 512 * MiB;
constexpr size_t WS_XN8 = 640 * MiB;
constexpr size_t WS_XR = 576 * MiB;
constexpr size_t WS_Z = 704 * MiB;
constexpr size_t WS_GATED = 960 * MiB;
constexpr size_t WS_ACT = 704 * MiB;
constexpr size_t WS_YB = 976 * MiB;
constexpr size_t WS_PKV = 704 * MiB;
constexpr size_t WS_PQG = 960 * MiB;
constexpr size_t WS_Q = 1248 * MiB;
constexpr size_t WS_K = 1312 * MiB;
constexpr size_t WS_V = 1376 * MiB;
constexpr size_t WS_GS = 1440 * MiB;
constexpr size_t WS_O = 1504 * MiB;
constexpr size_t WS_END = 1568 * MiB;

__device__ __forceinline__ float bf2f(bf16_t v) { return __uint_as_float(((unsigned)v) << 16); }
__device__ __forceinline__ unsigned f2bf(float f) { unsigned u = __float_as_uint(f); return (u + 0x7fffu + ((u >> 16) & 1u)) >> 16; }
__device__ __forceinline__ unsigned pk2(float lo, float hi) { return f2bf(lo) | (f2bf(hi) << 16); }
__device__ __forceinline__ float wave_sum(float v) {
#pragma unroll
    for (int o = 1; o < 64; o <<= 1) v += __shfl_xor(v, o);
    return v;
}
__device__ __forceinline__ float siluf(float x) { return x / (1.f + expf(-x)); }
__device__ __forceinline__ float sigmoidf_(float x) { return 1.f / (1.f + expf(-x)); }

struct In {
    const float *x, *c, *ada_w, *ada_b, *norm_mix_g, *norm_ffn_g, *w_in, *v_g, *v_b, *w_s, *b_s, *w_out, *kv_ada_w, *kv_ada_b, *kv_norm_g, *kv_w, *k_norm_g, *fgate_b,
        *w_qg, *q_norm_g, *w_o, *router_w, *router_b, *exp_w1, *exp_b1, *exp_w2, *exp_b2, *final_g;
};

typedef const In __attribute__((address_space(4)))* InP;
__device__ __forceinline__ InP kin() { auto p = __builtin_amdgcn_kernarg_segment_ptr(); asm volatile("" : "+s"(p)); return (InP)p; }
__device__ __forceinline__ unsigned char* opq(unsigned char* p) { size_t z = 0; asm volatile("" : "+s"(z)); return p + z; }
struct KA { In in; unsigned char* ws; float* out; int L; int pad; };

__device__ __forceinline__ void transpose_item(const float* W, int K, int N, int ldw, bf16_t* WT, LAS float* scr, int item, int lane) {
    const int nblk = N / 32, kb = item / nblk, nb = item % nblk, k0 = 64 * kb, n0 = 32 * nb;
#pragma unroll 32
    for (int i = 0; i < 32; ++i) { const int kk = 2 * i + (lane >> 5); scr[kk * 33 + (lane & 31)] = W[(size_t)(k0 + kk) * ldw + n0 + (lane & 31)]; }
    __builtin_amdgcn_s_waitcnt(0xc07f); asm volatile("" ::: "memory");
    const int c = lane & 7;
#pragma unroll
    for (int j = 0; j < 4; ++j) { const int n = (lane >> 3) + 8 * j; const LAS float* s = scr + (8 * c) * 33 + n;
        u32x4 o; o.x = pk2(s[0 * 33], s[1 * 33]); o.y = pk2(s[2 * 33], s[3 * 33]); o.z = pk2(s[4 * 33], s[5 * 33]); o.w = pk2(s[6 * 33], s[7 * 33]);
        *(u32x4*)(WT + (size_t)(n0 + n) * K + k0 + 8 * c) = o; }
    __builtin_amdgcn_s_waitcnt(0xc07f); asm volatile("" ::: "memory");
}
__device__ __forceinline__ unsigned pk4_fp8(float a, float b, float c, float d) { int w = 0; w = __builtin_amdgcn_cvt_pk_fp8_f32(a, b, w, false); w = __builtin_amdgcn_cvt_pk_fp8_f32(c, d, w, true); return (unsigned)w; }
constexpr float W8_SCALE = 32.f, A8_SCALE = 4.f, MOE_DESCALE = 1.f / (32.f * 4.f);
__device__ __forceinline__ float a8(float x) { return __builtin_amdgcn_fmed3f(x * A8_SCALE, -448.f, 448.f); }
__device__ __forceinline__ unsigned pk4_fp8s(float a, float b, float c, float d) { return pk4_fp8(a8(a), a8(b), a8(c), a8(d)); }
__device__ __forceinline__ f32x4 fp8x4_to_f32(unsigned w) { const auto lo = __builtin_amdgcn_cvt_pk_f32_fp8((int)w, false), hi = __builtin_amdgcn_cvt_pk_f32_fp8((int)w, true); return (f32x4){lo[0], lo[1], hi[0], hi[1]}; }
constexpr int CVT_SCR = 128 * 33 * 4;
__device__ __forceinline__ void transpose_item_fp8(const float* W, int K, int N, int ldw, unsigned char* WT, LAS float* scr, int item, int lane) {
    const int nblk = N / 32, kb = item / nblk, nb = item % nblk, k0 = 128 * kb, n0 = 32 * nb;
#pragma unroll 64
    for (int i = 0; i < 64; ++i) { const int kk = 2 * i + (lane >> 5); scr[kk * 33 + (lane & 31)] = W[(size_t)(k0 + kk) * ldw + n0 + (lane & 31)]; }
    __builtin_amdgcn_s_waitcnt(0xc07f); asm volatile("" ::: "memory");
    const int n = lane >> 1, hf = lane & 1; const LAS float* sp = scr + (64 * hf) * 33 + n;
#pragma unroll
    for (int q = 0; q < 4; ++q) { u32x4 o;
        o.x = pk4_fp8(sp[(16 * q + 0) * 33] * W8_SCALE, sp[(16 * q + 1) * 33] * W8_SCALE, sp[(16 * q + 2) * 33] * W8_SCALE, sp[(16 * q + 3) * 33] * W8_SCALE);
        o.y = pk4_fp8(sp[(16 * q + 4) * 33] * W8_SCALE, sp[(16 * q + 5) * 33] * W8_SCALE, sp[(16 * q + 6) * 33] * W8_SCALE, sp[(16 * q + 7) * 33] * W8_SCALE);
        o.z = pk4_fp8(sp[(16 * q + 8) * 33] * W8_SCALE, sp[(16 * q + 9) * 33] * W8_SCALE, sp[(16 * q + 10) * 33] * W8_SCALE, sp[(16 * q + 11) * 33] * W8_SCALE);
        o.w = pk4_fp8(sp[(16 * q + 12) * 33] * W8_SCALE, sp[(16 * q + 13) * 33] * W8_SCALE, sp[(16 * q + 14) * 33] * W8_SCALE, sp[(16 * q + 15) * 33] * W8_SCALE);
        *(u32x4*)(WT + (size_t)(n0 + n) * K + k0 + 64 * hf + 16 * q) = o; }
    __builtin_amdgcn_s_waitcnt(0xc07f); asm volatile("" ::: "memory");
}
constexpr int IT_WIN = 8 * 128, IT_WOUT = 16 * 32, IT_WKV = 8 * 64, IT_WQG = 8 * 64, IT_WO = 8 * 32, IT_W1 = 8 * 64  , IT_W2 = 8 * 32;
constexpr int IT_SMALL = IT_WIN + IT_WOUT + IT_WKV + IT_WQG + IT_WO;
constexpr int IT_ALL = IT_SMALL + 64 * IT_W1 + 64 * IT_W2;
constexpr int IT_FG = IT_SMALL + 32 * IT_W1 + 32 * IT_W2, IT_BG = 32 * IT_W1 + 32 * IT_W2;
__host__ __device__ __forceinline__ int fg_item(int i) { return i < IT_SMALL + 32 * IT_W1 ? i : i + 32 * IT_W1; }
__host__ __device__ __forceinline__ int bg_item(int k) { return k < 32 * IT_W1 ? IT_SMALL + 32 * IT_W1 + k : IT_SMALL + 64 * IT_W1 + 32 * IT_W2 + (k - 32 * IT_W1); }
constexpr int CW_CVT = 2048;
__device__ __forceinline__ void cvt_item(InP inp, unsigned char* ws, int it, LAS float* scr, int lane) {
    if (it < IT_WIN) { transpose_item_fp8(inp->w_in, 1024, 4096, 4096, ws + WS_WIN, scr, it, lane); return; } it -= IT_WIN;
    if (it < IT_WOUT) { transpose_item_fp8(inp->w_out, 2048, 1024, 1024, ws + WS_WOUT, scr, it, lane); return; } it -= IT_WOUT;
    if (it < IT_WKV) { transpose_item_fp8(inp->kv_w, 1024, 2048, 2064, ws + WS_WKV, scr, it, lane); return; } it -= IT_WKV;
    if (it < IT_WQG) { transpose_item_fp8(inp->w_qg, 1024, 2048, 2048, ws + WS_WQG, scr, it, lane); return; } it -= IT_WQG;
    if (it < IT_WO) { transpose_item_fp8(inp->w_o, 1024, 1024, 1024, ws + WS_WO, scr, it, lane); return; } it -= IT_WO;
    if (it < 64 * IT_W1) { const int e = it / IT_W1; transpose_item_fp8(inp->exp_w1 + (size_t)e * 1024 * 2048, 1024, 2048, 2048, ws + WS_W1 + (size_t)e * 2048 * 1024, scr, it % IT_W1, lane); return; } it -= 64 * IT_W1;
    { const int e = it / IT_W2; transpose_item_fp8(inp->exp_w2 + (size_t)e * 1024 * 1024, 1024, 1024, 1024, ws + WS_W2 + (size_t)e * 1024 * 1024, scr, it % IT_W2, lane); }
}
constexpr int ADA_ITEMS = 96 + 96 + 32;
__device__ __forceinline__ void ada_item(InP inp, float* mods, int item, const LAS float* sc  , LAS float* red  , int tid) {
    const int lane = tid & 63, wave = tid >> 6;
    int which, cg; const float* w; const float* bias; int ldw;
    if (item < 96) { which = 0; cg = item; w = inp->ada_w; bias = inp->ada_b; ldw = 6144; }
    else if (item < 192) { which = 1; cg = item - 96; w = inp->ada_w + (size_t)1024 * 6144; bias = inp->ada_b + 6144; ldw = 6144; }
    else { which = 2; cg = item - 192; w = inp->kv_ada_w; bias = inp->kv_ada_b; ldw = 2048; }
    const int col = cg * 64 + lane;
    float acc[8];
#pragma unroll
    for (int b = 0; b < 8; ++b) acc[b] = 0.f;
    for (int k = wave * 128; k < wave * 128 + 128; ++k) {
        const float wv = w[(size_t)k * ldw + col];
#pragma unroll
        for (int b = 0; b < 8; ++b) acc[b] += sc[b * 1024 + k] * wv;
    }
#pragma unroll
    for (int b = 0; b < 8; ++b) red[(wave * 8 + b) * 64 + lane] = acc[b];
    __syncthreads();
    {
        const int b = tid >> 6; float s = 0.f;
#pragma unroll
        for (int w8 = 0; w8 < 8; ++w8) s += red[(w8 * 8 + b) * 64 + lane];
        mods[((size_t)which * 8 + b) * 6144 + col] = s + bias[col];
    }
    __syncthreads();
}
__device__ __forceinline__ void row_load(const float* xrow, int lane, f32x4 (&v)[4]) {
#pragma unroll
    for (int j = 0; j < 2; ++j) { v[2 * j] = ((const f32x4*)xrow)[2 * lane + 128 * j]; v[2 * j + 1] = ((const f32x4*)xrow)[2 * lane + 128 * j + 1]; }
}
__device__ __forceinline__ void bf8_to_f32(u32x4 w, f32x4& a, f32x4& b) {
    a = (f32x4){__uint_as_float(w.x << 16), __uint_as_float(w.x & 0xffff0000u), __uint_as_float(w.y << 16), __uint_as_float(w.y & 0xffff0000u)};
    b = (f32x4){__uint_as_float(w.z << 16), __uint_as_float(w.z & 0xffff0000u), __uint_as_float(w.w << 16), __uint_as_float(w.w & 0xffff0000u)};
}
__device__ __forceinline__ void row_load_bf(const bf16_t* xrow, int lane, f32x4 (&v)[4]) {
#pragma unroll
    for (int j = 0; j < 2; ++j) bf8_to_f32(((const u32x4*)xrow)[lane + 64 * j], v[2 * j], v[2 * j + 1]);
}
__device__ __forceinline__ float row_rstd(const f32x4 (&v)[4]) {
    float s = 0.f;
#pragma unroll
    for (int j = 0; j < 4; ++j) s += (v[j].x * v[j].x + v[j].y * v[j].y) + (v[j].z * v[j].z + v[j].w * v[j].w);
    return 1.f / sqrtf(wave_sum(s) * (1.f / 1024.f) + EPS);
}
__device__ __forceinline__ f32x4 row_vec(const float* p, int lane, int q) { return ((const f32x4*)p)[2 * lane + 128 * (q >> 1) + (q & 1)]; }
__device__ __forceinline__ void row_modnorm(const f32x4 (&v)[4], float rstd, const float* g, const float* sh, const float* sc, int lane, f32x4 (&h)[4]) {
#pragma unroll
    for (int q = 0; q < 4; ++q) h[q] = (v[q] * rstd * row_vec(g, lane, q)) * (1.f + row_vec(sc, lane, q)) + row_vec(sh, lane, q);
}
__device__ __forceinline__ void row_store_bf16(bf16_t* orow, int lane, const f32x4 (&h)[4]) {
#pragma unroll
    for (int j = 0; j < 2; ++j) { u32x4 w; w.x = pk2(h[2 * j].x, h[2 * j].y); w.y = pk2(h[2 * j].z, h[2 * j].w); w.z = pk2(h[2 * j + 1].x, h[2 * j + 1].y); w.w = pk2(h[2 * j + 1].z, h[2 * j + 1].w);
        ((u32x4*)orow)[lane + 64 * j] = w; }
}

__device__ __forceinline__ void row_store_fp8(unsigned char* orow, int lane, const f32x4 (&h)[4]) {
#pragma unroll
    for (int j = 0; j < 2; ++j) { u32x2 w; w.x = pk4_fp8s(h[2 * j].x, h[2 * j].y, h[2 * j].z, h[2 * j].w);
        w.y = pk4_fp8s(h[2 * j + 1].x, h[2 * j + 1].y, h[2 * j + 1].z, h[2 * j + 1].w); ((u32x2*)orow)[lane + 64 * j] = w; }
}
__device__ __forceinline__ void row4_norm_mod_store(const float* xrow, const float* g, const float* sh, const float* sc, unsigned char* orow, int lane) {
    f32x4 v[4]; float s = 0.f;
#pragma unroll
    for (int j = 0; j < 4; ++j) { v[j] = ((const f32x4*)xrow)[lane + 64 * j]; s += (v[j].x * v[j].x + v[j].y * v[j].y) + (v[j].z * v[j].z + v[j].w * v[j].w); }
    const float rstd = 1.f / sqrtf(wave_sum(s) * (1.f / 1024.f) + EPS);
#pragma unroll
    for (int j = 0; j < 4; ++j) { const f32x4 gg = ((const f32x4*)g)[lane + 64 * j], s1 = ((const f32x4*)sc)[lane + 64 * j], s0 = ((const f32x4*)sh)[lane + 64 * j];
        const f32x4 h = (v[j] * rstd * gg) * (1.f + s1) + s0; ((unsigned*)orow)[lane + 64 * j] = pk4_fp8s(h.x, h.y, h.z, h.w); }
}
__device__ __forceinline__ void row_store_f32(float* orow, int lane, const f32x4 (&h)[4]) {
#pragma unroll
    for (int j = 0; j < 2; ++j)
#pragma unroll
        for (int sq = 0; sq < 2; ++sq) { const int src = 32 * sq + (lane >> 1); f32x4 a, c;
#pragma unroll
            for (int i = 0; i < 4; ++i) { a[i] = __shfl(h[2 * j][i], src); c[i] = __shfl(h[2 * j + 1][i], src); }
            ((f32x4*)orow)[128 * j + 64 * sq + lane] = (lane & 1) ? c : a; }
}

__device__ __forceinline__ void route_row(const LAS float* hs  , const float* rw, const float* rb, int lane, int (&te)[4], float (&tg)[4]) {
    const int e = lane & 31, half = lane >> 5; float acc = 0.f;
    for (int k = half * 512; k < half * 512 + 512; ++k) acc += hs[k] * rw[k * 32 + e];
    acc += __shfl_xor(acc, 32);
    float val = acc + rb[e];
    float tv[4];
#pragma unroll
    for (int q = 0; q < 4; ++q) {
        float bv = val; int bi = e;
#pragma unroll
        for (int o = 1; o < 32; o <<= 1) { const float ov = __shfl_xor(bv, o); const int oi = __shfl_xor(bi, o); if (ov > bv || (ov == bv && oi < bi)) { bv = ov; bi = oi; } }
        te[q] = bi; tv[q] = bv; if (e == bi) val = -INFINITY;
    }
    float s = 0.f;
#pragma unroll
    for (int q = 0; q < 4; ++q) { tg[q] = expf(tv[q] - tv[0]); s += tg[q]; }
#pragma unroll
    for (int q = 0; q < 4; ++q) tg[q] /= s;
}

namespace pg {
constexpr int BM = 256, BK = 64, HALF = 128, HTB = HALF * BK * 2  , STAGE_BYTES = 8 * HTB, NXCD = 8, WGM = 8;
__host__ __device__ __forceinline__ int lds_byte(int r, int c) { const int st = (r >> 4) * 2 + (c >> 5), rr = r & 15, cc = c & 31, ob = rr * 64 + cc * 2; return st * 1024 + (ob ^ (((ob >> 9) & 1) << 5)); }
__host__ __device__ __forceinline__ void stage_rc(int b, int& R, int& C) { const int st = b / 1024, sb = b % 1024, swz = sb ^ (((sb >> 9) & 1) << 5); R = (st >> 1) * 16 + swz / 64; C = (st & 1) * 32 + (swz % 64) / 2; }
__host__ __device__ __forceinline__ int perm32(int rho) { const int n = rho >> 4, i = rho & 15; return 8 * (i >> 2) + 4 * n + (i & 3); }
struct Unit { int pm, pn, e; };
struct NoPre {};
struct StaticOrder {
    int nM, nN, nwg, G, c;
    __device__ void init(int nM_, int nN_, int G_, int c_) { nM = nM_; nN = nN_; nwg = nM * nN; G = G_; c = c_; }
    __device__ bool next(int i, Unit& u) const {
        const long L = (long)i * G + c; if (L >= nwg) return false;
        int wgid = (int)L; { const int q = nwg / NXCD, r = nwg % NXCD, xcd = wgid % NXCD, off = wgid / NXCD; wgid = (xcd < r ? xcd * (q + 1) : r * (q + 1) + (xcd - r) * q) + off; }
        const int nig = WGM * nN, gid = wgid / nig, fm = gid * WGM, gsz = (nM - fm) < WGM ? (nM - fm) : WGM;
        u.pm = fm + ((wgid % nig) % gsz); u.pn = (wgid % nig) / gsz; return true;
    }
};
typedef float f32x2 __attribute__((ext_vector_type(2)));
typedef __bf16 bf16x2v __attribute__((ext_vector_type(2)));
__device__ __forceinline__ unsigned cvt_pk_bf16(float lo, float hi) { const f32x2 v = {lo, hi}; return __builtin_bit_cast(unsigned, __builtin_convertvector(v, bf16x2v)); }
typedef int v8i32 __attribute__((ext_vector_type(8)));
typedef int v4i32 __attribute__((ext_vector_type(4)));
__device__ __forceinline__ f32x2 gelu_pk(f32x2 v) {
    const f32x2 av = __builtin_elementwise_abs(v), d = av * 0.2316418882f + 1.0f;
    f32x2 t; t.x = __builtin_amdgcn_rcpf(d.x); t.y = __builtin_amdgcn_rcpf(d.y);
    f32x2 q = t * 0.5307027145f + (-0.7265760135f); q = q * t + 0.7107068705f; q = q * t + (-0.142248368f); q = q * t + 0.127414796f; q = q * t;
    const f32x2 s = (v * v) * (-0.72134752044f);
    f32x2 e; e.x = __builtin_amdgcn_exp2f(s.x); e.y = __builtin_amdgcn_exp2f(s.y);
    const f32x2 m = v * (q * e), r = v - m;
    f32x2 o; o.x = v.x < 0.f ? m.x : r.x; o.y = v.y < 0.f ? m.y : r.y; return o;
}
__device__ __forceinline__ float fast_sigmoid(float x) { return __builtin_amdgcn_rcpf(1.f + __builtin_amdgcn_exp2f(-LOG2E * x)); }

template <bool PERM, bool F8 = false> struct SrcPlain { const char* B; int K2; static constexpr bool FP8 = F8, TAB = false;
    __device__ __forceinline__ void fill(Unit& u) const { u.e = 0; }
    __device__ __forceinline__ unsigned arow_off(const Unit& u, int h, int R) const { return (unsigned)(u.pm * BM + h * HALF + R) * (unsigned)K2; }
    __device__ __forceinline__ const char* bhalf(const Unit& u, int h) const { return B + (size_t)(u.pn * BM + h * HALF) * K2; }
    static __device__ __forceinline__ int brow(int R) { return PERM ? ((R & ~31) + perm32(R & 31)) : R; } };
struct SrcHeads { const char* B; int K2; static constexpr bool FP8 = true, TAB = false;
    __device__ __forceinline__ void fill(Unit& u) const { u.e = 0; }
    __device__ __forceinline__ unsigned arow_off(const Unit& u, int h, int R) const { return (unsigned)(u.pm * BM + h * HALF + R) * (unsigned)K2; }
    __device__ __forceinline__ const char* bhalf(const Unit& u, int h) const { return B + (size_t)(u.pn * BM + h * 32) * K2; }
    static __device__ __forceinline__ int brow(int R) { return 64 * (R >> 5) + perm32(R & 31); } };
struct SrcMoeA { const char* W1; const int* list; const int* blke; int K2; const LAS int* tab; static constexpr bool FP8 = true, TAB = true;
    __device__ __forceinline__ unsigned arow_off(const Unit& u, int h, int R) const { int t = list[u.pm * BM + h * HALF + R]; t = t < 0 ? 0 : t; return (unsigned)t * (unsigned)K2; }
    __device__ __forceinline__ void fill(Unit& u) const { u.e = __builtin_amdgcn_readfirstlane(tab[u.pm]); }
    __device__ __forceinline__ const char* bhalf(const Unit& u, int h) const { return W1 + ((size_t)u.e * 2048 + h * 1024 + u.pn * 128) * K2; }
    static __device__ __forceinline__ int brow(int R) { return (R & ~31) + perm32(R & 31); } };
struct SrcMoeB { const char* W2; const int* blke; int K2; const LAS int* tab; static constexpr bool FP8 = true, TAB = true;
    __device__ __forceinline__ unsigned arow_off(const Unit& u, int h, int R) const { return (unsigned)(u.pm * BM + h * HALF + R) * (unsigned)K2; }
    __device__ __forceinline__ void fill(Unit& u) const { u.e = __builtin_amdgcn_readfirstlane(tab[u.pm]); }
    __device__ __forceinline__ const char* bhalf(const Unit& u, int h) const { return W2 + ((size_t)u.e * 1024 + u.pn * BM + h * 8) * K2; }
    static __device__ __forceinline__ int brow(int R) { return 64 * (R >> 5) + 16 * ((R & 15) >> 2) + 4 * ((R >> 4) & 1) + (R & 3); } };

__device__ __forceinline__ u32x4 quad_tr(u32x4 w, int lane) { const int a = ((lane >> 2) + 16 * (lane & 3)) * 4; u32x4 r;
    r.x = (unsigned)__builtin_amdgcn_ds_bpermute(a, (int)w.x); r.y = (unsigned)__builtin_amdgcn_ds_bpermute(a, (int)w.y); r.z = (unsigned)__builtin_amdgcn_ds_bpermute(a, (int)w.z); r.w = (unsigned)__builtin_amdgcn_ds_bpermute(a, (int)w.w); return r; }
struct EpGeluZ { bf16_t* Z; float ds; using Pre = NoPre;
    __device__ __forceinline__ Pre prefetch(const Unit&, int, int, int, int) const { return {}; }
    __device__ __forceinline__ void operator()(const f32x4 (&acc)[2][2][4][2], const Unit& u, int wr, int wc, int fr, int fq, const Pre&) const {
        const int row0 = u.pm * BM + wr * 64 + fr, col0 = u.pn * BM + wc * 32 + 8 * fq;
#pragma unroll
        for (int ai = 0; ai < 2; ++ai)
#pragma unroll
            for (int m = 0; m < 4; ++m) { bf16_t* rowp = Z + (size_t)(row0 + ai * HALF + m * 16) * 4096 + col0;
#pragma unroll
                for (int bj = 0; bj < 2; ++bj) { const f32x4 v0 = acc[ai][bj][m][0] * ds, v1 = acc[ai][bj][m][1] * ds;
                    const f32x2 a = gelu_pk((f32x2){v0[0], v0[1]}), b = gelu_pk((f32x2){v0[2], v0[3]}), c = gelu_pk((f32x2){v1[0], v1[1]}), d = gelu_pk((f32x2){v1[2], v1[3]});
                    u32x4 w; w.x = cvt_pk_bf16(a.x, a.y); w.y = cvt_pk_bf16(b.x, b.y); w.z = cvt_pk_bf16(c.x, c.y); w.w = cvt_pk_bf16(d.x, d.y);
                    *(u32x4*)(rowp + bj * HALF) = w; } }
    } };
template <bool F32BASE> struct EpResid { const void* base; bf16_t* out; const float* gate; float ds; using Pre = NoPre;
    __device__ __forceinline__ Pre prefetch(const Unit&, int, int, int, int) const { return {}; }
    __device__ __forceinline__ void operator()(const f32x4 (&acc)[2][2][4][2], const Unit& u, int wr, int wc, int fr, int fq, const Pre&) const {
        const int b = u.pm >> 4; const float* gt = gate + (size_t)b * 6144; const int col0 = u.pn * BM + wc * 32 + 8 * fq;
        f32x4 gv[2][2];
#pragma unroll
        for (int bj = 0; bj < 2; ++bj)
#pragma unroll
            for (int n = 0; n < 2; ++n) gv[bj][n] = *(const f32x4*)(gt + col0 + bj * HALF + 4 * n) * ds;
#pragma unroll
        for (int ai = 0; ai < 2; ++ai)
#pragma unroll
            for (int m = 0; m < 4; ++m) { const size_t off = (size_t)(u.pm * BM + ai * HALF + wr * 64 + m * 16 + fr) * DM + col0;
#pragma unroll
                for (int bj = 0; bj < 2; ++bj) { f32x4 b0, b1;
                    if constexpr (F32BASE) { b0 = *(const f32x4*)((const float*)base + off + bj * HALF); b1 = *(const f32x4*)((const float*)base + off + bj * HALF + 4); }
                    else bf8_to_f32(*(const u32x4*)((const bf16_t*)base + off + bj * HALF), b0, b1);
                    const f32x4 r0 = b0 + gv[bj][0] * acc[ai][bj][m][0], r1 = b1 + gv[bj][1] * acc[ai][bj][m][1];
                    u32x4 w; w.x = cvt_pk_bf16(r0[0], r0[1]); w.y = cvt_pk_bf16(r0[2], r0[3]); w.z = cvt_pk_bf16(r1[0], r1[1]); w.w = cvt_pk_bf16(r1[2], r1[3]);
                    *(u32x4*)(out + off + bj * HALF) = w; } }
    } };
struct EpSwiglu { unsigned char* act; const float* b1; const int* blke;
    struct Pre { f32x4 bg[2], bl[2]; };
    __device__ __forceinline__ Pre prefetch(const Unit& u, int wr, int wc, int fr, int fq) const { Pre p; const float* bb = b1 + (size_t)u.e * 2048 + u.pn * 128 + wc * 32 + 8 * fq;
#pragma unroll
        for (int n = 0; n < 2; ++n) { p.bg[n] = *(const f32x4*)(bb + 4 * n); p.bl[n] = *(const f32x4*)(bb + 1024 + 4 * n); }
        return p; }
    __device__ __forceinline__ void operator()(const f32x4 (&acc)[2][2][4][2], const Unit& u, int wr, int wc, int fr, int fq, const Pre& pre) const {
        const int col0 = u.pn * 128 + wc * 32 + 8 * fq;
        f32x4 bg[2], bl[2];
#pragma unroll
        for (int n = 0; n < 2; ++n) { bg[n] = pre.bg[n]; bl[n] = pre.bl[n] * A8_SCALE + A8_SCALE; }
#pragma unroll
        for (int ai = 0; ai < 2; ++ai)
#pragma unroll
            for (int m = 0; m < 4; ++m) { const int row = u.pm * BM + ai * HALF + wr * 64 + m * 16 + fr; float a[8];
#pragma unroll
                for (int n = 0; n < 2; ++n) { const f32x4 g4 = acc[ai][0][m][n] * MOE_DESCALE + bg[n], l4 = acc[ai][1][m][n] * (MOE_DESCALE * A8_SCALE) + bl[n];
#pragma unroll
                    for (int j = 0; j < 4; j += 2) {
                        f32x2 g = {fminf(g4[j], 7.f), fminf(g4[j + 1], 7.f)}; f32x2 l = {__builtin_amdgcn_fmed3f(l4[j], -6.f * A8_SCALE, 8.f * A8_SCALE), __builtin_amdgcn_fmed3f(l4[j + 1], -6.f * A8_SCALE, 8.f * A8_SCALE)};
                        const f32x2 x = g * (-1.702f * LOG2E); f32x2 e; e.x = __builtin_amdgcn_exp2f(x.x); e.y = __builtin_amdgcn_exp2f(x.y);
                        const f32x2 d = e + 1.0f; f32x2 r; r.x = __builtin_amdgcn_rcpf(d.x); r.y = __builtin_amdgcn_rcpf(d.y);
                        const f32x2 o = l * (g * r); a[4 * n + j] = o.x; a[4 * n + j + 1] = o.y; } }
                u32x2 w; w.x = pk4_fp8(a[0], a[1], a[2], a[3]); w.y = pk4_fp8(a[4], a[5], a[6], a[7]);
                *(u32x2*)(act + (size_t)row * 1024 + col0) = w; }
    } };
struct EpMoeOut { unsigned char* yb; const float* b2; const int* blke; const float* rowg;
    struct Pre { f32x4 bv[2][2]; float rg[2][4]; };
    __device__ __forceinline__ Pre prefetch(const Unit& u, int wr, int wc, int fr, int fq) const { Pre p; const float* bb = b2 + (size_t)u.e * 1024 + u.pn * BM + wc * 64 + 16 * fq;
#pragma unroll
        for (int bj = 0; bj < 2; ++bj)
#pragma unroll
            for (int n = 0; n < 2; ++n) p.bv[bj][n] = *(const f32x4*)(bb + 8 * bj + 4 * n);
#pragma unroll
        for (int ai = 0; ai < 2; ++ai)
#pragma unroll
            for (int m = 0; m < 4; ++m) p.rg[ai][m] = rowg[u.pm * BM + ai * HALF + wr * 64 + m * 16 + fr];
        return p; }
    __device__ __forceinline__ void operator()(const f32x4 (&acc)[2][2][4][2], const Unit& u, int wr, int wc, int fr, int fq, const Pre& pre) const {
        const int lane = fr + 16 * fq;
        unsigned char* op = yb + (size_t)(u.pm * BM + wr * 64 + (lane >> 2)) * 1024 + u.pn * BM + wc * 64 + 16 * (lane & 3);
#pragma unroll
        for (int ai = 0; ai < 2; ++ai)
#pragma unroll
            for (int m = 0; m < 4; ++m) { const float rg = pre.rg[ai][m]; u32x4 w;
                { const f32x4 v = (acc[ai][0][m][0] * MOE_DESCALE + pre.bv[0][0]) * rg; w.x = pk4_fp8s(v[0], v[1], v[2], v[3]); }
                { const f32x4 v = (acc[ai][0][m][1] * MOE_DESCALE + pre.bv[0][1]) * rg; w.y = pk4_fp8s(v[0], v[1], v[2], v[3]); }
                { const f32x4 v = (acc[ai][1][m][0] * MOE_DESCALE + pre.bv[1][0]) * rg; w.z = pk4_fp8s(v[0], v[1], v[2], v[3]); }
                { const f32x4 v = (acc[ai][1][m][1] * MOE_DESCALE + pre.bv[1][1]) * rg; w.w = pk4_fp8s(v[0], v[1], v[2], v[3]); }
                *(u32x4*)(op + (size_t)(ai * HALF + m * 16) * 1024) = quad_tr(w, lane); }
    } };
template <int MODE> struct EpHeads { bf16_t* o0; bf16_t* o1; const float* g; using Pre = NoPre;
    __device__ __forceinline__ Pre prefetch(const Unit&, int, int, int, int) const { return {}; }
    static __device__ __forceinline__ float sum_fq(float v) {
        auto p = __builtin_amdgcn_permlane16_swap(__float_as_uint(v), __float_as_uint(v), false, false); v = __uint_as_float(p[0]) + __uint_as_float(p[1]);
        auto q = __builtin_amdgcn_permlane32_swap(__float_as_uint(v), __float_as_uint(v), false, false); return __uint_as_float(q[0]) + __uint_as_float(q[1]); }
    __device__ __forceinline__ void operator()(const f32x4 (&acc)[2][2][4][2], const Unit& u, int wr, int wc, int fr, int fq, const Pre&) const {
        const bool first = u.pn < 4; bf16_t* O = first ? o0 : o1; const int colbase = (u.pn & 3) * 256 + wc * 64 + 8 * fq;
        float rr[2][4];
        if (first) {
            f32x4 gv[2][2];
#pragma unroll
            for (int bj = 0; bj < 2; ++bj)
#pragma unroll
                for (int n = 0; n < 2; ++n) gv[bj][n] = *(const f32x4*)(g + 32 * bj + 8 * fq + 4 * n);
#pragma unroll
            for (int ai = 0; ai < 2; ++ai)
#pragma unroll
                for (int m = 0; m < 4; ++m) { float ss = 0.f;
#pragma unroll
                    for (int bj = 0; bj < 2; ++bj)
#pragma unroll
                        for (int n = 0; n < 2; ++n) { const f32x4 x = acc[ai][bj][m][n]; ss += (x[0] * x[0] + x[1] * x[1]) + (x[2] * x[2] + x[3] * x[3]); }
                    rr[ai][m] = ss; }
#pragma unroll
            for (int ai = 0; ai < 2; ++ai)
#pragma unroll
                for (int m = 0; m < 4; ++m) { float r = __builtin_amdgcn_rsqf(sum_fq(rr[ai][m]) * (1.f / 64.f) + EPS * (1.f / (MOE_DESCALE * MOE_DESCALE))); if (MODE == 1) r *= C2; rr[ai][m] = r; }
#pragma unroll
            for (int ai = 0; ai < 2; ++ai)
#pragma unroll
                for (int m = 0; m < 4; ++m) { const int row = u.pm * BM + ai * HALF + wr * 64 + m * 16 + fr;
#pragma unroll
                    for (int bj = 0; bj < 2; ++bj) { const f32x4 v0 = acc[ai][bj][m][0] * rr[ai][m] * gv[bj][0], v1 = acc[ai][bj][m][1] * rr[ai][m] * gv[bj][1];
                        u32x4 w; w.x = cvt_pk_bf16(v0[0], v0[1]); w.y = cvt_pk_bf16(v0[2], v0[3]); w.z = cvt_pk_bf16(v1[0], v1[1]); w.w = cvt_pk_bf16(v1[2], v1[3]);
                        *(u32x4*)(O + (size_t)row * DM + colbase + 32 * bj) = w; } }
        } else {
#pragma unroll
            for (int ai = 0; ai < 2; ++ai)
#pragma unroll
                for (int m = 0; m < 4; ++m) { const int row = u.pm * BM + ai * HALF + wr * 64 + m * 16 + fr;
#pragma unroll
                    for (int bj = 0; bj < 2; ++bj) { f32x4 v[2];
#pragma unroll
                        for (int n = 0; n < 2; ++n) { f32x4 x = acc[ai][bj][m][n] * MOE_DESCALE; if (MODE == 1) { x[0] = fast_sigmoid(x[0]); x[1] = fast_sigmoid(x[1]); x[2] = fast_sigmoid(x[2]); x[3] = fast_sigmoid(x[3]); } v[n] = x; }
                        u32x4 w; w.x = cvt_pk_bf16(v[0][0], v[0][1]); w.y = cvt_pk_bf16(v[0][2], v[0][3]); w.z = cvt_pk_bf16(v[1][0], v[1][1]); w.w = cvt_pk_bf16(v[1][2], v[1][3]);
                        *(u32x4*)(O + (size_t)row * DM + colbase + 32 * bj) = w; } }
        }
    } };

template <class Epi, class Sched, class Src, bool ALIGN_EPI>
__device__ __forceinline__ void gemm_phase(LAS unsigned char* lds, const char* Abase, int K, const Sched& S, const Src& src, const Epi& E) {
    int tid_ = threadIdx.x; asm volatile("" : "+v"(tid_));
    const int tid = tid_, wid = __builtin_amdgcn_readfirstlane(tid >> 6), lane = tid & 63, wr = wid >> 2, wc = wid & 3, fr = lane & 15, fq = lane >> 4;
    const int nt = K / BK; constexpr bool PARK = Src::FP8;
    int sR[2], sC[2]; unsigned voffB[2];
#pragma unroll
    for (int i = 0; i < 2; ++i) { stage_rc(tid * 16 + i * 8192, sR[i], sC[i]); voffB[i] = (unsigned)(Src::brow(sR[i]) * K + sC[i]) * 2u; }
    const size_t kstep = (size_t)(BK * 2);
    const unsigned ldsw = (unsigned)wid * 1024u;
    const int aoff = lds_byte(wr * 64 + fr, fq * 8), boff = lds_byte(wc * 32 + fr, fq * 8);
#define PG_SA(b, h) (((b) * 2 + (h)) * HTB)
#define PG_SB(b, h) ((4 + (b) * 2 + (h)) * HTB)
#define PG_STAGE(bufoff, gbase, v0, v1) do { \
        __builtin_amdgcn_global_load_lds((const unsigned*)((const char*)(gbase) + (v0)), (LAS unsigned*)(lds + (bufoff) + ldsw), 16, 0, 0); \
        __builtin_amdgcn_global_load_lds((const unsigned*)((const char*)(gbase) + (v1)), (LAS unsigned*)(lds + (bufoff) + ldsw + 8192), 16, 0, 0); } while (0)
#define PG_LD16(p) (*(const LAS v4i32*)(p))
#define PG_LDA(dst, b, h) do { if constexpr (Src::FP8) { _Pragma("unroll") for (int m = 0; m < 4; ++m) { const v4i32 x0_ = PG_LD16(lds + PG_SA(b, h) + aoff + m * 2048), x1_ = PG_LD16(lds + PG_SA(b, h) + aoff + m * 2048 + 1024); \
            dst##8[m] = __builtin_shufflevector(x0_, x1_, 0, 1, 2, 3, 4, 5, 6, 7); } } else { \
        _Pragma("unroll") for (int m = 0; m < 4; ++m) _Pragma("unroll") for (int k = 0; k < 2; ++k) dst[m][k] = *(const LAS bf16x8*)(lds + PG_SA(b, h) + aoff + m * 2048 + k * 1024); } } while (0)
#define PG_LDB(dst, b, h) do { if constexpr (Src::FP8) { _Pragma("unroll") for (int n = 0; n < 2; ++n) { const v4i32 x0_ = PG_LD16(lds + PG_SB(b, h) + boff + n * 2048), x1_ = PG_LD16(lds + PG_SB(b, h) + boff + n * 2048 + 1024); \
            dst##8[n] = __builtin_shufflevector(x0_, x1_, 0, 1, 2, 3, 4, 5, 6, 7); } } else { \
        _Pragma("unroll") for (int n = 0; n < 2; ++n) _Pragma("unroll") for (int k = 0; k < 2; ++k) dst[n][k] = *(const LAS bf16x8*)(lds + PG_SB(b, h) + boff + n * 2048 + k * 1024); } } while (0)
#define PG_MMA(ai, bj, At, Bt) do { __builtin_amdgcn_s_setprio(1); if constexpr (Src::FP8) { _Pragma("unroll") for (int m = 0; m < 4; ++m) _Pragma("unroll") for (int n = 0; n < 2; ++n) \
        acc[ai][bj][m][n] = __builtin_amdgcn_mfma_scale_f32_16x16x128_f8f6f4(Bt##8[n], At##8[m], acc[ai][bj][m][n], 0, 0, 0, 0x7f7f7f7f, 0, 0x7f7f7f7f); } else { \
        _Pragma("unroll") for (int m = 0; m < 4; ++m) _Pragma("unroll") for (int n = 0; n < 2; ++n) _Pragma("unroll") for (int k = 0; k < 2; ++k) \
        acc[ai][bj][m][n] = __builtin_amdgcn_mfma_f32_16x16x32_bf16(Bt[n][k], At[m][k], acc[ai][bj][m][n], 0, 0, 0); } __builtin_amdgcn_s_setprio(0); } while (0)
#define PG_WAIT_V(n) asm volatile("s_waitcnt vmcnt(" #n ")" ::: "memory")
#define PG_WAIT_L(n) asm volatile("s_waitcnt lgkmcnt(" #n ")" ::: "memory")
#define PG_BAR __builtin_amdgcn_s_barrier()
#define PG_SCHED __builtin_amdgcn_sched_barrier(0)
    Unit cur, nxt; int ui = 0;
    if (!S.next(0, cur)) return;
    if constexpr (Src::TAB) { LAS int* tw = (LAS int*)(lds + STAGE_BYTES + 8192); for (int i = tid; i <= MAXBLK; i += 512) tw[i] = src.blke[i]; __syncthreads(); }
    src.fill(cur); typename Epi::Pre pre;
    f32x4 acc[2][2][4][2];
#pragma unroll
    for (int a = 0; a < 2; ++a)
#pragma unroll
        for (int b = 0; b < 2; ++b)
#pragma unroll
            for (int m = 0; m < 4; ++m)
#pragma unroll
                for (int n = 0; n < 2; ++n) acc[a][b][m][n] = (f32x4){0.f, 0.f, 0.f, 0.f};
    bf16x8 At[4][2], B0[2][2], B1[2][2]; v8i32 At8[4], B08[2], B18[2];
    unsigned vc[2][2], vn[2][2];
#pragma unroll
    for (int h = 0; h < 2; ++h)
#pragma unroll
        for (int i = 0; i < 2; ++i) vc[h][i] = src.arow_off(cur, h, sR[i]) + (unsigned)sC[i] * 2u;
    const char* cB0 = src.bhalf(cur, 0); const char* cB1 = src.bhalf(cur, 1);
    const char* const cA = Abase;
    PG_STAGE(PG_SB(0, 0), cB0, voffB[0], voffB[1]); PG_STAGE(PG_SB(0, 1), cB1, voffB[0], voffB[1]); PG_STAGE(PG_SA(0, 0), cA, vc[0][0], vc[0][1]); PG_STAGE(PG_SA(0, 1), cA, vc[1][0], vc[1][1]);
    if (wr == 1) PG_BAR;
    PG_WAIT_V(2); PG_BAR;
    PG_STAGE(PG_SB(1, 0), cB0 + kstep, voffB[0], voffB[1]); PG_STAGE(PG_SA(1, 0), cA + kstep, vc[0][0], vc[0][1]); PG_STAGE(PG_SB(1, 1), cB1 + kstep, voffB[0], voffB[1]);
    PG_WAIT_V(6); PG_BAR;
    for (;;) {
        const bool has_next = S.next(ui + 1, nxt);
        const char* nB0 = cB0; const char* nB1 = cB1;
#pragma unroll
        for (int h = 0; h < 2; ++h)
#pragma unroll
            for (int i = 0; i < 2; ++i) vn[h][i] = vc[h][i];
        if (has_next) { src.fill(nxt); nB0 = src.bhalf(nxt, 0); nB1 = src.bhalf(nxt, 1);
#pragma unroll
            for (int h = 0; h < 2; ++h)
#pragma unroll
                for (int i = 0; i < 2; ++i) vn[h][i] = src.arow_off(nxt, h, sR[i]) + (unsigned)sC[i] * 2u; }
        asm volatile("" : "+v"(vn[0][0]), "+v"(vn[0][1]), "+v"(vn[1][0]), "+v"(vn[1][1]));
        if constexpr (PARK) { u32x4 pv; pv.x = vn[0][0]; pv.y = vn[0][1]; pv.z = vn[1][0]; pv.w = vn[1][1]; *(LAS u32x4*)(lds + STAGE_BYTES + tid * 16) = pv; }
#pragma unroll 1
        for (int t = 0; t < nt; t += 2) {
            const bool last = (t == nt - 2);
            if constexpr (PARK) { if (last) { int t2 = threadIdx.x; asm volatile("" : "+v"(t2)); pre = E.prefetch(cur, wr, wc, t2 & 15, (t2 & 63) >> 4); } }
            const char* a1 = cA + (size_t)(t + 1) * kstep;
            const char* a2 = last ? cA : cA + (size_t)(t + 2) * kstep; const char* a3 = a2 + kstep;
            const char* b20 = last ? nB0 : cB0 + (size_t)(t + 2) * kstep; const char* b21 = last ? nB1 : cB1 + (size_t)(t + 2) * kstep;
            const char* b30 = b20 + kstep; const char* b31 = b21 + kstep;
            unsigned w00, w01, w10, w11;
            if constexpr (!PARK) { w00 = last ? vn[0][0] : vc[0][0]; w01 = last ? vn[0][1] : vc[0][1]; w10 = last ? vn[1][0] : vc[1][0]; w11 = last ? vn[1][1] : vc[1][1]; }
            if constexpr (Src::FP8) asm volatile("" : "+s"(a1), "+s"(a2), "+s"(a3), "+s"(b20), "+s"(b21), "+s"(b30), "+s"(b31));
            PG_LDB(B0, 0, 0); PG_LDB(B1, 0, 1); PG_SCHED; PG_LDA(At, 0, 0); PG_STAGE(PG_SA(1, 1), a1, vc[1][0], vc[1][1]);
            if constexpr (PARK) { if (last) { const u32x4 pv = *(const LAS u32x4*)(lds + STAGE_BYTES + tid * 16); vc[0][0] = pv.x; vc[0][1] = pv.y; vc[1][0] = pv.z; vc[1][1] = pv.w; }
                w00 = vc[0][0]; w01 = vc[0][1]; w10 = vc[1][0]; w11 = vc[1][1]; }
            PG_WAIT_V(8); PG_WAIT_L(0); PG_BAR; PG_MMA(0, 0, At, B0); PG_MMA(0, 1, At, B1); PG_BAR; PG_SCHED;
            PG_LDA(At, 0, 1); PG_STAGE(PG_SB(0, 0), b20, voffB[0], voffB[1]); PG_STAGE(PG_SB(0, 1), b21, voffB[0], voffB[1]); PG_STAGE(PG_SA(0, 0), a2, w00, w01);
            PG_WAIT_V(8); PG_WAIT_L(0); PG_BAR; PG_MMA(1, 0, At, B0); PG_MMA(1, 1, At, B1); PG_BAR; PG_SCHED;
            PG_LDB(B0, 1, 0); PG_LDB(B1, 1, 1); PG_SCHED; PG_LDA(At, 1, 0); PG_STAGE(PG_SA(0, 1), a2, w10, w11);
            PG_WAIT_V(8); PG_WAIT_L(0); PG_BAR; PG_MMA(0, 0, At, B0); PG_MMA(0, 1, At, B1); PG_BAR; PG_SCHED;
            PG_LDA(At, 1, 1); PG_STAGE(PG_SB(1, 0), b30, voffB[0], voffB[1]); PG_STAGE(PG_SB(1, 1), b31, voffB[0], voffB[1]); PG_STAGE(PG_SA(1, 0), a3, w00, w01);
            PG_WAIT_V(8); PG_WAIT_L(0); PG_BAR; PG_MMA(1, 0, At, B0); PG_MMA(1, 1, At, B1); PG_BAR; PG_SCHED;
        }
        if constexpr (ALIGN_EPI) { if (wr == 0) PG_BAR; }
        if constexpr (PARK) { int t2 = threadIdx.x; asm volatile("" : "+v"(t2)); E(acc, cur, wr, wc, t2 & 15, (t2 & 63) >> 4, pre); }
        else { pre = E.prefetch(cur, wr, wc, fr, fq); E(acc, cur, wr, wc, fr, fq, pre); }
        if (!has_next) break;
#pragma unroll
        for (int a = 0; a < 2; ++a)
#pragma unroll
            for (int b = 0; b < 2; ++b)
#pragma unroll
                for (int m = 0; m < 4; ++m)
#pragma unroll
                    for (int n = 0; n < 2; ++n) acc[a][b][m][n] = (f32x4){0.f, 0.f, 0.f, 0.f};
        cur = nxt; cB0 = nB0; cB1 = nB1; ++ui;
        if constexpr (!PARK) {
#pragma unroll
        for (int h = 0; h < 2; ++h)
#pragma unroll
            for (int i = 0; i < 2; ++i) vc[h][i] = vn[h][i]; }
        if constexpr (ALIGN_EPI) { if (wr == 1) PG_BAR; }
    }
    PG_WAIT_V(0);
    if constexpr (!ALIGN_EPI) { if (wr == 0) PG_BAR; }
    PG_BAR;
#undef PG_SA
#undef PG_SB
#undef PG_STAGE
#undef PG_LDA
#undef PG_LDB
#undef PG_MMA
#undef PG_LD16
#undef PG_WAIT_V
#undef PG_WAIT_L
#undef PG_BAR
#undef PG_SCHED
}
}
#include <hip/hip_bf16.h>
#include <cmath>
namespace attn_body {
using bf16=__hip_bfloat16;
using bf16x8=__attribute__((ext_vector_type(8)))short;
using s16x4=__attribute__((ext_vector_type(4)))short;
using f32x16=__attribute__((ext_vector_type(16)))float;
using u32x4=__attribute__((ext_vector_type(4)))unsigned;
constexpr int BATCH=8,NHEAD=16,SEQ=4096,D=64,DM=NHEAD*D;
constexpr int NW=8,QBLK=32,QB=QBLK*NW,KVBLK=64,NQB=SEQ/QB;
constexpr int ATTN_PITCH=DM, ATTN_UNIT_ROWS=QB;
__device__ __forceinline__ int crow(int r,int hi){return (r&3)+8*(r>>2)+4*hi;}
#define SBAR() __builtin_amdgcn_sched_barrier(0)
__device__ __forceinline__ void cmask(f32x16&p0,f32x16&p1,int jb,int qrel,int hi){
  const float NEG=-INFINITY; int kb=64*jb+4*hi;
  #pragma unroll
  for(int r=0;r<16;++r){int kv=kb+(r&3)+8*(r>>2); if(kv>qrel)p0[r]=NEG; if(kv+32>qrel)p1[r]=NEG;}
}

constexpr int NSLOT=3, SLOTB=8192;
constexpr int LDS_K=0, LDS_V=NSLOT*SLOTB, LDS_WS=2*NSLOT*SLOTB, LDS_OST=LDS_WS+NW*64*4, LDS_GPAD=LDS_OST+NW*4096, LDS_G3=LDS_GPAD+128*8, LDS_BYTES=LDS_G3+SEQ*8;
constexpr float C2_=0.125f*1.4426950408889634f;
__device__ __forceinline__ void glds16(const void*gsrc,unsigned lds_dst){unsigned keep;
  asm volatile("s_mov_b32 %0, m0\n\ts_mov_b32 m0, %2\n\ts_nop 0\n\tglobal_load_lds_dwordx4 %1, off\n\ts_mov_b32 m0, %0":"=&s"(keep):"v"(gsrc),"s"(lds_dst):"memory");}
__device__ __forceinline__ float max3f(float a,float b,float c){float r;asm("v_max3_f32 %0, %1, %2, %3":"=v"(r):"v"(a),"v"(b),"v"(c));return r;}
__device__ __forceinline__ float max2f(float a,float b){float r;asm("v_max_f32_e32 %0, %1, %2":"=v"(r):"v"(a),"v"(b));return r;}
__device__ __forceinline__ float fadd_s(float a,float b){float r;asm("v_add_f32_e32 %0, %1, %2":"=v"(r):"v"(a),"v"(b));return r;}
__device__ __forceinline__ float fsub_s(float a,float b){float r;asm("v_sub_f32_e32 %0, %1, %2":"=v"(r):"v"(a),"v"(b));return r;}
typedef float f32x2_t __attribute__((ext_vector_type(2))); typedef __bf16 bf16x2_t __attribute__((ext_vector_type(2)));
__device__ __forceinline__ unsigned cvtpk_s(float lo,float hi){f32x2_t v={lo,hi};bf16x2_t b=__builtin_convertvector(v,bf16x2_t);return __builtin_bit_cast(unsigned,b);}
#define WAIT_BAR(N) asm volatile("s_waitcnt vmcnt(" #N ") lgkmcnt(0)\n\ts_barrier":::"memory")

__device__ __forceinline__ void qkt(f32x16&p0,f32x16&p1,const char*Kslot,const bf16x8*qr,bf16x8 ka0,bf16x8 ka1,bf16x8 qa,int r32,int hi){
  const char*kb=Kslot+hi*1024+r32*16;
  { const f32x16 z=f32x16{}; p0=__builtin_amdgcn_mfma_f32_32x32x16_bf16(ka0,qa,z,0,0,0); p1=__builtin_amdgcn_mfma_f32_32x32x16_bf16(ka1,qa,z,0,0,0); }
  #pragma unroll
  for(int d0=0;d0<4;++d0){
    const bf16x8 b0=*reinterpret_cast<const bf16x8*>(kb+d0*2048);
    const bf16x8 b1=*reinterpret_cast<const bf16x8*>(kb+d0*2048+512);
    p0=__builtin_amdgcn_mfma_f32_32x32x16_bf16(b0,qr[d0],p0,0,0,0);p1=__builtin_amdgcn_mfma_f32_32x32x16_bf16(b1,qr[d0],p1,0,0,0);}
}
typedef __attribute__((address_space(3))) const char* lds_cptr;
typedef short v4i16_t __attribute__((ext_vector_type(4)));
__device__ __forceinline__ void kload8(bf16x8*kf,lds_cptr kp){
  kf[0]=*(const __attribute__((address_space(3))) bf16x8*)(kp);      kf[1]=*(const __attribute__((address_space(3))) bf16x8*)(kp+512);
  kf[2]=*(const __attribute__((address_space(3))) bf16x8*)(kp+2048); kf[3]=*(const __attribute__((address_space(3))) bf16x8*)(kp+2560);
  kf[4]=*(const __attribute__((address_space(3))) bf16x8*)(kp+4096); kf[5]=*(const __attribute__((address_space(3))) bf16x8*)(kp+4608);
  kf[6]=*(const __attribute__((address_space(3))) bf16x8*)(kp+6144); kf[7]=*(const __attribute__((address_space(3))) bf16x8*)(kp+6656);
}
__device__ __forceinline__ void kload2(bf16x8*kf,lds_cptr kp,int j){ kf[2*j]=*(const __attribute__((address_space(3))) bf16x8*)(kp+j*2048); kf[2*j+1]=*(const __attribute__((address_space(3))) bf16x8*)(kp+j*2048+512); }
__device__ __forceinline__ s16x4 vtr(lds_cptr p){ return __builtin_bit_cast(s16x4,__builtin_amdgcn_ds_read_tr16_b64_v4i16((__attribute__((address_space(3))) v4i16_t*)p)); }
__device__ __forceinline__ float rowmax(const f32x16&p0,const f32x16&p1){
  float a=max3f(p0[0],p0[1],p1[0]),b=max3f(p0[2],p0[3],p1[1]);a=max3f(a,p1[2],p1[3]);
  #pragma unroll
  for(int r=4;r<16;r+=4){a=max3f(a,p0[r],p0[r+1]);b=max3f(b,p0[r+2],p0[r+3]);a=max3f(a,p1[r],p1[r+1]);b=max3f(b,p1[r+2],p1[r+3]);}
  const float m=max2f(a,b);
  auto rr=__builtin_amdgcn_permlane32_swap(__float_as_uint(m),__float_as_uint(m),false,false);
  return max2f(__uint_as_float(rr[0]),__uint_as_float(rr[1]));
}
__device__ __forceinline__ void pv(f32x16*o,int vb,bf16x8 pa0,bf16x8 pa1,bf16x8 pa2,bf16x8 pa3){
  #pragma unroll
  for(int d0=0;d0<2;++d0){s16x4 lo[4],hi[4];
    #pragma unroll
    for(int ks=0;ks<4;++ks){
      asm volatile("ds_read_b64_tr_b16 %0,%1 offset:%c2":"=&v"(lo[ks]):"v"(vb),"i"(d0*4096+ks*1024):"memory");
      asm volatile("ds_read_b64_tr_b16 %0,%1 offset:%c2":"=&v"(hi[ks]):"v"(vb),"i"(d0*4096+ks*1024+512):"memory");}
    asm volatile("s_waitcnt lgkmcnt(0)":::"memory");SBAR();
    #define PK(k) (bf16x8){lo[k][0],lo[k][1],lo[k][2],lo[k][3],hi[k][0],hi[k][1],hi[k][2],hi[k][3]}
    o[d0]=__builtin_amdgcn_mfma_f32_32x32x16_bf16(pa0,PK(0),o[d0],0,0,0);
    o[d0]=__builtin_amdgcn_mfma_f32_32x32x16_bf16(pa1,PK(1),o[d0],0,0,0);
    o[d0]=__builtin_amdgcn_mfma_f32_32x32x16_bf16(pa2,PK(2),o[d0],0,0,0);
    o[d0]=__builtin_amdgcn_mfma_f32_32x32x16_bf16(pa3,PK(3),o[d0],0,0,0);
    #undef PK
  }
}

#ifndef ATTN_STORE16
#define ATTN_STORE16(p,v) (*(u32x4*)(p)=(v))
#endif
template<int THRL> __device__ __forceinline__ void attn_unit(int b,int h,int qb,const bf16*Q,const bf16*__restrict__ K,const bf16*__restrict__ V,const bf16*__restrict__ GATE,bf16*O,char*shm,float skipthr){
  int tid_=threadIdx.x; asm volatile("":"+v"(tid_));
  const int tid=tid_,lane=tid&63,r32=lane&31,hi=lane>>5; const int wid=__builtin_amdgcn_readfirstlane(tid>>6);
  const long rowbase=(long)b*SEQ; const int q0=qb*QB;
  const bf16*Qw=Q+(rowbase+q0+wid*QBLK)*DM+h*D;
  const unsigned lds0=(unsigned)(uintptr_t)shm;
  int tskip;
  { typedef __attribute__((address_space(3))) const unsigned long long* lds_u64q; const lds_u64q gt_=(lds_u64q)((__attribute__((address_space(3))) const char*)shm+LDS_G3);
    const int NT0=(q0+QB)/KVBLK; const unsigned long long e0=gt_[q0], e1=gt_[lane<NT0?64*lane+63:q0];
    const float G0=(__uint_as_float((unsigned)e0<<16)+__uint_as_float((unsigned)e0&0xffff0000u))+__uint_as_float((unsigned)(e0>>32)<<16);
    const float G1=(__uint_as_float((unsigned)e1<<16)+__uint_as_float((unsigned)e1&0xffff0000u))+__uint_as_float((unsigned)(e1>>32)<<16);
    const int ns=__builtin_popcountll(__ballot(lane<NT0 && (G1-G0)<skipthr)); tskip=__builtin_amdgcn_readfirstlane(min(ns&~1,NT0-6)); }
  const bf16*Kh=K+(rowbase+(long)tskip*KVBLK)*DM+h*D,*Vh=V+(rowbase+(long)tskip*KVBLK)*DM+h*D;
  float*wsf=(float*)(shm+LDS_WS)+wid*64;
  const bf16*ksrc=Kh+(long)lane*DM+wid*8;
  const bf16*vsrc=Vh+(long)(16*(wid&3)+(lane>>2))*DM+(wid>>2)*32+(lane&3)*8;
  const unsigned kdst=lds0+LDS_K+wid*1024, vdst=lds0+LDS_V+wid*1024;
  #define DMA_K(t,slot) glds16(ksrc+(long)(t)*KVBLK*DM,(unsigned)__builtin_amdgcn_readfirstlane(kdst+(slot)))
  #define DMA_V(t,slot) glds16(vsrc+(long)(t)*KVBLK*DM,(unsigned)__builtin_amdgcn_readfirstlane(vdst+(slot)))
  const int vb0=(int)(lds0+LDS_V)+((lane>>4)&1)*32+(lane&3)*8+(4*hi+((lane&15)>>2))*64;
  const char*Kbase=shm+LDS_K; bf16x8 kf[8];
  const lds_cptr shm3=(lds_cptr)shm; const lds_cptr kp0=shm3+LDS_K+hi*1024+r32*16; const lds_cptr vp0=shm3+LDS_V+((lane>>4)&1)*32+(lane&3)*8+(4*hi+((lane&15)>>2))*64;
  const int NT=(q0+QB)/KVBLK-tskip;
  DMA_K(0,0);DMA_V(0,0);DMA_K(1,SLOTB);
  bf16x8 qr[4];
  #pragma unroll
  for(int d0=0;d0<4;++d0)qr[d0]=*reinterpret_cast<const bf16x8*>(&Qw[(long)r32*DM+d0*16+hi*8]);
  float mhat=0.f,l_reg=0.f;f32x16 o[2];o[0]=f32x16{};o[1]=f32x16{};
  typedef __attribute__((address_space(3))) const unsigned long long* lds_u64p;
  const lds_u64p g3p=(lds_u64p)(shm3+LDS_G3)+tskip*KVBLK+r32;
  { const unsigned long long e=((lds_u64p)(shm3+LDS_G3))[q0+wid*QBLK+r32]; const unsigned lo_=(unsigned)e,hi_=(unsigned)(e>>32); mhat=(__uint_as_float(lo_<<16)+__uint_as_float(lo_&0xffff0000u))+__uint_as_float(hi_<<16); }
  u32x4 qa; qa.x=hi?0u:0x3f803f80u; qa.y=0u; qa.z=0u; qa.w=0u;
  #define SETREF() do{ const float x_=-mhat; const unsigned b1_=cvtpk_s(x_,0.f)&0xffffu; const float r1_=x_-__uint_as_float(b1_<<16); const unsigned b2_=cvtpk_s(r1_,0.f)&0xffffu; \
      const float r2_=r1_-__uint_as_float(b2_<<16); const unsigned b3_=cvtpk_s(r2_,0.f)&0xffffu; qa.y=hi?0u:(0x3f80u|(b1_<<16)); qa.z=hi?0u:(b2_|(b3_<<16)); asm volatile("":"+v"(qa)); }while(0)
  SETREF();
  unsigned long long ga0,ga1;
  #define GARD(t) do{ ga0=g3p[(t)*64]; ga1=g3p[(t)*64+32]; }while(0)
  #define KAF(g) __builtin_bit_cast(bf16x8,(u32x4){(unsigned)(g),(unsigned)((g)>>32),0x3f803f80u,0u})
  #define QAF() __builtin_bit_cast(bf16x8,qa)
  const int qrel=wid*QBLK+r32;
  #define CMASK(P0,P1,t) do{int jb_=(t)-(NT-4); if(jb_>=0)cmask(P0,P1,jb_,qrel,hi);}while(0)
  bool resc=false;
  #define START(P0,P1) do{ const float rm=rowmax(P0,P1); resc=false; \
    { const float dl=__builtin_fmaxf(rm,0.f); mhat=fadd_s(mhat,dl);     \
      _Pragma("unroll") for(int r=0;r<16;++r){P0[r]=fsub_s(P0[r],dl);P1[r]=fsub_s(P1[r],dl);} \
      SETREF(); } \
    _Pragma("unroll") for(int r=0;r<16;++r)P0[r]=__builtin_amdgcn_exp2f(P0[r]); }while(0)
  #define RESC() do{ if(resc){ asm volatile("s_waitcnt lgkmcnt(0)":::"memory"); \
      _Pragma("unroll") for(int d_=0;d_<2;++d_) _Pragma("unroll") for(int r=0;r<16;++r)o[d_][r]*=wsf[crow(r,hi)]; } }while(0)
  f32x16 pA0,pA1,pB0,pB1;
  int sl_prev=0,sl_cur=0,sl_next=SLOTB;
  #define ROT() do{sl_prev=sl_cur;sl_cur=sl_next;sl_next=(sl_next==(NSLOT-1)*SLOTB)?0:sl_next+SLOTB;}while(0)
  DMA_K(2,2*SLOTB);
  WAIT_BAR(3);
  GARD(0); qkt(pA0,pA1,Kbase,qr,KAF(ga0),KAF(ga1),QAF(),r32,hi);asm volatile("s_nop 15\n\ts_nop 7":"+v"(pA0),"+v"(pA1));CMASK(pA0,pA1,0);
  START(pA0,pA1);
  _Pragma("unroll") for(int r=0;r<16;++r)pA1[r]=__builtin_amdgcn_exp2f(pA1[r]);
  WAIT_BAR(0);
  DMA_K(3,0);DMA_V(1,SLOTB);
  ROT();
  kload8(kf,kp0+sl_cur); GARD(1);
  WAIT_BAR(2);
  s16x4 vlo[8],vhi[8]; u32x4 pw0,pw1,pw2,pw3;
  #define PKW(P,B) cvtpk_s(P[B],P[B+1])
  #define PAF(k) __builtin_bit_cast(bf16x8,pw##k)
  #define VFR(i) (bf16x8){vlo[i][0],vlo[i][1],vlo[i][2],vlo[i][3],vhi[i][0],vhi[i][1],vhi[i][2],vhi[i][3]}
  #define PIN(x) asm volatile("":"+v"(x))
  #define MX3(a,b,c) __builtin_fmaxf(__builtin_fmaxf((a),(b)),(c))
  #define GAPA(MF,A0,A1,A2,A3,W0,W1,PW) do{ MF; sacc+=A0; sacc+=A1; sacc+=A2; sacc+=A3; PIN(sacc); W0; W1; PIN(PW); SBAR(); }while(0)
  #define EX(v) __builtin_amdgcn_exp2f(v)
  #define GAPB(MF,X,B) do{ MF; X[B]=EX(X[B]); X[B+1]=EX(X[B+1]); X[B+2]=EX(X[B+2]); X[B+3]=EX(X[B+3]); PIN(X); SBAR(); }while(0)
  #define VRD(i) do{ vlo[i]=vtr(vp_+(((i)>>2)*4096+((i)&3)*1024)); vhi[i]=vtr(vp_+(((i)>>2)*4096+((i)&3)*1024+512)); }while(0)
  #define KRD(G,j) do{ if(G){ kload2(kf,kp0+sl_next,j); SBAR(); } }while(0)
  #define STEP(C0,C1,P0,P1,t,GK,GV,GL) do{ SBAR(); \
    const lds_cptr vp_=vp0+sl_prev; \
    { const f32x16 z_=f32x16{}; C0=__builtin_amdgcn_mfma_f32_32x32x16_bf16(KAF(ga0),QAF(),z_,0,0,0); C1=__builtin_amdgcn_mfma_f32_32x32x16_bf16(KAF(ga1),QAF(),z_,0,0,0); } SBAR(); \
    VRD(0); SBAR(); float sacc=(P0[0]+P0[1]); \
    GAPA(C0=__builtin_amdgcn_mfma_f32_32x32x16_bf16(kf[0],qr[0],C0,0,0,0), P0[2],P0[3],P0[4],P0[5],     pw0[0]=PKW(P0,0), pw0[1]=PKW(P0,2), pw0); \
    VRD(4); SBAR(); GAPA(C1=__builtin_amdgcn_mfma_f32_32x32x16_bf16(kf[1],qr[0],C1,0,0,0), P0[6],P0[7],P0[8],P0[9],     pw0[2]=PKW(P0,4), pw0[3]=PKW(P0,6), pw0); \
    VRD(1); SBAR(); GAPA(C0=__builtin_amdgcn_mfma_f32_32x32x16_bf16(kf[2],qr[1],C0,0,0,0),   P0[10],P0[11],P0[12],P0[13], pw1[0]=PKW(P0,8), pw1[1]=PKW(P0,10), pw1); \
    VRD(5); SBAR(); GAPA(C1=__builtin_amdgcn_mfma_f32_32x32x16_bf16(kf[3],qr[1],C1,0,0,0),   P0[14],P0[15],P1[0],P1[1],   pw1[2]=PKW(P0,12),pw1[3]=PKW(P0,14), pw1); \
    VRD(2); SBAR(); GAPA(C0=__builtin_amdgcn_mfma_f32_32x32x16_bf16(kf[4],qr[2],C0,0,0,0),   P1[2],P1[3],P1[4],P1[5],     pw2[0]=PKW(P1,0), pw2[1]=PKW(P1,2), pw2); \
    VRD(6); SBAR(); GAPA(C1=__builtin_amdgcn_mfma_f32_32x32x16_bf16(kf[5],qr[2],C1,0,0,0),   P1[6],P1[7],P1[8],P1[9],     pw2[2]=PKW(P1,4), pw2[3]=PKW(P1,6), pw2); \
    VRD(3); SBAR(); GAPA(C0=__builtin_amdgcn_mfma_f32_32x32x16_bf16(kf[6],qr[3],C0,0,0,0),   P1[10],P1[11],P1[12],P1[13], pw3[0]=PKW(P1,8), pw3[1]=PKW(P1,10), pw3); \
    VRD(7); SBAR(); GAPA(C1=__builtin_amdgcn_mfma_f32_32x32x16_bf16(kf[7],qr[3],C1,0,0,0),   P1[14],P1[15],0.f,0.f,       pw3[2]=PKW(P1,12),pw3[3]=PKW(P1,14), pw3); \
    l_reg+=sacc; \
    if(GK){DMA_K((t)+3,sl_cur);} if(GV){DMA_V((t)+1,sl_next);} \
    CMASK(C0,C1,t); \
    { float a=MX3(C0[0],C0[1],C1[0]),b=MX3(C0[2],C0[3],C1[1]); a=MX3(a,C1[2],C1[3]); \
      _Pragma("unroll") for(int r=4;r<16;r+=4){a=MX3(a,C0[r],C0[r+1]);b=MX3(b,C0[r+2],C0[r+3]);a=MX3(a,C1[r],C1[r+1]);b=MX3(b,C1[r+2],C1[r+3]);} \
      float rm=__builtin_fmaxf(a,b); { auto rr=__builtin_amdgcn_permlane32_swap(__float_as_uint(rm),__float_as_uint(rm),false,false); rm=__builtin_fmaxf(__uint_as_float(rr[0]),__uint_as_float(rr[1])); } \
      resc=false; \
      if(__builtin_expect(__any(rm>(float)THRL),0)){ const float dl=__builtin_fmaxf(rm,0.f); mhat+=dl; \
        _Pragma("unroll") for(int r=0;r<16;++r){C0[r]-=dl;C1[r]-=dl;} \
        SETREF(); \
        const float f=__builtin_amdgcn_exp2f(-dl); l_reg*=f; if(hi==0)wsf[r32]=f; resc=true; } } \
    SBAR(); \
    GAPB(o[0]=__builtin_amdgcn_mfma_f32_32x32x16_bf16(PAF(0),VFR(0),o[0],0,0,0), C0,0); \
    GAPB(o[1]=__builtin_amdgcn_mfma_f32_32x32x16_bf16(PAF(0),VFR(4),o[1],0,0,0), C0,4); \
    KRD(GL,0); GAPB(o[0]=__builtin_amdgcn_mfma_f32_32x32x16_bf16(PAF(1),VFR(1),o[0],0,0,0), C0,8); \
    KRD(GL,1); GAPB(o[1]=__builtin_amdgcn_mfma_f32_32x32x16_bf16(PAF(1),VFR(5),o[1],0,0,0), C0,12); \
    KRD(GL,2); GAPB(o[0]=__builtin_amdgcn_mfma_f32_32x32x16_bf16(PAF(2),VFR(2),o[0],0,0,0), C1,0); \
    KRD(GL,3); GAPB(o[1]=__builtin_amdgcn_mfma_f32_32x32x16_bf16(PAF(2),VFR(6),o[1],0,0,0), C1,4); \
    if(GL){ GARD((t)+1); SBAR(); } GAPB(o[0]=__builtin_amdgcn_mfma_f32_32x32x16_bf16(PAF(3),VFR(3),o[0],0,0,0), C1,8); \
    GAPB(o[1]=__builtin_amdgcn_mfma_f32_32x32x16_bf16(PAF(3),VFR(7),o[1],0,0,0), C1,12); \
    }while(0)
  int t=1;
  #undef CMASK
  #define CMASK(P0,P1,t) do{}while(0)
  for(;t+5<NT;t+=2){
    STEP(pB0,pB1,pA0,pA1,t,true,true,true);     WAIT_BAR(2); RESC(); ROT();
    STEP(pA0,pA1,pB0,pB1,t+1,true,true,true);   WAIT_BAR(2); RESC(); ROT();
  }
  #undef CMASK
  #define CMASK(P0,P1,t) do{int jb_=(t)-(NT-4); if(jb_>=0)cmask(P0,P1,jb_,qrel,hi);}while(0)
  #define ENDW(tt) do{ if((tt)+3<NT){WAIT_BAR(2);} else if((tt)+2<NT){WAIT_BAR(1);} else {WAIT_BAR(0);} }while(0)
  #undef CMASK
  #define CMASK(P0,P1,t) do{}while(0)
  STEP(pB0,pB1,pA0,pA1,NT-5,true,true,true);   WAIT_BAR(2); RESC(); ROT();
  #undef CMASK
  #define CMASK(P0,P1,t) cmask(P0,P1,0,qrel,hi)
  STEP(pA0,pA1,pB0,pB1,NT-4,true,true,true);   WAIT_BAR(2); RESC(); ROT();
  #undef CMASK
  #define CMASK(P0,P1,t) cmask(P0,P1,1,qrel,hi)
  STEP(pB0,pB1,pA0,pA1,NT-3,false,true,true);  WAIT_BAR(1); RESC(); ROT();
  #undef CMASK
  #define CMASK(P0,P1,t) cmask(P0,P1,2,qrel,hi)
  STEP(pA0,pA1,pB0,pB1,NT-2,false,true,true);  WAIT_BAR(0); RESC(); ROT();
  #undef CMASK
  #define CMASK(P0,P1,t) cmask(P0,P1,3,qrel,hi)
  STEP(pB0,pB1,pA0,pA1,NT-1,false,false,false); RESC();
  { float sacc=pB0[0]+pB0[1]; _Pragma("unroll") for(int r=2;r<16;++r)sacc+=pB0[r]; _Pragma("unroll") for(int r=0;r<16;++r)sacc+=pB1[r]; l_reg+=sacc;
    pw0=(u32x4){PKW(pB0,0),PKW(pB0,2),PKW(pB0,4),PKW(pB0,6)};pw1=(u32x4){PKW(pB0,8),PKW(pB0,10),PKW(pB0,12),PKW(pB0,14)};pw2=(u32x4){PKW(pB1,0),PKW(pB1,2),PKW(pB1,4),PKW(pB1,6)};pw3=(u32x4){PKW(pB1,8),PKW(pB1,10),PKW(pB1,12),PKW(pB1,14)};
    SBAR(); pv(o,vb0+sl_cur,PAF(0),PAF(1),PAF(2),PAF(3)); }
  #undef PKW
  #undef PAF
  #undef VFR
  #undef PIN
  #undef MX3
  #undef GAPA
  #undef GAPB
  #undef EX
  #undef VRD
  #undef KRD
  #undef STEP
  #undef ENDW
  {auto rr=__builtin_amdgcn_permlane32_swap(__float_as_uint(l_reg),__float_as_uint(l_reg),false,false);l_reg=__uint_as_float(rr[0])+__uint_as_float(rr[1]);}
  if(hi==0)wsf[32+r32]=l_reg;asm volatile("s_waitcnt lgkmcnt(0)":::"memory");
  float rli[16];
  #pragma unroll
  for(int r=0;r<16;++r)rli[r]=__builtin_amdgcn_rcpf(wsf[32+crow(r,hi)]);
  unsigned char*Ow8=(unsigned char*)O+(rowbase+q0+wid*QBLK)*DM+h*D; const bf16*Gw=GATE+(rowbase+q0+wid*QBLK)*DM+h*D;
  { bf16*stg=(bf16*)(shm+LDS_OST)+wid*2048;
    #pragma unroll
    for(int r=0;r<16;++r){const int orow=crow(r,hi);
      #pragma unroll
      for(int d0=0;d0<2;++d0)stg[orow*64+d0*32+r32]=__float2bfloat16(o[d0][r]*rli[r]);}
    asm volatile("s_waitcnt lgkmcnt(0)":::"memory");
    #pragma unroll
    for(int i=0;i<4;++i){const int row=i*8+(lane>>3),ch=lane&7; const u32x4 v=*(const u32x4*)(stg+row*64+ch*8); const u32x4 gv=*(const u32x4*)(Gw+(long)row*DM+ch*8); u32x4 w;
      #define GLO(a,g) (__uint_as_float((a)<<16)*__uint_as_float((g)<<16))
      #define GHI(a,g) (__uint_as_float((a)&0xffff0000u)*__uint_as_float((g)&0xffff0000u))
      u32x2 w8; w8.x=pk4_fp8s(GLO(v.x,gv.x),GHI(v.x,gv.x),GLO(v.y,gv.y),GHI(v.y,gv.y)); w8.y=pk4_fp8s(GLO(v.z,gv.z),GHI(v.z,gv.z),GLO(v.w,gv.w),GHI(v.w,gv.w));
      #undef GLO
      #undef GHI
      (void)w; *(u32x2*)(Ow8+(long)row*DM+ch*8)=w8;} }
  asm volatile("s_waitcnt lgkmcnt(0)\n\ts_barrier":::"memory");
  #undef DMA_K
  #undef DMA_V
  #undef CMASK
  #undef START
  #undef RESC
  #undef ROT
  #undef SETREF
  #undef GARD
  #undef KAF
  #undef QAF
}
constexpr int ATTN_LDS_BYTES=LDS_BYTES;
struct AttnTensors { const bf16* Q; const bf16* K; const bf16* V; const bf16* GATE; bf16* O; const unsigned long long* G3; const float* qg; const float* kg; };
template<int THRL=8> __device__ __forceinline__ void attn_phase(char*lds,const AttnTensors&T,int grid,int block){
  const int v0=(grid%8==0)?(block%8)*(grid/8)+block/8:block;
  float skipthr; { float a=fabsf(T.qg[threadIdx.x&63]),b=fabsf(T.kg[threadIdx.x&63]);
    #pragma unroll
    for(int o=1;o<64;o<<=1){a=fmaxf(a,__shfl_xor(a,o));b=fmaxf(b,__shfl_xor(b,o));}
    const float qkmax=64.f*a*b*C2_*1.05f; skipthr=-(42.f+3.f*qkmax); }
  for(int v=v0;v<BATCH*NHEAD*2;v+=grid){
    const int bh=v>>1,odd=v&1;
    {
      const u32x4*src=(const u32x4*)(T.G3+(size_t)bh*SEQ); u32x4*dst=(u32x4*)(lds+LDS_G3);
      #pragma unroll
      for(int i=0;i<4;++i)dst[threadIdx.x+512*i]=src[threadIdx.x+512*i];
      if(threadIdx.x<128)((unsigned long long*)(lds+LDS_GPAD))[threadIdx.x]=0x3f80000000000000ull|0xc6eaull;
      asm volatile("s_waitcnt vmcnt(0) lgkmcnt(0)\n\ts_barrier":::"memory"); }
    #pragma unroll 1
    for(int i=0;i<8;++i){ const int j=i>>1; const int qb=(i&1)?(15-2*j-odd):(2*j+odd); attn_unit<THRL>(bh/NHEAD,bh%NHEAD,qb,T.Q,T.K,T.V,T.GATE,T.O,lds,skipthr); }
  }
}
#undef SBAR
#undef WAIT_BAR
}

constexpr int RING_BYTES = 131072;
constexpr int LDS_BYTES = 163840;
constexpr int LDSCTL_OFF = LDS_BYTES - 1024, MISC_OFF = LDSCTL_OFF + 320;
constexpr int CW_BAR = 4096;
typedef GAS unsigned gu32;
#define RLX_AGENT __ATOMIC_RELAXED, __HIP_MEMORY_SCOPE_AGENT
#define XB_TMO      128
#define XB_XCNT(j)  (256  + 64 * (j))
#define XB_XSUB(j)  (1280 + 64 * (j))
#define XB_XGEN(j)  (2304 + 64 * (j))
#define XB_TOP      3328
#define XB_TOPGEN   3392
#define XCD_BAR_WORDS 3456
#define XB_SPIN_CAP (1u << 18)
__device__ __forceinline__ unsigned xb_ld(unsigned* p)              { return __hip_atomic_load(p, __ATOMIC_RELAXED, __HIP_MEMORY_SCOPE_AGENT); }
__device__ __forceinline__ unsigned xb_add(unsigned* p, unsigned v) { return __hip_atomic_fetch_add(p, v, __ATOMIC_RELAXED, __HIP_MEMORY_SCOPE_AGENT); }
__device__ __forceinline__ unsigned xb_xcc_id() { return (unsigned)__builtin_amdgcn_s_getreg((3 << 11) | 20) & 0xFu; }
#define XB_SPIN(cond, bar) do { unsigned _sp = 0; while (cond) { __builtin_amdgcn_s_sleep(1); \
    if ((++_sp & 255u) == 0u) { if (xb_ld(&(bar)[XB_TMO])) break; if (_sp > XB_SPIN_CAP) { atomicAdd(&(bar)[XB_TMO], 1u); break; } } } } while (0)
struct XcdBarrier { unsigned* bar; unsigned x; volatile LAS unsigned* st; };
__device__ __forceinline__ XcdBarrier xcd_barrier_post(unsigned* bar, volatile LAS unsigned* st) {
    XcdBarrier b; b.bar = bar; b.x = xb_xcc_id(); b.st = st;
    if (threadIdx.x == 0) (void)xb_add(&bar[XB_XCNT(b.x)], 1u);
    return b;
}
__device__ __forceinline__ void xcd_barrier_complete(unsigned* bar, unsigned x, unsigned& nloc, unsigned& nx) {
    const unsigned G = gridDim.x * gridDim.y * gridDim.z;
    unsigned sum, cnt, mine, sp = 0u;
    for (;;) {
        sum = 0u; cnt = 0u; mine = 0u;
#pragma unroll
        for (unsigned j = 0; j < 16; ++j) { const unsigned c = xb_ld(&bar[XB_XCNT(j)]); sum += c; cnt += (c > 0u) ? 1u : 0u; mine = (j == x) ? c : mine; }
        if (sum == G) break;
        __builtin_amdgcn_s_sleep(1);
        if ((++sp & 255u) == 0u) { if (xb_ld(&bar[XB_TMO])) break; if (sp > XB_SPIN_CAP) { atomicAdd(&bar[XB_TMO], 1u); break; } }
    }
    nloc = mine > 0u ? mine : 1u; nx = cnt > 0u ? cnt : 1u;
}
__device__ __forceinline__ void xcd_barrier(const XcdBarrier& b) {
    asm volatile("s_waitcnt vmcnt(0)" ::: "memory");
    __syncthreads();
    if (threadIdx.x == 0) {
        unsigned* bar = b.bar; unsigned bx = b.x;
        asm volatile("" : "+s"(bar), "+s"(bx));
        __builtin_amdgcn_s_waitcnt(0);
        unsigned nloc = b.st[0], nx = b.st[1];
        if (nloc == 0u) { xcd_barrier_complete(bar, bx, nloc, nx); b.st[0] = nloc; b.st[1] = nx; }
        const unsigned old = xb_add(&bar[XB_XSUB(bx)], 1u);
        const unsigned gen = old / nloc;
        if (old + 1u == (gen + 1u) * nloc) {
            __builtin_amdgcn_fence(__ATOMIC_RELEASE, "agent");
            asm volatile("s_waitcnt vmcnt(0)" ::: "memory");
            const unsigned og = xb_add(&bar[XB_TOP], 1u);
            const unsigned tg = og / nx;
            if (og + 1u == (tg + 1u) * nx) xb_add(&bar[XB_TOPGEN], 1u);
            else XB_SPIN(xb_ld(&bar[XB_TOPGEN]) == tg, bar);
            __builtin_amdgcn_fence(__ATOMIC_ACQUIRE, "agent");
            xb_add(&bar[XB_XGEN(bx)], 1u);
            asm volatile("s_waitcnt vmcnt(0)" ::: "memory");
        } else {
            XB_SPIN(xb_ld(&bar[XB_XGEN(bx)]) == gen, bar);
            __builtin_amdgcn_fence(__ATOMIC_ACQUIRE, "agent");
            asm volatile("s_waitcnt vmcnt(0)" ::: "memory");
        }
    }
    __syncthreads();
}

__device__ __forceinline__ void bg_cvt(unsigned char* ws, LAS unsigned char* lds, int wave, int lane, volatile LAS unsigned* flag) {
    const InP in = kin(); LAS float* scr = (LAS float*)(lds + wave * CVT_SCR); volatile LAS unsigned* cur = flag + 1;
    const unsigned c = blockIdx.x, G = gridDim.x;
    for (;;) {
        if (*flag != 0u) break;
        if (*cur * G + c >= (unsigned)IT_BG) break;
        unsigned k = 0u; if (lane == 0) k = __hip_atomic_fetch_add((LAS unsigned*)cur, 1u, __ATOMIC_RELAXED, __HIP_MEMORY_SCOPE_WORKGROUP); k = (unsigned)__builtin_amdgcn_readfirstlane((int)k);
        const unsigned it = k * G + c; if (it >= (unsigned)IT_BG) break;
        cvt_item(in, ws, bg_item((int)it), scr, lane);
    }
}
__device__ __forceinline__ void xcd_barrier_bg(const XcdBarrier& b, unsigned char* ws, LAS unsigned char* lds, volatile LAS unsigned* flag) {
    asm volatile("s_waitcnt vmcnt(0)" ::: "memory");
    if (threadIdx.x == 0) *flag = 0u;
    __syncthreads();
    const int wave = __builtin_amdgcn_readfirstlane((int)threadIdx.x >> 6), lane = threadIdx.x & 63;
    if (wave != 0) { bg_cvt(ws, lds, wave, lane, flag); asm volatile("s_waitcnt vmcnt(0)" ::: "memory"); }
    else if (threadIdx.x == 0) {
        unsigned* bar = b.bar; unsigned bx = b.x;
        asm volatile("" : "+s"(bar), "+s"(bx));
        __builtin_amdgcn_s_waitcnt(0);
        unsigned nloc = b.st[0], nx = b.st[1];
        if (nloc == 0u) { xcd_barrier_complete(bar, bx, nloc, nx); b.st[0] = nloc; b.st[1] = nx; }
        const unsigned old = xb_add(&bar[XB_XSUB(bx)], 1u);
        const unsigned gen = old / nloc;
        if (old + 1u == (gen + 1u) * nloc) {
            __builtin_amdgcn_fence(__ATOMIC_RELEASE, "agent");
            asm volatile("s_waitcnt vmcnt(0)" ::: "memory");
            const unsigned og = xb_add(&bar[XB_TOP], 1u);
            const unsigned tg = og / nx;
            if (og + 1u == (tg + 1u) * nx) xb_add(&bar[XB_TOPGEN], 1u);
            else XB_SPIN(xb_ld(&bar[XB_TOPGEN]) == tg, bar);
            __builtin_amdgcn_fence(__ATOMIC_ACQUIRE, "agent");
            xb_add(&bar[XB_XGEN(bx)], 1u);
            asm volatile("s_waitcnt vmcnt(0)" ::: "memory");
        } else {
            XB_SPIN(xb_ld(&bar[XB_XGEN(bx)]) == gen, bar);
            __builtin_amdgcn_fence(__ATOMIC_ACQUIRE, "agent");
            asm volatile("s_waitcnt vmcnt(0)" ::: "memory");
        }
        *flag = 1u;
    }
    __syncthreads();
}

struct Frame { unsigned char* ws; float* out; LAS unsigned char* lds; int bid, G; };
#define TID_LANE_WAVE const int tid = threadIdx.x, lane = tid & 63, wave = __builtin_amdgcn_readfirstlane(tid >> 6); (void)tid; (void)lane; (void)wave

__device__ __forceinline__ void ph_prologue(const Frame& F) {
    TID_LANE_WAVE;
    const InP in = kin(); unsigned char* ws = opq(F.ws);
    LAS float* sc = (LAS float*)F.lds; LAS float* red = (LAS float*)(F.lds + 32768);
    __syncthreads();
    if (F.bid < ADA_ITEMS) {
        for (int i = tid; i < 8 * 1024; i += 512) sc[i] = siluf(in->c[i]);
        __syncthreads();
        for (int it = F.bid; it < ADA_ITEMS; it += F.G) ada_item(in, (float*)(ws + WS_MODS), it, sc, red, tid);
    }
    __syncthreads();
    LAS float* scr = (LAS float*)(F.lds + wave * CVT_SCR);
    const int gw = F.bid * 8 + wave, ngw = F.G * 8;
    for (int it = gw; it < IT_FG; it += ngw) cvt_item(in, ws, fg_item(it), scr, lane);
    bf16_t* wsb = (bf16_t*)(ws + WS_WS);
    for (int i = F.bid * 512 + tid; i < 8 * 128 * 128; i += F.G * 512) { const int s = i & 127, t = (i >> 7) & 127; wsb[i] = (bf16_t)f2bf(s <= t ? in->w_s[i] : 0.f); }
}
__device__ __forceinline__ void ph_norm0(const Frame& F) {
    TID_LANE_WAVE; const InP in = kin(); unsigned char* ws = opq(F.ws); const int gw = F.bid * 8 + wave, ngw = F.G * 8;
    const float* mods = (const float*)(ws + WS_MODS);
    for (int r = gw; r < T; r += ngw) { const int b = r / SEQ;
        row4_norm_mod_store(in->x + (size_t)r * DM, in->norm_mix_g, mods + (size_t)b * 6144 + 0, mods + (size_t)b * 6144 + 1024, ws + WS_XN8 + (size_t)r * DM, lane); }
}
__device__ __forceinline__ void ph_norm_router(const Frame& F, int L) {
    TID_LANE_WAVE; const InP in = kin(); unsigned char* ws = opq(F.ws);
    LAS u32x4* WPB = (LAS u32x4*)F.lds;
    LAS float* lg = (LAS float*)(F.lds + 131072) + wave * 512;
    LAS int* hist = (LAS int*)(F.lds + 131072 + 16384);
    LAS float* rs_s = (LAS float*)(F.lds + 131072 + 16384 + 256) + wave * 16;
    LAS float* pb = (LAS float*)(F.lds + 131072);
    LAS float* rbl = (LAS float*)(F.lds + 131072 + 16384 + 256 + 512);
    const float* mods = (const float*)(ws + WS_MODS) + (size_t)L * 8 * 6144;
    const bf16_t* XR = (const bf16_t*)(ws + WS_XR);
    for (int grp = F.bid; grp < 256; grp += F.G) {
        const int b = grp >> 5; const float* gsc = mods + (size_t)b * 6144 + 4096; const float* gg = in->norm_ffn_g + L * 1024; const float* rw = in->router_w + (size_t)L * 1024 * 32;
        __syncthreads();
        float bpart = 0.f; const float* gsh = mods + (size_t)b * 6144 + 3072;
#pragma unroll 4
        for (int cidx = tid; cidx < 32 * 2 * 64; cidx += 512) { const int l = cidx & 63, hh = (cidx >> 6) & 1, s2 = cidx >> 7, e = 16 * hh + (l & 15), k0 = 32 * s2 + 8 * (l >> 4);
            unsigned hi[4], lo[4];
#pragma unroll
            for (int h2 = 0; h2 < 2; ++h2) { const f32x4 g4 = *(const f32x4*)(gg + k0 + 4 * h2), s4 = *(const f32x4*)(gsc + k0 + 4 * h2), h4 = *(const f32x4*)(gsh + k0 + 4 * h2); float wv[4];
#pragma unroll
                for (int q = 0; q < 4; ++q) { const float r_ = rw[(k0 + 4 * h2 + q) * 32 + e]; wv[q] = g4[q] * (1.f + s4[q]) * r_; bpart += h4[q] * r_; }
#pragma unroll
                for (int q = 0; q < 4; q += 2) { const unsigned a0 = f2bf(wv[q]), a1 = f2bf(wv[q + 1]); hi[2 * h2 + (q >> 1)] = a0 | (a1 << 16);
                    lo[2 * h2 + (q >> 1)] = f2bf(wv[q] - __uint_as_float(a0 << 16)) | (f2bf(wv[q + 1] - __uint_as_float(a1 << 16)) << 16); } }
            WPB[((s2 * 2 + 0) * 2 + hh) * 64 + l] = (u32x4){hi[0], hi[1], hi[2], hi[3]}; WPB[((s2 * 2 + 1) * 2 + hh) * 64 + l] = (u32x4){lo[0], lo[1], lo[2], lo[3]}; }
        pb[tid] = bpart;
        if (tid < 32) hist[tid] = 0;
        __syncthreads();
        if (tid < 32) { float t = in->router_b[L * 32 + tid];
#pragma unroll
            for (int p = 0; p < 16; ++p) t += pb[((p >> 2) << 7) | ((tid >> 4) << 6) | ((p & 3) << 4) | (tid & 15)];
            rbl[tid] = t; }
        __syncthreads();
        const int r0 = grp * 128 + wave * 16, j = lane & 15, kq = lane >> 4;
        {
            const bf16_t* xrow = XR + (size_t)(r0 + j) * DM + 8 * kq;
            f32x4 acc0 = {0.f, 0.f, 0.f, 0.f}, acc1 = {0.f, 0.f, 0.f, 0.f}; float ssq = 0.f;
#pragma unroll 16
            for (int s2 = 0; s2 < 32; ++s2) {
                const u32x4 xw = *(const u32x4*)(xrow + 32 * s2); f32x4 xa, xb; bf8_to_f32(xw, xa, xb);
                ssq += ((xa.x * xa.x + xa.y * xa.y) + (xa.z * xa.z + xa.w * xa.w)) + ((xb.x * xb.x + xb.y * xb.y) + (xb.z * xb.z + xb.w * xb.w));
                const bf16x8 xf = __builtin_bit_cast(bf16x8, xw);
#pragma unroll
                for (int pc = 0; pc < 2; ++pc) { const bf16x8 w0 = __builtin_bit_cast(bf16x8, WPB[((s2 * 2 + pc) * 2 + 0) * 64 + lane]), w1 = __builtin_bit_cast(bf16x8, WPB[((s2 * 2 + pc) * 2 + 1) * 64 + lane]);
                    acc0 = __builtin_amdgcn_mfma_f32_16x16x32_bf16(w0, xf, acc0, 0, 0, 0); acc1 = __builtin_amdgcn_mfma_f32_16x16x32_bf16(w1, xf, acc1, 0, 0, 0); }
            }
            ssq += __shfl_xor(ssq, 16); ssq += __shfl_xor(ssq, 32);
            const float rstd = 1.f / sqrtf(ssq * (1.f / 1024.f) + EPS);
            const f32x4 b0 = *(const LAS f32x4*)(rbl + 4 * kq), b1 = *(const LAS f32x4*)(rbl + 16 + 4 * kq);
            *(LAS f32x4*)(lg + j * 32 + 4 * kq) = acc0 * rstd + b0; *(LAS f32x4*)(lg + j * 32 + 16 + 4 * kq) = acc1 * rstd + b1;
            if (kq == 0) rs_s[j] = rstd;
        }
        __builtin_amdgcn_s_waitcnt(0xc07f); asm volatile("" ::: "memory");
        if (lane < 16) {
            float v[32];
#pragma unroll
            for (int q = 0; q < 8; ++q) { const f32x4 t4 = *(const LAS f32x4*)(lg + lane * 32 + 4 * q); v[4 * q] = t4.x; v[4 * q + 1] = t4.y; v[4 * q + 2] = t4.z; v[4 * q + 3] = t4.w; }
            int ti[4]; float tv[4];
#pragma unroll
            for (int p = 0; p < 4; ++p) { float bv = -INFINITY; int bi = 0;
#pragma unroll
                for (int e = 0; e < 32; ++e) { bool ok = v[e] > bv;
#pragma unroll
                    for (int pp = 0; pp < p; ++pp) ok = ok && (ti[pp] != e);
                    if (ok) { bv = v[e]; bi = e; } }
                ti[p] = bi; tv[p] = bv; }
            float tg[4]; float sm = 0.f;
#pragma unroll
            for (int p = 0; p < 4; ++p) { tg[p] = expf(tv[p] - tv[0]); sm += tg[p]; }
            const int r = r0 + lane;
            *(i32x4*)((int*)(ws + WS_TOPE) + r * 4) = (i32x4){ti[0], ti[1], ti[2], ti[3]};
            *(f32x4*)((float*)(ws + WS_TOPG) + r * 4) = (f32x4){tg[0] / sm, tg[1] / sm, tg[2] / sm, tg[3] / sm};
#pragma unroll
            for (int p = 0; p < 4; ++p) __hip_atomic_fetch_add(&hist[ti[p]], 1, __ATOMIC_RELAXED, __HIP_MEMORY_SCOPE_WORKGROUP);
        }
#pragma unroll 4
        for (int i = 0; i < 16; ++i) { const int r = r0 + i; f32x4 v[4], h[4]; row_load_bf(XR + (size_t)r * DM, lane, v);
            row_modnorm(v, rs_s[i], gg, mods + (size_t)b * 6144 + 3072, gsc, lane, h); row_store_fp8(ws + WS_XN8 + (size_t)r * DM, lane, h); }
        __syncthreads();
        if (tid < 32) ((int*)(ws + WS_HIST))[grp * 32 + tid] = hist[tid];
    }
}
__device__ __forceinline__ void ph_list(const Frame& F) {
    TID_LANE_WAVE; unsigned char* ws = opq(F.ws);
    LAS int* tot = (LAS int*)F.lds; LAS int* before = tot + 32; LAS int* pstart = tot + 64; LAS int* se = tot + 128; LAS int* part = tot + 640;
    const int* hist = (const int*)(ws + WS_HIST); const int* tope = (const int*)(ws + WS_TOPE); const float* topg = (const float*)(ws + WS_TOPG);
    int* dest = (int*)(ws + WS_DEST); int* list = (int*)(ws + WS_LIST); float* rowg = (float*)(ws + WS_ROWG); int* blke = (int*)(ws + WS_BLKE);
    for (int w = F.bid; w < 256; w += F.G) {
        __syncthreads();
        const int mye = tope[w * 512 + tid]; se[tid] = mye;
        { const int e = tid & 31, p = tid >> 5; int a = 0, bf = 0;
#pragma unroll 4
            for (int i = p * 16; i < p * 16 + 16; ++i) { const int h = hist[i * 32 + e]; a += h; bf += (i < w) ? h : 0; }
            part[p * 32 + e] = a; part[512 + p * 32 + e] = bf; }
        __syncthreads();
        if (tid < 32) { int a = 0, bf = 0;
#pragma unroll
            for (int p = 0; p < 16; ++p) { a += part[p * 32 + tid]; bf += part[512 + p * 32 + tid]; }
            tot[tid] = a; before[tid] = bf; }
        __syncthreads();
        if (tid == 0) { int p = 0; for (int e = 0; e < 32; ++e) { pstart[e] = p; p += (tot[e] + 255) / 256 * 256; } pstart[32] = p; }
        __syncthreads();
        { int rank = 0;
            for (int i4 = 0; i4 < 128; ++i4) { const i32x4 q = *(const LAS i32x4*)(se + 4 * i4); const int i0 = 4 * i4;
                rank += (q.x == mye && i0 < tid) + (q.y == mye && i0 + 1 < tid) + (q.z == mye && i0 + 2 < tid) + (q.w == mye && i0 + 3 < tid); }
            const int slot = w * 512 + tid, d = pstart[mye] + before[mye] + rank;
            dest[slot] = d; list[d] = slot >> 2; rowg[d] = topg[slot]; }
        if (w < 32) { const int e = w; for (int r = pstart[e] + tot[e] + tid; r < pstart[e + 1]; r += 512) { list[r] = -1; rowg[r] = 0.f; }
            for (int bk = pstart[e] / 256 + tid; bk < pstart[e + 1] / 256; bk += 512) blke[bk] = e; }
        if (w == 32 && tid == 0) blke[MAXBLK] = pstart[32] / 256;
    }
}
__device__ __forceinline__ void ph_combine(const Frame& F, int L) {
    TID_LANE_WAVE; const InP in = kin(); unsigned char* ws = opq(F.ws); float* out = F.out;
    LAS u32x4* WFB = (LAS u32x4*)F.lds;
    LAS float* rs_s = (LAS float*)(F.lds + 65536) + wave * 16;
    LAS float* pb = (LAS float*)(F.lds + 65536 + 1024);
    LAS float* fbl = (LAS float*)(F.lds + 65536 + 1024 + 2048);
    const float* mods = (const float*)(ws + WS_MODS);
    bf16_t* XR = (bf16_t*)(ws + WS_XR); const unsigned char* YB = ws + WS_YB; const int* dest = (const int*)(ws + WS_DEST);
    for (int grp = F.bid; grp < 256; grp += F.G) {
        const int b = grp >> 5, r0 = grp * 128 + wave * 16;
        if (L == 0) {
            __syncthreads();
            const float* ksc = mods + ((size_t)16 + b) * 6144 + 1024; const float* ksh = mods + ((size_t)16 + b) * 6144; float bpart = 0.f;
#pragma unroll 4
            for (int cidx = tid; cidx < 32 * 64; cidx += 512) { const int l = cidx & 63, s2 = cidx >> 6, e = l & 15, k0 = 32 * s2 + 8 * (l >> 4);
                unsigned hi[4], lo[4];
#pragma unroll
                for (int h2 = 0; h2 < 2; ++h2) { const f32x4 g4 = *(const f32x4*)(in->kv_norm_g + k0 + 4 * h2), s4 = *(const f32x4*)(ksc + k0 + 4 * h2), h4 = *(const f32x4*)(ksh + k0 + 4 * h2); float wv[4];
#pragma unroll
                    for (int q = 0; q < 4; ++q) { const float r_ = in->kv_w[(size_t)(k0 + 4 * h2 + q) * 2064 + 2048 + e]; wv[q] = g4[q] * (1.f + s4[q]) * r_; bpart += h4[q] * r_; }
#pragma unroll
                    for (int q = 0; q < 4; q += 2) { const unsigned a0 = f2bf(wv[q]), a1 = f2bf(wv[q + 1]); hi[2 * h2 + (q >> 1)] = a0 | (a1 << 16);
                        lo[2 * h2 + (q >> 1)] = f2bf(wv[q] - __uint_as_float(a0 << 16)) | (f2bf(wv[q + 1] - __uint_as_float(a1 << 16)) << 16); } }
                WFB[(s2 * 2 + 0) * 64 + l] = (u32x4){hi[0], hi[1], hi[2], hi[3]}; WFB[(s2 * 2 + 1) * 64 + l] = (u32x4){lo[0], lo[1], lo[2], lo[3]}; }
            pb[tid] = bpart;
            __syncthreads();
            if (tid < 16) { float t = in->fgate_b[tid];
#pragma unroll
                for (int p = 0; p < 32; ++p) t += pb[(p << 4) | tid];
                fbl[tid] = t; }
            __syncthreads();
        }
        const float* gt = mods + ((size_t)L * 8 + b) * 6144 + 5120;
#pragma unroll 1
        for (int i = 0; i < 16; ++i) {
            const int r = r0 + i; f32x4 v[4]; row_load_bf(XR + (size_t)r * DM, lane, v);
            f32x4 y[4];
#pragma unroll
            for (int j = 0; j < 4; ++j) y[j] = (f32x4){0.f, 0.f, 0.f, 0.f};
            const i32x4 d4 = *(const i32x4*)(dest + r * 4); const int dd[4] = {d4.x, d4.y, d4.z, d4.w};
#pragma unroll
            for (int q = 0; q < 4; ++q) { const unsigned char* yr = YB + (size_t)dd[q] * 1024;
#pragma unroll
                for (int j = 0; j < 2; ++j) { const u32x2 w = ((const u32x2*)yr)[lane + 64 * j]; y[2 * j] += fp8x4_to_f32(w.x); y[2 * j + 1] += fp8x4_to_f32(w.y); } }
#pragma unroll
            for (int j = 0; j < 4; ++j) v[j] = v[j] + row_vec(gt, lane, j) * (1.f / A8_SCALE) * y[j];
            const float rs = row_rstd(v);
            if (L == 1) { f32x4 o4[4];
#pragma unroll
                for (int j = 0; j < 4; ++j) o4[j] = v[j] * rs * row_vec(in->final_g, lane, j);
                row_store_f32(out + (size_t)r * DM, lane, o4);
                continue;
            }
            row_store_bf16(XR + (size_t)r * DM, lane, v);
            f32x4 h[4];
            row_modnorm(v, rs, in->norm_mix_g + 1024, mods + ((size_t)8 + b) * 6144 + 0, mods + ((size_t)8 + b) * 6144 + 1024, lane, h);
            row_store_fp8(ws + WS_XN8 + (size_t)r * DM, lane, h);
            row_modnorm(v, rs, in->kv_norm_g, mods + ((size_t)16 + b) * 6144 + 0, mods + ((size_t)16 + b) * 6144 + 1024, lane, h);
            row_store_fp8(ws + WS_HKV + (size_t)r * DM, lane, h);
            if (lane == 0) rs_s[i] = rs;
        }
        if (L == 0) {
            __builtin_amdgcn_fence(__ATOMIC_RELEASE, "workgroup"); asm volatile("s_waitcnt vmcnt(0) lgkmcnt(0)" ::: "memory"); __builtin_amdgcn_fence(__ATOMIC_ACQUIRE, "workgroup");
            const int j = lane & 15, kq = lane >> 4; const bf16_t* xrow = XR + (size_t)(r0 + j) * DM + 8 * kq;
            f32x4 acc = {0.f, 0.f, 0.f, 0.f};
#pragma unroll 16
            for (int s2 = 0; s2 < 32; ++s2) { const bf16x8 xf = __builtin_bit_cast(bf16x8, __builtin_nontemporal_load((const u32x4*)(xrow + 32 * s2)));
#pragma unroll
                for (int pc = 0; pc < 2; ++pc) acc = __builtin_amdgcn_mfma_f32_16x16x32_bf16(__builtin_bit_cast(bf16x8, WFB[(s2 * 2 + pc) * 64 + lane]), xf, acc, 0, 0, 0); }
            const float rstd = rs_s[j]; const f32x4 fb = *(const LAS f32x4*)(fbl + 4 * kq);
            f32x4 lf;
#pragma unroll
            for (int q = 0; q < 4; ++q) { const float xg = acc[q] * rstd + fb[q]; lf[q] = fminf(xg, 0.f) - log1pf(expf(-fabsf(xg))); }
            *(f32x4*)((float*)(ws + WS_LOGF) + (size_t)(r0 + j) * 16 + 4 * kq) = lf;
        }
    }
}
__device__ __forceinline__ void ph_cumsum(const Frame& F) {
    TID_LANE_WAVE; unsigned char* ws = opq(F.ws); LAS float* wtot = (LAS float*)F.lds;
    for (int bh = F.bid; bh < NB * NH; bh += F.G) {
        const int b = bh >> 4, h = bh & 15;
        const float* lf = (const float*)(ws + WS_LOGF); float v[8]; float run = 0.f;
#pragma unroll
        for (int i = 0; i < 8; ++i) { run += lf[((size_t)b * SEQ + tid * 8 + i) * 16 + h]; v[i] = run; }
        float inc = run;
#pragma unroll
        for (int o = 1; o < 64; o <<= 1) { const float t = __shfl_up(inc, o); if (lane >= o) inc += t; }
        if (lane == 63) wtot[wave] = inc;
        __syncthreads();
        float off = inc - run;
        for (int w8 = 0; w8 < wave; ++w8) off += wtot[w8];
        float* fc = (float*)(ws + WS_FC) + (size_t)bh * SEQ; unsigned long long* g3 = (unsigned long long*)(ws + WS_G3) + (size_t)bh * SEQ;
#pragma unroll
        for (int i = 0; i < 8; ++i) { const float Fv = v[i] + off; fc[tid * 8 + i] = Fv;
            const float g = -Fv * LOG2E; const unsigned b1 = f2bf(g); const float r1 = g - __uint_as_float(b1 << 16); const unsigned b2 = f2bf(r1); const float r2 = r1 - __uint_as_float(b2 << 16); const unsigned b3 = f2bf(r2);
            g3[tid * 8 + i] = (unsigned long long)(b1 | (b2 << 16)) | ((unsigned long long)(b3 | (0x3f80u << 16)) << 32); }
        __syncthreads();
    }
}


typedef short s16x4 __attribute__((ext_vector_type(4)));
__device__ __forceinline__ s16x4 ds_tr16(LAS unsigned char* p) { return __builtin_bit_cast(s16x4, __builtin_amdgcn_ds_read_tr16_b64_v4i16((LAS s16x4*)p)); }
__device__ __forceinline__ void ph_spatial(const Frame& F) {
    const InP in = kin(); unsigned char* ws = opq(F.ws);
    LAS unsigned char* L = F.lds;
    constexpr int VN_STRIDE = 544, WC_STRIDE = 272, OFF_VN = 0, OFF_WC = 128 * VN_STRIDE, OFF_ST = OFF_WC + 128 * WC_STRIDE;
    LAS float* st = (LAS float*)(L + OFF_ST);
    const bf16_t* Z = (const bf16_t*)(ws + WS_Z); unsigned char* GT = ws + WS_GATED; const bf16_t* WSB = (const bf16_t*)(ws + WS_WS);
    for (int ch = F.bid; ch < T / 128; ch += F.G) {
        const int t0 = ch * 128;
        __syncthreads();
        { int tid_ = threadIdx.x; asm volatile("" : "+v"(tid_)); const int lane = tid_ & 63, wave = __builtin_amdgcn_readfirstlane(tid_ >> 6);
#pragma unroll 4
        for (int i = 0; i < 16; ++i) {
            const int tl = wave * 16 + i; const bf16_t* vrow = Z + (size_t)(t0 + tl) * 4096 + 2048;
            float v[32]; float s = 0.f;
#pragma unroll
            for (int j = 0; j < 4; ++j) { const u32x4 w = *(const u32x4*)(vrow + (lane + 64 * j) * 8); const unsigned ww[4] = {w.x, w.y, w.z, w.w};
#pragma unroll
                for (int q = 0; q < 4; ++q) { v[j * 8 + 2 * q] = __uint_as_float(ww[q] << 16); v[j * 8 + 2 * q + 1] = __uint_as_float(ww[q] & 0xffff0000u); } }
#pragma unroll
            for (int q = 0; q < 32; ++q) s += v[q];
            const float mean = wave_sum(s) * (1.f / 2048.f); float qq = 0.f;
#pragma unroll
            for (int q = 0; q < 32; ++q) { const float d = v[q] - mean; qq += d * d; }
            const float rstd = 1.f / sqrtf(wave_sum(qq) * (1.f / 2048.f) + EPS);
            if (lane == 0) { st[2 * tl] = mean; st[2 * tl + 1] = rstd; }
        } }
        u32x4 vw[8], wcw[4];
        { int tid_ = threadIdx.x; asm volatile("" : "+v"(tid_)); const int tid = tid_, c8 = tid & 31;
#pragma unroll
            for (int q = 0; q < 8; ++q) vw[q] = *(const u32x4*)(Z + (size_t)(t0 + (tid >> 5) + 16 * q) * 4096 + 2048 + c8 * 8);
#pragma unroll
            for (int q = 0; q < 4; ++q) { const int cidx = tid + 512 * q, r = cidx >> 4, c16 = cidx & 15; wcw[q] = *(const u32x4*)(WSB + r * 128 + c16 * 8); } }
#pragma unroll 1
        for (int g = 0; g < 8; ++g) {
            int tid_ = threadIdx.x; asm volatile("" : "+v"(tid_));
            const int tid = tid_, lane = tid & 63, wave = __builtin_amdgcn_readfirstlane(tid >> 6), fr = lane & 15, fq = lane >> 4;
            __syncthreads();
#pragma unroll
            for (int q = 0; q < 4; ++q) { const int cidx = tid + 512 * q, r = cidx >> 4, c16 = cidx & 15; *(LAS u32x4*)(L + OFF_WC + r * WC_STRIDE + c16 * 16) = wcw[q]; }
            {
                const int c8 = tid & 31; const float* vg = in->v_g + g * 256 + c8 * 8; const float* vb = in->v_b + g * 256 + c8 * 8;
                const f32x4 g0 = *(const f32x4*)vg, g1 = *(const f32x4*)(vg + 4), b0 = *(const f32x4*)vb, b1 = *(const f32x4*)(vb + 4);
#pragma unroll
                for (int q = 0; q < 8; ++q) { const int s = (tid >> 5) + 16 * q;
                    const u32x4 w = vw[q];
                    const float mean = st[2 * s], rstd = st[2 * s + 1];
                    f32x4 x0 = {__uint_as_float(w.x << 16), __uint_as_float(w.x & 0xffff0000u), __uint_as_float(w.y << 16), __uint_as_float(w.y & 0xffff0000u)};
                    f32x4 x1 = {__uint_as_float(w.z << 16), __uint_as_float(w.z & 0xffff0000u), __uint_as_float(w.w << 16), __uint_as_float(w.w & 0xffff0000u)};
                    x0 = (x0 - mean) * rstd * g0 + b0; x1 = (x1 - mean) * rstd * g1 + b1;
                    u32x4 o; o.x = pk2(x0[0], x0[1]); o.y = pk2(x0[2], x0[3]); o.z = pk2(x1[0], x1[1]); o.w = pk2(x1[2], x1[3]);
                    *(LAS u32x4*)(L + OFF_VN + s * VN_STRIDE + c8 * 16) = o; }
            }
            u32x2 uw[8][2]; float bsv[8];
#pragma unroll
            for (int tb = 0; tb < 8; ++tb) { const int t = 16 * tb + fr; bsv[tb] = in->b_s[g * 128 + t];
#pragma unroll
                for (int db = 0; db < 2; ++db) uw[tb][db] = *(const u32x2*)(Z + (size_t)(t0 + t) * 4096 + 256 * g + 32 * wave + 16 * db + 4 * fq); }
            __syncthreads();
            if (g < 7) { const int c8 = tid & 31;
#pragma unroll
                for (int q = 0; q < 8; ++q) vw[q] = *(const u32x4*)(Z + (size_t)(t0 + (tid >> 5) + 16 * q) * 4096 + 2048 + (g + 1) * 256 + c8 * 8);
#pragma unroll
                for (int q = 0; q < 4; ++q) { const int cidx = tid + 512 * q, r = cidx >> 4, c16 = cidx & 15; wcw[q] = *(const u32x4*)(WSB + (size_t)(g + 1) * 16384 + r * 128 + c16 * 8); } }
            f32x4 acc[8][2];
#pragma unroll
            for (int tb = 0; tb < 8; ++tb) { acc[tb][0] = (f32x4){0.f, 0.f, 0.f, 0.f}; acc[tb][1] = (f32x4){0.f, 0.f, 0.f, 0.f}; }
#pragma unroll
            for (int ks = 0; ks < 4; ++ks) {
                const int s0 = 32 * ks; bf16x8 X[2];
#pragma unroll
                for (int db = 0; db < 2; ++db) { LAS unsigned char* p = L + OFF_VN + (s0 + 4 * fq + (fr >> 2)) * VN_STRIDE + (32 * wave + 16 * db + 4 * (fr & 3)) * 2;
                    const s16x4 lo = ds_tr16(p), hi = ds_tr16(p + 16 * VN_STRIDE);
                    X[db] = (bf16x8){lo[0], lo[1], lo[2], lo[3], hi[0], hi[1], hi[2], hi[3]}; }
#pragma unroll
                for (int tb = 0; tb < 8; ++tb) if (2 * ks <= tb) {
                    LAS unsigned char* p = L + OFF_WC + (16 * tb + fr) * WC_STRIDE + (s0 + 4 * fq) * 2;
                    const u32x2 y0 = *(LAS u32x2*)p, y1 = *(LAS u32x2*)(p + 32);
                    const bf16x8 Y = __builtin_bit_cast(bf16x8, (u32x4){y0.x, y0.y, y1.x, y1.y});
                    acc[tb][0] = __builtin_amdgcn_mfma_f32_16x16x32_bf16(X[0], Y, acc[tb][0], 0, 0, 0);
                    acc[tb][1] = __builtin_amdgcn_mfma_f32_16x16x32_bf16(X[1], Y, acc[tb][1], 0, 0, 0); }
            }
#pragma unroll
            for (int tb = 0; tb < 8; ++tb) { const int t = 16 * tb + fr;
#pragma unroll
                for (int db = 0; db < 2; ++db) { const int dd = 256 * g + 32 * wave + 16 * db + 4 * fq;
                    const u32x2 uwv = uw[tb][db];
                    const f32x4 m = acc[tb][db] + bsv[tb];
                    *(unsigned*)(GT + (size_t)(t0 + t) * 2048 + dd) = pk4_fp8s(__uint_as_float(uwv.x << 16) * m[0], __uint_as_float(uwv.x & 0xffff0000u) * m[1], __uint_as_float(uwv.y << 16) * m[2], __uint_as_float(uwv.y & 0xffff0000u) * m[3]); } }
        }
    }
}

constexpr int NPH = 18;
struct PA { In in; unsigned char* ws; float* out; int ph_lo, ph_hi, li, pad; };
__global__ void __launch_bounds__(512, 2) fwd(PA args) {
    extern __shared__ __attribute__((aligned(16))) unsigned char lds[];
    Frame F; F.ws = args.ws; F.out = args.out; F.lds = (LAS unsigned char*)lds;
    F.bid = blockIdx.x; F.G = gridDim.x;
    LAS unsigned char* ldsl = (LAS unsigned char*)lds;
    volatile LAS unsigned* MISC = (volatile LAS unsigned*)(ldsl + MISC_OFF);
    for (int u = threadIdx.x; u < (LDS_BYTES - LDSCTL_OFF) / 4; u += 512) ((LAS unsigned*)(ldsl + LDSCTL_OFF))[u] = 0u;
    __syncthreads();
    unsigned char* const ws0 = args.ws;
    XcdBarrier bar = xcd_barrier_post((unsigned*)(ws0 + WS_CTL) + CW_BAR + args.li * XCD_BAR_WORDS, MISC + 8);
    const int lo = args.ph_lo, hi = args.ph_hi;
#ifndef PHMASK
#define PHMASK 0x3ffffu
#endif
#define IN(k) (((PHMASK >> (k)) & 1u) && lo <= (k) && (k) < hi)
#define SEAM(k) do { if (lo <= (k) && (k) + 1 < hi) { if ((k) <= 13) xcd_barrier_bg(bar, ws0, ldsl, MISC + 12); else xcd_barrier(bar); } } while (0)
    const int c = (int)blockIdx.x, G = (int)gridDim.x;

    if (IN(0)) { ph_prologue(F); } SEAM(0);
    if (IN(1)) { ph_norm0(F); } SEAM(1);
    if (IN(2)) {
        unsigned char* ws = opq(ws0);
        pg::StaticOrder S; S.init(T / 256, 4096 / 256, G, c);
        pg::SrcPlain<true, true> src{(const char*)(ws + WS_WIN), 1024}; pg::EpGeluZ E{(bf16_t*)(ws + WS_Z), MOE_DESCALE};
        pg::gemm_phase<pg::EpGeluZ, pg::StaticOrder, pg::SrcPlain<true, true>, true>(ldsl, (const char*)(ws + WS_XN8), 512, S, src, E);
    } SEAM(2);
    if (IN(3)) { ph_spatial(F); } SEAM(3);
    if (IN(4)) {
        unsigned char* ws = opq(ws0); const float* mods = (const float*)(ws + WS_MODS);
        pg::StaticOrder S; S.init(T / 256, 1024 / 256, G, c);
        pg::SrcPlain<true, true> src{(const char*)(ws + WS_WOUT), 2048}; pg::EpResid<true> E{kin()->x, (bf16_t*)(ws + WS_XR), mods + 2048, MOE_DESCALE};
        pg::gemm_phase<pg::EpResid<true>, pg::StaticOrder, pg::SrcPlain<true, true>, true>(ldsl, (const char*)(ws + WS_GATED), 1024, S, src, E);
    } SEAM(4);
#define LAYER_MOE(L, P0) \
    if (IN(P0)) { ph_norm_router(F, L); } SEAM(P0); \
    if (IN(P0 + 1)) { if ((P0) == 13) { TID_LANE_WAVE; if (tid == 0) MISC[12] = 0u; __syncthreads(); bg_cvt(ws0, ldsl, wave, lane, MISC + 12); } ph_list(F); } SEAM(P0 + 1); \
    if (IN(P0 + 2)) {     \
        unsigned char* ws = opq(ws0); const int* blke = (const int*)(ws + WS_BLKE); \
        pg::StaticOrder S; S.init(blke[MAXBLK], 8, G, c); \
        pg::SrcMoeA src{(const char*)(ws + WS_W1) + (size_t)L * 32 * 2048 * 1024, (const int*)(ws + WS_LIST), blke, 1024, (const LAS int*)(ldsl + pg::STAGE_BYTES + 8192)}; pg::EpSwiglu E{ws + WS_ACT, kin()->exp_b1 + (size_t)L * 32 * 2048, blke}; \
        pg::gemm_phase<pg::EpSwiglu, pg::StaticOrder, pg::SrcMoeA, true>(ldsl, (const char*)(ws + WS_XN8), 512, S, src, E);     \
    } SEAM(P0 + 2); \
    if (IN(P0 + 3)) {     \
        unsigned char* ws = opq(ws0); const int* blke = (const int*)(ws + WS_BLKE); \
        pg::StaticOrder S; S.init(blke[MAXBLK], 4, G, c); \
        { const int nu = blke[MAXBLK] * 4, mx = (nu + G - 1) / G, mine = c < nu ? (nu - c + G - 1) / G : 0;     \
          if (mine < mx) { const int r8 = (nu % G) >> 3, k = (c >> 3) - r8, nsl = (G >> 3) - r8, d = (k + 1) * 27 / (nsl + 1); for (int i = 0; i < d; ++i) __builtin_amdgcn_s_sleep(16); } } \
        pg::SrcMoeB src{(const char*)(ws + WS_W2) + (size_t)L * 32 * 1024 * 1024, blke, 1024, (const LAS int*)(ldsl + pg::STAGE_BYTES + 8192)}; pg::EpMoeOut E{ws + WS_YB, kin()->exp_b2 + (size_t)L * 32 * 1024, blke, (const float*)(ws + WS_ROWG)}; \
        pg::gemm_phase<pg::EpMoeOut, pg::StaticOrder, pg::SrcMoeB, true>(ldsl, (const char*)(ws + WS_ACT), 512, S, src, E); \
    } SEAM(P0 + 3); \
    if (IN(P0 + 4)) { ph_combine(F, L); } SEAM(P0 + 4);

    LAYER_MOE(0, 5)
    if (IN(10)) {
        unsigned char* ws = opq(ws0);
        ph_cumsum(F);
        pg::StaticOrder S; S.init(T / 256, 2048 / 256, G, c);
        { pg::SrcHeads src{(const char*)(ws + WS_WKV), 1024}; pg::EpHeads<0> E{(bf16_t*)(ws + WS_K), (bf16_t*)(ws + WS_V), kin()->k_norm_g};
          pg::gemm_phase<pg::EpHeads<0>, pg::StaticOrder, pg::SrcHeads, true>(ldsl, (const char*)(ws + WS_HKV), 512, S, src, E); }
        { pg::SrcHeads src{(const char*)(ws + WS_WQG), 1024}; pg::EpHeads<1> E{(bf16_t*)(ws + WS_Q), (bf16_t*)(ws + WS_GS), kin()->q_norm_g};
          pg::gemm_phase<pg::EpHeads<1>, pg::StaticOrder, pg::SrcHeads, true>(ldsl, (const char*)(ws + WS_XN8), 512, S, src, E); }
    } SEAM(10);
    if (IN(11)) {
        unsigned char* ws = opq(ws0);
        static_assert(attn_body::ATTN_LDS_BYTES <= RING_BYTES, "attention LDS");
        const attn_body::AttnTensors AT{(const attn_body::bf16*)(ws + WS_Q), (const attn_body::bf16*)(ws + WS_K), (const attn_body::bf16*)(ws + WS_V), (const attn_body::bf16*)(ws + WS_GS), (attn_body::bf16*)(ws + WS_O), (const unsigned long long*)(ws + WS_G3), kin()->q_norm_g, kin()->k_norm_g};
        attn_body::attn_phase<8>((char*)lds, AT, G, c);
    } SEAM(11);
    if (IN(12)) {
        unsigned char* ws = opq(ws0); const float* mods = (const float*)(ws + WS_MODS);
        pg::StaticOrder S; S.init(T / 256, 1024 / 256, G, c);
        pg::SrcPlain<true, true> src{(const char*)(ws + WS_WO), 1024}; pg::EpResid<false> E{(const bf16_t*)(ws + WS_XR), (bf16_t*)(ws + WS_XR), mods + 8 * 6144 + 2048, MOE_DESCALE};
        pg::gemm_phase<pg::EpResid<false>, pg::StaticOrder, pg::SrcPlain<true, true>, true>(ldsl, (const char*)(ws + WS_O), 512, S, src, E);
    } SEAM(12);
    LAYER_MOE(1, 13)
#undef LAYER_MOE
#undef IN
#undef SEAM
}

#include <cstring>
extern "C" void kernel_launch(void* const* d_in, const int* in_sizes, int n_in, void* d_out, int out_size, void* d_ws, size_t ws_size, hipStream_t stream) {
    if (n_in != 28 || ws_size < WS_END || out_size != T * DM) { fprintf(stderr, "kernel_launch: unexpected arguments (n_in %d, ws %zu, out %d)\n", n_in, ws_size, out_size); return; }
    static int grid = 0;
    if (grid == 0) {
        int dev = 0, cus = 0, per_cu = 0;
        if (hipGetDevice(&dev) != hipSuccess || hipDeviceGetAttribute(&cus, hipDeviceAttributeMultiprocessorCount, dev) != hipSuccess) { grid = -1; return; }
        if (hipFuncSetAttribute((const void*)fwd, hipFuncAttributeMaxDynamicSharedMemorySize, LDS_BYTES) != hipSuccess) { fprintf(stderr, "kernel_launch: hipFuncSetAttribute failed\n"); grid = -1; return; }
        if (hipOccupancyMaxActiveBlocksPerMultiprocessor(&per_cu, (const void*)fwd, 512, LDS_BYTES) != hipSuccess || per_cu < 1) fprintf(stderr, "kernel_launch: occupancy query says %d\n", per_cu);
        (void)hipGetLastError();
        grid = cus;
    }
    if (grid < 0) return;
    KA a; memset((void*)&a, 0, sizeof(a));
    { const float** p = (const float**)&a.in; for (int i = 0; i < 28; ++i) p[i] = (const float*)d_in[i]; }
    a.ws = (unsigned char*)d_ws; a.out = (float*)d_out;
    PA pa; memset((void*)&pa, 0, sizeof(pa)); pa.in = a.in; pa.ws = a.ws; pa.out = a.out;
    (void)hipMemsetAsync((unsigned char*)d_ws + WS_CTL, 0, 1 * MiB, stream);
    pa.ph_lo = 0; pa.ph_hi = NPH; pa.li = 0;
    hipLaunchKernelGGL(fwd, dim3(grid), dim3(512), LDS_BYTES, stream, pa);
}
```

```cpp
#include <hip/hip_runtime.h>
#include <cstdio>
#include <cstdint>

#define LAS __attribute__((address_space(3)))
#define GAS __attribute__((address_space(1)))
typedef unsigned short bf16_t;
typedef float f32x4 __attribute__((ext_vector_type(4)));
typedef short bf16x8 __attribute__((ext_vector_type(8)));
typedef unsigned u32x4 __attribute__((ext_vector_type(4)));
typedef unsigned u32x2 __attribute__((ext_vector_type(2)));
typedef int i32x4 __attribute__((ext_vector_type(4)));

constexpr int NB = 8, SEQ = 4096, DM = 1024, T = NB * SEQ;
constexpr int GW = 2048, NG = 8, GD = 256, CH = 128;
constexpr int NH = 16, HD = 64;
constexpr int NE = 32, TOPK = 4;
constexpr int MAXBLK = 544, MAXROWS = MAXBLK * 256;
constexpr float EPS = 1e-6f;
constexpr float LOG2E = 1.4426950408889634f;
constexpr float C2 = 0.125f * LOG2E;

constexpr size_t MiB = 1u << 20;
constexpr size_t WS_CTL = 0;
constexpr size_t WS_MODS = 1 * MiB;
constexpr size_t WS_RB2 = 1 * MiB + 3 * 8 * 6144 * 4;
constexpr size_t WS_FB2 = WS_RB2 + 2 * 8 * 32 * 4;
constexpr size_t WS_HIST = 2 * MiB;
constexpr size_t WS_BLKE = 2 * MiB + 65536;
constexpr size_t WS_TOPE = 3 * MiB;
constexpr size_t WS_TOPG = 4 * MiB;
constexpr size_t WS_DEST = 5 * MiB;
constexpr size_t WS_LIST = 6 * MiB;
constexpr size_t WS_ROWG = 7 * MiB;
constexpr size_t WS_VSTAT = 8 * MiB;
constexpr size_t WS_LOGF = 9 * MiB;
constexpr size_t WS_FC = 11 * MiB;
constexpr size_t WS_G3 = 13 * MiB;
constexpr size_t WS_WIN = 32 * MiB;
constexpr size_t WS_WOUT = 40 * MiB;
constexpr size_t WS_WKV = 44 * MiB;
constexpr size_t WS_WQG = 48 * MiB;
constexpr size_t WS_WO = 52 * MiB;
constexpr size_t WS_WS = 54 * MiB;
constexpr size_t WS_W1 = 64 * MiB;
constexpr size_t WS_W2 = 320 * MiB;
constexpr size_t WS_XN = 448 * MiB;
constexpr size_t WS_HKV = 512 * MiB;
constexpr size_t WS_XN8 = 640 * MiB;
constexpr size_t WS_XR = 576 * MiB;
constexpr size_t WS_Z = 704 * MiB;
constexpr size_t WS_GATED = 960 * MiB;
constexpr size_t WS_ACT = 704 * MiB;
constexpr size_t WS_YB = 976 * MiB;
constexpr size_t WS_PKV = 704 * MiB;
constexpr size_t WS_PQG = 960 * MiB;
constexpr size_t WS_Q = 1248 * MiB;
constexpr size_t WS_K = 1312 * MiB;
constexpr size_t WS_V = 1376 * MiB;
constexpr size_t WS_GS = 1440 * MiB;
constexpr size_t WS_O = 1504 * MiB;
constexpr size_t WS_END = 1568 * MiB;

__device__ __forceinline__ float bf2f(bf16_t v) { return __uint_as_float(((unsigned)v) << 16); }
__device__ __forceinline__ unsigned f2bf(float f) { unsigned u = __float_as_uint(f); return (u + 0x7fffu + ((u >> 16) & 1u)) >> 16; }
__device__ __forceinline__ unsigned pk2(float lo, float hi) { return f2bf(lo) | (f2bf(hi) << 16); }
__device__ __forceinline__ float wave_sum(float v) {
#pragma unroll
    for (int o = 1; o < 64; o <<= 1) v += __shfl_xor(v, o);
    return v;
}
__device__ __forceinline__ float siluf(float x) { return x / (1.f + expf(-x)); }
__device__ __forceinline__ float sigmoidf_(float x) { return 1.f / (1.f + expf(-x)); }

struct In {
    const float *x, *c, *ada_w, *ada_b, *norm_mix_g, *norm_ffn_g, *w_in, *v_g, *v_b, *w_s, *b_s, *w_out, *kv_ada_w, *kv_ada_b, *kv_norm_g, *kv_w, *k_norm_g, *fgate_b,
        *w_qg, *q_norm_g, *w_o, *router_w, *router_b, *exp_w1, *exp_b1, *exp_w2, *exp_b2, *final_g;
};

typedef const In __attribute__((address_space(4)))* InP;
__device__ __forceinline__ InP kin() { auto p = __builtin_amdgcn_kernarg_segment_ptr(); asm volatile("" : "+s"(p)); return (InP)p; }
__device__ __forceinline__ unsigned char* opq(unsigned char* p) { size_t z = 0; asm volatile("" : "+s"(z)); return p + z; }
struct KA { In in; unsigned char* ws; float* out; int L; int pad; };

__device__ __forceinline__ void transpose_item(const float* W, int K, int N, int ldw, bf16_t* WT, LAS float* scr, int item, int lane) {
    const int nblk = N / 32, kb = item / nblk, nb = item % nblk, k0 = 64 * kb, n0 = 32 * nb;
#pragma unroll 32
    for (int i = 0; i < 32; ++i) { const int kk = 2 * i + (lane >> 5); scr[kk * 33 + (lane & 31)] = W[(size_t)(k0 + kk) * ldw + n0 + (lane & 31)]; }
    __builtin_amdgcn_s_waitcnt(0xc07f); asm volatile("" ::: "memory");
    const int c = lane & 7;
#pragma unroll
    for (int j = 0; j < 4; ++j) { const int n = (lane >> 3) + 8 * j; const LAS float* s = scr + (8 * c) * 33 + n;
        u32x4 o; o.x = pk2(s[0 * 33], s[1 * 33]); o.y = pk2(s[2 * 33], s[3 * 33]); o.z = pk2(s[4 * 33], s[5 * 33]); o.w = pk2(s[6 * 33], s[7 * 33]);
        *(u32x4*)(WT + (size_t)(n0 + n) * K + k0 + 8 * c) = o; }
    __builtin_amdgcn_s_waitcnt(0xc07f); asm volatile("" ::: "memory");
}
__device__ __forceinline__ unsigned pk4_fp8(float a, float b, float c, float d) { int w = 0; w = __builtin_amdgcn_cvt_pk_fp8_f32(a, b, w, false); w = __builtin_amdgcn_cvt_pk_fp8_f32(c, d, w, true); return (unsigned)w; }
constexpr float W8_SCALE = 32.f, A8_SCALE = 4.f, MOE_DESCALE = 1.f / (32.f * 4.f);
__device__ __forceinline__ float a8(float x) { return __builtin_amdgcn_fmed3f(x * A8_SCALE, -448.f, 448.f); }
__device__ __forceinline__ unsigned pk4_fp8s(float a, float b, float c, float d) { return pk4_fp8(a8(a), a8(b), a8(c), a8(d)); }
__device__ __forceinline__ f32x4 fp8x4_to_f32(unsigned w) { const auto lo = __builtin_amdgcn_cvt_pk_f32_fp8((int)w, false), hi = __builtin_amdgcn_cvt_pk_f32_fp8((int)w, true); return (f32x4){lo[0], lo[1], hi[0], hi[1]}; }
constexpr int CVT_SCR = 128 * 33 * 4;
__device__ __forceinline__ void transpose_item_fp8(const float* W, int K, int N, int ldw, unsigned char* WT, LAS float* scr, int item, int lane) {
    const int nblk = N / 32, kb = item / nblk, nb = item % nblk, k0 = 128 * kb, n0 = 32 * nb;
#pragma unroll 64
    for (int i = 0; i < 64; ++i) { const int kk = 2 * i + (lane >> 5); scr[kk * 33 + (lane & 31)] = W[(size_t)(k0 + kk) * ldw + n0 + (lane & 31)]; }
    __builtin_amdgcn_s_waitcnt(0xc07f); asm volatile("" ::: "memory");
    const int n = lane >> 1, hf = lane & 1; const LAS float* sp = scr + (64 * hf) * 33 + n;
#pragma unroll
    for (int q = 0; q < 4; ++q) { u32x4 o;
        o.x = pk4_fp8(sp[(16 * q + 0) * 33] * W8_SCALE, sp[(16 * q + 1) * 33] * W8_SCALE, sp[(16 * q + 2) * 33] * W8_SCALE, sp[(16 * q + 3) * 33] * W8_SCALE);
        o.y = pk4_fp8(sp[(16 * q + 4) * 33] * W8_SCALE, sp[(16 * q + 5) * 33] * W8_SCALE, sp[(16 * q + 6) * 33] * W8_SCALE, sp[(16 * q + 7) * 33] * W8_SCALE);
        o.z = pk4_fp8(sp[(16 * q + 8) * 33] * W8_SCALE, sp[(16 * q + 9) * 33] * W8_SCALE, sp[(16 * q + 10) * 33] * W8_SCALE, sp[(16 * q + 11) * 33] * W8_SCALE);
        o.w = pk4_fp8(sp[(16 * q + 12) * 33] * W8_SCALE, sp[(16 * q + 13) * 33] * W8_SCALE, sp[(16 * q + 14) * 33] * W8_SCALE, sp[(16 * q + 15) * 33] * W8_SCALE);
        *(u32x4*)(WT + (size_t)(n0 + n) * K + k0 + 64 * hf + 16 * q) = o; }
    __builtin_amdgcn_s_waitcnt(0xc07f); asm volatile("" ::: "memory");
}
constexpr int IT_WIN = 8 * 128, IT_WOUT = 16 * 32, IT_WKV = 8 * 64, IT_WQG = 8 * 64, IT_WO = 8 * 32, IT_W1 = 8 * 64  , IT_W2 = 8 * 32;
constexpr int IT_SMALL = IT_WIN + IT_WOUT + IT_WKV + IT_WQG + IT_WO;
constexpr int IT_ALL = IT_SMALL + 64 * IT_W1 + 64 * IT_W2;
constexpr int IT_FG = IT_SMALL + 32 * IT_W1 + 32 * IT_W2, IT_BG = 32 * IT_W1 + 32 * IT_W2;
__host__ __device__ __forceinline__ int fg_item(int i) { return i < IT_SMALL + 32 * IT_W1 ? i : i + 32 * IT_W1; }
__host__ __device__ __forceinline__ int bg_item(int k) { return k < 32 * IT_W1 ? IT_SMALL + 32 * IT_W1 + k : IT_SMALL + 64 * IT_W1 + 32 * IT_W2 + (k - 32 * IT_W1); }
constexpr int CW_CVT = 2048;
__device__ __forceinline__ void cvt_item(InP inp, unsigned char* ws, int it, LAS float* scr, int lane) {
    if (it < IT_WIN) { transpose_item_fp8(inp->w_in, 1024, 4096, 4096, ws + WS_WIN, scr, it, lane); return; } it -= IT_WIN;
    if (it < IT_WOUT) { transpose_item_fp8(inp->w_out, 2048, 1024, 1024, ws + WS_WOUT, scr, it, lane); return; } it -= IT_WOUT;
    if (it < IT_WKV) { transpose_item_fp8(inp->kv_w, 1024, 2048, 2064, ws + WS_WKV, scr, it, lane); return; } it -= IT_WKV;
    if (it < IT_WQG) { transpose_item_fp8(inp->w_qg, 1024, 2048, 2048, ws + WS_WQG, scr, it, lane); return; } it -= IT_WQG;
    if (it < IT_WO) { transpose_item_fp8(inp->w_o, 1024, 1024, 1024, ws + WS_WO, scr, it, lane); return; } it -= IT_WO;
    if (it < 64 * IT_W1) { const int e = it / IT_W1; transpose_item_fp8(inp->exp_w1 + (size_t)e * 1024 * 2048, 1024, 2048, 2048, ws + WS_W1 + (size_t)e * 2048 * 1024, scr, it % IT_W1, lane); return; } it -= 64 * IT_W1;
    { const int e = it / IT_W2; transpose_item_fp8(inp->exp_w2 + (size_t)e * 1024 * 1024, 1024, 1024, 1024, ws + WS_W2 + (size_t)e * 1024 * 1024, scr, it % IT_W2, lane); }
}
constexpr int ADA_ITEMS = 96 + 96 + 32;
__device__ __forceinline__ void ada_item(InP inp, float* mods, int item, const LAS float* sc  , LAS float* red  , int tid) {
    const int lane = tid & 63, wave = tid >> 6;
    int which, cg; const float* w; const float* bias; int ldw;
    if (item < 96) { which = 0; cg = item; w = inp->ada_w; bias = inp->ada_b; ldw = 6144; }
    else if (item < 192) { which = 1; cg = item - 96; w = inp->ada_w + (size_t)1024 * 6144; bias = inp->ada_b + 6144; ldw = 6144; }
    else { which = 2; cg = item - 192; w = inp->kv_ada_w; bias = inp->kv_ada_b; ldw = 2048; }
    const int col = cg * 64 + lane;
    float acc[8];
#pragma unroll
    for (int b = 0; b < 8; ++b) acc[b] = 0.f;
    for (int k = wave * 128; k < wave * 128 + 128; ++k) {
        const float wv = w[(size_t)k * ldw + col];
#pragma unroll
        for (int b = 0; b < 8; ++b) acc[b] += sc[b * 1024 + k] * wv;
    }
#pragma unroll
    for (int b = 0; b < 8; ++b) red[(wave * 8 + b) * 64 + lane] = acc[b];
    __syncthreads();
    {
        const int b = tid >> 6; float s = 0.f;
#pragma unroll
        for (int w8 = 0; w8 < 8; ++w8) s += red[(w8 * 8 + b) * 64 + lane];
        mods[((size_t)which * 8 + b) * 6144 + col] = s + bias[col];
    }
    __syncthreads();
}
__device__ __forceinline__ void row_load(const float* xrow, int lane, f32x4 (&v)[4]) {
#pragma unroll
    for (int j = 0; j < 2; ++j) { v[2 * j] = ((const f32x4*)xrow)[2 * lane + 128 * j]; v[2 * j + 1] = ((const f32x4*)xrow)[2 * lane + 128 * j + 1]; }
}
__device__ __forceinline__ void bf8_to_f32(u32x4 w, f32x4& a, f32x4& b) {
    a = (f32x4){__uint_as_float(w.x << 16), __uint_as_float(w.x & 0xffff0000u), __uint_as_float(w.y << 16), __uint_as_float(w.y & 0xffff0000u)};
    b = (f32x4){__uint_as_float(w.z << 16), __uint_as_float(w.z & 0xffff0000u), __uint_as_float(w.w << 16), __uint_as_float(w.w & 0xffff0000u)};
}
__device__ __forceinline__ void row_load_bf(const bf16_t* xrow, int lane, f32x4 (&v)[4]) {
#pragma unroll
    for (int j = 0; j < 2; ++j) bf8_to_f32(((const u32x4*)xrow)[lane + 64 * j], v[2 * j], v[2 * j + 1]);
}
__device__ __forceinline__ float row_rstd(const f32x4 (&v)[4]) {
    float s = 0.f;
#pragma unroll
    for (int j = 0; j < 4; ++j) s += (v[j].x * v[j].x + v[j].y * v[j].y) + (v[j].z * v[j].z + v[j].w * v[j].w);
    return 1.f / sqrtf(wave_sum(s) * (1.f / 1024.f) + EPS);
}
__device__ __forceinline__ f32x4 row_vec(const float* p, int lane, int q) { return ((const f32x4*)p)[2 * lane + 128 * (q >> 1) + (q & 1)]; }
__device__ __forceinline__ void row_modnorm(const f32x4 (&v)[4], float rstd, const float* g, const float* sh, const float* sc, int lane, f32x4 (&h)[4]) {
#pragma unroll
    for (int q = 0; q < 4; ++q) h[q] = (v[q] * rstd * row_vec(g, lane, q)) * (1.f + row_vec(sc, lane, q)) + row_vec(sh, lane, q);
}
__device__ __forceinline__ void row_store_bf16(bf16_t* orow, int lane, const f32x4 (&h)[4]) {
#pragma unroll
    for (int j = 0; j < 2; ++j) { u32x4 w; w.x = pk2(h[2 * j].x, h[2 * j].y); w.y = pk2(h[2 * j].z, h[2 * j].w); w.z = pk2(h[2 * j + 1].x, h[2 * j + 1].y); w.w = pk2(h[2 * j + 1].z, h[2 * j + 1].w);
        ((u32x4*)orow)[lane + 64 * j] = w; }
}

__device__ __forceinline__ void row_store_fp8(unsigned char* orow, int lane, const f32x4 (&h)[4]) {
#pragma unroll
    for (int j = 0; j < 2; ++j) { u32x2 w; w.x = pk4_fp8s(h[2 * j].x, h[2 * j].y, h[2 * j].z, h[2 * j].w);
        w.y = pk4_fp8s(h[2 * j + 1].x, h[2 * j + 1].y, h[2 * j + 1].z, h[2 * j + 1].w); ((u32x2*)orow)[lane + 64 * j] = w; }
}
__device__ __forceinline__ void row4_norm_mod_store(const float* xrow, const float* g, const float* sh, const float* sc, unsigned char* orow, int lane) {
    f32x4 v[4]; float s = 0.f;
#pragma unroll
    for (int j = 0; j < 4; ++j) { v[j] = ((const f32x4*)xrow)[lane + 64 * j]; s += (v[j].x * v[j].x + v[j].y * v[j].y) + (v[j].z * v[j].z + v[j].w * v[j].w); }
    const float rstd = 1.f / sqrtf(wave_sum(s) * (1.f / 1024.f) + EPS);
#pragma unroll
    for (int j = 0; j < 4; ++j) { const f32x4 gg = ((const f32x4*)g)[lane + 64 * j], s1 = ((const f32x4*)sc)[lane + 64 * j], s0 = ((const f32x4*)sh)[lane + 64 * j];
        const f32x4 h = (v[j] * rstd * gg) * (1.f + s1) + s0; ((unsigned*)orow)[lane + 64 * j] = pk4_fp8s(h.x, h.y, h.z, h.w); }
}
__device__ __forceinline__ void row_store_f32(float* orow, int lane, const f32x4 (&h)[4]) {
#pragma unroll
    for (int j = 0; j < 2; ++j)
#pragma unroll
        for (int sq = 0; sq < 2; ++sq) { const int src = 32 * sq + (lane >> 1); f32x4 a, c;
#pragma unroll
            for (int i = 0; i < 4; ++i) { a[i] = __shfl(h[2 * j][i], src); c[i] = __shfl(h[2 * j + 1][i], src); }
            ((f32x4*)orow)[128 * j + 64 * sq + lane] = (lane & 1) ? c : a; }
}

__device__ __forceinline__ void route_row(const LAS float* hs  , const float* rw, const float* rb, int lane, int (&te)[4], float (&tg)[4]) {
    const int e = lane & 31, half = lane >> 5; float acc = 0.f;
    for (int k = half * 512; k < half * 512 + 512; ++k) acc += hs[k] * rw[k * 32 + e];
    acc += __shfl_xor(acc, 32);
    float val = acc + rb[e];
    float tv[4];
#pragma unroll
    for (int q = 0; q < 4; ++q) {
        float bv = val; int bi = e;
#pragma unroll
        for (int o = 1; o < 32; o <<= 1) { const float ov = __shfl_xor(bv, o); const int oi = __shfl_xor(bi, o); if (ov > bv || (ov == bv && oi < bi)) { bv = ov; bi = oi; } }
        te[q] = bi; tv[q] = bv; if (e == bi) val = -INFINITY;
    }
    float s = 0.f;
#pragma unroll
    for (int q = 0; q < 4; ++q) { tg[q] = expf(tv[q] - tv[0]); s += tg[q]; }
#pragma unroll
    for (int q = 0; q < 4; ++q) tg[q] /= s;
}

namespace pg {
constexpr int BM = 256, BK = 64, HALF = 128, HTB = HALF * BK * 2  , STAGE_BYTES = 8 * HTB, NXCD = 8, WGM = 8;
__host__ __device__ __forceinline__ int lds_byte(int r, int c) { const int st = (r >> 4) * 2 + (c >> 5), rr = r & 15, cc = c & 31, ob = rr * 64 + cc * 2; return st * 1024 + (ob ^ (((ob >> 9) & 1) << 5)); }
__host__ __device__ __forceinline__ void stage_rc(int b, int& R, int& C) { const int st = b / 1024, sb = b % 1024, swz = sb ^ (((sb >> 9) & 1) << 5); R = (st >> 1) * 16 + swz / 64; C = (st & 1) * 32 + (swz % 64) / 2; }
__host__ __device__ __forceinline__ int perm32(int rho) { const int n = rho >> 4, i = rho & 15; return 8 * (i >> 2) + 4 * n + (i & 3); }
struct Unit { int pm, pn, e; };
struct NoPre {};
struct StaticOrder {
    int nM, nN, nwg, G, c;
    __device__ void init(int nM_, int nN_, int G_, int c_) { nM = nM_; nN = nN_; nwg = nM * nN; G = G_; c = c_; }
    __device__ bool next(int i, Unit& u) const {
        const long L = (long)i * G + c; if (L >= nwg) return false;
        int wgid = (int)L; { const int q = nwg / NXCD, r = nwg % NXCD, xcd = wgid % NXCD, off = wgid / NXCD; wgid = (xcd < r ? xcd * (q + 1) : r * (q + 1) + (xcd - r) * q) + off; }
        const int nig = WGM * nN, gid = wgid / nig, fm = gid * WGM, gsz = (nM - fm) < WGM ? (nM - fm) : WGM;
        u.pm = fm + ((wgid % nig) % gsz); u.pn = (wgid % nig) / gsz; return true;
    }
};
typedef float f32x2 __attribute__((ext_vector_type(2)));
typedef __bf16 bf16x2v __attribute__((ext_vector_type(2)));
__device__ __forceinline__ unsigned cvt_pk_bf16(float lo, float hi) { const f32x2 v = {lo, hi}; return __builtin_bit_cast(unsigned, __builtin_convertvector(v, bf16x2v)); }
typedef int v8i32 __attribute__((ext_vector_type(8)));
typedef int v4i32 __attribute__((ext_vector_type(4)));
__device__ __forceinline__ f32x2 gelu_pk(f32x2 v) {
    const f32x2 av = __builtin_elementwise_abs(v), d = av * 0.2316418882f + 1.0f;
    f32x2 t; t.x = __builtin_amdgcn_rcpf(d.x); t.y = __builtin_amdgcn_rcpf(d.y);
    f32x2 q = t * 0.5307027145f + (-0.7265760135f); q = q * t + 0.7107068705f; q = q * t + (-0.142248368f); q = q * t + 0.127414796f; q = q * t;
    const f32x2 s = (v * v) * (-0.72134752044f);
    f32x2 e; e.x = __builtin_amdgcn_exp2f(s.x); e.y = __builtin_amdgcn_exp2f(s.y);
    const f32x2 m = v * (q * e), r = v - m;
    f32x2 o; o.x = v.x < 0.f ? m.x : r.x; o.y = v.y < 0.f ? m.y : r.y; return o;
}
__device__ __forceinline__ float fast_sigmoid(float x) { return __builtin_amdgcn_rcpf(1.f + __builtin_amdgcn_exp2f(-LOG2E * x)); }

template <bool PERM, bool F8 = false> struct SrcPlain { const char* B; int K2; static constexpr bool FP8 = F8, TAB = false;
    __device__ __forceinline__ void fill(Unit& u) const { u.e = 0; }
    __device__ __forceinline__ unsigned arow_off(const Unit& u, int h, int R) const { return (unsigned)(u.pm * BM + h * HALF + R) * (unsigned)K2; }
    __device__ __forceinline__ const char* bhalf(const Unit& u, int h) const { return B + (size_t)(u.pn * BM + h * HALF) * K2; }
    static __device__ __forceinline__ int brow(int R) { return PERM ? ((R & ~31) + perm32(R & 31)) : R; } };
struct SrcHeads { const char* B; int K2; static constexpr bool FP8 = true, TAB = false;
    __device__ __forceinline__ void fill(Unit& u) const { u.e = 0; }
    __device__ __forceinline__ unsigned arow_off(const Unit& u, int h, int R) const { return (unsigned)(u.pm * BM + h * HALF + R) * (unsigned)K2; }
    __device__ __forceinline__ const char* bhalf(const Unit& u, int h) const { return B + (size_t)(u.pn * BM + h * 32) * K2; }
    static __device__ __forceinline__ int brow(int R) { return 64 * (R >> 5) + perm32(R & 31); } };
struct SrcMoeA { const char* W1; const int* list; const int* blke; int K2; const LAS int* tab; static constexpr bool FP8 = true, TAB = true;
    __device__ __forceinline__ unsigned arow_off(const Unit& u, int h, int R) const { int t = list[u.pm * BM + h * HALF + R]; t = t < 0 ? 0 : t; return (unsigned)t * (unsigned)K2; }
    __device__ __forceinline__ void fill(Unit& u) const { u.e = __builtin_amdgcn_readfirstlane(tab[u.pm]); }
    __device__ __forceinline__ const char* bhalf(const Unit& u, int h) const { return W1 + ((size_t)u.e * 2048 + h * 1024 + u.pn * 128) * K2; }
    static __device__ __forceinline__ int brow(int R) { return (R & ~31) + perm32(R & 31); } };
struct SrcMoeB { const char* W2; const int* blke; int K2; const LAS int* tab; static constexpr bool FP8 = true, TAB = true;
    __device__ __forceinline__ unsigned arow_off(const Unit& u, int h, int R) const { return (unsigned)(u.pm * BM + h * HALF + R) * (unsigned)K2; }
    __device__ __forceinline__ void fill(Unit& u) const { u.e = __builtin_amdgcn_readfirstlane(tab[u.pm]); }
    __device__ __forceinline__ const char* bhalf(const Unit& u, int h) const { return W2 + ((size_t)u.e * 1024 + u.pn * BM + h * 8) * K2; }
    static __device__ __forceinline__ int brow(int R) { return 64 * (R >> 5) + 16 * ((R & 15) >> 2) + 4 * ((R >> 4) & 1) + (R & 3); } };

__device__ __forceinline__ u32x4 quad_tr(u32x4 w, int lane) { const int a = ((lane >> 2) + 16 * (lane & 3)) * 4; u32x4 r;
    r.x = (unsigned)__builtin_amdgcn_ds_bpermute(a, (int)w.x); r.y = (unsigned)__builtin_amdgcn_ds_bpermute(a, (int)w.y); r.z = (unsigned)__builtin_amdgcn_ds_bpermute(a, (int)w.z); r.w = (unsigned)__builtin_amdgcn_ds_bpermute(a, (int)w.w); return r; }
struct EpGeluZ { bf16_t* Z; float ds; using Pre = NoPre;
    __device__ __forceinline__ Pre prefetch(const Unit&, int, int, int, int) const { return {}; }
    __device__ __forceinline__ void operator()(const f32x4 (&acc)[2][2][4][2], const Unit& u, int wr, int wc, int fr, int fq, const Pre&) const {
        const int row0 = u.pm * BM + wr * 64 + fr, col0 = u.pn * BM + wc * 32 + 8 * fq;
#pragma unroll
        for (int ai = 0; ai < 2; ++ai)
#pragma unroll
            for (int m = 0; m < 4; ++m) { bf16_t* rowp = Z + (size_t)(row0 + ai * HALF + m * 16) * 4096 + col0;
#pragma unroll
                for (int bj = 0; bj < 2; ++bj) { const f32x4 v0 = acc[ai][bj][m][0] * ds, v1 = acc[ai][bj][m][1] * ds;
                    const f32x2 a = gelu_pk((f32x2){v0[0], v0[1]}), b = gelu_pk((f32x2){v0[2], v0[3]}), c = gelu_pk((f32x2){v1[0], v1[1]}), d = gelu_pk((f32x2){v1[2], v1[3]});
                    u32x4 w; w.x = cvt_pk_bf16(a.x, a.y); w.y = cvt_pk_bf16(b.x, b.y); w.z = cvt_pk_bf16(c.x, c.y); w.w = cvt_pk_bf16(d.x, d.y);
                    *(u32x4*)(rowp + bj * HALF) = w; } }
    } };
template <bool F32BASE> struct EpResid { const void* base; bf16_t* out; const float* gate; float ds; using Pre = NoPre;
    __device__ __forceinline__ Pre prefetch(const Unit&, int, int, int, int) const { return {}; }
    __device__ __forceinline__ void operator()(const f32x4 (&acc)[2][2][4][2], const Unit& u, int wr, int wc, int fr, int fq, const Pre&) const {
        const int b = u.pm >> 4; const float* gt = gate + (size_t)b * 6144; const int col0 = u.pn * BM + wc * 32 + 8 * fq;
        f32x4 gv[2][2];
#pragma unroll
        for (int bj = 0; bj < 2; ++bj)
#pragma unroll
            for (int n = 0; n < 2; ++n) gv[bj][n] = *(const f32x4*)(gt + col0 + bj * HALF + 4 * n) * ds;
#pragma unroll
        for (int ai = 0; ai < 2; ++ai)
#pragma unroll
            for (int m = 0; m < 4; ++m) { const size_t off = (size_t)(u.pm * BM + ai * HALF + wr * 64 + m * 16 + fr) * DM + col0;
#pragma unroll
                for (int bj = 0; bj < 2; ++bj) { f32x4 b0, b1;
                    if constexpr (F32BASE) { b0 = *(const f32x4*)((const float*)base + off + bj * HALF); b1 = *(const f32x4*)((const float*)base + off + bj * HALF + 4); }
                    else bf8_to_f32(*(const u32x4*)((const bf16_t*)base + off + bj * HALF), b0, b1);
                    const f32x4 r0 = b0 + gv[bj][0] * acc[ai][bj][m][0], r1 = b1 + gv[bj][1] * acc[ai][bj][m][1];
                    u32x4 w; w.x = cvt_pk_bf16(r0[0], r0[1]); w.y = cvt_pk_bf16(r0[2], r0[3]); w.z = cvt_pk_bf16(r1[0], r1[1]); w.w = cvt_pk_bf16(r1[2], r1[3]);
                    *(u32x4*)(out + off + bj * HALF) = w; } }
    } };
struct EpSwiglu { unsigned char* act; const float* b1; const int* blke;
    struct Pre { f32x4 bg[2], bl[2]; };
    __device__ __forceinline__ Pre prefetch(const Unit& u, int wr, int wc, int fr, int fq) const { Pre p; const float* bb = b1 + (size_t)u.e * 2048 + u.pn * 128 + wc * 32 + 8 * fq;
#pragma unroll
        for (int n = 0; n < 2; ++n) { p.bg[n] = *(const f32x4*)(bb + 4 * n); p.bl[n] = *(const f32x4*)(bb + 1024 + 4 * n); }
        return p; }
    __device__ __forceinline__ void operator()(const f32x4 (&acc)[2][2][4][2], const Unit& u, int wr, int wc, int fr, int fq, const Pre& pre) const {
        const int col0 = u.pn * 128 + wc * 32 + 8 * fq;
        f32x4 bg[2], bl[2];
#pragma unroll
        for (int n = 0; n < 2; ++n) { bg[n] = pre.bg[n]; bl[n] = pre.bl[n] * A8_SCALE + A8_SCALE; }
#pragma unroll
        for (int ai = 0; ai < 2; ++ai)
#pragma unroll
            for (int m = 0; m < 4; ++m) { const int row = u.pm * BM + ai * HALF + wr * 64 + m * 16 + fr; float a[8];
#pragma unroll
                for (int n = 0; n < 2; ++n) { const f32x4 g4 = acc[ai][0][m][n] * MOE_DESCALE + bg[n], l4 = acc[ai][1][m][n] * (MOE_DESCALE * A8_SCALE) + bl[n];
#pragma unroll
                    for (int j = 0; j < 4; j += 2) {
                        f32x2 g = {fminf(g4[j], 7.f), fminf(g4[j + 1], 7.f)}; f32x2 l = {__builtin_amdgcn_fmed3f(l4[j], -6.f * A8_SCALE, 8.f * A8_SCALE), __builtin_amdgcn_fmed3f(l4[j + 1], -6.f * A8_SCALE, 8.f * A8_SCALE)};
                        const f32x2 x = g * (-1.702f * LOG2E); f32x2 e; e.x = __builtin_amdgcn_exp2f(x.x); e.y = __builtin_amdgcn_exp2f(x.y);
                        const f32x2 d = e + 1.0f; f32x2 r; r.x = __builtin_amdgcn_rcpf(d.x); r.y = __builtin_amdgcn_rcpf(d.y);
                        const f32x2 o = l * (g * r); a[4 * n + j] = o.x; a[4 * n + j + 1] = o.y; } }
                u32x2 w; w.x = pk4_fp8(a[0], a[1], a[2], a[3]); w.y = pk4_fp8(a[4], a[5], a[6], a[7]);
                *(u32x2*)(act + (size_t)row * 1024 + col0) = w; }
    } };
struct EpMoeOut { unsigned char* yb; const float* b2; const int* blke; const float* rowg;
    struct Pre { f32x4 bv[2][2]; float rg[2][4]; };
    __device__ __forceinline__ Pre prefetch(const Unit& u, int wr, int wc, int fr, int fq) const { Pre p; const float* bb = b2 + (size_t)u.e * 1024 + u.pn * BM + wc * 64 + 16 * fq;
#pragma unroll
        for (int bj = 0; bj < 2; ++bj)
#pragma unroll
            for (int n = 0; n < 2; ++n) p.bv[bj][n] = *(const f32x4*)(bb + 8 * bj + 4 * n);
#pragma unroll
        for (int ai = 0; ai < 2; ++ai)
#pragma unroll
            for (int m = 0; m < 4; ++m) p.rg[ai][m] = rowg[u.pm * BM + ai * HALF + wr * 64 + m * 16 + fr];
        return p; }
    __device__ __forceinline__ void operator()(const f32x4 (&acc)[2][2][4][2], const Unit& u, int wr, int wc, int fr, int fq, const Pre& pre) const {
        const int lane = fr + 16 * fq;
        unsigned char* op = yb + (size_t)(u.pm * BM + wr * 64 + (lane >> 2)) * 1024 + u.pn * BM + wc * 64 + 16 * (lane & 3);
#pragma unroll
        for (int ai = 0; ai < 2; ++ai)
#pragma unroll
            for (int m = 0; m < 4; ++m) { const float rg = pre.rg[ai][m]; u32x4 w;
                { const f32x4 v = (acc[ai][0][m][0] * MOE_DESCALE + pre.bv[0][0]) * rg; w.x = pk4_fp8s(v[0], v[1], v[2], v[3]); }
                { const f32x4 v = (acc[ai][0][m][1] * MOE_DESCALE + pre.bv[0][1]) * rg; w.y = pk4_fp8s(v[0], v[1], v[2], v[3]); }
                { const f32x4 v = (acc[ai][1][m][0] * MOE_DESCALE + pre.bv[1][0]) * rg; w.z = pk4_fp8s(v[0], v[1], v[2], v[3]); }
                { const f32x4 v = (acc[ai][1][m][1] * MOE_DESCALE + pre.bv[1][1]) * rg; w.w = pk4_fp8s(v[0], v[1], v[2], v[3]); }
                *(u32x4*)(op + (size_t)(ai * HALF + m * 16) * 1024) = quad_tr(w, lane); }
    } };
template <int MODE> struct EpHeads { bf16_t* o0; bf16_t* o1; const float* g; using Pre = NoPre;
    __device__ __forceinline__ Pre prefetch(const Unit&, int, int, int, int) const { return {}; }
    static __device__ __forceinline__ float sum_fq(float v) {
        auto p = __builtin_amdgcn_permlane16_swap(__float_as_uint(v), __float_as_uint(v), false, false); v = __uint_as_float(p[0]) + __uint_as_float(p[1]);
        auto q = __builtin_amdgcn_permlane32_swap(__float_as_uint(v), __float_as_uint(v), false, false); return __uint_as_float(q[0]) + __uint_as_float(q[1]); }
    __device__ __forceinline__ void operator()(const f32x4 (&acc)[2][2][4][2], const Unit& u, int wr, int wc, int fr, int fq, const Pre&) const {
        const bool first = u.pn < 4; bf16_t* O = first ? o0 : o1; const int colbase = (u.pn & 3) * 256 + wc * 64 + 8 * fq;
        float rr[2][4];
        if (first) {
            f32x4 gv[2][2];
#pragma unroll
            for (int bj = 0; bj < 2; ++bj)
#pragma unroll
                for (int n = 0; n < 2; ++n) gv[bj][n] = *(const f32x4*)(g + 32 * bj + 8 * fq + 4 * n);
#pragma unroll
            for (int ai = 0; ai < 2; ++ai)
#pragma unroll
                for (int m = 0; m < 4; ++m) { float ss = 0.f;
#pragma unroll
                    for (int bj = 0; bj < 2; ++bj)
#pragma unroll
                        for (int n = 0; n < 2; ++n) { const f32x4 x = acc[ai][bj][m][n]; ss += (x[0] * x[0] + x[1] * x[1]) + (x[2] * x[2] + x[3] * x[3]); }
                    rr[ai][m] = ss; }
#pragma unroll
            for (int ai = 0; ai < 2; ++ai)
#pragma unroll
                for (int m = 0; m < 4; ++m) { float r = __builtin_amdgcn_rsqf(sum_fq(rr[ai][m]) * (1.f / 64.f) + EPS * (1.f / (MOE_DESCALE * MOE_DESCALE))); if (MODE == 1) r *= C2; rr[ai][m] = r; }
#pragma unroll
            for (int ai = 0; ai < 2; ++ai)
#pragma unroll
                for (int m = 0; m < 4; ++m) { const int row = u.pm * BM + ai * HALF + wr * 64 + m * 16 + fr;
#pragma unroll
                    for (int bj = 0; bj < 2; ++bj) { const f32x4 v0 = acc[ai][bj][m][0] * rr[ai][m] * gv[bj][0], v1 = acc[ai][bj][m][1] * rr[ai][m] * gv[bj][1];
                        u32x4 w; w.x = cvt_pk_bf16(v0[0], v0[1]); w.y = cvt_pk_bf16(v0[2], v0[3]); w.z = cvt_pk_bf16(v1[0], v1[1]); w.w = cvt_pk_bf16(v1[2], v1[3]);
                        *(u32x4*)(O + (size_t)row * DM + colbase + 32 * bj) = w; } }
        } else {
#pragma unroll
            for (int ai = 0; ai < 2; ++ai)
#pragma unroll
                for (int m = 0; m < 4; ++m) { const int row = u.pm * BM + ai * HALF + wr * 64 + m * 16 + fr;
#pragma unroll
                    for (int bj = 0; bj < 2; ++bj) { f32x4 v[2];
#pragma unroll
                        for (int n = 0; n < 2; ++n) { f32x4 x = acc[ai][bj][m][n] * MOE_DESCALE; if (MODE == 1) { x[0] = fast_sigmoid(x[0]); x[1] = fast_sigmoid(x[1]); x[2] = fast_sigmoid(x[2]); x[3] = fast_sigmoid(x[3]); } v[n] = x; }
                        u32x4 w; w.x = cvt_pk_bf16(v[0][0], v[0][1]); w.y = cvt_pk_bf16(v[0][2], v[0][3]); w.z = cvt_pk_bf16(v[1][0], v[1][1]); w.w = cvt_pk_bf16(v[1][2], v[1][3]);
                        *(u32x4*)(O + (size_t)row * DM + colbase + 32 * bj) = w; } }
        }
    } };

__device__ __forceinline__ f32x4 zero4() { double a, b; asm volatile("v_mov_b64 %0, 0" : "=v"(a)); asm volatile("v_mov_b64 %0, 0" : "=v"(b));
    const f32x2 x = __builtin_bit_cast(f32x2, a), y = __builtin_bit_cast(f32x2, b); return (f32x4){x[0], x[1], y[0], y[1]}; }
template <class Epi, class Sched, class Src, bool ALIGN_EPI>
__device__ __forceinline__ void gemm_phase(LAS unsigned char* lds, const char* Abase, int K, const Sched& S, const Src& src, const Epi& E) {
    int tid_ = threadIdx.x; asm volatile("" : "+v"(tid_));
    const int tid = tid_, wid = __builtin_amdgcn_readfirstlane(tid >> 6), lane = tid & 63, wr = wid >> 2, wc = wid & 3, fr = lane & 15, fq = lane >> 4;
    const int nt = K / BK; constexpr bool PARK = Src::FP8;
    int sR[2], sC[2]; unsigned voffB[2];
#pragma unroll
    for (int i = 0; i < 2; ++i) { stage_rc(tid * 16 + i * 8192, sR[i], sC[i]); voffB[i] = (unsigned)(Src::brow(sR[i]) * K + sC[i]) * 2u; }
    const size_t kstep = (size_t)(BK * 2);
    const unsigned ldsw = (unsigned)wid * 1024u;
    const int aoff = lds_byte(wr * 64 + fr, fq * 8), boff = lds_byte(wc * 32 + fr, fq * 8);
#define PG_SA(b, h) (((b) * 2 + (h)) * HTB)
#define PG_SB(b, h) ((4 + (b) * 2 + (h)) * HTB)
#define PG_STAGE(bufoff, gbase, v0, v1) do { \
        __builtin_amdgcn_global_load_lds((const unsigned*)((const char*)(gbase) + (v0)), (LAS unsigned*)(lds + (bufoff) + ldsw), 16, 0, 0); \
        __builtin_amdgcn_global_load_lds((const unsigned*)((const char*)(gbase) + (v1)), (LAS unsigned*)(lds + (bufoff) + ldsw + 8192), 16, 0, 0); } while (0)
#define PG_LD16(p) (*(const LAS v4i32*)(p))
#define PG_LDA(dst, b, h) do { if constexpr (Src::FP8) { _Pragma("unroll") for (int m = 0; m < 4; ++m) { const v4i32 x0_ = PG_LD16(lds + PG_SA(b, h) + aoff + m * 2048), x1_ = PG_LD16(lds + PG_SA(b, h) + aoff + m * 2048 + 1024); \
            dst##8[m] = __builtin_shufflevector(x0_, x1_, 0, 1, 2, 3, 4, 5, 6, 7); } } else { \
        _Pragma("unroll") for (int m = 0; m < 4; ++m) _Pragma("unroll") for (int k = 0; k < 2; ++k) dst[m][k] = *(const LAS bf16x8*)(lds + PG_SA(b, h) + aoff + m * 2048 + k * 1024); } } while (0)
#define PG_LDB(dst, b, h) do { if constexpr (Src::FP8) { _Pragma("unroll") for (int n = 0; n < 2; ++n) { const v4i32 x0_ = PG_LD16(lds + PG_SB(b, h) + boff + n * 2048), x1_ = PG_LD16(lds + PG_SB(b, h) + boff + n * 2048 + 1024); \
            dst##8[n] = __builtin_shufflevector(x0_, x1_, 0, 1, 2, 3, 4, 5, 6, 7); } } else { \
        _Pragma("unroll") for (int n = 0; n < 2; ++n) _Pragma("unroll") for (int k = 0; k < 2; ++k) dst[n][k] = *(const LAS bf16x8*)(lds + PG_SB(b, h) + boff + n * 2048 + k * 1024); } } while (0)
#define PG_MMA(ai, bj, At, Bt) do { __builtin_amdgcn_s_setprio(1); if constexpr (Src::FP8) { _Pragma("unroll") for (int m = 0; m < 4; ++m) _Pragma("unroll") for (int n = 0; n < 2; ++n) \
        acc[ai][bj][m][n] = __builtin_amdgcn_mfma_scale_f32_16x16x128_f8f6f4(Bt##8[n], At##8[m], acc[ai][bj][m][n], 0, 0, 0, 0x7f7f7f7f, 0, 0x7f7f7f7f); } else { \
        _Pragma("unroll") for (int m = 0; m < 4; ++m) _Pragma("unroll") for (int n = 0; n < 2; ++n) _Pragma("unroll") for (int k = 0; k < 2; ++k) \
        acc[ai][bj][m][n] = __builtin_amdgcn_mfma_f32_16x16x32_bf16(Bt[n][k], At[m][k], acc[ai][bj][m][n], 0, 0, 0); } __builtin_amdgcn_s_setprio(0); } while (0)
#define PG_WAIT_V(n) asm volatile("s_waitcnt vmcnt(" #n ")" ::: "memory")
#define PG_WAIT_L(n) asm volatile("s_waitcnt lgkmcnt(" #n ")" ::: "memory")
#define PG_BAR __builtin_amdgcn_s_barrier()
#define PG_SCHED __builtin_amdgcn_sched_barrier(0)
    Unit cur, nxt; int ui = 0;
    if (!S.next(0, cur)) return;
    if constexpr (Src::TAB) { LAS int* tw = (LAS int*)(lds + STAGE_BYTES + 8192); for (int i = tid; i <= MAXBLK; i += 512) tw[i] = src.blke[i]; __syncthreads(); }
    src.fill(cur); typename Epi::Pre pre;
    f32x4 acc[2][2][4][2];
#pragma unroll
    for (int a = 0; a < 2; ++a)
#pragma unroll
        for (int b = 0; b < 2; ++b)
#pragma unroll
            for (int m = 0; m < 4; ++m)
#pragma unroll
                for (int n = 0; n < 2; ++n) acc[a][b][m][n] = zero4();
    bf16x8 At[4][2], B0[2][2], B1[2][2]; v8i32 At8[4], B08[2], B18[2];
    unsigned vc[2][2], vn[2][2];
#pragma unroll
    for (int h = 0; h < 2; ++h)
#pragma unroll
        for (int i = 0; i < 2; ++i) vc[h][i] = src.arow_off(cur, h, sR[i]) + (unsigned)sC[i] * 2u;
    const char* cB0 = src.bhalf(cur, 0); const char* cB1 = src.bhalf(cur, 1);
    const char* const cA = Abase;
    PG_STAGE(PG_SB(0, 0), cB0, voffB[0], voffB[1]); PG_STAGE(PG_SB(0, 1), cB1, voffB[0], voffB[1]); PG_STAGE(PG_SA(0, 0), cA, vc[0][0], vc[0][1]); PG_STAGE(PG_SA(0, 1), cA, vc[1][0], vc[1][1]);
    if (wr == 1) PG_BAR;
    PG_WAIT_V(2); PG_BAR;
    PG_STAGE(PG_SB(1, 0), cB0 + kstep, voffB[0], voffB[1]); PG_STAGE(PG_SA(1, 0), cA + kstep, vc[0][0], vc[0][1]); PG_STAGE(PG_SB(1, 1), cB1 + kstep, voffB[0], voffB[1]);
    PG_WAIT_V(6); PG_BAR;
    for (;;) {
        const bool has_next = S.next(ui + 1, nxt);
        const char* nB0 = cB0; const char* nB1 = cB1;
#pragma unroll
        for (int h = 0; h < 2; ++h)
#pragma unroll
            for (int i = 0; i < 2; ++i) vn[h][i] = vc[h][i];
        if (has_next) { src.fill(nxt); nB0 = src.bhalf(nxt, 0); nB1 = src.bhalf(nxt, 1);
#pragma unroll
            for (int h = 0; h < 2; ++h)
#pragma unroll
                for (int i = 0; i < 2; ++i) vn[h][i] = src.arow_off(nxt, h, sR[i]) + (unsigned)sC[i] * 2u; }
        asm volatile("" : "+v"(vn[0][0]), "+v"(vn[0][1]), "+v"(vn[1][0]), "+v"(vn[1][1]));
        if constexpr (PARK) { u32x4 pv; pv.x = vn[0][0]; pv.y = vn[0][1]; pv.z = vn[1][0]; pv.w = vn[1][1]; *(LAS u32x4*)(lds + STAGE_BYTES + tid * 16) = pv; }
#pragma unroll 1
        for (int t = 0; t < nt; t += 2) {
            const bool last = (t == nt - 2);
            if constexpr (PARK) { if (last) { int t2 = threadIdx.x; asm volatile("" : "+v"(t2)); pre = E.prefetch(cur, wr, wc, t2 & 15, (t2 & 63) >> 4); } }
            const char* a1 = cA + (size_t)(t + 1) * kstep;
            const char* a2 = last ? cA : cA + (size_t)(t + 2) * kstep; const char* a3 = a2 + kstep;
            const char* b20 = last ? nB0 : cB0 + (size_t)(t + 2) * kstep; const char* b21 = last ? nB1 : cB1 + (size_t)(t + 2) * kstep;
            const char* b30 = b20 + kstep; const char* b31 = b21 + kstep;
            unsigned w00, w01, w10, w11;
            if constexpr (!PARK) { w00 = last ? vn[0][0] : vc[0][0]; w01 = last ? vn[0][1] : vc[0][1]; w10 = last ? vn[1][0] : vc[1][0]; w11 = last ? vn[1][1] : vc[1][1]; }
            if constexpr (Src::FP8) asm volatile("" : "+s"(a1), "+s"(a2), "+s"(a3), "+s"(b20), "+s"(b21), "+s"(b30), "+s"(b31));
            PG_LDB(B0, 0, 0); PG_LDB(B1, 0, 1); PG_SCHED; PG_LDA(At, 0, 0); PG_STAGE(PG_SA(1, 1), a1, vc[1][0], vc[1][1]);
            if constexpr (PARK) { if (last) { const u32x4 pv = *(const LAS u32x4*)(lds + STAGE_BYTES + tid * 16); vc[0][0] = pv.x; vc[0][1] = pv.y; vc[1][0] = pv.z; vc[1][1] = pv.w; }
                w00 = vc[0][0]; w01 = vc[0][1]; w10 = vc[1][0]; w11 = vc[1][1]; }
            PG_WAIT_V(8); PG_WAIT_L(0); PG_BAR; PG_MMA(0, 0, At, B0); PG_MMA(0, 1, At, B1); PG_BAR; PG_SCHED;
            PG_LDA(At, 0, 1); PG_STAGE(PG_SB(0, 0), b20, voffB[0], voffB[1]); PG_STAGE(PG_SB(0, 1), b21, voffB[0], voffB[1]); PG_STAGE(PG_SA(0, 0), a2, w00, w01);
            PG_WAIT_V(8); PG_WAIT_L(0); PG_BAR; PG_MMA(1, 0, At, B0); PG_MMA(1, 1, At, B1); PG_BAR; PG_SCHED;
            PG_LDB(B0, 1, 0); PG_LDB(B1, 1, 1); PG_SCHED; PG_LDA(At, 1, 0); PG_STAGE(PG_SA(0, 1), a2, w10, w11);
            PG_WAIT_V(8); PG_WAIT_L(0); PG_BAR; PG_MMA(0, 0, At, B0); PG_MMA(0, 1, At, B1); PG_BAR; PG_SCHED;
            PG_LDA(At, 1, 1); PG_STAGE(PG_SB(1, 0), b30, voffB[0], voffB[1]); PG_STAGE(PG_SB(1, 1), b31, voffB[0], voffB[1]); PG_STAGE(PG_SA(1, 0), a3, w00, w01);
            PG_WAIT_V(8); PG_WAIT_L(0); PG_BAR; PG_MMA(1, 0, At, B0); PG_MMA(1, 1, At, B1); PG_BAR; PG_SCHED;
        }
        if constexpr (ALIGN_EPI) { if (wr == 0) PG_BAR; }
        if constexpr (PARK) { int t2 = threadIdx.x; asm volatile("" : "+v"(t2)); E(acc, cur, wr, wc, t2 & 15, (t2 & 63) >> 4, pre); }
        else { pre = E.prefetch(cur, wr, wc, fr, fq); E(acc, cur, wr, wc, fr, fq, pre); }
        if (!has_next) break;
#pragma unroll
        for (int a = 0; a < 2; ++a)
#pragma unroll
            for (int b = 0; b < 2; ++b)
#pragma unroll
                for (int m = 0; m < 4; ++m)
#pragma unroll
                    for (int n = 0; n < 2; ++n) acc[a][b][m][n] = zero4();
        cur = nxt; cB0 = nB0; cB1 = nB1; ++ui;
        if constexpr (!PARK) {
#pragma unroll
        for (int h = 0; h < 2; ++h)
#pragma unroll
            for (int i = 0; i < 2; ++i) vc[h][i] = vn[h][i]; }
        if constexpr (ALIGN_EPI) { if (wr == 1) PG_BAR; }
    }
    PG_WAIT_V(0);
    if constexpr (!ALIGN_EPI) { if (wr == 0) PG_BAR; }
    PG_BAR;
#undef PG_SA
#undef PG_SB
#undef PG_STAGE
#undef PG_LDA
#undef PG_LDB
#undef PG_MMA
#undef PG_LD16
#undef PG_WAIT_V
#undef PG_WAIT_L
#undef PG_BAR
#undef PG_SCHED
}
}
#include <hip/hip_bf16.h>
#include <cmath>
namespace attn_body {
using bf16=__hip_bfloat16;
using bf16x8=__attribute__((ext_vector_type(8)))short;
using s16x4=__attribute__((ext_vector_type(4)))short;
using f32x16=__attribute__((ext_vector_type(16)))float;
using u32x4=__attribute__((ext_vector_type(4)))unsigned;
constexpr int BATCH=8,NHEAD=16,SEQ=4096,D=64,DM=NHEAD*D;
constexpr int NW=8,QBLK=32,QB=QBLK*NW,KVBLK=64,NQB=SEQ/QB;
constexpr int ATTN_PITCH=DM, ATTN_UNIT_ROWS=QB;
__device__ __forceinline__ int crow(int r,int hi){return (r&3)+8*(r>>2)+4*hi;}
#define SBAR() __builtin_amdgcn_sched_barrier(0)
__device__ __forceinline__ void cmask(f32x16&p0,f32x16&p1,int jb,int qrel,int hi){
  const float NEG=-INFINITY; int kb=64*jb+4*hi;
  #pragma unroll
  for(int r=0;r<16;++r){int kv=kb+(r&3)+8*(r>>2); if(kv>qrel)p0[r]=NEG; if(kv+32>qrel)p1[r]=NEG;}
}

constexpr int NSLOT=3, SLOTB=8192;
constexpr int LDS_K=0, LDS_V=NSLOT*SLOTB, LDS_WS=2*NSLOT*SLOTB, LDS_OST=LDS_WS+NW*64*4, LDS_GPAD=LDS_OST+NW*4096, LDS_G3=LDS_GPAD+128*8, LDS_BYTES=LDS_G3+SEQ*8;
constexpr float C2_=0.125f*1.4426950408889634f;
__device__ __forceinline__ void glds16(const void*gsrc,unsigned lds_dst){unsigned keep;
  asm volatile("s_mov_b32 %0, m0\n\ts_mov_b32 m0, %2\n\ts_nop 0\n\tglobal_load_lds_dwordx4 %1, off\n\ts_mov_b32 m0, %0":"=&s"(keep):"v"(gsrc),"s"(lds_dst):"memory");}
__device__ __forceinline__ float max3f(float a,float b,float c){float r;asm("v_max3_f32 %0, %1, %2, %3":"=v"(r):"v"(a),"v"(b),"v"(c));return r;}
__device__ __forceinline__ float max2f(float a,float b){float r;asm("v_max_f32_e32 %0, %1, %2":"=v"(r):"v"(a),"v"(b));return r;}
__device__ __forceinline__ float fadd_s(float a,float b){float r;asm("v_add_f32_e32 %0, %1, %2":"=v"(r):"v"(a),"v"(b));return r;}
__device__ __forceinline__ float fsub_s(float a,float b){float r;asm("v_sub_f32_e32 %0, %1, %2":"=v"(r):"v"(a),"v"(b));return r;}
typedef float f32x2_t __attribute__((ext_vector_type(2))); typedef __bf16 bf16x2_t __attribute__((ext_vector_type(2)));
__device__ __forceinline__ unsigned cvtpk_s(float lo,float hi){f32x2_t v={lo,hi};bf16x2_t b=__builtin_convertvector(v,bf16x2_t);return __builtin_bit_cast(unsigned,b);}
#define WAIT_BAR(N) asm volatile("s_waitcnt vmcnt(" #N ") lgkmcnt(0)\n\ts_barrier":::"memory")

__device__ __forceinline__ void qkt(f32x16&p0,f32x16&p1,const char*Kslot,const bf16x8*qr,bf16x8 ka0,bf16x8 ka1,bf16x8 qa,int r32,int hi){
  const char*kb=Kslot+hi*1024+r32*16;
  { const f32x16 z=f32x16{}; p0=__builtin_amdgcn_mfma_f32_32x32x16_bf16(ka0,qa,z,0,0,0); p1=__builtin_amdgcn_mfma_f32_32x32x16_bf16(ka1,qa,z,0,0,0); }
  #pragma unroll
  for(int d0=0;d0<4;++d0){
    const bf16x8 b0=*reinterpret_cast<const bf16x8*>(kb+d0*2048);
    const bf16x8 b1=*reinterpret_cast<const bf16x8*>(kb+d0*2048+512);
    p0=__builtin_amdgcn_mfma_f32_32x32x16_bf16(b0,qr[d0],p0,0,0,0);p1=__builtin_amdgcn_mfma_f32_32x32x16_bf16(b1,qr[d0],p1,0,0,0);}
}
typedef __attribute__((address_space(3))) const char* lds_cptr;
typedef short v4i16_t __attribute__((ext_vector_type(4)));
__device__ __forceinline__ void kload8(bf16x8*kf,lds_cptr kp){
  kf[0]=*(const __attribute__((address_space(3))) bf16x8*)(kp);      kf[1]=*(const __attribute__((address_space(3))) bf16x8*)(kp+512);
  kf[2]=*(const __attribute__((address_space(3))) bf16x8*)(kp+2048); kf[3]=*(const __attribute__((address_space(3))) bf16x8*)(kp+2560);
  kf[4]=*(const __attribute__((address_space(3))) bf16x8*)(kp+4096); kf[5]=*(const __attribute__((address_space(3))) bf16x8*)(kp+4608);
  kf[6]=*(const __attribute__((address_space(3))) bf16x8*)(kp+6144); kf[7]=*(const __attribute__((address_space(3))) bf16x8*)(kp+6656);
}
__device__ __forceinline__ void kload2(bf16x8*kf,lds_cptr kp,int j){ kf[2*j]=*(const __attribute__((address_space(3))) bf16x8*)(kp+j*2048); kf[2*j+1]=*(const __attribute__((address_space(3))) bf16x8*)(kp+j*2048+512); }
__device__ __forceinline__ s16x4 vtr(lds_cptr p){ return __builtin_bit_cast(s16x4,__builtin_amdgcn_ds_read_tr16_b64_v4i16((__attribute__((address_space(3))) v4i16_t*)p)); }
__device__ __forceinline__ float rowmax(const f32x16&p0,const f32x16&p1){
  float a=max3f(p0[0],p0[1],p1[0]),b=max3f(p0[2],p0[3],p1[1]);a=max3f(a,p1[2],p1[3]);
  #pragma unroll
  for(int r=4;r<16;r+=4){a=max3f(a,p0[r],p0[r+1]);b=max3f(b,p0[r+2],p0[r+3]);a=max3f(a,p1[r],p1[r+1]);b=max3f(b,p1[r+2],p1[r+3]);}
  const float m=max2f(a,b);
  auto rr=__builtin_amdgcn_permlane32_swap(__float_as_uint(m),__float_as_uint(m),false,false);
  return max2f(__uint_as_float(rr[0]),__uint_as_float(rr[1]));
}
__device__ __forceinline__ void pv(f32x16*o,int vb,bf16x8 pa0,bf16x8 pa1,bf16x8 pa2,bf16x8 pa3){
  #pragma unroll
  for(int d0=0;d0<2;++d0){s16x4 lo[4],hi[4];
    #pragma unroll
    for(int ks=0;ks<4;++ks){
      asm volatile("ds_read_b64_tr_b16 %0,%1 offset:%c2":"=&v"(lo[ks]):"v"(vb),"i"(d0*4096+ks*1024):"memory");
      asm volatile("ds_read_b64_tr_b16 %0,%1 offset:%c2":"=&v"(hi[ks]):"v"(vb),"i"(d0*4096+ks*1024+512):"memory");}
    asm volatile("s_waitcnt lgkmcnt(0)":::"memory");SBAR();
    #define PK(k) (bf16x8){lo[k][0],lo[k][1],lo[k][2],lo[k][3],hi[k][0],hi[k][1],hi[k][2],hi[k][3]}
    o[d0]=__builtin_amdgcn_mfma_f32_32x32x16_bf16(pa0,PK(0),o[d0],0,0,0);
    o[d0]=__builtin_amdgcn_mfma_f32_32x32x16_bf16(pa1,PK(1),o[d0],0,0,0);
    o[d0]=__builtin_amdgcn_mfma_f32_32x32x16_bf16(pa2,PK(2),o[d0],0,0,0);
    o[d0]=__builtin_amdgcn_mfma_f32_32x32x16_bf16(pa3,PK(3),o[d0],0,0,0);
    #undef PK
  }
}

#ifndef ATTN_STORE16
#define ATTN_STORE16(p,v) (*(u32x4*)(p)=(v))
#endif
template<int THRL> __device__ __forceinline__ void attn_unit(int b,int h,int qb,const bf16*Q,const bf16*__restrict__ K,const bf16*__restrict__ V,const bf16*__restrict__ GATE,bf16*O,char*shm,float skipthr){
  int tid_=threadIdx.x; asm volatile("":"+v"(tid_));
  const int tid=tid_,lane=tid&63,r32=lane&31,hi=lane>>5; const int wid=__builtin_amdgcn_readfirstlane(tid>>6);
  const long rowbase=(long)b*SEQ; const int q0=qb*QB;
  const bf16*Qw=Q+(rowbase+q0+wid*QBLK)*DM+h*D;
  const unsigned lds0=(unsigned)(uintptr_t)shm;
  int tskip;
  { typedef __attribute__((address_space(3))) const unsigned long long* lds_u64q; const lds_u64q gt_=(lds_u64q)((__attribute__((address_space(3))) const char*)shm+LDS_G3);
    const int NT0=(q0+QB)/KVBLK; const unsigned long long e0=gt_[q0], e1=gt_[lane<NT0?64*lane+63:q0];
    const float G0=(__uint_as_float((unsigned)e0<<16)+__uint_as_float((unsigned)e0&0xffff0000u))+__uint_as_float((unsigned)(e0>>32)<<16);
    const float G1=(__uint_as_float((unsigned)e1<<16)+__uint_as_float((unsigned)e1&0xffff0000u))+__uint_as_float((unsigned)(e1>>32)<<16);
    const int ns=__builtin_popcountll(__ballot(lane<NT0 && (G1-G0)<skipthr)); tskip=__builtin_amdgcn_readfirstlane(min(ns&~1,NT0-6)); }
  const bf16*Kh=K+(rowbase+(long)tskip*KVBLK)*DM+h*D,*Vh=V+(rowbase+(long)tskip*KVBLK)*DM+h*D;
  float*wsf=(float*)(shm+LDS_WS)+wid*64;
  const bf16*ksrc=Kh+(long)lane*DM+wid*8;
  const bf16*vsrc=Vh+(long)(16*(wid&3)+(lane>>2))*DM+(wid>>2)*32+(lane&3)*8;
  const unsigned kdst=lds0+LDS_K+wid*1024, vdst=lds0+LDS_V+wid*1024;
  #define DMA_K(t,slot) glds16(ksrc+(long)(t)*KVBLK*DM,(unsigned)__builtin_amdgcn_readfirstlane(kdst+(slot)))
  #define DMA_V(t,slot) glds16(vsrc+(long)(t)*KVBLK*DM,(unsigned)__builtin_amdgcn_readfirstlane(vdst+(slot)))
  const int vb0=(int)(lds0+LDS_V)+((lane>>4)&1)*32+(lane&3)*8+(4*hi+((lane&15)>>2))*64;
  const char*Kbase=shm+LDS_K; bf16x8 kf[8];
  const lds_cptr shm3=(lds_cptr)shm; const lds_cptr kp0=shm3+LDS_K+hi*1024+r32*16; const lds_cptr vp0=shm3+LDS_V+((lane>>4)&1)*32+(lane&3)*8+(4*hi+((lane&15)>>2))*64;
  const int NT=(q0+QB)/KVBLK-tskip;
  DMA_K(0,0);DMA_V(0,0);DMA_K(1,SLOTB);
  bf16x8 qr[4];
  #pragma unroll
  for(int d0=0;d0<4;++d0)qr[d0]=*reinterpret_cast<const bf16x8*>(&Qw[(long)r32*DM+d0*16+hi*8]);
  float mhat=0.f,l_reg=0.f;f32x16 o[2];o[0]=f32x16{};o[1]=f32x16{};
  typedef __attribute__((address_space(3))) const unsigned long long* lds_u64p;
  const lds_u64p g3p=(lds_u64p)(shm3+LDS_G3)+tskip*KVBLK+r32;
  { const unsigned long long e=((lds_u64p)(shm3+LDS_G3))[q0+wid*QBLK+r32]; const unsigned lo_=(unsigned)e,hi_=(unsigned)(e>>32); mhat=(__uint_as_float(lo_<<16)+__uint_as_float(lo_&0xffff0000u))+__uint_as_float(hi_<<16); }
  u32x4 qa; qa.x=hi?0u:0x3f803f80u; qa.y=0u; qa.z=0u; qa.w=0u;
  #define SETREF() do{ const float x_=-mhat; const unsigned b1_=cvtpk_s(x_,0.f)&0xffffu; const float r1_=x_-__uint_as_float(b1_<<16); const unsigned b2_=cvtpk_s(r1_,0.f)&0xffffu; \
      const float r2_=r1_-__uint_as_float(b2_<<16); const unsigned b3_=cvtpk_s(r2_,0.f)&0xffffu; qa.y=hi?0u:(0x3f80u|(b1_<<16)); qa.z=hi?0u:(b2_|(b3_<<16)); asm volatile("":"+v"(qa)); }while(0)
  SETREF();
  unsigned long long ga0,ga1;
  #define GARD(t) do{ ga0=g3p[(t)*64]; ga1=g3p[(t)*64+32]; }while(0)
  #define KAF(g) __builtin_bit_cast(bf16x8,(u32x4){(unsigned)(g),(unsigned)((g)>>32),0x3f803f80u,0u})
  #define QAF() __builtin_bit_cast(bf16x8,qa)
  const int qrel=wid*QBLK+r32;
  #define CMASK(P0,P1,t) do{int jb_=(t)-(NT-4); if(jb_>=0)cmask(P0,P1,jb_,qrel,hi);}while(0)
  bool resc=false;
  #define START(P0,P1) do{ const float rm=rowmax(P0,P1); resc=false; \
    { const float dl=__builtin_fmaxf(rm,0.f); mhat=fadd_s(mhat,dl);     \
      _Pragma("unroll") for(int r=0;r<16;++r){P0[r]=fsub_s(P0[r],dl);P1[r]=fsub_s(P1[r],dl);} \
      SETREF(); } \
    _Pragma("unroll") for(int r=0;r<16;++r)P0[r]=__builtin_amdgcn_exp2f(P0[r]); }while(0)
  #define RESC() do{ if(resc){ asm volatile("s_waitcnt lgkmcnt(0)":::"memory"); \
      _Pragma("unroll") for(int d_=0;d_<2;++d_) _Pragma("unroll") for(int r=0;r<16;++r)o[d_][r]*=wsf[crow(r,hi)]; } }while(0)
  f32x16 pA0,pA1,pB0,pB1;
  int sl_prev=0,sl_cur=0,sl_next=SLOTB;
  #define ROT() do{sl_prev=sl_cur;sl_cur=sl_next;sl_next=(sl_next==(NSLOT-1)*SLOTB)?0:sl_next+SLOTB;}while(0)
  DMA_K(2,2*SLOTB);
  WAIT_BAR(3);
  GARD(0); qkt(pA0,pA1,Kbase,qr,KAF(ga0),KAF(ga1),QAF(),r32,hi);asm volatile("s_nop 15\n\ts_nop 7":"+v"(pA0),"+v"(pA1));CMASK(pA0,pA1,0);
  START(pA0,pA1);
  _Pragma("unroll") for(int r=0;r<16;++r)pA1[r]=__builtin_amdgcn_exp2f(pA1[r]);
  WAIT_BAR(0);
  DMA_K(3,0);DMA_V(1,SLOTB);
  ROT();
  kload8(kf,kp0+sl_cur); GARD(1);
  WAIT_BAR(2);
  s16x4 vlo[8],vhi[8]; u32x4 pw0,pw1,pw2,pw3;
  #define PKW(P,B) cvtpk_s(P[B],P[B+1])
  #define PAF(k) __builtin_bit_cast(bf16x8,pw##k)
  #define VFR(i) (bf16x8){vlo[i][0],vlo[i][1],vlo[i][2],vlo[i][3],vhi[i][0],vhi[i][1],vhi[i][2],vhi[i][3]}
  #define PIN(x) asm volatile("":"+v"(x))
  #define MX3(a,b,c) __builtin_fmaxf(__builtin_fmaxf((a),(b)),(c))
  #define GAPA(MF,A0,A1,A2,A3,W0,W1,PW) do{ MF; sacc+=A0; sacc+=A1; sacc+=A2; sacc+=A3; PIN(sacc); W0; W1; PIN(PW); SBAR(); }while(0)
  #define EX(v) __builtin_amdgcn_exp2f(v)
  #define GAPB(MF,X,B) do{ MF; X[B]=EX(X[B]); X[B+1]=EX(X[B+1]); X[B+2]=EX(X[B+2]); X[B+3]=EX(X[B+3]); PIN(X); SBAR(); }while(0)
  #define VRD(i) do{ vlo[i]=vtr(vp_+(((i)>>2)*4096+((i)&3)*1024)); vhi[i]=vtr(vp_+(((i)>>2)*4096+((i)&3)*1024+512)); }while(0)
  #define KRD(G,j) do{ if(G){ kload2(kf,kp0+sl_next,j); SBAR(); } }while(0)
  #define STEP(C0,C1,P0,P1,t,GK,GV,GL) do{ SBAR(); \
    const lds_cptr vp_=vp0+sl_prev; \
    { const f32x16 z_=f32x16{}; C0=__builtin_amdgcn_mfma_f32_32x32x16_bf16(KAF(ga0),QAF(),z_,0,0,0); C1=__builtin_amdgcn_mfma_f32_32x32x16_bf16(KAF(ga1),QAF(),z_,0,0,0); } SBAR(); \
    VRD(0); SBAR(); float sacc=(P0[0]+P0[1]); \
    GAPA(C0=__builtin_amdgcn_mfma_f32_32x32x16_bf16(kf[0],qr[0],C0,0,0,0), P0[2],P0[3],P0[4],P0[5],     pw0[0]=PKW(P0,0), pw0[1]=PKW(P0,2), pw0); \
    VRD(4); SBAR(); GAPA(C1=__builtin_amdgcn_mfma_f32_32x32x16_bf16(kf[1],qr[0],C1,0,0,0), P0[6],P0[7],P0[8],P0[9],     pw0[2]=PKW(P0,4), pw0[3]=PKW(P0,6), pw0); \
    VRD(1); SBAR(); GAPA(C0=__builtin_amdgcn_mfma_f32_32x32x16_bf16(kf[2],qr[1],C0,0,0,0),   P0[10],P0[11],P0[12],P0[13], pw1[0]=PKW(P0,8), pw1[1]=PKW(P0,10), pw1); \
    VRD(5); SBAR(); GAPA(C1=__builtin_amdgcn_mfma_f32_32x32x16_bf16(kf[3],qr[1],C1,0,0,0),   P0[14],P0[15],P1[0],P1[1],   pw1[2]=PKW(P0,12),pw1[3]=PKW(P0,14), pw1); \
    VRD(2); SBAR(); GAPA(C0=__builtin_amdgcn_mfma_f32_32x32x16_bf16(kf[4],qr[2],C0,0,0,0),   P1[2],P1[3],P1[4],P1[5],     pw2[0]=PKW(P1,0), pw2[1]=PKW(P1,2), pw2); \
    VRD(6); SBAR(); GAPA(C1=__builtin_amdgcn_mfma_f32_32x32x16_bf16(kf[5],qr[2],C1,0,0,0),   P1[6],P1[7],P1[8],P1[9],     pw2[2]=PKW(P1,4), pw2[3]=PKW(P1,6), pw2); \
    VRD(3); SBAR(); GAPA(C0=__builtin_amdgcn_mfma_f32_32x32x16_bf16(kf[6],qr[3],C0,0,0,0),   P1[10],P1[11],P1[12],P1[13], pw3[0]=PKW(P1,8), pw3[1]=PKW(P1,10), pw3); \
    VRD(7); SBAR(); GAPA(C1=__builtin_amdgcn_mfma_f32_32x32x16_bf16(kf[7],qr[3],C1,0,0,0),   P1[14],P1[15],0.f,0.f,       pw3[2]=PKW(P1,12),pw3[3]=PKW(P1,14), pw3); \
    l_reg+=sacc; \
    if(GK){DMA_K((t)+3,sl_cur);} if(GV){DMA_V((t)+1,sl_next);} \
    CMASK(C0,C1,t); \
    { float a=MX3(C0[0],C0[1],C1[0]),b=MX3(C0[2],C0[3],C1[1]); a=MX3(a,C1[2],C1[3]); \
      _Pragma("unroll") for(int r=4;r<16;r+=4){a=MX3(a,C0[r],C0[r+1]);b=MX3(b,C0[r+2],C0[r+3]);a=MX3(a,C1[r],C1[r+1]);b=MX3(b,C1[r+2],C1[r+3]);} \
      float rm=__builtin_fmaxf(a,b); { auto rr=__builtin_amdgcn_permlane32_swap(__float_as_uint(rm),__float_as_uint(rm),false,false); rm=__builtin_fmaxf(__uint_as_float(rr[0]),__uint_as_float(rr[1])); } \
      resc=false; \
      if(__builtin_expect(__any(rm>(float)THRL),0)){ const float dl=__builtin_fmaxf(rm,0.f); mhat+=dl; \
        _Pragma("unroll") for(int r=0;r<16;++r){C0[r]-=dl;C1[r]-=dl;} \
        SETREF(); \
        const float f=__builtin_amdgcn_exp2f(-dl); l_reg*=f; if(hi==0)wsf[r32]=f; resc=true; } } \
    SBAR(); \
    GAPB(o[0]=__builtin_amdgcn_mfma_f32_32x32x16_bf16(PAF(0),VFR(0),o[0],0,0,0), C0,0); \
    GAPB(o[1]=__builtin_amdgcn_mfma_f32_32x32x16_bf16(PAF(0),VFR(4),o[1],0,0,0), C0,4); \
    KRD(GL,0); GAPB(o[0]=__builtin_amdgcn_mfma_f32_32x32x16_bf16(PAF(1),VFR(1),o[0],0,0,0), C0,8); \
    KRD(GL,1); GAPB(o[1]=__builtin_amdgcn_mfma_f32_32x32x16_bf16(PAF(1),VFR(5),o[1],0,0,0), C0,12); \
    KRD(GL,2); GAPB(o[0]=__builtin_amdgcn_mfma_f32_32x32x16_bf16(PAF(2),VFR(2),o[0],0,0,0), C1,0); \
    KRD(GL,3); GAPB(o[1]=__builtin_amdgcn_mfma_f32_32x32x16_bf16(PAF(2),VFR(6),o[1],0,0,0), C1,4); \
    if(GL){ GARD((t)+1); SBAR(); } GAPB(o[0]=__builtin_amdgcn_mfma_f32_32x32x16_bf16(PAF(3),VFR(3),o[0],0,0,0), C1,8); \
    GAPB(o[1]=__builtin_amdgcn_mfma_f32_32x32x16_bf16(PAF(3),VFR(7),o[1],0,0,0), C1,12); \
    }while(0)
  int t=1;
  #undef CMASK
  #define CMASK(P0,P1,t) do{}while(0)
  for(;t+5<NT;t+=2){
    STEP(pB0,pB1,pA0,pA1,t,true,true,true);     WAIT_BAR(2); RESC(); ROT();
    STEP(pA0,pA1,pB0,pB1,t+1,true,true,true);   WAIT_BAR(2); RESC(); ROT();
  }
  #undef CMASK
  #define CMASK(P0,P1,t) do{int jb_=(t)-(NT-4); if(jb_>=0)cmask(P0,P1,jb_,qrel,hi);}while(0)
  #define ENDW(tt) do{ if((tt)+3<NT){WAIT_BAR(2);} else if((tt)+2<NT){WAIT_BAR(1);} else {WAIT_BAR(0);} }while(0)
  #undef CMASK
  #define CMASK(P0,P1,t) do{}while(0)
  STEP(pB0,pB1,pA0,pA1,NT-5,true,true,true);   WAIT_BAR(2); RESC(); ROT();
  #undef CMASK
  #define CMASK(P0,P1,t) cmask(P0,P1,0,qrel,hi)
  STEP(pA0,pA1,pB0,pB1,NT-4,true,true,true);   WAIT_BAR(2); RESC(); ROT();
  #undef CMASK
  #define CMASK(P0,P1,t) cmask(P0,P1,1,qrel,hi)
  STEP(pB0,pB1,pA0,pA1,NT-3,false,true,true);  WAIT_BAR(1); RESC(); ROT();
  #undef CMASK
  #define CMASK(P0,P1,t) cmask(P0,P1,2,qrel,hi)
  STEP(pA0,pA1,pB0,pB1,NT-2,false,true,true);  WAIT_BAR(0); RESC(); ROT();
  #undef CMASK
  #define CMASK(P0,P1,t) cmask(P0,P1,3,qrel,hi)
  STEP(pB0,pB1,pA0,pA1,NT-1,false,false,false); RESC();
  { float sacc=pB0[0]+pB0[1]; _Pragma("unroll") for(int r=2;r<16;++r)sacc+=pB0[r]; _Pragma("unroll") for(int r=0;r<16;++r)sacc+=pB1[r]; l_reg+=sacc;
    pw0=(u32x4){PKW(pB0,0),PKW(pB0,2),PKW(pB0,4),PKW(pB0,6)};pw1=(u32x4){PKW(pB0,8),PKW(pB0,10),PKW(pB0,12),PKW(pB0,14)};pw2=(u32x4){PKW(pB1,0),PKW(pB1,2),PKW(pB1,4),PKW(pB1,6)};pw3=(u32x4){PKW(pB1,8),PKW(pB1,10),PKW(pB1,12),PKW(pB1,14)};
    SBAR(); pv(o,vb0+sl_cur,PAF(0),PAF(1),PAF(2),PAF(3)); }
  #undef PKW
  #undef PAF
  #undef VFR
  #undef PIN
  #undef MX3
  #undef GAPA
  #undef GAPB
  #undef EX
  #undef VRD
  #undef KRD
  #undef STEP
  #undef ENDW
  {auto rr=__builtin_amdgcn_permlane32_swap(__float_as_uint(l_reg),__float_as_uint(l_reg),false,false);l_reg=__uint_as_float(rr[0])+__uint_as_float(rr[1]);}
  if(hi==0)wsf[32+r32]=l_reg;asm volatile("s_waitcnt lgkmcnt(0)":::"memory");
  float rli[16];
  #pragma unroll
  for(int r=0;r<16;++r)rli[r]=__builtin_amdgcn_rcpf(wsf[32+crow(r,hi)]);
  unsigned char*Ow8=(unsigned char*)O+(rowbase+q0+wid*QBLK)*DM+h*D; const bf16*Gw=GATE+(rowbase+q0+wid*QBLK)*DM+h*D;
  { bf16*stg=(bf16*)(shm+LDS_OST)+wid*2048;
    #pragma unroll
    for(int r=0;r<16;++r){const int orow=crow(r,hi);
      #pragma unroll
      for(int d0=0;d0<2;++d0)stg[orow*64+d0*32+r32]=__float2bfloat16(o[d0][r]*rli[r]);}
    asm volatile("s_waitcnt lgkmcnt(0)":::"memory");
    #pragma unroll
    for(int i=0;i<4;++i){const int row=i*8+(lane>>3),ch=lane&7; const u32x4 v=*(const u32x4*)(stg+row*64+ch*8); const u32x4 gv=*(const u32x4*)(Gw+(long)row*DM+ch*8); u32x4 w;
      #define GLO(a,g) (__uint_as_float((a)<<16)*__uint_as_float((g)<<16))
      #define GHI(a,g) (__uint_as_float((a)&0xffff0000u)*__uint_as_float((g)&0xffff0000u))
      u32x2 w8; w8.x=pk4_fp8s(GLO(v.x,gv.x),GHI(v.x,gv.x),GLO(v.y,gv.y),GHI(v.y,gv.y)); w8.y=pk4_fp8s(GLO(v.z,gv.z),GHI(v.z,gv.z),GLO(v.w,gv.w),GHI(v.w,gv.w));
      #undef GLO
      #undef GHI
      (void)w; *(u32x2*)(Ow8+(long)row*DM+ch*8)=w8;} }
  asm volatile("s_waitcnt lgkmcnt(0)\n\ts_barrier":::"memory");
  #undef DMA_K
  #undef DMA_V
  #undef CMASK
  #undef START
  #undef RESC
  #undef ROT
  #undef SETREF
  #undef GARD
  #undef KAF
  #undef QAF
}
constexpr int ATTN_LDS_BYTES=LDS_BYTES;
struct AttnTensors { const bf16* Q; const bf16* K; const bf16* V; const bf16* GATE; bf16* O; const unsigned long long* G3; const float* qg; const float* kg; };
template<int THRL=8> __device__ __forceinline__ void attn_phase(char*lds,const AttnTensors&T,int grid,int block){
  const int v0=(grid%8==0)?(block%8)*(grid/8)+block/8:block;
  float skipthr; { float a=fabsf(T.qg[threadIdx.x&63]),b=fabsf(T.kg[threadIdx.x&63]);
    #pragma unroll
    for(int o=1;o<64;o<<=1){a=fmaxf(a,__shfl_xor(a,o));b=fmaxf(b,__shfl_xor(b,o));}
    const float qkmax=64.f*a*b*C2_*1.05f; skipthr=-(42.f+3.f*qkmax); }
  for(int v=v0;v<BATCH*NHEAD*2;v+=grid){
    const int bh=v>>1,odd=v&1;
    {
      const u32x4*src=(const u32x4*)(T.G3+(size_t)bh*SEQ); u32x4*dst=(u32x4*)(lds+LDS_G3);
      #pragma unroll
      for(int i=0;i<4;++i)dst[threadIdx.x+512*i]=src[threadIdx.x+512*i];
      if(threadIdx.x<128)((unsigned long long*)(lds+LDS_GPAD))[threadIdx.x]=0x3f80000000000000ull|0xc6eaull;
      asm volatile("s_waitcnt vmcnt(0) lgkmcnt(0)\n\ts_barrier":::"memory"); }
    #pragma unroll 1
    for(int i=0;i<8;++i){ const int j=i>>1; const int qb=(i&1)?(15-2*j-odd):(2*j+odd); attn_unit<THRL>(bh/NHEAD,bh%NHEAD,qb,T.Q,T.K,T.V,T.GATE,T.O,lds,skipthr); }
  }
}
#undef SBAR
#undef WAIT_BAR
}

constexpr int RING_BYTES = 131072;
constexpr int LDS_BYTES = 163840;
constexpr int LDSCTL_OFF = LDS_BYTES - 1024, MISC_OFF = LDSCTL_OFF + 320;
constexpr int CW_BAR = 4096;
typedef GAS unsigned gu32;
#define RLX_AGENT __ATOMIC_RELAXED, __HIP_MEMORY_SCOPE_AGENT
#define XB_TMO      128
#define XB_XCNT(j)  (256  + 64 * (j))
#define XB_XSUB(j)  (1280 + 64 * (j))
#define XB_XGEN(j)  (2304 + 64 * (j))
#define XB_TOP      3328
#define XB_TOPGEN   3392
#define XCD_BAR_WORDS 3456
#define XB_SPIN_CAP (1u << 18)
__device__ __forceinline__ unsigned xb_ld(unsigned* p)              { return __hip_atomic_load(p, __ATOMIC_RELAXED, __HIP_MEMORY_SCOPE_AGENT); }
__device__ __forceinline__ unsigned xb_add(unsigned* p, unsigned v) { return __hip_atomic_fetch_add(p, v, __ATOMIC_RELAXED, __HIP_MEMORY_SCOPE_AGENT); }
__device__ __forceinline__ unsigned xb_xcc_id() { return (unsigned)__builtin_amdgcn_s_getreg((3 << 11) | 20) & 0xFu; }
#define XB_SPIN(cond, bar) do { unsigned _sp = 0; while (cond) { __builtin_amdgcn_s_sleep(1); \
    if ((++_sp & 255u) == 0u) { if (xb_ld(&(bar)[XB_TMO])) break; if (_sp > XB_SPIN_CAP) { atomicAdd(&(bar)[XB_TMO], 1u); break; } } } } while (0)
struct XcdBarrier { unsigned* bar; unsigned x; volatile LAS unsigned* st; };
__device__ __forceinline__ XcdBarrier xcd_barrier_post(unsigned* bar, volatile LAS unsigned* st) {
    XcdBarrier b; b.bar = bar; b.x = xb_xcc_id(); b.st = st;
    if (threadIdx.x == 0) (void)xb_add(&bar[XB_XCNT(b.x)], 1u);
    return b;
}
__device__ __forceinline__ void xcd_barrier_complete(unsigned* bar, unsigned x, unsigned& nloc, unsigned& nx) {
    const unsigned G = gridDim.x * gridDim.y * gridDim.z;
    unsigned sum, cnt, mine, sp = 0u;
    for (;;) {
        sum = 0u; cnt = 0u; mine = 0u;
#pragma unroll
        for (unsigned j = 0; j < 16; ++j) { const unsigned c = xb_ld(&bar[XB_XCNT(j)]); sum += c; cnt += (c > 0u) ? 1u : 0u; mine = (j == x) ? c : mine; }
        if (sum == G) break;
        __builtin_amdgcn_s_sleep(1);
        if ((++sp & 255u) == 0u) { if (xb_ld(&bar[XB_TMO])) break; if (sp > XB_SPIN_CAP) { atomicAdd(&bar[XB_TMO], 1u); break; } }
    }
    nloc = mine > 0u ? mine : 1u; nx = cnt > 0u ? cnt : 1u;
}
__device__ __forceinline__ void xcd_barrier(const XcdBarrier& b) {
    asm volatile("s_waitcnt vmcnt(0)" ::: "memory");
    __syncthreads();
    if (threadIdx.x == 0) {
        unsigned* bar = b.bar; unsigned bx = b.x;
        asm volatile("" : "+s"(bar), "+s"(bx));
        __builtin_amdgcn_s_waitcnt(0);
        unsigned nloc = b.st[0], nx = b.st[1];
        if (nloc == 0u) { xcd_barrier_complete(bar, bx, nloc, nx); b.st[0] = nloc; b.st[1] = nx; }
        const unsigned old = xb_add(&bar[XB_XSUB(bx)], 1u);
        const unsigned gen = old / nloc;
        if (old + 1u == (gen + 1u) * nloc) {
            __builtin_amdgcn_fence(__ATOMIC_RELEASE, "agent");
            asm volatile("s_waitcnt vmcnt(0)" ::: "memory");
            const unsigned og = xb_add(&bar[XB_TOP], 1u);
            const unsigned tg = og / nx;
            if (og + 1u == (tg + 1u) * nx) xb_add(&bar[XB_TOPGEN], 1u);
            else XB_SPIN(xb_ld(&bar[XB_TOPGEN]) == tg, bar);
            __builtin_amdgcn_fence(__ATOMIC_ACQUIRE, "agent");
            xb_add(&bar[XB_XGEN(bx)], 1u);
            asm volatile("s_waitcnt vmcnt(0)" ::: "memory");
        } else {
            XB_SPIN(xb_ld(&bar[XB_XGEN(bx)]) == gen, bar);
            __builtin_amdgcn_fence(__ATOMIC_ACQUIRE, "agent");
            asm volatile("s_waitcnt vmcnt(0)" ::: "memory");
        }
    }
    __syncthreads();
}

__device__ __forceinline__ void bg_cvt(unsigned char* ws, LAS unsigned char* lds, int wave, int lane, volatile LAS unsigned* flag) {
    const InP in = kin(); LAS float* scr = (LAS float*)(lds + wave * CVT_SCR); volatile LAS unsigned* cur = flag + 1;
    const unsigned c = blockIdx.x, G = gridDim.x;
    for (;;) {
        if (*flag != 0u) break;
        if (*cur * G + c >= (unsigned)IT_BG) break;
        unsigned k = 0u; if (lane == 0) k = __hip_atomic_fetch_add((LAS unsigned*)cur, 1u, __ATOMIC_RELAXED, __HIP_MEMORY_SCOPE_WORKGROUP); k = (unsigned)__builtin_amdgcn_readfirstlane((int)k);
        const unsigned it = k * G + c; if (it >= (unsigned)IT_BG) break;
        cvt_item(in, ws, bg_item((int)it), scr, lane);
    }
}
__device__ __forceinline__ void xcd_barrier_bg(const XcdBarrier& b, unsigned char* ws, LAS unsigned char* lds, volatile LAS unsigned* flag) {
    asm volatile("s_waitcnt vmcnt(0)" ::: "memory");
    if (threadIdx.x == 0) *flag = 0u;
    __syncthreads();
    const int wave = __builtin_amdgcn_readfirstlane((int)threadIdx.x >> 6), lane = threadIdx.x & 63;
    if (wave != 0) { bg_cvt(ws, lds, wave, lane, flag); asm volatile("s_waitcnt vmcnt(0)" ::: "memory"); }
    else if (threadIdx.x == 0) {
        unsigned* bar = b.bar; unsigned bx = b.x;
        asm volatile("" : "+s"(bar), "+s"(bx));
        __builtin_amdgcn_s_waitcnt(0);
        unsigned nloc = b.st[0], nx = b.st[1];
        if (nloc == 0u) { xcd_barrier_complete(bar, bx, nloc, nx); b.st[0] = nloc; b.st[1] = nx; }
        const unsigned old = xb_add(&bar[XB_XSUB(bx)], 1u);
        const unsigned gen = old / nloc;
        if (old + 1u == (gen + 1u) * nloc) {
            __builtin_amdgcn_fence(__ATOMIC_RELEASE, "agent");
            asm volatile("s_waitcnt vmcnt(0)" ::: "memory");
            const unsigned og = xb_add(&bar[XB_TOP], 1u);
            const unsigned tg = og / nx;
            if (og + 1u == (tg + 1u) * nx) xb_add(&bar[XB_TOPGEN], 1u);
            else XB_SPIN(xb_ld(&bar[XB_TOPGEN]) == tg, bar);
            __builtin_amdgcn_fence(__ATOMIC_ACQUIRE, "agent");
            xb_add(&bar[XB_XGEN(bx)], 1u);
            asm volatile("s_waitcnt vmcnt(0)" ::: "memory");
        } else {
            XB_SPIN(xb_ld(&bar[XB_XGEN(bx)]) == gen, bar);
            __builtin_amdgcn_fence(__ATOMIC_ACQUIRE, "agent");
            asm volatile("s_waitcnt vmcnt(0)" ::: "memory");
        }
        *flag = 1u;
    }
    __syncthreads();
}

struct Frame { unsigned char* ws; float* out; LAS unsigned char* lds; int bid, G; };
#define TID_LANE_WAVE const int tid = threadIdx.x, lane = tid & 63, wave = __builtin_amdgcn_readfirstlane(tid >> 6); (void)tid; (void)lane; (void)wave

__device__ __forceinline__ void ph_prologue(const Frame& F) {
    TID_LANE_WAVE;
    const InP in = kin(); unsigned char* ws = opq(F.ws);
    LAS float* sc = (LAS float*)F.lds; LAS float* red = (LAS float*)(F.lds + 32768);
    __syncthreads();
    if (F.bid < ADA_ITEMS) {
        for (int i = tid; i < 8 * 1024; i += 512) sc[i] = siluf(in->c[i]);
        __syncthreads();
        for (int it = F.bid; it < ADA_ITEMS; it += F.G) ada_item(in, (float*)(ws + WS_MODS), it, sc, red, tid);
    }
    __syncthreads();
    LAS float* scr = (LAS float*)(F.lds + wave * CVT_SCR);
    const int gw = F.bid * 8 + wave, ngw = F.G * 8;
    for (int it = gw; it < IT_FG; it += ngw) cvt_item(in, ws, fg_item(it), scr, lane);
    bf16_t* wsb = (bf16_t*)(ws + WS_WS);
    for (int i = F.bid * 512 + tid; i < 8 * 128 * 128; i += F.G * 512) { const int s = i & 127, t = (i >> 7) & 127; wsb[i] = (bf16_t)f2bf(s <= t ? in->w_s[i] : 0.f); }
}
__device__ __forceinline__ void ph_norm0(const Frame& F) {
    TID_LANE_WAVE; const InP in = kin(); unsigned char* ws = opq(F.ws); const int gw = F.bid * 8 + wave, ngw = F.G * 8;
    const float* mods = (const float*)(ws + WS_MODS);
    for (int r = gw; r < T; r += ngw) { const int b = r / SEQ;
        row4_norm_mod_store(in->x + (size_t)r * DM, in->norm_mix_g, mods + (size_t)b * 6144 + 0, mods + (size_t)b * 6144 + 1024, ws + WS_XN8 + (size_t)r * DM, lane); }
}
__device__ __forceinline__ void ph_norm_router(const Frame& F, int L) {
    TID_LANE_WAVE; const InP in = kin(); unsigned char* ws = opq(F.ws);
    LAS u32x4* WPB = (LAS u32x4*)F.lds;
    LAS float* lg = (LAS float*)(F.lds + 131072) + wave * 512;
    LAS int* hist = (LAS int*)(F.lds + 131072 + 16384);
    LAS float* rs_s = (LAS float*)(F.lds + 131072 + 16384 + 256) + wave * 16;
    LAS float* pb = (LAS float*)(F.lds + 131072);
    LAS float* rbl = (LAS float*)(F.lds + 131072 + 16384 + 256 + 512);
    const float* mods = (const float*)(ws + WS_MODS) + (size_t)L * 8 * 6144;
    const bf16_t* XR = (const bf16_t*)(ws + WS_XR);
    for (int grp = F.bid; grp < 256; grp += F.G) {
        const int b = grp >> 5; const float* gsc = mods + (size_t)b * 6144 + 4096; const float* gg = in->norm_ffn_g + L * 1024; const float* rw = in->router_w + (size_t)L * 1024 * 32;
        __syncthreads();
        float bpart = 0.f; const float* gsh = mods + (size_t)b * 6144 + 3072;
#pragma unroll 4
        for (int cidx = tid; cidx < 32 * 2 * 64; cidx += 512) { const int l = cidx & 63, hh = (cidx >> 6) & 1, s2 = cidx >> 7, e = 16 * hh + (l & 15), k0 = 32 * s2 + 8 * (l >> 4);
            unsigned hi[4], lo[4];
#pragma unroll
            for (int h2 = 0; h2 < 2; ++h2) { const f32x4 g4 = *(const f32x4*)(gg + k0 + 4 * h2), s4 = *(const f32x4*)(gsc + k0 + 4 * h2), h4 = *(const f32x4*)(gsh + k0 + 4 * h2); float wv[4];
#pragma unroll
                for (int q = 0; q < 4; ++q) { const float r_ = rw[(k0 + 4 * h2 + q) * 32 + e]; wv[q] = g4[q] * (1.f + s4[q]) * r_; bpart += h4[q] * r_; }
#pragma unroll
                for (int q = 0; q < 4; q += 2) { const unsigned a0 = f2bf(wv[q]), a1 = f2bf(wv[q + 1]); hi[2 * h2 + (q >> 1)] = a0 | (a1 << 16);
                    lo[2 * h2 + (q >> 1)] = f2bf(wv[q] - __uint_as_float(a0 << 16)) | (f2bf(wv[q + 1] - __uint_as_float(a1 << 16)) << 16); } }
            WPB[((s2 * 2 + 0) * 2 + hh) * 64 + l] = (u32x4){hi[0], hi[1], hi[2], hi[3]}; WPB[((s2 * 2 + 1) * 2 + hh) * 64 + l] = (u32x4){lo[0], lo[1], lo[2], lo[3]}; }
        pb[tid] = bpart;
        if (tid < 32) hist[tid] = 0;
        __syncthreads();
        if (tid < 32) { float t = in->router_b[L * 32 + tid];
#pragma unroll
            for (int p = 0; p < 16; ++p) t += pb[((p >> 2) << 7) | ((tid >> 4) << 6) | ((p & 3) << 4) | (tid & 15)];
            rbl[tid] = t; }
        __syncthreads();
        const int r0 = grp * 128 + wave * 16, j = lane & 15, kq = lane >> 4;
        {
            const bf16_t* xrow = XR + (size_t)(r0 + j) * DM + 8 * kq;
            f32x4 acc0 = {0.f, 0.f, 0.f, 0.f}, acc1 = {0.f, 0.f, 0.f, 0.f}; float ssq = 0.f;
#pragma unroll 16
            for (int s2 = 0; s2 < 32; ++s2) {
                const u32x4 xw = *(const u32x4*)(xrow + 32 * s2); f32x4 xa, xb; bf8_to_f32(xw, xa, xb);
                ssq += ((xa.x * xa.x + xa.y * xa.y) + (xa.z * xa.z + xa.w * xa.w)) + ((xb.x * xb.x + xb.y * xb.y) + (xb.z * xb.z + xb.w * xb.w));
                const bf16x8 xf = __builtin_bit_cast(bf16x8, xw);
#pragma unroll
                for (int pc = 0; pc < 2; ++pc) { const bf16x8 w0 = __builtin_bit_cast(bf16x8, WPB[((s2 * 2 + pc) * 2 + 0) * 64 + lane]), w1 = __builtin_bit_cast(bf16x8, WPB[((s2 * 2 + pc) * 2 + 1) * 64 + lane]);
                    acc0 = __builtin_amdgcn_mfma_f32_16x16x32_bf16(w0, xf, acc0, 0, 0, 0); acc1 = __builtin_amdgcn_mfma_f32_16x16x32_bf16(w1, xf, acc1, 0, 0, 0); }
            }
            ssq += __shfl_xor(ssq, 16); ssq += __shfl_xor(ssq, 32);
            const float rstd = 1.f / sqrtf(ssq * (1.f / 1024.f) + EPS);
            const f32x4 b0 = *(const LAS f32x4*)(rbl + 4 * kq), b1 = *(const LAS f32x4*)(rbl + 16 + 4 * kq);
            *(LAS f32x4*)(lg + j * 32 + 4 * kq) = acc0 * rstd + b0; *(LAS f32x4*)(lg + j * 32 + 16 + 4 * kq) = acc1 * rstd + b1;
            if (kq == 0) rs_s[j] = rstd;
        }
        __builtin_amdgcn_s_waitcnt(0xc07f); asm volatile("" ::: "memory");
        if (lane < 16) {
            float v[32];
#pragma unroll
            for (int q = 0; q < 8; ++q) { const f32x4 t4 = *(const LAS f32x4*)(lg + lane * 32 + 4 * q); v[4 * q] = t4.x; v[4 * q + 1] = t4.y; v[4 * q + 2] = t4.z; v[4 * q + 3] = t4.w; }
            int ti[4]; float tv[4];
#pragma unroll
            for (int p = 0; p < 4; ++p) { float bv = -INFINITY; int bi = 0;
#pragma unroll
                for (int e = 0; e < 32; ++e) { bool ok = v[e] > bv;
#pragma unroll
                    for (int pp = 0; pp < p; ++pp) ok = ok && (ti[pp] != e);
                    if (ok) { bv = v[e]; bi = e; } }
                ti[p] = bi; tv[p] = bv; }
            float tg[4]; float sm = 0.f;
#pragma unroll
            for (int p = 0; p < 4; ++p) { tg[p] = expf(tv[p] - tv[0]); sm += tg[p]; }
            const int r = r0 + lane;
            *(i32x4*)((int*)(ws + WS_TOPE) + r * 4) = (i32x4){ti[0], ti[1], ti[2], ti[3]};
            *(f32x4*)((float*)(ws + WS_TOPG) + r * 4) = (f32x4){tg[0] / sm, tg[1] / sm, tg[2] / sm, tg[3] / sm};
#pragma unroll
            for (int p = 0; p < 4; ++p) __hip_atomic_fetch_add(&hist[ti[p]], 1, __ATOMIC_RELAXED, __HIP_MEMORY_SCOPE_WORKGROUP);
        }
#pragma unroll 4
        for (int i = 0; i < 16; ++i) { const int r = r0 + i; f32x4 v[4], h[4]; row_load_bf(XR + (size_t)r * DM, lane, v);
            row_modnorm(v, rs_s[i], gg, mods + (size_t)b * 6144 + 3072, gsc, lane, h); row_store_fp8(ws + WS_XN8 + (size_t)r * DM, lane, h); }
        __syncthreads();
        if (tid < 32) ((int*)(ws + WS_HIST))[grp * 32 + tid] = hist[tid];
    }
}
__device__ __forceinline__ void ph_list(const Frame& F) {
    TID_LANE_WAVE; unsigned char* ws = opq(F.ws);
    LAS int* tot = (LAS int*)F.lds; LAS int* before = tot + 32; LAS int* pstart = tot + 64; LAS int* se = tot + 128; LAS int* part = tot + 640;
    const int* hist = (const int*)(ws + WS_HIST); const int* tope = (const int*)(ws + WS_TOPE); const float* topg = (const float*)(ws + WS_TOPG);
    int* dest = (int*)(ws + WS_DEST); int* list = (int*)(ws + WS_LIST); float* rowg = (float*)(ws + WS_ROWG); int* blke = (int*)(ws + WS_BLKE);
    for (int w = F.bid; w < 256; w += F.G) {
        __syncthreads();
        const int mye = tope[w * 512 + tid]; se[tid] = mye;
        { const int e = tid & 31, p = tid >> 5; int a = 0, bf = 0;
#pragma unroll 4
            for (int i = p * 16; i < p * 16 + 16; ++i) { const int h = hist[i * 32 + e]; a += h; bf += (i < w) ? h : 0; }
            part[p * 32 + e] = a; part[512 + p * 32 + e] = bf; }
        __syncthreads();
        if (tid < 32) { int a = 0, bf = 0;
#pragma unroll
            for (int p = 0; p < 16; ++p) { a += part[p * 32 + tid]; bf += part[512 + p * 32 + tid]; }
            tot[tid] = a; before[tid] = bf; }
        __syncthreads();
        if (tid == 0) { int p = 0; for (int e = 0; e < 32; ++e) { pstart[e] = p; p += (tot[e] + 255) / 256 * 256; } pstart[32] = p; }
        __syncthreads();
        { int rank = 0;
            for (int i4 = 0; i4 < 128; ++i4) { const i32x4 q = *(const LAS i32x4*)(se + 4 * i4); const int i0 = 4 * i4;
                rank += (q.x == mye && i0 < tid) + (q.y == mye && i0 + 1 < tid) + (q.z == mye && i0 + 2 < tid) + (q.w == mye && i0 + 3 < tid); }
            const int slot = w * 512 + tid, d = pstart[mye] + before[mye] + rank;
            dest[slot] = d; list[d] = slot >> 2; rowg[d] = topg[slot]; }
        if (w < 32) { const int e = w; for (int r = pstart[e] + tot[e] + tid; r < pstart[e + 1]; r += 512) { list[r] = -1; rowg[r] = 0.f; }
            for (int bk = pstart[e] / 256 + tid; bk < pstart[e + 1] / 256; bk += 512) blke[bk] = e; }
        if (w == 32 && tid == 0) blke[MAXBLK] = pstart[32] / 256;
    }
}
__device__ __forceinline__ void ph_combine(const Frame& F, int L) {
    TID_LANE_WAVE; const InP in = kin(); unsigned char* ws = opq(F.ws); float* out = F.out;
    LAS u32x4* WFB = (LAS u32x4*)F.lds;
    LAS float* rs_s = (LAS float*)(F.lds + 65536) + wave * 16;
    LAS float* pb = (LAS float*)(F.lds + 65536 + 1024);
    LAS float* fbl = (LAS float*)(F.lds + 65536 + 1024 + 2048);
    const float* mods = (const float*)(ws + WS_MODS);
    bf16_t* XR = (bf16_t*)(ws + WS_XR); const unsigned char* YB = ws + WS_YB; const int* dest = (const int*)(ws + WS_DEST);
    for (int grp = F.bid; grp < 256; grp += F.G) {
        const int b = grp >> 5, r0 = grp * 128 + wave * 16;
        if (L == 0) {
            __syncthreads();
            const float* ksc = mods + ((size_t)16 + b) * 6144 + 1024; const float* ksh = mods + ((size_t)16 + b) * 6144; float bpart = 0.f;
#pragma unroll 4
            for (int cidx = tid; cidx < 32 * 64; cidx += 512) { const int l = cidx & 63, s2 = cidx >> 6, e = l & 15, k0 = 32 * s2 + 8 * (l >> 4);
                unsigned hi[4], lo[4];
#pragma unroll
                for (int h2 = 0; h2 < 2; ++h2) { const f32x4 g4 = *(const f32x4*)(in->kv_norm_g + k0 + 4 * h2), s4 = *(const f32x4*)(ksc + k0 + 4 * h2), h4 = *(const f32x4*)(ksh + k0 + 4 * h2); float wv[4];
#pragma unroll
                    for (int q = 0; q < 4; ++q) { const float r_ = in->kv_w[(size_t)(k0 + 4 * h2 + q) * 2064 + 2048 + e]; wv[q] = g4[q] * (1.f + s4[q]) * r_; bpart += h4[q] * r_; }
#pragma unroll
                    for (int q = 0; q < 4; q += 2) { const unsigned a0 = f2bf(wv[q]), a1 = f2bf(wv[q + 1]); hi[2 * h2 + (q >> 1)] = a0 | (a1 << 16);
                        lo[2 * h2 + (q >> 1)] = f2bf(wv[q] - __uint_as_float(a0 << 16)) | (f2bf(wv[q + 1] - __uint_as_float(a1 << 16)) << 16); } }
                WFB[(s2 * 2 + 0) * 64 + l] = (u32x4){hi[0], hi[1], hi[2], hi[3]}; WFB[(s2 * 2 + 1) * 64 + l] = (u32x4){lo[0], lo[1], lo[2], lo[3]}; }
            pb[tid] = bpart;
            __syncthreads();
            if (tid < 16) { float t = in->fgate_b[tid];
#pragma unroll
                for (int p = 0; p < 32; ++p) t += pb[(p << 4) | tid];
                fbl[tid] = t; }
            __syncthreads();
        }
        const float* gt = mods + ((size_t)L * 8 + b) * 6144 + 5120;
#pragma unroll 1
        for (int i = 0; i < 16; ++i) {
            const int r = r0 + i; f32x4 v[4]; row_load_bf(XR + (size_t)r * DM, lane, v);
            f32x4 y[4];
#pragma unroll
            for (int j = 0; j < 4; ++j) y[j] = (f32x4){0.f, 0.f, 0.f, 0.f};
            const i32x4 d4 = *(const i32x4*)(dest + r * 4); const int dd[4] = {d4.x, d4.y, d4.z, d4.w};
#pragma unroll
            for (int q = 0; q < 4; ++q) { const unsigned char* yr = YB + (size_t)dd[q] * 1024;
#pragma unroll
                for (int j = 0; j < 2; ++j) { const u32x2 w = ((const u32x2*)yr)[lane + 64 * j]; y[2 * j] += fp8x4_to_f32(w.x); y[2 * j + 1] += fp8x4_to_f32(w.y); } }
#pragma unroll
            for (int j = 0; j < 4; ++j) v[j] = v[j] + row_vec(gt, lane, j) * (1.f / A8_SCALE) * y[j];
            const float rs = row_rstd(v);
            if (L == 1) { f32x4 o4[4];
#pragma unroll
                for (int j = 0; j < 4; ++j) o4[j] = v[j] * rs * row_vec(in->final_g, lane, j);
                row_store_f32(out + (size_t)r * DM, lane, o4);
                continue;
            }
            row_store_bf16(XR + (size_t)r * DM, lane, v);
            f32x4 h[4];
            row_modnorm(v, rs, in->norm_mix_g + 1024, mods + ((size_t)8 + b) * 6144 + 0, mods + ((size_t)8 + b) * 6144 + 1024, lane, h);
            row_store_fp8(ws + WS_XN8 + (size_t)r * DM, lane, h);
            row_modnorm(v, rs, in->kv_norm_g, mods + ((size_t)16 + b) * 6144 + 0, mods + ((size_t)16 + b) * 6144 + 1024, lane, h);
            row_store_fp8(ws + WS_HKV + (size_t)r * DM, lane, h);
            if (lane == 0) rs_s[i] = rs;
        }
        if (L == 0) {
            __builtin_amdgcn_fence(__ATOMIC_RELEASE, "workgroup"); asm volatile("s_waitcnt vmcnt(0) lgkmcnt(0)" ::: "memory"); __builtin_amdgcn_fence(__ATOMIC_ACQUIRE, "workgroup");
            const int j = lane & 15, kq = lane >> 4; const bf16_t* xrow = XR + (size_t)(r0 + j) * DM + 8 * kq;
            f32x4 acc = {0.f, 0.f, 0.f, 0.f};
#pragma unroll 16
            for (int s2 = 0; s2 < 32; ++s2) { const bf16x8 xf = __builtin_bit_cast(bf16x8, __builtin_nontemporal_load((const u32x4*)(xrow + 32 * s2)));
#pragma unroll
                for (int pc = 0; pc < 2; ++pc) acc = __builtin_amdgcn_mfma_f32_16x16x32_bf16(__builtin_bit_cast(bf16x8, WFB[(s2 * 2 + pc) * 64 + lane]), xf, acc, 0, 0, 0); }
            const float rstd = rs_s[j]; const f32x4 fb = *(const LAS f32x4*)(fbl + 4 * kq);
            f32x4 lf;
#pragma unroll
            for (int q = 0; q < 4; ++q) { const float xg = acc[q] * rstd + fb[q]; lf[q] = fminf(xg, 0.f) - log1pf(expf(-fabsf(xg))); }
            *(f32x4*)((float*)(ws + WS_LOGF) + (size_t)(r0 + j) * 16 + 4 * kq) = lf;
        }
    }
}
__device__ __forceinline__ void ph_cumsum(const Frame& F) {
    TID_LANE_WAVE; unsigned char* ws = opq(F.ws); LAS float* wtot = (LAS float*)F.lds;
    for (int bh = F.bid; bh < NB * NH; bh += F.G) {
        const int b = bh >> 4, h = bh & 15;
        const float* lf = (const float*)(ws + WS_LOGF); float v[8]; float run = 0.f;
#pragma unroll
        for (int i = 0; i < 8; ++i) { run += lf[((size_t)b * SEQ + tid * 8 + i) * 16 + h]; v[i] = run; }
        float inc = run;
#pragma unroll
        for (int o = 1; o < 64; o <<= 1) { const float t = __shfl_up(inc, o); if (lane >= o) inc += t; }
        if (lane == 63) wtot[wave] = inc;
        __syncthreads();
        float off = inc - run;
        for (int w8 = 0; w8 < wave; ++w8) off += wtot[w8];
        float* fc = (float*)(ws + WS_FC) + (size_t)bh * SEQ; unsigned long long* g3 = (unsigned long long*)(ws + WS_G3) + (size_t)bh * SEQ;
#pragma unroll
        for (int i = 0; i < 8; ++i) { const float Fv = v[i] + off; fc[tid * 8 + i] = Fv;
            const float g = -Fv * LOG2E; const unsigned b1 = f2bf(g); const float r1 = g - __uint_as_float(b1 << 16); const unsigned b2 = f2bf(r1); const float r2 = r1 - __uint_as_float(b2 << 16); const unsigned b3 = f2bf(r2);
            g3[tid * 8 + i] = (unsigned long long)(b1 | (b2 << 16)) | ((unsigned long long)(b3 | (0x3f80u << 16)) << 32); }
        __syncthreads();
    }
}


typedef short s16x4 __attribute__((ext_vector_type(4)));
__device__ __forceinline__ s16x4 ds_tr16(LAS unsigned char* p) { return __builtin_bit_cast(s16x4, __builtin_amdgcn_ds_read_tr16_b64_v4i16((LAS s16x4*)p)); }
__device__ __forceinline__ void ph_spatial(const Frame& F) {
    const InP in = kin(); unsigned char* ws = opq(F.ws);
    LAS unsigned char* L = F.lds;
    constexpr int VN_STRIDE = 544, WC_STRIDE = 272, OFF_VN = 0, OFF_WC = 128 * VN_STRIDE, OFF_ST = OFF_WC + 128 * WC_STRIDE;
    LAS float* st = (LAS float*)(L + OFF_ST);
    const bf16_t* Z = (const bf16_t*)(ws + WS_Z); unsigned char* GT = ws + WS_GATED; const bf16_t* WSB = (const bf16_t*)(ws + WS_WS);
    for (int ch = F.bid; ch < T / 128; ch += F.G) {
        const int t0 = ch * 128;
        __syncthreads();
        { int tid_ = threadIdx.x; asm volatile("" : "+v"(tid_)); const int lane = tid_ & 63, wave = __builtin_amdgcn_readfirstlane(tid_ >> 6);
#pragma unroll 4
        for (int i = 0; i < 16; ++i) {
            const int tl = wave * 16 + i; const bf16_t* vrow = Z + (size_t)(t0 + tl) * 4096 + 2048;
            float v[32]; float s = 0.f;
#pragma unroll
            for (int j = 0; j < 4; ++j) { const u32x4 w = *(const u32x4*)(vrow + (lane + 64 * j) * 8); const unsigned ww[4] = {w.x, w.y, w.z, w.w};
#pragma unroll
                for (int q = 0; q < 4; ++q) { v[j * 8 + 2 * q] = __uint_as_float(ww[q] << 16); v[j * 8 + 2 * q + 1] = __uint_as_float(ww[q] & 0xffff0000u); } }
#pragma unroll
            for (int q = 0; q < 32; ++q) s += v[q];
            const float mean = wave_sum(s) * (1.f / 2048.f); float qq = 0.f;
#pragma unroll
            for (int q = 0; q < 32; ++q) { const float d = v[q] - mean; qq += d * d; }
            const float rstd = 1.f / sqrtf(wave_sum(qq) * (1.f / 2048.f) + EPS);
            if (lane == 0) { st[2 * tl] = mean; st[2 * tl + 1] = rstd; }
        } }
        u32x4 vw[8], wcw[4];
        { int tid_ = threadIdx.x; asm volatile("" : "+v"(tid_)); const int tid = tid_, c8 = tid & 31;
#pragma unroll
            for (int q = 0; q < 8; ++q) vw[q] = *(const u32x4*)(Z + (size_t)(t0 + (tid >> 5) + 16 * q) * 4096 + 2048 + c8 * 8);
#pragma unroll
            for (int q = 0; q < 4; ++q) { const int cidx = tid + 512 * q, r = cidx >> 4, c16 = cidx & 15; wcw[q] = *(const u32x4*)(WSB + r * 128 + c16 * 8); } }
#pragma unroll 1
        for (int g = 0; g < 8; ++g) {
            int tid_ = threadIdx.x; asm volatile("" : "+v"(tid_));
            const int tid = tid_, lane = tid & 63, wave = __builtin_amdgcn_readfirstlane(tid >> 6), fr = lane & 15, fq = lane >> 4;
            __syncthreads();
#pragma unroll
            for (int q = 0; q < 4; ++q) { const int cidx = tid + 512 * q, r = cidx >> 4, c16 = cidx & 15; *(LAS u32x4*)(L + OFF_WC + r * WC_STRIDE + c16 * 16) = wcw[q]; }
            {
                const int c8 = tid & 31; const float* vg = in->v_g + g * 256 + c8 * 8; const float* vb = in->v_b + g * 256 + c8 * 8;
                const f32x4 g0 = *(const f32x4*)vg, g1 = *(const f32x4*)(vg + 4), b0 = *(const f32x4*)vb, b1 = *(const f32x4*)(vb + 4);
#pragma unroll
                for (int q = 0; q < 8; ++q) { const int s = (tid >> 5) + 16 * q;
                    const u32x4 w = vw[q];
                    const float mean = st[2 * s], rstd = st[2 * s + 1];
                    f32x4 x0 = {__uint_as_float(w.x << 16), __uint_as_float(w.x & 0xffff0000u), __uint_as_float(w.y << 16), __uint_as_float(w.y & 0xffff0000u)};
                    f32x4 x1 = {__uint_as_float(w.z << 16), __uint_as_float(w.z & 0xffff0000u), __uint_as_float(w.w << 16), __uint_as_float(w.w & 0xffff0000u)};
                    x0 = (x0 - mean) * rstd * g0 + b0; x1 = (x1 - mean) * rstd * g1 + b1;
                    u32x4 o; o.x = pk2(x0[0], x0[1]); o.y = pk2(x0[2], x0[3]); o.z = pk2(x1[0], x1[1]); o.w = pk2(x1[2], x1[3]);
                    *(LAS u32x4*)(L + OFF_VN + s * VN_STRIDE + c8 * 16) = o; }
            }
            u32x2 uw[8][2]; float bsv[8];
#pragma unroll
            for (int tb = 0; tb < 8; ++tb) { const int t = 16 * tb + fr; bsv[tb] = in->b_s[g * 128 + t];
#pragma unroll
                for (int db = 0; db < 2; ++db) uw[tb][db] = *(const u32x2*)(Z + (size_t)(t0 + t) * 4096 + 256 * g + 32 * wave + 16 * db + 4 * fq); }
            __syncthreads();
            if (g < 7) { const int c8 = tid & 31;
#pragma unroll
                for (int q = 0; q < 8; ++q) vw[q] = *(const u32x4*)(Z + (size_t)(t0 + (tid >> 5) + 16 * q) * 4096 + 2048 + (g + 1) * 256 + c8 * 8);
#pragma unroll
                for (int q = 0; q < 4; ++q) { const int cidx = tid + 512 * q, r = cidx >> 4, c16 = cidx & 15; wcw[q] = *(const u32x4*)(WSB + (size_t)(g + 1) * 16384 + r * 128 + c16 * 8); } }
            f32x4 acc[8][2];
#pragma unroll
            for (int tb = 0; tb < 8; ++tb) { acc[tb][0] = (f32x4){0.f, 0.f, 0.f, 0.f}; acc[tb][1] = (f32x4){0.f, 0.f, 0.f, 0.f}; }
#pragma unroll
            for (int ks = 0; ks < 4; ++ks) {
                const int s0 = 32 * ks; bf16x8 X[2];
#pragma unroll
                for (int db = 0; db < 2; ++db) { LAS unsigned char* p = L + OFF_VN + (s0 + 4 * fq + (fr >> 2)) * VN_STRIDE + (32 * wave + 16 * db + 4 * (fr & 3)) * 2;
                    const s16x4 lo = ds_tr16(p), hi = ds_tr16(p + 16 * VN_STRIDE);
                    X[db] = (bf16x8){lo[0], lo[1], lo[2], lo[3], hi[0], hi[1], hi[2], hi[3]}; }
#pragma unroll
                for (int tb = 0; tb < 8; ++tb) if (2 * ks <= tb) {
                    LAS unsigned char* p = L + OFF_WC + (16 * tb + fr) * WC_STRIDE + (s0 + 4 * fq) * 2;
                    const u32x2 y0 = *(LAS u32x2*)p, y1 = *(LAS u32x2*)(p + 32);
                    const bf16x8 Y = __builtin_bit_cast(bf16x8, (u32x4){y0.x, y0.y, y1.x, y1.y});
                    acc[tb][0] = __builtin_amdgcn_mfma_f32_16x16x32_bf16(X[0], Y, acc[tb][0], 0, 0, 0);
                    acc[tb][1] = __builtin_amdgcn_mfma_f32_16x16x32_bf16(X[1], Y, acc[tb][1], 0, 0, 0); }
            }
#pragma unroll
            for (int tb = 0; tb < 8; ++tb) { const int t = 16 * tb + fr;
#pragma unroll
                for (int db = 0; db < 2; ++db) { const int dd = 256 * g + 32 * wave + 16 * db + 4 * fq;
                    const u32x2 uwv = uw[tb][db];
                    const f32x4 m = acc[tb][db] + bsv[tb];
                    *(unsigned*)(GT + (size_t)(t0 + t) * 2048 + dd) = pk4_fp8s(__uint_as_float(uwv.x << 16) * m[0], __uint_as_float(uwv.x & 0xffff0000u) * m[1], __uint_as_float(uwv.y << 16) * m[2], __uint_as_float(uwv.y & 0xffff0000u) * m[3]); } }
        }
    }
}

constexpr int NPH = 18;
struct PA { In in; unsigned char* ws; float* out; int ph_lo, ph_hi, li, pad; };
__global__ void __launch_bounds__(512, 2) fwd(PA args) {
    extern __shared__ __attribute__((aligned(16))) unsigned char lds[];
    Frame F; F.ws = args.ws; F.out = args.out; F.lds = (LAS unsigned char*)lds;
    F.bid = blockIdx.x; F.G = gridDim.x;
    LAS unsigned char* ldsl = (LAS unsigned char*)lds;
    volatile LAS unsigned* MISC = (volatile LAS unsigned*)(ldsl + MISC_OFF);
    for (int u = threadIdx.x; u < (LDS_BYTES - LDSCTL_OFF) / 4; u += 512) ((LAS unsigned*)(ldsl + LDSCTL_OFF))[u] = 0u;
    __syncthreads();
    unsigned char* const ws0 = args.ws;
    XcdBarrier bar = xcd_barrier_post((unsigned*)(ws0 + WS_CTL) + CW_BAR + args.li * XCD_BAR_WORDS, MISC + 8);
    const int lo = args.ph_lo, hi = args.ph_hi;
#ifndef PHMASK
#define PHMASK 0x3ffffu
#endif
#define IN(k) (((PHMASK >> (k)) & 1u) && lo <= (k) && (k) < hi)
#define SEAM(k) do { if (lo <= (k) && (k) + 1 < hi) { if ((k) <= 13) xcd_barrier_bg(bar, ws0, ldsl, MISC + 12); else xcd_barrier(bar); } } while (0)
    const int c = (int)blockIdx.x, G = (int)gridDim.x;

    if (IN(0)) { ph_prologue(F); } SEAM(0);
    if (IN(1)) { ph_norm0(F); } SEAM(1);
    if (IN(2)) {
        unsigned char* ws = opq(ws0);
        pg::StaticOrder S; S.init(T / 256, 4096 / 256, G, c);
        pg::SrcPlain<true, true> src{(const char*)(ws + WS_WIN), 1024}; pg::EpGeluZ E{(bf16_t*)(ws + WS_Z), MOE_DESCALE};
        pg::gemm_phase<pg::EpGeluZ, pg::StaticOrder, pg::SrcPlain<true, true>, true>(ldsl, (const char*)(ws + WS_XN8), 512, S, src, E);
    } SEAM(2);
    if (IN(3)) { ph_spatial(F); } SEAM(3);
    if (IN(4)) {
        unsigned char* ws = opq(ws0); const float* mods = (const float*)(ws + WS_MODS);
        pg::StaticOrder S; S.init(T / 256, 1024 / 256, G, c);
        pg::SrcPlain<true, true> src{(const char*)(ws + WS_WOUT), 2048}; pg::EpResid<true> E{kin()->x, (bf16_t*)(ws + WS_XR), mods + 2048, MOE_DESCALE};
        pg::gemm_phase<pg::EpResid<true>, pg::StaticOrder, pg::SrcPlain<true, true>, true>(ldsl, (const char*)(ws + WS_GATED), 1024, S, src, E);
    } SEAM(4);
#define LAYER_MOE(L, P0) \
    if (IN(P0)) { ph_norm_router(F, L); } SEAM(P0); \
    if (IN(P0 + 1)) { if ((P0) == 13) { TID_LANE_WAVE; if (tid == 0) MISC[12] = 0u; __syncthreads(); bg_cvt(ws0, ldsl, wave, lane, MISC + 12); } ph_list(F); } SEAM(P0 + 1); \
    if (IN(P0 + 2)) {     \
        unsigned char* ws = opq(ws0); const int* blke = (const int*)(ws + WS_BLKE); \
        pg::StaticOrder S; S.init(blke[MAXBLK], 8, G, c); \
        pg::SrcMoeA src{(const char*)(ws + WS_W1) + (size_t)L * 32 * 2048 * 1024, (const int*)(ws + WS_LIST), blke, 1024, (const LAS int*)(ldsl + pg::STAGE_BYTES + 8192)}; pg::EpSwiglu E{ws + WS_ACT, kin()->exp_b1 + (size_t)L * 32 * 2048, blke}; \
        pg::gemm_phase<pg::EpSwiglu, pg::StaticOrder, pg::SrcMoeA, true>(ldsl, (const char*)(ws + WS_XN8), 512, S, src, E);     \
    } SEAM(P0 + 2); \
    if (IN(P0 + 3)) {     \
        unsigned char* ws = opq(ws0); const int* blke = (const int*)(ws + WS_BLKE); \
        pg::StaticOrder S; S.init(blke[MAXBLK], 4, G, c); \
        { const int nu = blke[MAXBLK] * 4, mx = (nu + G - 1) / G, mine = c < nu ? (nu - c + G - 1) / G : 0;     \
          if (mine < mx) { const int r8 = (nu % G) >> 3, k = (c >> 3) - r8, nsl = (G >> 3) - r8, d = (k + 1) * 27 / (nsl + 1); for (int i = 0; i < d; ++i) __builtin_amdgcn_s_sleep(16); } } \
        pg::SrcMoeB src{(const char*)(ws + WS_W2) + (size_t)L * 32 * 1024 * 1024, blke, 1024, (const LAS int*)(ldsl + pg::STAGE_BYTES + 8192)}; pg::EpMoeOut E{ws + WS_YB, kin()->exp_b2 + (size_t)L * 32 * 1024, blke, (const float*)(ws + WS_ROWG)}; \
        pg::gemm_phase<pg::EpMoeOut, pg::StaticOrder, pg::SrcMoeB, true>(ldsl, (const char*)(ws + WS_ACT), 512, S, src, E); \
    } SEAM(P0 + 3); \
    if (IN(P0 + 4)) { ph_combine(F, L); } SEAM(P0 + 4);

    LAYER_MOE(0, 5)
    if (IN(10)) {
        unsigned char* ws = opq(ws0);
        ph_cumsum(F);
        pg::StaticOrder S; S.init(T / 256, 2048 / 256, G, c);
        { pg::SrcHeads src{(const char*)(ws + WS_WKV), 1024}; pg::EpHeads<0> E{(bf16_t*)(ws + WS_K), (bf16_t*)(ws + WS_V), kin()->k_norm_g};
          pg::gemm_phase<pg::EpHeads<0>, pg::StaticOrder, pg::SrcHeads, true>(ldsl, (const char*)(ws + WS_HKV), 512, S, src, E); }
        { pg::SrcHeads src{(const char*)(ws + WS_WQG), 1024}; pg::EpHeads<1> E{(bf16_t*)(ws + WS_Q), (bf16_t*)(ws + WS_GS), kin()->q_norm_g};
          pg::gemm_phase<pg::EpHeads<1>, pg::StaticOrder, pg::SrcHeads, true>(ldsl, (const char*)(ws + WS_XN8), 512, S, src, E); }
    } SEAM(10);
    if (IN(11)) {
        unsigned char* ws = opq(ws0);
        static_assert(attn_body::ATTN_LDS_BYTES <= RING_BYTES, "attention LDS");
        const attn_body::AttnTensors AT{(const attn_body::bf16*)(ws + WS_Q), (const attn_body::bf16*)(ws + WS_K), (const attn_body::bf16*)(ws + WS_V), (const attn_body::bf16*)(ws + WS_GS), (attn_body::bf16*)(ws + WS_O), (const unsigned long long*)(ws + WS_G3), kin()->q_norm_g, kin()->k_norm_g};
        attn_body::attn_phase<8>((char*)lds, AT, G, c);
    } SEAM(11);
    if (IN(12)) {
        unsigned char* ws = opq(ws0); const float* mods = (const float*)(ws + WS_MODS);
        pg::StaticOrder S; S.init(T / 256, 1024 / 256, G, c);
        pg::SrcPlain<true, true> src{(const char*)(ws + WS_WO), 1024}; pg::EpResid<false> E{(const bf16_t*)(ws + WS_XR), (bf16_t*)(ws + WS_XR), mods + 8 * 6144 + 2048, MOE_DESCALE};
        pg::gemm_phase<pg::EpResid<false>, pg::StaticOrder, pg::SrcPlain<true, true>, true>(ldsl, (const char*)(ws + WS_O), 512, S, src, E);
    } SEAM(12);
    LAYER_MOE(1, 13)
#undef LAYER_MOE
#undef IN
#undef SEAM
}

#include <cstring>
extern "C" void kernel_launch(void* const* d_in, const int* in_sizes, int n_in, void* d_out, int out_size, void* d_ws, size_t ws_size, hipStream_t stream) {
    if (n_in != 28 || ws_size < WS_END || out_size != T * DM) { fprintf(stderr, "kernel_launch: unexpected arguments (n_in %d, ws %zu, out %d)\n", n_in, ws_size, out_size); return; }
    static int grid = 0;
    if (grid == 0) {
        int dev = 0, cus = 0, per_cu = 0;
        if (hipGetDevice(&dev) != hipSuccess || hipDeviceGetAttribute(&cus, hipDeviceAttributeMultiprocessorCount, dev) != hipSuccess) { grid = -1; return; }
        if (hipFuncSetAttribute((const void*)fwd, hipFuncAttributeMaxDynamicSharedMemorySize, LDS_BYTES) != hipSuccess) { fprintf(stderr, "kernel_launch: hipFuncSetAttribute failed\n"); grid = -1; return; }
        if (hipOccupancyMaxActiveBlocksPerMultiprocessor(&per_cu, (const void*)fwd, 512, LDS_BYTES) != hipSuccess || per_cu < 1) fprintf(stderr, "kernel_launch: occupancy query says %d\n", per_cu);
        (void)hipGetLastError();
        grid = cus;
    }
    if (grid < 0) return;
    KA a; memset((void*)&a, 0, sizeof(a));
    { const float** p = (const float**)&a.in; for (int i = 0; i < 28; ++i) p[i] = (const float*)d_in[i]; }
    a.ws = (unsigned char*)d_ws; a.out = (float*)d_out;
    PA pa; memset((void*)&pa, 0, sizeof(pa)); pa.in = a.in; pa.ws = a.ws; pa.out = a.out;
    (void)hipMemsetAsync((unsigned char*)d_ws + WS_CTL, 0, 1 * MiB, stream);
    pa.ph_lo = 0; pa.ph_hi = NPH; pa.li = 0;
    hipLaunchKernelGGL(fwd, dim3(grid), dim3(512), LDS_BYTES, stream, pa);
}
```

```cpp
#include <hip/hip_runtime.h>
#include <cstdio>
#include <cstdint>

#define LAS __attribute__((address_space(3)))
#define GAS __attribute__((address_space(1)))
typedef unsigned short bf16_t;
typedef float f32x4 __attribute__((ext_vector_type(4)));
typedef short bf16x8 __attribute__((ext_vector_type(8)));
typedef unsigned u32x4 __attribute__((ext_vector_type(4)));
typedef unsigned u32x2 __attribute__((ext_vector_type(2)));
typedef int i32x4 __attribute__((ext_vector_type(4)));

constexpr int NB = 8, SEQ = 4096, DM = 1024, T = NB * SEQ;
constexpr int GW = 2048, NG = 8, GD = 256, CH = 128;
constexpr int NH = 16, HD = 64;
constexpr int NE = 32, TOPK = 4;
constexpr int MAXBLK = 544, MAXROWS = MAXBLK * 256;
constexpr float EPS = 1e-6f;
constexpr float LOG2E = 1.4426950408889634f;
constexpr float C2 = 0.125f * LOG2E;

constexpr size_t MiB = 1u << 20;
constexpr size_t WS_CTL = 0;
constexpr size_t WS_MODS = 1 * MiB;
constexpr size_t WS_RB2 = 1 * MiB + 3 * 8 * 6144 * 4;
constexpr size_t WS_FB2 = WS_RB2 + 2 * 8 * 32 * 4;
constexpr size_t WS_HIST = 2 * MiB;
constexpr size_t WS_BLKE = 2 * MiB + 65536;
constexpr size_t WS_TOPE = 3 * MiB;
constexpr size_t WS_TOPG = 4 * MiB;
constexpr size_t WS_DEST = 5 * MiB;
constexpr size_t WS_LIST = 6 * MiB;
constexpr size_t WS_ROWG = 7 * MiB;
constexpr size_t WS_VSTAT = 8 * MiB;
constexpr size_t WS_LOGF = 9 * MiB;
constexpr size_t WS_FC = 11 * MiB;
constexpr size_t WS_G3 = 13 * MiB;
constexpr size_t WS_WIN = 32 * MiB;
constexpr size_t WS_WOUT = 40 * MiB;
constexpr size_t WS_WKV = 44 * MiB;
constexpr size_t WS_WQG = 48 * MiB;
constexpr size_t WS_WO = 52 * MiB;
constexpr size_t WS_WS = 54 * MiB;
constexpr size_t WS_W1 = 64 * MiB;
constexpr size_t WS_W2 = 320 * MiB;
constexpr size_t WS_XN = 448 * MiB;
constexpr size_t WS_HKV = 512 * MiB;
constexpr size_t WS_XN8 = 640 * MiB;
constexpr size_t WS_XR = 576 * MiB;
constexpr size_t WS_Z = 704 * MiB;
constexpr size_t WS_GATED = 960 * MiB;
constexpr size_t WS_ACT = 704 * MiB;
constexpr size_t WS_YB = 976 * MiB;
constexpr size_t WS_PKV = 704 * MiB;
constexpr size_t WS_PQG = 960 * MiB;
constexpr size_t WS_Q = 1248 * MiB;
constexpr size_t WS_K = 1312 * MiB;
constexpr size_t WS_V = 1376 * MiB;
constexpr size_t WS_GS = 1440 * MiB;
constexpr size_t WS_O = 1504 * MiB;
constexpr size_t WS_END = 1568 * MiB;

__device__ __forceinline__ float bf2f(bf16_t v) { return __uint_as_float(((unsigned)v) << 16); }
__device__ __forceinline__ unsigned f2bf(float f) { unsigned u = __float_as_uint(f); return (u + 0x7fffu + ((u >> 16) & 1u)) >> 16; }
__device__ __forceinline__ unsigned pk2(float lo, float hi) { return f2bf(lo) | (f2bf(hi) << 16); }
__device__ __forceinline__ float wave_sum(float v) {
#pragma unroll
    for (int o = 1; o < 64; o <<= 1) v += __shfl_xor(v, o);
    return v;
}
__device__ __forceinline__ float siluf(float x) { return x / (1.f + expf(-x)); }
__device__ __forceinline__ float sigmoidf_(float x) { return 1.f / (1.f + expf(-x)); }

struct In {
    const float *x, *c, *ada_w, *ada_b, *norm_mix_g, *norm_ffn_g, *w_in, *v_g, *v_b, *w_s, *b_s, *w_out, *kv_ada_w, *kv_ada_b, *kv_norm_g, *kv_w, *k_norm_g, *fgate_b,
        *w_qg, *q_norm_g, *w_o, *router_w, *router_b, *exp_w1, *exp_b1, *exp_w2, *exp_b2, *final_g;
};

typedef const In __attribute__((address_space(4)))* InP;
__device__ __forceinline__ InP kin() { auto p = __builtin_amdgcn_kernarg_segment_ptr(); asm volatile("" : "+s"(p)); return (InP)p; }
__device__ __forceinline__ unsigned char* opq(unsigned char* p) { size_t z = 0; asm volatile("" : "+s"(z)); return p + z; }
struct KA { In in; unsigned char* ws; float* out; int L; int pad; };

__device__ __forceinline__ void transpose_item(const float* W, int K, int N, int ldw, bf16_t* WT, LAS float* scr, int item, int lane) {
    const int nblk = N / 32, kb = item / nblk, nb = item % nblk, k0 = 64 * kb, n0 = 32 * nb;
#pragma unroll 32
    for (int i = 0; i < 32; ++i) { const int kk = 2 * i + (lane >> 5); scr[kk * 33 + (lane & 31)] = W[(size_t)(k0 + kk) * ldw + n0 + (lane & 31)]; }
    __builtin_amdgcn_s_waitcnt(0xc07f); asm volatile("" ::: "memory");
    const int c = lane & 7;
#pragma unroll
    for (int j = 0; j < 4; ++j) { const int n = (lane >> 3) + 8 * j; const LAS float* s = scr + (8 * c) * 33 + n;
        u32x4 o; o.x = pk2(s[0 * 33], s[1 * 33]); o.y = pk2(s[2 * 33], s[3 * 33]); o.z = pk2(s[4 * 33], s[5 * 33]); o.w = pk2(s[6 * 33], s[7 * 33]);
        *(u32x4*)(WT + (size_t)(n0 + n) * K + k0 + 8 * c) = o; }
    __builtin_amdgcn_s_waitcnt(0xc07f); asm volatile("" ::: "memory");
}
__device__ __forceinline__ unsigned pk4_fp8(float a, float b, float c, float d) { int w = 0; w = __builtin_amdgcn_cvt_pk_fp8_f32(a, b, w, false); w = __builtin_amdgcn_cvt_pk_fp8_f32(c, d, w, true); return (unsigned)w; }
constexpr float W8_SCALE = 32.f, A8_SCALE = 4.f, MOE_DESCALE = 1.f / (32.f * 4.f);
__device__ __forceinline__ float a8(float x) { return __builtin_amdgcn_fmed3f(x * A8_SCALE, -448.f, 448.f); }
__device__ __forceinline__ unsigned pk4_fp8s(float a, float b, float c, float d) { return pk4_fp8(a8(a), a8(b), a8(c), a8(d)); }
__device__ __forceinline__ f32x4 fp8x4_to_f32(unsigned w) { const auto lo = __builtin_amdgcn_cvt_pk_f32_fp8((int)w, false), hi = __builtin_amdgcn_cvt_pk_f32_fp8((int)w, true); return (f32x4){lo[0], lo[1], hi[0], hi[1]}; }
constexpr int CVT_SCR = 128 * 33 * 4;
__device__ __forceinline__ void transpose_item_fp8(const float* W, int K, int N, int ldw, unsigned char* WT, LAS float* scr, int item, int lane) {
    const int nblk = N / 32, kb = item / nblk, nb = item % nblk, k0 = 128 * kb, n0 = 32 * nb;
#pragma unroll 64
    for (int i = 0; i < 64; ++i) { const int kk = 2 * i + (lane >> 5); scr[kk * 33 + (lane & 31)] = W[(size_t)(k0 + kk) * ldw + n0 + (lane & 31)]; }
    __builtin_amdgcn_s_waitcnt(0xc07f); asm volatile("" ::: "memory");
    const int n = lane >> 1, hf = lane & 1; const LAS float* sp = scr + (64 * hf) * 33 + n;
#pragma unroll
    for (int q = 0; q < 4; ++q) { u32x4 o;
        o.x = pk4_fp8(sp[(16 * q + 0) * 33] * W8_SCALE, sp[(16 * q + 1) * 33] * W8_SCALE, sp[(16 * q + 2) * 33] * W8_SCALE, sp[(16 * q + 3) * 33] * W8_SCALE);
        o.y = pk4_fp8(sp[(16 * q + 4) * 33] * W8_SCALE, sp[(16 * q + 5) * 33] * W8_SCALE, sp[(16 * q + 6) * 33] * W8_SCALE, sp[(16 * q + 7) * 33] * W8_SCALE);
        o.z = pk4_fp8(sp[(16 * q + 8) * 33] * W8_SCALE, sp[(16 * q + 9) * 33] * W8_SCALE, sp[(16 * q + 10) * 33] * W8_SCALE, sp[(16 * q + 11) * 33] * W8_SCALE);
        o.w = pk4_fp8(sp[(16 * q + 12) * 33] * W8_SCALE, sp[(16 * q + 13) * 33] * W8_SCALE, sp[(16 * q + 14) * 33] * W8_SCALE, sp[(16 * q + 15) * 33] * W8_SCALE);
        *(u32x4*)(WT + (size_t)(n0 + n) * K + k0 + 64 * hf + 16 * q) = o; }
    __builtin_amdgcn_s_waitcnt(0xc07f); asm volatile("" ::: "memory");
}
constexpr int IT_WIN = 8 * 128, IT_WOUT = 16 * 32, IT_WKV = 8 * 64, IT_WQG = 8 * 64, IT_WO = 8 * 32, IT_W1 = 8 * 64  , IT_W2 = 8 * 32;
constexpr int IT_SMALL = IT_WIN + IT_WOUT + IT_WKV + IT_WQG + IT_WO;
constexpr int IT_ALL = IT_SMALL + 64 * IT_W1 + 64 * IT_W2;
constexpr int IT_FG = IT_SMALL + 32 * IT_W1 + 32 * IT_W2, IT_BG = 32 * IT_W1 + 32 * IT_W2;
__host__ __device__ __forceinline__ int fg_item(int i) { return i < IT_SMALL + 32 * IT_W1 ? i : i + 32 * IT_W1; }
__host__ __device__ __forceinline__ int bg_item(int k) { return k < 32 * IT_W1 ? IT_SMALL + 32 * IT_W1 + k : IT_SMALL + 64 * IT_W1 + 32 * IT_W2 + (k - 32 * IT_W1); }
constexpr int CW_CVT = 2048;
__device__ __forceinline__ void cvt_item(InP inp, unsigned char* ws, int it, LAS float* scr, int lane) {
    if (it < IT_WIN) { transpose_item_fp8(inp->w_in, 1024, 4096, 4096, ws + WS_WIN, scr, it, lane); return; } it -= IT_WIN;
    if (it < IT_WOUT) { transpose_item_fp8(inp->w_out, 2048, 1024, 1024, ws + WS_WOUT, scr, it, lane); return; } it -= IT_WOUT;
    if (it < IT_WKV) { transpose_item_fp8(inp->kv_w, 1024, 2048, 2064, ws + WS_WKV, scr, it, lane); return; } it -= IT_WKV;
    if (it < IT_WQG) { transpose_item_fp8(inp->w_qg, 1024, 2048, 2048, ws + WS_WQG, scr, it, lane); return; } it -= IT_WQG;
    if (it < IT_WO) { transpose_item_fp8(inp->w_o, 1024, 1024, 1024, ws + WS_WO, scr, it, lane); return; } it -= IT_WO;
    if (it < 64 * IT_W1) { const int e = it / IT_W1; transpose_item_fp8(inp->exp_w1 + (size_t)e * 1024 * 2048, 1024, 2048, 2048, ws + WS_W1 + (size_t)e * 2048 * 1024, scr, it % IT_W1, lane); return; } it -= 64 * IT_W1;
    { const int e = it / IT_W2; transpose_item_fp8(inp->exp_w2 + (size_t)e * 1024 * 1024, 1024, 1024, 1024, ws + WS_W2 + (size_t)e * 1024 * 1024, scr, it % IT_W2, lane); }
}
constexpr int ADA_ITEMS = 96 + 96 + 32;
__device__ __forceinline__ void ada_item(InP inp, float* mods, int item, const LAS float* sc  , LAS float* red  , int tid) {
    const int lane = tid & 63, wave = tid >> 6;
    int which, cg; const float* w; const float* bias; int ldw;
    if (item < 96) { which = 0; cg = item; w = inp->ada_w; bias = inp->ada_b; ldw = 6144; }
    else if (item < 192) { which = 1; cg = item - 96; w = inp->ada_w + (size_t)1024 * 6144; bias = inp->ada_b + 6144; ldw = 6144; }
    else { which = 2; cg = item - 192; w = inp->kv_ada_w; bias = inp->kv_ada_b; ldw = 2048; }
    const int col = cg * 64 + lane;
    float acc[8];
#pragma unroll
    for (int b = 0; b < 8; ++b) acc[b] = 0.f;
    for (int k0 = wave * 128; k0 < wave * 128 + 128; k0 += 16) {
        float wv[16];
#pragma unroll
        for (int i = 0; i < 16; ++i) wv[i] = w[(size_t)(k0 + i) * ldw + col];
#pragma unroll
        for (int i = 0; i < 16; i += 4) {
#pragma unroll
            for (int b = 0; b < 8; ++b) { const f32x4 s4 = *(const LAS f32x4*)(sc + b * 1024 + k0 + i);
                asm("v_fmac_f32_e32 %0, %1, %2" : "+v"(acc[b]) : "v"(s4.x), "v"(wv[i])); asm("v_fmac_f32_e32 %0, %1, %2" : "+v"(acc[b]) : "v"(s4.y), "v"(wv[i + 1]));
                asm("v_fmac_f32_e32 %0, %1, %2" : "+v"(acc[b]) : "v"(s4.z), "v"(wv[i + 2])); asm("v_fmac_f32_e32 %0, %1, %2" : "+v"(acc[b]) : "v"(s4.w), "v"(wv[i + 3])); }
            asm volatile("" ::: "memory"); }
    }
#pragma unroll
    for (int b = 0; b < 8; ++b) red[(wave * 8 + b) * 64 + lane] = acc[b];
    __syncthreads();
    {
        const int b = tid >> 6; float s = 0.f;
#pragma unroll
        for (int w8 = 0; w8 < 8; ++w8) s += red[(w8 * 8 + b) * 64 + lane];
        mods[((size_t)which * 8 + b) * 6144 + col] = s + bias[col];
    }
    __syncthreads();
}
__device__ __forceinline__ void row_load(const float* xrow, int lane, f32x4 (&v)[4]) {
#pragma unroll
    for (int j = 0; j < 2; ++j) { v[2 * j] = ((const f32x4*)xrow)[2 * lane + 128 * j]; v[2 * j + 1] = ((const f32x4*)xrow)[2 * lane + 128 * j + 1]; }
}
__device__ __forceinline__ void bf8_to_f32(u32x4 w, f32x4& a, f32x4& b) {
    a = (f32x4){__uint_as_float(w.x << 16), __uint_as_float(w.x & 0xffff0000u), __uint_as_float(w.y << 16), __uint_as_float(w.y & 0xffff0000u)};
    b = (f32x4){__uint_as_float(w.z << 16), __uint_as_float(w.z & 0xffff0000u), __uint_as_float(w.w << 16), __uint_as_float(w.w & 0xffff0000u)};
}
__device__ __forceinline__ void row_load_bf(const bf16_t* xrow, int lane, f32x4 (&v)[4]) {
#pragma unroll
    for (int j = 0; j < 2; ++j) bf8_to_f32(((const u32x4*)xrow)[lane + 64 * j], v[2 * j], v[2 * j + 1]);
}
__device__ __forceinline__ float row_rstd(const f32x4 (&v)[4]) {
    float s = 0.f;
#pragma unroll
    for (int j = 0; j < 4; ++j) s += (v[j].x * v[j].x + v[j].y * v[j].y) + (v[j].z * v[j].z + v[j].w * v[j].w);
    return 1.f / sqrtf(wave_sum(s) * (1.f / 1024.f) + EPS);
}
__device__ __forceinline__ f32x4 row_vec(const float* p, int lane, int q) { return ((const f32x4*)p)[2 * lane + 128 * (q >> 1) + (q & 1)]; }
__device__ __forceinline__ void stage_vec(LAS float* dst, const float* src, int tid) { ((LAS u32x2*)dst)[tid] = ((const u32x2*)src)[tid]; }
__device__ __forceinline__ f32x4 row_vec_l(const LAS float* p, int lane, int q) { return ((const LAS f32x4*)p)[2 * lane + 128 * (q >> 1) + (q & 1)]; }
__device__ __forceinline__ void row_modnorm_l(const f32x4 (&v)[4], float rstd, const LAS float* g, const LAS float* sh, const LAS float* sc, int lane, f32x4 (&h)[4]) {
#pragma unroll
    for (int q = 0; q < 4; ++q) h[q] = (v[q] * rstd * row_vec_l(g, lane, q)) * (1.f + row_vec_l(sc, lane, q)) + row_vec_l(sh, lane, q);
}
__device__ __forceinline__ void row_modnorm(const f32x4 (&v)[4], float rstd, const float* g, const float* sh, const float* sc, int lane, f32x4 (&h)[4]) {
#pragma unroll
    for (int q = 0; q < 4; ++q) h[q] = (v[q] * rstd * row_vec(g, lane, q)) * (1.f + row_vec(sc, lane, q)) + row_vec(sh, lane, q);
}
__device__ __forceinline__ void row_store_bf16(bf16_t* orow, int lane, const f32x4 (&h)[4]) {
#pragma unroll
    for (int j = 0; j < 2; ++j) { u32x4 w; w.x = pk2(h[2 * j].x, h[2 * j].y); w.y = pk2(h[2 * j].z, h[2 * j].w); w.z = pk2(h[2 * j + 1].x, h[2 * j + 1].y); w.w = pk2(h[2 * j + 1].z, h[2 * j + 1].w);
        ((u32x4*)orow)[lane + 64 * j] = w; }
}

__device__ __forceinline__ void row_store_fp8(unsigned char* orow, int lane, const f32x4 (&h)[4]) {
#pragma unroll
    for (int j = 0; j < 2; ++j) { u32x2 w; w.x = pk4_fp8s(h[2 * j].x, h[2 * j].y, h[2 * j].z, h[2 * j].w);
        w.y = pk4_fp8s(h[2 * j + 1].x, h[2 * j + 1].y, h[2 * j + 1].z, h[2 * j + 1].w); ((u32x2*)orow)[lane + 64 * j] = w; }
}
__device__ __forceinline__ void row4_norm_mod_store(const float* xrow, const float* g, const float* sh, const float* sc, unsigned char* orow, int lane) {
    f32x4 v[4]; float s = 0.f;
#pragma unroll
    for (int j = 0; j < 4; ++j) { v[j] = ((const f32x4*)xrow)[lane + 64 * j]; s += (v[j].x * v[j].x + v[j].y * v[j].y) + (v[j].z * v[j].z + v[j].w * v[j].w); }
    const float rstd = 1.f / sqrtf(wave_sum(s) * (1.f / 1024.f) + EPS);
#pragma unroll
    for (int j = 0; j < 4; ++j) { const f32x4 gg = ((const f32x4*)g)[lane + 64 * j], s1 = ((const f32x4*)sc)[lane + 64 * j], s0 = ((const f32x4*)sh)[lane + 64 * j];
        const f32x4 h = (v[j] * rstd * gg) * (1.f + s1) + s0; ((unsigned*)orow)[lane + 64 * j] = pk4_fp8s(h.x, h.y, h.z, h.w); }
}
__device__ __forceinline__ void row_store_f32(float* orow, int lane, const f32x4 (&h)[4]) {
#pragma unroll
    for (int j = 0; j < 2; ++j)
#pragma unroll
        for (int sq = 0; sq < 2; ++sq) { const int src = 32 * sq + (lane >> 1); f32x4 a, c;
#pragma unroll
            for (int i = 0; i < 4; ++i) { a[i] = __shfl(h[2 * j][i], src); c[i] = __shfl(h[2 * j + 1][i], src); }
            ((f32x4*)orow)[128 * j + 64 * sq + lane] = (lane & 1) ? c : a; }
}

__device__ __forceinline__ void route_row(const LAS float* hs  , const float* rw, const float* rb, int lane, int (&te)[4], float (&tg)[4]) {
    const int e = lane & 31, half = lane >> 5; float acc = 0.f;
    for (int k = half * 512; k < half * 512 + 512; ++k) acc += hs[k] * rw[k * 32 + e];
    acc += __shfl_xor(acc, 32);
    float val = acc + rb[e];
    float tv[4];
#pragma unroll
    for (int q = 0; q < 4; ++q) {
        float bv = val; int bi = e;
#pragma unroll
        for (int o = 1; o < 32; o <<= 1) { const float ov = __shfl_xor(bv, o); const int oi = __shfl_xor(bi, o); if (ov > bv || (ov == bv && oi < bi)) { bv = ov; bi = oi; } }
        te[q] = bi; tv[q] = bv; if (e == bi) val = -INFINITY;
    }
    float s = 0.f;
#pragma unroll
    for (int q = 0; q < 4; ++q) { tg[q] = expf(tv[q] - tv[0]); s += tg[q]; }
#pragma unroll
    for (int q = 0; q < 4; ++q) tg[q] /= s;
}

namespace pg {
constexpr int BM = 256, BK = 64, HALF = 128, HTB = HALF * BK * 2  , STAGE_BYTES = 8 * HTB, NXCD = 8, WGM = 8;
__host__ __device__ __forceinline__ int lds_byte(int r, int c) { const int st = (r >> 4) * 2 + (c >> 5), rr = r & 15, cc = c & 31, ob = rr * 64 + cc * 2; return st * 1024 + (ob ^ (((ob >> 9) & 1) << 5)); }
__host__ __device__ __forceinline__ void stage_rc(int b, int& R, int& C) { const int st = b / 1024, sb = b % 1024, swz = sb ^ (((sb >> 9) & 1) << 5); R = (st >> 1) * 16 + swz / 64; C = (st & 1) * 32 + (swz % 64) / 2; }
__host__ __device__ __forceinline__ int perm32(int rho) { const int n = rho >> 4, i = rho & 15; return 8 * (i >> 2) + 4 * n + (i & 3); }
struct Unit { int pm, pn, e; };
struct NoPre {};
struct StaticOrder {
    int nM, nN, nwg, G, c;
    __device__ void init(int nM_, int nN_, int G_, int c_) { nM = nM_; nN = nN_; nwg = nM * nN; G = G_; c = c_; }
    __device__ bool next(int i, Unit& u) const {
        const long L = (long)i * G + c; if (L >= nwg) return false;
        int wgid = (int)L; { const int q = nwg / NXCD, r = nwg % NXCD, xcd = wgid % NXCD, off = wgid / NXCD; wgid = (xcd < r ? xcd * (q + 1) : r * (q + 1) + (xcd - r) * q) + off; }
        const int nig = WGM * nN, gid = wgid / nig, fm = gid * WGM, gsz = (nM - fm) < WGM ? (nM - fm) : WGM;
        u.pm = fm + ((wgid % nig) % gsz); u.pn = (wgid % nig) / gsz; return true;
    }
};
typedef float f32x2 __attribute__((ext_vector_type(2)));
typedef __bf16 bf16x2v __attribute__((ext_vector_type(2)));
__device__ __forceinline__ unsigned cvt_pk_bf16(float lo, float hi) { const f32x2 v = {lo, hi}; return __builtin_bit_cast(unsigned, __builtin_convertvector(v, bf16x2v)); }
typedef int v8i32 __attribute__((ext_vector_type(8)));
typedef int v4i32 __attribute__((ext_vector_type(4)));
__device__ __forceinline__ f32x2 gelu_pk(f32x2 v) {
    const f32x2 av = __builtin_elementwise_abs(v), d = av * 0.2316418882f + 1.0f;
    f32x2 t; t.x = __builtin_amdgcn_rcpf(d.x); t.y = __builtin_amdgcn_rcpf(d.y);
    f32x2 q = t * 0.5307027145f + (-0.7265760135f); q = q * t + 0.7107068705f; q = q * t + (-0.142248368f); q = q * t + 0.127414796f; q = q * t;
    const f32x2 s = (v * v) * (-0.72134752044f);
    f32x2 e; e.x = __builtin_amdgcn_exp2f(s.x); e.y = __builtin_amdgcn_exp2f(s.y);
    const f32x2 m = v * (q * e), r = v - m;
    f32x2 o; o.x = v.x < 0.f ? m.x : r.x; o.y = v.y < 0.f ? m.y : r.y; return o;
}
__device__ __forceinline__ float fast_sigmoid(float x) { return __builtin_amdgcn_rcpf(1.f + __builtin_amdgcn_exp2f(-LOG2E * x)); }

template <bool PERM, bool F8 = false> struct SrcPlain { const char* B; int K2; static constexpr bool FP8 = F8, TAB = false;
    __device__ __forceinline__ void fill(Unit& u) const { u.e = 0; }
    __device__ __forceinline__ unsigned arow_off(const Unit& u, int h, int R) const { return (unsigned)(u.pm * BM + h * HALF + R) * (unsigned)K2; }
    __device__ __forceinline__ const char* bhalf(const Unit& u, int h) const { return B + (size_t)(u.pn * BM + h * HALF) * K2; }
    static __device__ __forceinline__ int brow(int R) { return PERM ? ((R & ~31) + perm32(R & 31)) : R; } };
struct SrcHeads { const char* B; int K2; static constexpr bool FP8 = true, TAB = false;
    __device__ __forceinline__ void fill(Unit& u) const { u.e = 0; }
    __device__ __forceinline__ unsigned arow_off(const Unit& u, int h, int R) const { return (unsigned)(u.pm * BM + h * HALF + R) * (unsigned)K2; }
    __device__ __forceinline__ const char* bhalf(const Unit& u, int h) const { return B + (size_t)(u.pn * BM + h * 32) * K2; }
    static __device__ __forceinline__ int brow(int R) { return 64 * (R >> 5) + perm32(R & 31); } };
struct SrcMoeA { const char* W1; const int* list; const int* blke; int K2; const LAS int* tab; static constexpr bool FP8 = true, TAB = true;
    __device__ __forceinline__ unsigned arow_off(const Unit& u, int h, int R) const { int t = list[u.pm * BM + h * HALF + R]; t = t < 0 ? 0 : t; return (unsigned)t * (unsigned)K2; }
    __device__ __forceinline__ void fill(Unit& u) const { u.e = __builtin_amdgcn_readfirstlane(tab[u.pm]); }
    __device__ __forceinline__ const char* bhalf(const Unit& u, int h) const { return W1 + ((size_t)u.e * 2048 + h * 1024 + u.pn * 128) * K2; }
    static __device__ __forceinline__ int brow(int R) { return (R & ~31) + perm32(R & 31); } };
struct SrcMoeB { const char* W2; const int* blke; int K2; const LAS int* tab; static constexpr bool FP8 = true, TAB = true;
    __device__ __forceinline__ unsigned arow_off(const Unit& u, int h, int R) const { return (unsigned)(u.pm * BM + h * HALF + R) * (unsigned)K2; }
    __device__ __forceinline__ void fill(Unit& u) const { u.e = __builtin_amdgcn_readfirstlane(tab[u.pm]); }
    __device__ __forceinline__ const char* bhalf(const Unit& u, int h) const { return W2 + ((size_t)u.e * 1024 + u.pn * BM + h * 8) * K2; }
    static __device__ __forceinline__ int brow(int R) { return 64 * (R >> 5) + 16 * ((R & 15) >> 2) + 4 * ((R >> 4) & 1) + (R & 3); } };

__device__ __forceinline__ u32x4 quad_tr(u32x4 w, int lane) { const int a = ((lane >> 2) + 16 * (lane & 3)) * 4; u32x4 r;
    r.x = (unsigned)__builtin_amdgcn_ds_bpermute(a, (int)w.x); r.y = (unsigned)__builtin_amdgcn_ds_bpermute(a, (int)w.y); r.z = (unsigned)__builtin_amdgcn_ds_bpermute(a, (int)w.z); r.w = (unsigned)__builtin_amdgcn_ds_bpermute(a, (int)w.w); return r; }
struct EpGeluZ { bf16_t* Z; float ds; using Pre = NoPre;
    __device__ __forceinline__ Pre prefetch(const Unit&, int, int, int, int) const { return {}; }
    __device__ __forceinline__ void operator()(const f32x4 (&acc)[2][2][4][2], const Unit& u, int wr, int wc, int fr, int fq, const Pre&) const {
        const int row0 = u.pm * BM + wr * 64 + fr, col0 = u.pn * BM + wc * 32 + 8 * fq;
#pragma unroll
        for (int ai = 0; ai < 2; ++ai)
#pragma unroll
            for (int m = 0; m < 4; ++m) { bf16_t* rowp = Z + (size_t)(row0 + ai * HALF + m * 16) * 4096 + col0;
#pragma unroll
                for (int bj = 0; bj < 2; ++bj) { const f32x4 v0 = acc[ai][bj][m][0] * ds, v1 = acc[ai][bj][m][1] * ds;
                    const f32x2 a = gelu_pk((f32x2){v0[0], v0[1]}), b = gelu_pk((f32x2){v0[2], v0[3]}), c = gelu_pk((f32x2){v1[0], v1[1]}), d = gelu_pk((f32x2){v1[2], v1[3]});
                    u32x4 w; w.x = cvt_pk_bf16(a.x, a.y); w.y = cvt_pk_bf16(b.x, b.y); w.z = cvt_pk_bf16(c.x, c.y); w.w = cvt_pk_bf16(d.x, d.y);
                    *(u32x4*)(rowp + bj * HALF) = w; } }
    } };
template <bool F32BASE> struct EpResid { const void* base; bf16_t* out; const float* gate; float ds; using Pre = NoPre;
    __device__ __forceinline__ Pre prefetch(const Unit&, int, int, int, int) const { return {}; }
    __device__ __forceinline__ void operator()(const f32x4 (&acc)[2][2][4][2], const Unit& u, int wr, int wc, int fr, int fq, const Pre&) const {
        const int b = u.pm >> 4; const float* gt = gate + (size_t)b * 6144; const int col0 = u.pn * BM + wc * 32 + 8 * fq;
        f32x4 gv[2][2];
#pragma unroll
        for (int bj = 0; bj < 2; ++bj)
#pragma unroll
            for (int n = 0; n < 2; ++n) gv[bj][n] = *(const f32x4*)(gt + col0 + bj * HALF + 4 * n) * ds;
#pragma unroll
        for (int ai = 0; ai < 2; ++ai)
#pragma unroll
            for (int m = 0; m < 4; ++m) { const size_t off = (size_t)(u.pm * BM + ai * HALF + wr * 64 + m * 16 + fr) * DM + col0;
#pragma unroll
                for (int bj = 0; bj < 2; ++bj) { f32x4 b0, b1;
                    if constexpr (F32BASE) { b0 = *(const f32x4*)((const float*)base + off + bj * HALF); b1 = *(const f32x4*)((const float*)base + off + bj * HALF + 4); }
                    else bf8_to_f32(*(const u32x4*)((const bf16_t*)base + off + bj * HALF), b0, b1);
                    const f32x4 r0 = b0 + gv[bj][0] * acc[ai][bj][m][0], r1 = b1 + gv[bj][1] * acc[ai][bj][m][1];
                    u32x4 w; w.x = cvt_pk_bf16(r0[0], r0[1]); w.y = cvt_pk_bf16(r0[2], r0[3]); w.z = cvt_pk_bf16(r1[0], r1[1]); w.w = cvt_pk_bf16(r1[2], r1[3]);
                    *(u32x4*)(out + off + bj * HALF) = w; } }
    } };
struct EpSwiglu { unsigned char* act; const float* b1; const int* blke;
    struct Pre { f32x4 bg[2], bl[2]; };
    __device__ __forceinline__ Pre prefetch(const Unit& u, int wr, int wc, int fr, int fq) const { Pre p; const float* bb = b1 + (size_t)u.e * 2048 + u.pn * 128 + wc * 32 + 8 * fq;
#pragma unroll
        for (int n = 0; n < 2; ++n) { p.bg[n] = *(const f32x4*)(bb + 4 * n); p.bl[n] = *(const f32x4*)(bb + 1024 + 4 * n); }
        return p; }
    __device__ __forceinline__ void operator()(const f32x4 (&acc)[2][2][4][2], const Unit& u, int wr, int wc, int fr, int fq, const Pre& pre) const {
        const int col0 = u.pn * 128 + wc * 32 + 8 * fq;
        f32x4 bg[2], bl[2];
#pragma unroll
        for (int n = 0; n < 2; ++n) { bg[n] = pre.bg[n]; bl[n] = pre.bl[n] * A8_SCALE + A8_SCALE; }
#pragma unroll
        for (int ai = 0; ai < 2; ++ai)
#pragma unroll
            for (int m = 0; m < 4; ++m) { const int row = u.pm * BM + ai * HALF + wr * 64 + m * 16 + fr; float a[8];
#pragma unroll
                for (int n = 0; n < 2; ++n) { const f32x4 g4 = acc[ai][0][m][n] * MOE_DESCALE + bg[n], l4 = acc[ai][1][m][n] * (MOE_DESCALE * A8_SCALE) + bl[n];
#pragma unroll
                    for (int j = 0; j < 4; j += 2) {
                        f32x2 g = {fminf(g4[j], 7.f), fminf(g4[j + 1], 7.f)}; f32x2 l = {__builtin_amdgcn_fmed3f(l4[j], -6.f * A8_SCALE, 8.f * A8_SCALE), __builtin_amdgcn_fmed3f(l4[j + 1], -6.f * A8_SCALE, 8.f * A8_SCALE)};
                        const f32x2 x = g * (-1.702f * LOG2E); f32x2 e; e.x = __builtin_amdgcn_exp2f(x.x); e.y = __builtin_amdgcn_exp2f(x.y);
                        const f32x2 d = e + 1.0f; f32x2 r; r.x = __builtin_amdgcn_rcpf(d.x); r.y = __builtin_amdgcn_rcpf(d.y);
                        const f32x2 o = l * (g * r); a[4 * n + j] = o.x; a[4 * n + j + 1] = o.y; } }
                u32x2 w; w.x = pk4_fp8(a[0], a[1], a[2], a[3]); w.y = pk4_fp8(a[4], a[5], a[6], a[7]);
                *(u32x2*)(act + (size_t)row * 1024 + col0) = w; }
    } };
struct EpMoeOut { unsigned char* yb; const float* b2; const int* blke; const float* rowg;
    struct Pre { f32x4 bv[2][2]; float rg[2][4]; };
    __device__ __forceinline__ Pre prefetch(const Unit& u, int wr, int wc, int fr, int fq) const { Pre p; const float* bb = b2 + (size_t)u.e * 1024 + u.pn * BM + wc * 64 + 16 * fq;
#pragma unroll
        for (int bj = 0; bj < 2; ++bj)
#pragma unroll
            for (int n = 0; n < 2; ++n) p.bv[bj][n] = *(const f32x4*)(bb + 8 * bj + 4 * n);
#pragma unroll
        for (int ai = 0; ai < 2; ++ai)
#pragma unroll
            for (int m = 0; m < 4; ++m) p.rg[ai][m] = rowg[u.pm * BM + ai * HALF + wr * 64 + m * 16 + fr];
        return p; }
    __device__ __forceinline__ void operator()(const f32x4 (&acc)[2][2][4][2], const Unit& u, int wr, int wc, int fr, int fq, const Pre& pre) const {
        const int lane = fr + 16 * fq;
        unsigned char* op = yb + (size_t)(u.pm * BM + wr * 64 + (lane >> 2)) * 1024 + u.pn * BM + wc * 64 + 16 * (lane & 3);
#pragma unroll
        for (int ai = 0; ai < 2; ++ai)
#pragma unroll
            for (int m = 0; m < 4; ++m) { const float rg = pre.rg[ai][m]; u32x4 w;
                { const f32x4 v = (acc[ai][0][m][0] * MOE_DESCALE + pre.bv[0][0]) * rg; w.x = pk4_fp8s(v[0], v[1], v[2], v[3]); }
                { const f32x4 v = (acc[ai][0][m][1] * MOE_DESCALE + pre.bv[0][1]) * rg; w.y = pk4_fp8s(v[0], v[1], v[2], v[3]); }
                { const f32x4 v = (acc[ai][1][m][0] * MOE_DESCALE + pre.bv[1][0]) * rg; w.z = pk4_fp8s(v[0], v[1], v[2], v[3]); }
                { const f32x4 v = (acc[ai][1][m][1] * MOE_DESCALE + pre.bv[1][1]) * rg; w.w = pk4_fp8s(v[0], v[1], v[2], v[3]); }
                *(u32x4*)(op + (size_t)(ai * HALF + m * 16) * 1024) = quad_tr(w, lane); }
    } };
template <int MODE> struct EpHeads { bf16_t* o0; bf16_t* o1; const float* g; using Pre = NoPre;
    __device__ __forceinline__ Pre prefetch(const Unit&, int, int, int, int) const { return {}; }
    static __device__ __forceinline__ float sum_fq(float v) {
        auto p = __builtin_amdgcn_permlane16_swap(__float_as_uint(v), __float_as_uint(v), false, false); v = __uint_as_float(p[0]) + __uint_as_float(p[1]);
        auto q = __builtin_amdgcn_permlane32_swap(__float_as_uint(v), __float_as_uint(v), false, false); return __uint_as_float(q[0]) + __uint_as_float(q[1]); }
    __device__ __forceinline__ void operator()(const f32x4 (&acc)[2][2][4][2], const Unit& u, int wr, int wc, int fr, int fq, const Pre&) const {
        const bool first = u.pn < 4; bf16_t* O = first ? o0 : o1; const int colbase = (u.pn & 3) * 256 + wc * 64 + 8 * fq;
        float rr[2][4];
        if (first) {
            f32x4 gv[2][2];
#pragma unroll
            for (int bj = 0; bj < 2; ++bj)
#pragma unroll
                for (int n = 0; n < 2; ++n) gv[bj][n] = *(const f32x4*)(g + 32 * bj + 8 * fq + 4 * n);
#pragma unroll
            for (int ai = 0; ai < 2; ++ai)
#pragma unroll
                for (int m = 0; m < 4; ++m) { float ss = 0.f;
#pragma unroll
                    for (int bj = 0; bj < 2; ++bj)
#pragma unroll
                        for (int n = 0; n < 2; ++n) { const f32x4 x = acc[ai][bj][m][n]; ss += (x[0] * x[0] + x[1] * x[1]) + (x[2] * x[2] + x[3] * x[3]); }
                    rr[ai][m] = ss; }
#pragma unroll
            for (int ai = 0; ai < 2; ++ai)
#pragma unroll
                for (int m = 0; m < 4; ++m) { float r = __builtin_amdgcn_rsqf(sum_fq(rr[ai][m]) * (1.f / 64.f) + EPS * (1.f / (MOE_DESCALE * MOE_DESCALE))); if (MODE == 1) r *= C2; rr[ai][m] = r; }
#pragma unroll
            for (int ai = 0; ai < 2; ++ai)
#pragma unroll
                for (int m = 0; m < 4; ++m) { const int row = u.pm * BM + ai * HALF + wr * 64 + m * 16 + fr;
#pragma unroll
                    for (int bj = 0; bj < 2; ++bj) { const f32x4 v0 = acc[ai][bj][m][0] * rr[ai][m] * gv[bj][0], v1 = acc[ai][bj][m][1] * rr[ai][m] * gv[bj][1];
                        u32x4 w; w.x = cvt_pk_bf16(v0[0], v0[1]); w.y = cvt_pk_bf16(v0[2], v0[3]); w.z = cvt_pk_bf16(v1[0], v1[1]); w.w = cvt_pk_bf16(v1[2], v1[3]);
                        *(u32x4*)(O + (size_t)row * DM + colbase + 32 * bj) = w; } }
        } else {
#pragma unroll
            for (int ai = 0; ai < 2; ++ai)
#pragma unroll
                for (int m = 0; m < 4; ++m) { const int row = u.pm * BM + ai * HALF + wr * 64 + m * 16 + fr;
#pragma unroll
                    for (int bj = 0; bj < 2; ++bj) { f32x4 v[2];
#pragma unroll
                        for (int n = 0; n < 2; ++n) { f32x4 x = acc[ai][bj][m][n] * MOE_DESCALE; if (MODE == 1) { x[0] = fast_sigmoid(x[0]); x[1] = fast_sigmoid(x[1]); x[2] = fast_sigmoid(x[2]); x[3] = fast_sigmoid(x[3]); } v[n] = x; }
                        u32x4 w; w.x = cvt_pk_bf16(v[0][0], v[0][1]); w.y = cvt_pk_bf16(v[0][2], v[0][3]); w.z = cvt_pk_bf16(v[1][0], v[1][1]); w.w = cvt_pk_bf16(v[1][2], v[1][3]);
                        *(u32x4*)(O + (size_t)row * DM + colbase + 32 * bj) = w; } }
        }
    } };

__device__ __forceinline__ f32x4 zero4() { double a, b; asm volatile("v_mov_b64 %0, 0" : "=v"(a)); asm volatile("v_mov_b64 %0, 0" : "=v"(b));
    const f32x2 x = __builtin_bit_cast(f32x2, a), y = __builtin_bit_cast(f32x2, b); return (f32x4){x[0], x[1], y[0], y[1]}; }
template <class Epi, class Sched, class Src, bool ALIGN_EPI>
__device__ __forceinline__ void gemm_phase(LAS unsigned char* lds, const char* Abase, int K, const Sched& S, const Src& src, const Epi& E) {
    int tid_ = threadIdx.x; asm volatile("" : "+v"(tid_));
    const int tid = tid_, wid = __builtin_amdgcn_readfirstlane(tid >> 6), lane = tid & 63, wr = wid >> 2, wc = wid & 3, fr = lane & 15, fq = lane >> 4;
    const int nt = K / BK; constexpr bool PARK = Src::FP8;
    int sR[2], sC[2]; unsigned voffB[2];
#pragma unroll
    for (int i = 0; i < 2; ++i) { stage_rc(tid * 16 + i * 8192, sR[i], sC[i]); voffB[i] = (unsigned)(Src::brow(sR[i]) * K + sC[i]) * 2u; }
    const size_t kstep = (size_t)(BK * 2);
    const unsigned ldsw = (unsigned)wid * 1024u;
    const int aoff = lds_byte(wr * 64 + fr, fq * 8), boff = lds_byte(wc * 32 + fr, fq * 8);
#define PG_SA(b, h) (((b) * 2 + (h)) * HTB)
#define PG_SB(b, h) ((4 + (b) * 2 + (h)) * HTB)
#define PG_STAGE(bufoff, gbase, v0, v1) do { \
        __builtin_amdgcn_global_load_lds((const unsigned*)((const char*)(gbase) + (v0)), (LAS unsigned*)(lds + (bufoff) + ldsw), 16, 0, 0); \
        __builtin_amdgcn_global_load_lds((const unsigned*)((const char*)(gbase) + (v1)), (LAS unsigned*)(lds + (bufoff) + ldsw + 8192), 16, 0, 0); } while (0)
#define PG_LD16(p) (*(const LAS v4i32*)(p))
#define PG_LDA(dst, b, h) do { if constexpr (Src::FP8) { _Pragma("unroll") for (int m = 0; m < 4; ++m) { const v4i32 x0_ = PG_LD16(lds + PG_SA(b, h) + aoff + m * 2048), x1_ = PG_LD16(lds + PG_SA(b, h) + aoff + m * 2048 + 1024); \
            dst##8[m] = __builtin_shufflevector(x0_, x1_, 0, 1, 2, 3, 4, 5, 6, 7); } } else { \
        _Pragma("unroll") for (int m = 0; m < 4; ++m) _Pragma("unroll") for (int k = 0; k < 2; ++k) dst[m][k] = *(const LAS bf16x8*)(lds + PG_SA(b, h) + aoff + m * 2048 + k * 1024); } } while (0)
#define PG_LDB(dst, b, h) do { if constexpr (Src::FP8) { _Pragma("unroll") for (int n = 0; n < 2; ++n) { const v4i32 x0_ = PG_LD16(lds + PG_SB(b, h) + boff + n * 2048), x1_ = PG_LD16(lds + PG_SB(b, h) + boff + n * 2048 + 1024); \
            dst##8[n] = __builtin_shufflevector(x0_, x1_, 0, 1, 2, 3, 4, 5, 6, 7); } } else { \
        _Pragma("unroll") for (int n = 0; n < 2; ++n) _Pragma("unroll") for (int k = 0; k < 2; ++k) dst[n][k] = *(const LAS bf16x8*)(lds + PG_SB(b, h) + boff + n * 2048 + k * 1024); } } while (0)
#define PG_MMA(ai, bj, At, Bt) do { __builtin_amdgcn_s_setprio(1); if constexpr (Src::FP8) { _Pragma("unroll") for (int m = 0; m < 4; ++m) _Pragma("unroll") for (int n = 0; n < 2; ++n) \
        acc[ai][bj][m][n] = __builtin_amdgcn_mfma_scale_f32_16x16x128_f8f6f4(Bt##8[n], At##8[m], acc[ai][bj][m][n], 0, 0, 0, 0x7f7f7f7f, 0, 0x7f7f7f7f); } else { \
        _Pragma("unroll") for (int m = 0; m < 4; ++m) _Pragma("unroll") for (int n = 0; n < 2; ++n) _Pragma("unroll") for (int k = 0; k < 2; ++k) \
        acc[ai][bj][m][n] = __builtin_amdgcn_mfma_f32_16x16x32_bf16(Bt[n][k], At[m][k], acc[ai][bj][m][n], 0, 0, 0); } __builtin_amdgcn_s_setprio(0); } while (0)
#define PG_WAIT_V(n) asm volatile("s_waitcnt vmcnt(" #n ")" ::: "memory")
#define PG_WAIT_L(n) asm volatile("s_waitcnt lgkmcnt(" #n ")" ::: "memory")
#define PG_BAR __builtin_amdgcn_s_barrier()
#define PG_SCHED __builtin_amdgcn_sched_barrier(0)
    Unit cur, nxt; int ui = 0;
    if (!S.next(0, cur)) return;
    src.fill(cur); typename Epi::Pre pre;
    f32x4 acc[2][2][4][2];
#pragma unroll
    for (int a = 0; a < 2; ++a)
#pragma unroll
        for (int b = 0; b < 2; ++b)
#pragma unroll
            for (int m = 0; m < 4; ++m)
#pragma unroll
                for (int n = 0; n < 2; ++n) acc[a][b][m][n] = zero4();
    bf16x8 At[4][2], B0[2][2], B1[2][2]; v8i32 At8[4], B08[2], B18[2];
    unsigned vc[2][2], vn[2][2];
#pragma unroll
    for (int h = 0; h < 2; ++h)
#pragma unroll
        for (int i = 0; i < 2; ++i) vc[h][i] = src.arow_off(cur, h, sR[i]) + (unsigned)sC[i] * 2u;
    const char* cB0 = src.bhalf(cur, 0); const char* cB1 = src.bhalf(cur, 1);
    const char* const cA = Abase;
    PG_STAGE(PG_SB(0, 0), cB0, voffB[0], voffB[1]); PG_STAGE(PG_SB(0, 1), cB1, voffB[0], voffB[1]); PG_STAGE(PG_SA(0, 0), cA, vc[0][0], vc[0][1]); PG_STAGE(PG_SA(0, 1), cA, vc[1][0], vc[1][1]);
    if (wr == 1) PG_BAR;
    PG_WAIT_V(2); PG_BAR;
    PG_STAGE(PG_SB(1, 0), cB0 + kstep, voffB[0], voffB[1]); PG_STAGE(PG_SA(1, 0), cA + kstep, vc[0][0], vc[0][1]); PG_STAGE(PG_SB(1, 1), cB1 + kstep, voffB[0], voffB[1]);
    PG_WAIT_V(6); PG_BAR;
    for (;;) {
        const bool has_next = S.next(ui + 1, nxt);
        const char* nB0 = cB0; const char* nB1 = cB1;
#pragma unroll
        for (int h = 0; h < 2; ++h)
#pragma unroll
            for (int i = 0; i < 2; ++i) vn[h][i] = vc[h][i];
        if (has_next) { src.fill(nxt); nB0 = src.bhalf(nxt, 0); nB1 = src.bhalf(nxt, 1);
#pragma unroll
            for (int h = 0; h < 2; ++h)
#pragma unroll
                for (int i = 0; i < 2; ++i) vn[h][i] = src.arow_off(nxt, h, sR[i]) + (unsigned)sC[i] * 2u; }
        asm volatile("" : "+v"(vn[0][0]), "+v"(vn[0][1]), "+v"(vn[1][0]), "+v"(vn[1][1]));
        if constexpr (PARK) { u32x4 pv; pv.x = vn[0][0]; pv.y = vn[0][1]; pv.z = vn[1][0]; pv.w = vn[1][1]; *(LAS u32x4*)(lds + STAGE_BYTES + tid * 16) = pv; }
#pragma unroll 1
        for (int t = 0; t < nt; t += 2) {
            const bool last = (t == nt - 2);
            if constexpr (PARK) { if (last) { int t2 = threadIdx.x; asm volatile("" : "+v"(t2)); pre = E.prefetch(cur, wr, wc, t2 & 15, (t2 & 63) >> 4); } }
            const char* a1 = cA + (size_t)(t + 1) * kstep;
            const char* a2 = last ? cA : cA + (size_t)(t + 2) * kstep; const char* a3 = a2 + kstep;
            const char* b20 = last ? nB0 : cB0 + (size_t)(t + 2) * kstep; const char* b21 = last ? nB1 : cB1 + (size_t)(t + 2) * kstep;
            const char* b30 = b20 + kstep; const char* b31 = b21 + kstep;
            unsigned w00, w01, w10, w11;
            if constexpr (!PARK) { w00 = last ? vn[0][0] : vc[0][0]; w01 = last ? vn[0][1] : vc[0][1]; w10 = last ? vn[1][0] : vc[1][0]; w11 = last ? vn[1][1] : vc[1][1]; }
            if constexpr (Src::FP8) asm volatile("" : "+s"(a1), "+s"(a2), "+s"(a3), "+s"(b20), "+s"(b21), "+s"(b30), "+s"(b31));
            PG_LDB(B0, 0, 0); PG_LDB(B1, 0, 1); PG_SCHED; PG_LDA(At, 0, 0); PG_STAGE(PG_SA(1, 1), a1, vc[1][0], vc[1][1]);
            if constexpr (PARK) { if (last) { const u32x4 pv = *(const LAS u32x4*)(lds + STAGE_BYTES + tid * 16); vc[0][0] = pv.x; vc[0][1] = pv.y; vc[1][0] = pv.z; vc[1][1] = pv.w; }
                w00 = vc[0][0]; w01 = vc[0][1]; w10 = vc[1][0]; w11 = vc[1][1]; }
            PG_WAIT_V(8); PG_WAIT_L(0); PG_BAR; PG_MMA(0, 0, At, B0); PG_MMA(0, 1, At, B1); PG_BAR; PG_SCHED;
            PG_LDA(At, 0, 1); PG_STAGE(PG_SB(0, 0), b20, voffB[0], voffB[1]); PG_STAGE(PG_SB(0, 1), b21, voffB[0], voffB[1]); PG_STAGE(PG_SA(0, 0), a2, w00, w01);
            PG_WAIT_V(8); PG_WAIT_L(0); PG_BAR; PG_MMA(1, 0, At, B0); PG_MMA(1, 1, At, B1); PG_BAR; PG_SCHED;
            PG_LDB(B0, 1, 0); PG_LDB(B1, 1, 1); PG_SCHED; PG_LDA(At, 1, 0); PG_STAGE(PG_SA(0, 1), a2, w10, w11);
            PG_WAIT_V(8); PG_WAIT_L(0); PG_BAR; PG_MMA(0, 0, At, B0); PG_MMA(0, 1, At, B1); PG_BAR; PG_SCHED;
            PG_LDA(At, 1, 1); PG_STAGE(PG_SB(1, 0), b30, voffB[0], voffB[1]); PG_STAGE(PG_SB(1, 1), b31, voffB[0], voffB[1]); PG_STAGE(PG_SA(1, 0), a3, w00, w01);
            PG_WAIT_V(8); PG_WAIT_L(0); PG_BAR; PG_MMA(1, 0, At, B0); PG_MMA(1, 1, At, B1); PG_BAR; PG_SCHED;
        }
        if constexpr (ALIGN_EPI) { if (wr == 0) PG_BAR; }
        if constexpr (PARK) { int t2 = threadIdx.x; asm volatile("" : "+v"(t2)); E(acc, cur, wr, wc, t2 & 15, (t2 & 63) >> 4, pre); }
        else { pre = E.prefetch(cur, wr, wc, fr, fq); E(acc, cur, wr, wc, fr, fq, pre); }
        if (!has_next) break;
#pragma unroll
        for (int a = 0; a < 2; ++a)
#pragma unroll
            for (int b = 0; b < 2; ++b)
#pragma unroll
                for (int m = 0; m < 4; ++m)
#pragma unroll
                    for (int n = 0; n < 2; ++n) acc[a][b][m][n] = zero4();
        cur = nxt; cB0 = nB0; cB1 = nB1; ++ui;
        if constexpr (!PARK) {
#pragma unroll
        for (int h = 0; h < 2; ++h)
#pragma unroll
            for (int i = 0; i < 2; ++i) vc[h][i] = vn[h][i]; }
        if constexpr (ALIGN_EPI) { if (wr == 1) PG_BAR; }
    }
    PG_WAIT_V(0);
    if constexpr (!ALIGN_EPI) { if (wr == 0) PG_BAR; }
    PG_BAR;
#undef PG_SA
#undef PG_SB
#undef PG_STAGE
#undef PG_LDA
#undef PG_LDB
#undef PG_MMA
#undef PG_LD16
#undef PG_WAIT_V
#undef PG_WAIT_L
#undef PG_BAR
#undef PG_SCHED
}
}
#include <hip/hip_bf16.h>
#include <cmath>
namespace attn_body {
using bf16=__hip_bfloat16;
using bf16x8=__attribute__((ext_vector_type(8)))short;
using s16x4=__attribute__((ext_vector_type(4)))short;
using f32x16=__attribute__((ext_vector_type(16)))float;
using u32x4=__attribute__((ext_vector_type(4)))unsigned;
constexpr int BATCH=8,NHEAD=16,SEQ=4096,D=64,DM=NHEAD*D;
constexpr int NW=8,QBLK=32,QB=QBLK*NW,KVBLK=64,NQB=SEQ/QB;
constexpr int ATTN_PITCH=DM, ATTN_UNIT_ROWS=QB;
__device__ __forceinline__ int crow(int r,int hi){return (r&3)+8*(r>>2)+4*hi;}
#define SBAR() __builtin_amdgcn_sched_barrier(0)
__device__ __forceinline__ void cmask(f32x16&p0,f32x16&p1,int jb,int qrel,int hi){
  const float NEG=-INFINITY; int kb=64*jb+4*hi;
  #pragma unroll
  for(int r=0;r<16;++r){int kv=kb+(r&3)+8*(r>>2); if(kv>qrel)p0[r]=NEG; if(kv+32>qrel)p1[r]=NEG;}
}

constexpr int NSLOT=3, SLOTB=8192;
constexpr int LDS_K=0, LDS_V=NSLOT*SLOTB, LDS_WS=2*NSLOT*SLOTB, LDS_OST=LDS_WS+NW*64*4, LDS_GPAD=LDS_OST+NW*4096, LDS_G3=LDS_GPAD+128*8, LDS_BYTES=LDS_G3+SEQ*8;
constexpr float C2_=0.125f*1.4426950408889634f;
__device__ __forceinline__ void glds16(const void*gsrc,unsigned lds_dst){unsigned keep;
  asm volatile("s_mov_b32 %0, m0\n\ts_mov_b32 m0, %2\n\ts_nop 0\n\tglobal_load_lds_dwordx4 %1, off\n\ts_mov_b32 m0, %0":"=&s"(keep):"v"(gsrc),"s"(lds_dst):"memory");}
__device__ __forceinline__ float max3f(float a,float b,float c){float r;asm("v_max3_f32 %0, %1, %2, %3":"=v"(r):"v"(a),"v"(b),"v"(c));return r;}
__device__ __forceinline__ float max2f(float a,float b){float r;asm("v_max_f32_e32 %0, %1, %2":"=v"(r):"v"(a),"v"(b));return r;}
__device__ __forceinline__ float fadd_s(float a,float b){float r;asm("v_add_f32_e32 %0, %1, %2":"=v"(r):"v"(a),"v"(b));return r;}
__device__ __forceinline__ float fsub_s(float a,float b){float r;asm("v_sub_f32_e32 %0, %1, %2":"=v"(r):"v"(a),"v"(b));return r;}
typedef float f32x2_t __attribute__((ext_vector_type(2))); typedef __bf16 bf16x2_t __attribute__((ext_vector_type(2)));
__device__ __forceinline__ unsigned cvtpk_s(float lo,float hi){f32x2_t v={lo,hi};bf16x2_t b=__builtin_convertvector(v,bf16x2_t);return __builtin_bit_cast(unsigned,b);}
#define WAIT_BAR(N) asm volatile("s_waitcnt vmcnt(" #N ") lgkmcnt(0)\n\ts_barrier":::"memory")

__device__ __forceinline__ void qkt(f32x16&p0,f32x16&p1,const char*Kslot,const bf16x8*qr,bf16x8 ka0,bf16x8 ka1,bf16x8 qa,int r32,int hi){
  const char*kb=Kslot+hi*1024+r32*16;
  { const f32x16 z=f32x16{}; p0=__builtin_amdgcn_mfma_f32_32x32x16_bf16(ka0,qa,z,0,0,0); p1=__builtin_amdgcn_mfma_f32_32x32x16_bf16(ka1,qa,z,0,0,0); }
  #pragma unroll
  for(int d0=0;d0<4;++d0){
    const bf16x8 b0=*reinterpret_cast<const bf16x8*>(kb+d0*2048);
    const bf16x8 b1=*reinterpret_cast<const bf16x8*>(kb+d0*2048+512);
    p0=__builtin_amdgcn_mfma_f32_32x32x16_bf16(b0,qr[d0],p0,0,0,0);p1=__builtin_amdgcn_mfma_f32_32x32x16_bf16(b1,qr[d0],p1,0,0,0);}
}
typedef __attribute__((address_space(3))) const char* lds_cptr;
typedef short v4i16_t __attribute__((ext_vector_type(4)));
__device__ __forceinline__ void kload8(bf16x8*kf,lds_cptr kp){
  kf[0]=*(const __attribute__((address_space(3))) bf16x8*)(kp);      kf[1]=*(const __attribute__((address_space(3))) bf16x8*)(kp+512);
  kf[2]=*(const __attribute__((address_space(3))) bf16x8*)(kp+2048); kf[3]=*(const __attribute__((address_space(3))) bf16x8*)(kp+2560);
  kf[4]=*(const __attribute__((address_space(3))) bf16x8*)(kp+4096); kf[5]=*(const __attribute__((address_space(3))) bf16x8*)(kp+4608);
  kf[6]=*(const __attribute__((address_space(3))) bf16x8*)(kp+6144); kf[7]=*(const __attribute__((address_space(3))) bf16x8*)(kp+6656);
}
__device__ __forceinline__ void kload2(bf16x8*kf,lds_cptr kp,int j){ kf[2*j]=*(const __attribute__((address_space(3))) bf16x8*)(kp+j*2048); kf[2*j+1]=*(const __attribute__((address_space(3))) bf16x8*)(kp+j*2048+512); }
__device__ __forceinline__ s16x4 vtr(lds_cptr p){ return __builtin_bit_cast(s16x4,__builtin_amdgcn_ds_read_tr16_b64_v4i16((__attribute__((address_space(3))) v4i16_t*)p)); }
__device__ __forceinline__ float rowmax(const f32x16&p0,const f32x16&p1){
  float a=max3f(p0[0],p0[1],p1[0]),b=max3f(p0[2],p0[3],p1[1]);a=max3f(a,p1[2],p1[3]);
  #pragma unroll
  for(int r=4;r<16;r+=4){a=max3f(a,p0[r],p0[r+1]);b=max3f(b,p0[r+2],p0[r+3]);a=max3f(a,p1[r],p1[r+1]);b=max3f(b,p1[r+2],p1[r+3]);}
  const float m=max2f(a,b);
  auto rr=__builtin_amdgcn_permlane32_swap(__float_as_uint(m),__float_as_uint(m),false,false);
  return max2f(__uint_as_float(rr[0]),__uint_as_float(rr[1]));
}
__device__ __forceinline__ void pv(f32x16*o,int vb,bf16x8 pa0,bf16x8 pa1,bf16x8 pa2,bf16x8 pa3){
  #pragma unroll
  for(int d0=0;d0<2;++d0){s16x4 lo[4],hi[4];
    #pragma unroll
    for(int ks=0;ks<4;++ks){
      asm volatile("ds_read_b64_tr_b16 %0,%1 offset:%c2":"=&v"(lo[ks]):"v"(vb),"i"(d0*4096+ks*1024):"memory");
      asm volatile("ds_read_b64_tr_b16 %0,%1 offset:%c2":"=&v"(hi[ks]):"v"(vb),"i"(d0*4096+ks*1024+512):"memory");}
    asm volatile("s_waitcnt lgkmcnt(0)":::"memory");SBAR();
    #define PK(k) (bf16x8){lo[k][0],lo[k][1],lo[k][2],lo[k][3],hi[k][0],hi[k][1],hi[k][2],hi[k][3]}
    o[d0]=__builtin_amdgcn_mfma_f32_32x32x16_bf16(pa0,PK(0),o[d0],0,0,0);
    o[d0]=__builtin_amdgcn_mfma_f32_32x32x16_bf16(pa1,PK(1),o[d0],0,0,0);
    o[d0]=__builtin_amdgcn_mfma_f32_32x32x16_bf16(pa2,PK(2),o[d0],0,0,0);
    o[d0]=__builtin_amdgcn_mfma_f32_32x32x16_bf16(pa3,PK(3),o[d0],0,0,0);
    #undef PK
  }
}

#ifndef ATTN_STORE16
#define ATTN_STORE16(p,v) (*(u32x4*)(p)=(v))
#endif
template<int THRL> __device__ __forceinline__ void attn_unit(int b,int h,int qb,const bf16*Q,const bf16*__restrict__ K,const bf16*__restrict__ V,const bf16*__restrict__ GATE,bf16*O,char*shm,float skipthr){
  int tid_=threadIdx.x; asm volatile("":"+v"(tid_));
  const int tid=tid_,lane=tid&63,r32=lane&31,hi=lane>>5; const int wid=__builtin_amdgcn_readfirstlane(tid>>6);
  const long rowbase=(long)b*SEQ; const int q0=qb*QB;
  const bf16*Qw=Q+(rowbase+q0+wid*QBLK)*DM+h*D;
  const unsigned lds0=(unsigned)(uintptr_t)shm;
  int tskip;
  { typedef __attribute__((address_space(3))) const unsigned long long* lds_u64q; const lds_u64q gt_=(lds_u64q)((__attribute__((address_space(3))) const char*)shm+LDS_G3);
    const int NT0=(q0+QB)/KVBLK; const unsigned long long e0=gt_[q0], e1=gt_[lane<NT0?64*lane+63:q0];
    const float G0=(__uint_as_float((unsigned)e0<<16)+__uint_as_float((unsigned)e0&0xffff0000u))+__uint_as_float((unsigned)(e0>>32)<<16);
    const float G1=(__uint_as_float((unsigned)e1<<16)+__uint_as_float((unsigned)e1&0xffff0000u))+__uint_as_float((unsigned)(e1>>32)<<16);
    const int ns=__builtin_popcountll(__ballot(lane<NT0 && (G1-G0)<skipthr)); tskip=__builtin_amdgcn_readfirstlane(min(ns&~1,NT0-6)); }
  const bf16*Kh=K+(rowbase+(long)tskip*KVBLK)*DM+h*D,*Vh=V+(rowbase+(long)tskip*KVBLK)*DM+h*D;
  float*wsf=(float*)(shm+LDS_WS)+wid*64;
  const bf16*ksrc=Kh+(long)lane*DM+wid*8;
  const bf16*vsrc=Vh+(long)(16*(wid&3)+(lane>>2))*DM+(wid>>2)*32+(lane&3)*8;
  const unsigned kdst=lds0+LDS_K+wid*1024, vdst=lds0+LDS_V+wid*1024;
  #define DMA_K(t,slot) glds16(ksrc+(long)(t)*KVBLK*DM,(unsigned)__builtin_amdgcn_readfirstlane(kdst+(slot)))
  #define DMA_V(t,slot) glds16(vsrc+(long)(t)*KVBLK*DM,(unsigned)__builtin_amdgcn_readfirstlane(vdst+(slot)))
  const int vb0=(int)(lds0+LDS_V)+((lane>>4)&1)*32+(lane&3)*8+(4*hi+((lane&15)>>2))*64;
  const char*Kbase=shm+LDS_K; bf16x8 kf[8];
  const lds_cptr shm3=(lds_cptr)shm; const lds_cptr kp0=shm3+LDS_K+hi*1024+r32*16; const lds_cptr vp0=shm3+LDS_V+((lane>>4)&1)*32+(lane&3)*8+(4*hi+((lane&15)>>2))*64;
  const int NT=(q0+QB)/KVBLK-tskip;
  DMA_K(0,0);DMA_V(0,0);DMA_K(1,SLOTB);
  bf16x8 qr[4];
  #pragma unroll
  for(int d0=0;d0<4;++d0)qr[d0]=*reinterpret_cast<const bf16x8*>(&Qw[(long)r32*DM+d0*16+hi*8]);
  float mhat=0.f,l_reg=0.f;f32x16 o[2];o[0]=f32x16{};o[1]=f32x16{};
  typedef __attribute__((address_space(3))) const unsigned long long* lds_u64p;
  const lds_u64p g3p=(lds_u64p)(shm3+LDS_G3)+tskip*KVBLK+r32;
  { const unsigned long long e=((lds_u64p)(shm3+LDS_G3))[q0+wid*QBLK+r32]; const unsigned lo_=(unsigned)e,hi_=(unsigned)(e>>32); mhat=(__uint_as_float(lo_<<16)+__uint_as_float(lo_&0xffff0000u))+__uint_as_float(hi_<<16); }
  u32x4 qa; qa.x=hi?0u:0x3f803f80u; qa.y=0u; qa.z=0u; qa.w=0u;
  #define SETREF() do{ const float x_=-mhat; const unsigned b1_=cvtpk_s(x_,0.f)&0xffffu; const float r1_=x_-__uint_as_float(b1_<<16); const unsigned b2_=cvtpk_s(r1_,0.f)&0xffffu; \
      const float r2_=r1_-__uint_as_float(b2_<<16); const unsigned b3_=cvtpk_s(r2_,0.f)&0xffffu; qa.y=hi?0u:(0x3f80u|(b1_<<16)); qa.z=hi?0u:(b2_|(b3_<<16)); asm volatile("":"+v"(qa)); }while(0)
  SETREF();
  unsigned long long ga0,ga1;
  #define GARD(t) do{ ga0=g3p[(t)*64]; ga1=g3p[(t)*64+32]; }while(0)
  #define KAF(g) __builtin_bit_cast(bf16x8,(u32x4){(unsigned)(g),(unsigned)((g)>>32),0x3f803f80u,0u})
  #define QAF() __builtin_bit_cast(bf16x8,qa)
  const int qrel=wid*QBLK+r32;
  #define CMASK(P0,P1,t) do{int jb_=(t)-(NT-4); if(jb_>=0)cmask(P0,P1,jb_,qrel,hi);}while(0)
  bool resc=false;
  #define START(P0,P1) do{ const float rm=rowmax(P0,P1); resc=false; \
    { const float dl=__builtin_fmaxf(rm,0.f); mhat=fadd_s(mhat,dl);     \
      _Pragma("unroll") for(int r=0;r<16;++r){P0[r]=fsub_s(P0[r],dl);P1[r]=fsub_s(P1[r],dl);} \
      SETREF(); } \
    _Pragma("unroll") for(int r=0;r<16;++r)P0[r]=__builtin_amdgcn_exp2f(P0[r]); }while(0)
  #define RESC() do{ if(resc){ asm volatile("s_waitcnt lgkmcnt(0)":::"memory"); \
      _Pragma("unroll") for(int d_=0;d_<2;++d_) _Pragma("unroll") for(int r=0;r<16;++r)o[d_][r]*=wsf[crow(r,hi)]; } }while(0)
  f32x16 pA0,pA1,pB0,pB1;
  int sl_prev=0,sl_cur=0,sl_next=SLOTB;
  #define ROT() do{sl_prev=sl_cur;sl_cur=sl_next;sl_next=(sl_next==(NSLOT-1)*SLOTB)?0:sl_next+SLOTB;}while(0)
  DMA_K(2,2*SLOTB);
  WAIT_BAR(3);
  GARD(0); qkt(pA0,pA1,Kbase,qr,KAF(ga0),KAF(ga1),QAF(),r32,hi);asm volatile("s_nop 15\n\ts_nop 7":"+v"(pA0),"+v"(pA1));CMASK(pA0,pA1,0);
  START(pA0,pA1);
  _Pragma("unroll") for(int r=0;r<16;++r)pA1[r]=__builtin_amdgcn_exp2f(pA1[r]);
  WAIT_BAR(0);
  DMA_K(3,0);DMA_V(1,SLOTB);
  ROT();
  kload8(kf,kp0+sl_cur); GARD(1);
  WAIT_BAR(2);
  s16x4 vlo[8],vhi[8]; u32x4 pw0,pw1,pw2,pw3;
  #define PKW(P,B) cvtpk_s(P[B],P[B+1])
  #define PAF(k) __builtin_bit_cast(bf16x8,pw##k)
  #define VFR(i) (bf16x8){vlo[i][0],vlo[i][1],vlo[i][2],vlo[i][3],vhi[i][0],vhi[i][1],vhi[i][2],vhi[i][3]}
  #define PIN(x) asm volatile("":"+v"(x))
  #define MX3(a,b,c) __builtin_fmaxf(__builtin_fmaxf((a),(b)),(c))
  #define GAPA(MF,A0,A1,A2,A3,W0,W1,PW) do{ MF; sacc+=A0; sacc+=A1; sacc+=A2; sacc+=A3; PIN(sacc); W0; W1; PIN(PW); SBAR(); }while(0)
  #define EX(v) __builtin_amdgcn_exp2f(v)
  #define GAPB(MF,X,B) do{ MF; X[B]=EX(X[B]); X[B+1]=EX(X[B+1]); X[B+2]=EX(X[B+2]); X[B+3]=EX(X[B+3]); PIN(X); SBAR(); }while(0)
  #define VRD(i) do{ vlo[i]=vtr(vp_+(((i)>>2)*4096+((i)&3)*1024)); vhi[i]=vtr(vp_+(((i)>>2)*4096+((i)&3)*1024+512)); }while(0)
  #define KRD(G,j) do{ if(G){ kload2(kf,kp0+sl_next,j); SBAR(); } }while(0)
  #define STEP(C0,C1,P0,P1,t,GK,GV,GL) do{ SBAR(); \
    const lds_cptr vp_=vp0+sl_prev; \
    { const f32x16 z_=f32x16{}; C0=__builtin_amdgcn_mfma_f32_32x32x16_bf16(KAF(ga0),QAF(),z_,0,0,0); C1=__builtin_amdgcn_mfma_f32_32x32x16_bf16(KAF(ga1),QAF(),z_,0,0,0); } SBAR(); \
    VRD(0); SBAR(); float sacc=(P0[0]+P0[1]); \
    GAPA(C0=__builtin_amdgcn_mfma_f32_32x32x16_bf16(kf[0],qr[0],C0,0,0,0), P0[2],P0[3],P0[4],P0[5],     pw0[0]=PKW(P0,0), pw0[1]=PKW(P0,2), pw0); \
    VRD(4); SBAR(); GAPA(C1=__builtin_amdgcn_mfma_f32_32x32x16_bf16(kf[1],qr[0],C1,0,0,0), P0[6],P0[7],P0[8],P0[9],     pw0[2]=PKW(P0,4), pw0[3]=PKW(P0,6), pw0); \
    VRD(1); SBAR(); GAPA(C0=__builtin_amdgcn_mfma_f32_32x32x16_bf16(kf[2],qr[1],C0,0,0,0),   P0[10],P0[11],P0[12],P0[13], pw1[0]=PKW(P0,8), pw1[1]=PKW(P0,10), pw1); \
    VRD(5); SBAR(); GAPA(C1=__builtin_amdgcn_mfma_f32_32x32x16_bf16(kf[3],qr[1],C1,0,0,0),   P0[14],P0[15],P1[0],P1[1],   pw1[2]=PKW(P0,12),pw1[3]=PKW(P0,14), pw1); \
    VRD(2); SBAR(); GAPA(C0=__builtin_amdgcn_mfma_f32_32x32x16_bf16(kf[4],qr[2],C0,0,0,0),   P1[2],P1[3],P1[4],P1[5],     pw2[0]=PKW(P1,0), pw2[1]=PKW(P1,2), pw2); \
    VRD(6); SBAR(); GAPA(C1=__builtin_amdgcn_mfma_f32_32x32x16_bf16(kf[5],qr[2],C1,0,0,0),   P1[6],P1[7],P1[8],P1[9],     pw2[2]=PKW(P1,4), pw2[3]=PKW(P1,6), pw2); \
    VRD(3); SBAR(); GAPA(C0=__builtin_amdgcn_mfma_f32_32x32x16_bf16(kf[6],qr[3],C0,0,0,0),   P1[10],P1[11],P1[12],P1[13], pw3[0]=PKW(P1,8), pw3[1]=PKW(P1,10), pw3); \
    VRD(7); SBAR(); GAPA(C1=__builtin_amdgcn_mfma_f32_32x32x16_bf16(kf[7],qr[3],C1,0,0,0),   P1[14],P1[15],0.f,0.f,       pw3[2]=PKW(P1,12),pw3[3]=PKW(P1,14), pw3); \
    l_reg+=sacc; \
    if(GK){DMA_K((t)+3,sl_cur);} if(GV){DMA_V((t)+1,sl_next);} \
    CMASK(C0,C1,t); \
    { float a=MX3(C0[0],C0[1],C1[0]),b=MX3(C0[2],C0[3],C1[1]); a=MX3(a,C1[2],C1[3]); \
      _Pragma("unroll") for(int r=4;r<16;r+=4){a=MX3(a,C0[r],C0[r+1]);b=MX3(b,C0[r+2],C0[r+3]);a=MX3(a,C1[r],C1[r+1]);b=MX3(b,C1[r+2],C1[r+3]);} \
      float rm=__builtin_fmaxf(a,b); { auto rr=__builtin_amdgcn_permlane32_swap(__float_as_uint(rm),__float_as_uint(rm),false,false); rm=__builtin_fmaxf(__uint_as_float(rr[0]),__uint_as_float(rr[1])); } \
      resc=false; \
      if(__builtin_expect(__any(rm>(float)THRL),0)){ const float dl=__builtin_fmaxf(rm,0.f); mhat+=dl; \
        _Pragma("unroll") for(int r=0;r<16;++r){C0[r]-=dl;C1[r]-=dl;} \
        SETREF(); \
        const float f=__builtin_amdgcn_exp2f(-dl); l_reg*=f; if(hi==0)wsf[r32]=f; resc=true; } } \
    SBAR(); \
    GAPB(o[0]=__builtin_amdgcn_mfma_f32_32x32x16_bf16(PAF(0),VFR(0),o[0],0,0,0), C0,0); \
    GAPB(o[1]=__builtin_amdgcn_mfma_f32_32x32x16_bf16(PAF(0),VFR(4),o[1],0,0,0), C0,4); \
    KRD(GL,0); GAPB(o[0]=__builtin_amdgcn_mfma_f32_32x32x16_bf16(PAF(1),VFR(1),o[0],0,0,0), C0,8); \
    KRD(GL,1); GAPB(o[1]=__builtin_amdgcn_mfma_f32_32x32x16_bf16(PAF(1),VFR(5),o[1],0,0,0), C0,12); \
    KRD(GL,2); GAPB(o[0]=__builtin_amdgcn_mfma_f32_32x32x16_bf16(PAF(2),VFR(2),o[0],0,0,0), C1,0); \
    KRD(GL,3); GAPB(o[1]=__builtin_amdgcn_mfma_f32_32x32x16_bf16(PAF(2),VFR(6),o[1],0,0,0), C1,4); \
    if(GL){ GARD((t)+1); SBAR(); } GAPB(o[0]=__builtin_amdgcn_mfma_f32_32x32x16_bf16(PAF(3),VFR(3),o[0],0,0,0), C1,8); \
    GAPB(o[1]=__builtin_amdgcn_mfma_f32_32x32x16_bf16(PAF(3),VFR(7),o[1],0,0,0), C1,12); \
    }while(0)
  int t=1;
  #undef CMASK
  #define CMASK(P0,P1,t) do{}while(0)
  for(;t+5<NT;t+=2){
    STEP(pB0,pB1,pA0,pA1,t,true,true,true);     WAIT_BAR(2); RESC(); ROT();
    STEP(pA0,pA1,pB0,pB1,t+1,true,true,true);   WAIT_BAR(2); RESC(); ROT();
  }
  #undef CMASK
  #define CMASK(P0,P1,t) do{int jb_=(t)-(NT-4); if(jb_>=0)cmask(P0,P1,jb_,qrel,hi);}while(0)
  #define ENDW(tt) do{ if((tt)+3<NT){WAIT_BAR(2);} else if((tt)+2<NT){WAIT_BAR(1);} else {WAIT_BAR(0);} }while(0)
  #undef CMASK
  #define CMASK(P0,P1,t) do{}while(0)
  STEP(pB0,pB1,pA0,pA1,NT-5,true,true,true);   WAIT_BAR(2); RESC(); ROT();
  #undef CMASK
  #define CMASK(P0,P1,t) cmask(P0,P1,0,qrel,hi)
  STEP(pA0,pA1,pB0,pB1,NT-4,true,true,true);   WAIT_BAR(2); RESC(); ROT();
  #undef CMASK
  #define CMASK(P0,P1,t) cmask(P0,P1,1,qrel,hi)
  STEP(pB0,pB1,pA0,pA1,NT-3,false,true,true);  WAIT_BAR(1); RESC(); ROT();
  #undef CMASK
  #define CMASK(P0,P1,t) cmask(P0,P1,2,qrel,hi)
  STEP(pA0,pA1,pB0,pB1,NT-2,false,true,true);  WAIT_BAR(0); RESC(); ROT();
  #undef CMASK
  #define CMASK(P0,P1,t) cmask(P0,P1,3,qrel,hi)
  STEP(pB0,pB1,pA0,pA1,NT-1,false,false,false); RESC();
  { float sacc=pB0[0]+pB0[1]; _Pragma("unroll") for(int r=2;r<16;++r)sacc+=pB0[r]; _Pragma("unroll") for(int r=0;r<16;++r)sacc+=pB1[r]; l_reg+=sacc;
    pw0=(u32x4){PKW(pB0,0),PKW(pB0,2),PKW(pB0,4),PKW(pB0,6)};pw1=(u32x4){PKW(pB0,8),PKW(pB0,10),PKW(pB0,12),PKW(pB0,14)};pw2=(u32x4){PKW(pB1,0),PKW(pB1,2),PKW(pB1,4),PKW(pB1,6)};pw3=(u32x4){PKW(pB1,8),PKW(pB1,10),PKW(pB1,12),PKW(pB1,14)};
    SBAR(); pv(o,vb0+sl_cur,PAF(0),PAF(1),PAF(2),PAF(3)); }
  #undef PKW
  #undef PAF
  #undef VFR
  #undef PIN
  #undef MX3
  #undef GAPA
  #undef GAPB
  #undef EX
  #undef VRD
  #undef KRD
  #undef STEP
  #undef ENDW
  {auto rr=__builtin_amdgcn_permlane32_swap(__float_as_uint(l_reg),__float_as_uint(l_reg),false,false);l_reg=__uint_as_float(rr[0])+__uint_as_float(rr[1]);}
  if(hi==0)wsf[32+r32]=l_reg;asm volatile("s_waitcnt lgkmcnt(0)":::"memory");
  float rli[16];
  #pragma unroll
  for(int r=0;r<16;++r)rli[r]=__builtin_amdgcn_rcpf(wsf[32+crow(r,hi)]);
  unsigned char*Ow8=(unsigned char*)O+(rowbase+q0+wid*QBLK)*DM+h*D; const bf16*Gw=GATE+(rowbase+q0+wid*QBLK)*DM+h*D;
  u32x4 gvp[4];
  #pragma unroll
  for(int i=0;i<4;++i)gvp[i]=*(const u32x4*)(Gw+(long)(i*8+(lane>>3))*DM+(lane&7)*8);
  { bf16*stg=(bf16*)(shm+LDS_OST)+wid*2048;
    #pragma unroll
    for(int r=0;r<16;++r){const int orow=crow(r,hi);
      #pragma unroll
      for(int d0=0;d0<2;++d0)stg[orow*64+d0*32+r32]=__float2bfloat16(o[d0][r]*rli[r]);}
    asm volatile("s_waitcnt lgkmcnt(0)":::"memory");
    #pragma unroll
    for(int i=0;i<4;++i){const int row=i*8+(lane>>3),ch=lane&7; const u32x4 v=*(const u32x4*)(stg+row*64+ch*8); const u32x4 gv=gvp[i]; u32x4 w;
      #define GLO(a,g) (__uint_as_float((a)<<16)*__uint_as_float((g)<<16))
      #define GHI(a,g) (__uint_as_float((a)&0xffff0000u)*__uint_as_float((g)&0xffff0000u))
      u32x2 w8; w8.x=pk4_fp8s(GLO(v.x,gv.x),GHI(v.x,gv.x),GLO(v.y,gv.y),GHI(v.y,gv.y)); w8.y=pk4_fp8s(GLO(v.z,gv.z),GHI(v.z,gv.z),GLO(v.w,gv.w),GHI(v.w,gv.w));
      #undef GLO
      #undef GHI
      (void)w; *(u32x2*)(Ow8+(long)row*DM+ch*8)=w8;} }
  asm volatile("s_waitcnt lgkmcnt(0)\n\ts_barrier":::"memory");
  #undef DMA_K
  #undef DMA_V
  #undef CMASK
  #undef START
  #undef RESC
  #undef ROT
  #undef SETREF
  #undef GARD
  #undef KAF
  #undef QAF
}
constexpr int ATTN_LDS_BYTES=LDS_BYTES;
struct AttnTensors { const bf16* Q; const bf16* K; const bf16* V; const bf16* GATE; bf16* O; const unsigned long long* G3; const float* qg; const float* kg; };
template<int THRL=8> __device__ __forceinline__ void attn_phase(char*lds,const AttnTensors&T,int grid,int block){
  const int v0=(grid%8==0)?(block%8)*(grid/8)+block/8:block;
  float skipthr; { float a=fabsf(T.qg[threadIdx.x&63]),b=fabsf(T.kg[threadIdx.x&63]);
    #pragma unroll
    for(int o=1;o<64;o<<=1){a=fmaxf(a,__shfl_xor(a,o));b=fmaxf(b,__shfl_xor(b,o));}
    const float qkmax=64.f*a*b*C2_*1.05f; skipthr=-(42.f+3.f*qkmax); }
  if(__builtin_amdgcn_readfirstlane(threadIdx.x)>=256)__builtin_amdgcn_s_setprio(1);
  for(int v=v0;v<BATCH*NHEAD*2;v+=grid){
    const int bh=v>>1,odd=v&1;
    {
      const u32x4*src=(const u32x4*)(T.G3+(size_t)bh*SEQ); u32x4*dst=(u32x4*)(lds+LDS_G3);
      #pragma unroll
      for(int i=0;i<4;++i)dst[threadIdx.x+512*i]=src[threadIdx.x+512*i];
      if(threadIdx.x<128)((unsigned long long*)(lds+LDS_GPAD))[threadIdx.x]=0x3f80000000000000ull|0xc6eaull;
      asm volatile("s_waitcnt vmcnt(0) lgkmcnt(0)\n\ts_barrier":::"memory"); }
    #pragma unroll 1
    for(int i=0;i<8;++i){ const int j=i>>1; const int qb=(i&1)?(15-2*j-odd):(2*j+odd); attn_unit<THRL>(bh/NHEAD,bh%NHEAD,qb,T.Q,T.K,T.V,T.GATE,T.O,lds,skipthr); }
  }
  __builtin_amdgcn_s_setprio(0);
}
#undef SBAR
#undef WAIT_BAR
}

constexpr int RING_BYTES = 131072;
constexpr int LDS_BYTES = 163840;
constexpr int LDSCTL_OFF = LDS_BYTES - 1024, MISC_OFF = LDSCTL_OFF + 320;
constexpr int CW_BAR = 4096;
typedef GAS unsigned gu32;
#define RLX_AGENT __ATOMIC_RELAXED, __HIP_MEMORY_SCOPE_AGENT
#define XB_TMO      128
#define XB_XCNT(j)  (256  + 64 * (j))
#define XB_XSUB(j)  (1280 + 64 * (j))
#define XB_XGEN(j)  (2304 + 64 * (j))
#define XB_TOP      3328
#define XB_TOPGEN   3392
#define XCD_BAR_WORDS 3456
#define XB_SPIN_CAP (1u << 18)
__device__ __forceinline__ unsigned xb_ld(unsigned* p)              { return __hip_atomic_load(p, __ATOMIC_RELAXED, __HIP_MEMORY_SCOPE_AGENT); }
__device__ __forceinline__ unsigned xb_add(unsigned* p, unsigned v) { return __hip_atomic_fetch_add(p, v, __ATOMIC_RELAXED, __HIP_MEMORY_SCOPE_AGENT); }
__device__ __forceinline__ unsigned xb_xcc_id() { return (unsigned)__builtin_amdgcn_s_getreg((3 << 11) | 20) & 0xFu; }
#define XB_SPIN(cond, bar) do { unsigned _sp = 0; while (cond) { __builtin_amdgcn_s_sleep(1); \
    if ((++_sp & 255u) == 0u) { if (xb_ld(&(bar)[XB_TMO])) break; if (_sp > XB_SPIN_CAP) { atomicAdd(&(bar)[XB_TMO], 1u); break; } } } } while (0)
struct XcdBarrier { unsigned* bar; unsigned x; volatile LAS unsigned* st; };
__device__ __forceinline__ XcdBarrier xcd_barrier_post(unsigned* bar, volatile LAS unsigned* st) {
    XcdBarrier b; b.bar = bar; b.x = xb_xcc_id(); b.st = st;
    if (threadIdx.x == 0) (void)xb_add(&bar[XB_XCNT(b.x)], 1u);
    return b;
}
__device__ __forceinline__ void xcd_barrier_complete(unsigned* bar, unsigned x, unsigned& nloc, unsigned& nx) {
    const unsigned G = gridDim.x * gridDim.y * gridDim.z;
    unsigned sum, cnt, mine, sp = 0u;
    for (;;) {
        sum = 0u; cnt = 0u; mine = 0u;
#pragma unroll
        for (unsigned j = 0; j < 16; ++j) { const unsigned c = xb_ld(&bar[XB_XCNT(j)]); sum += c; cnt += (c > 0u) ? 1u : 0u; mine = (j == x) ? c : mine; }
        if (sum == G) break;
        __builtin_amdgcn_s_sleep(1);
        if ((++sp & 255u) == 0u) { if (xb_ld(&bar[XB_TMO])) break; if (sp > XB_SPIN_CAP) { atomicAdd(&bar[XB_TMO], 1u); break; } }
    }
    nloc = mine > 0u ? mine : 1u; nx = cnt > 0u ? cnt : 1u;
}
__device__ __forceinline__ void xcd_barrier(const XcdBarrier& b) {
    asm volatile("s_waitcnt vmcnt(0)" ::: "memory");
    __syncthreads();
    if (threadIdx.x == 0) {
        unsigned* bar = b.bar; unsigned bx = b.x;
        asm volatile("" : "+s"(bar), "+s"(bx));
        __builtin_amdgcn_s_waitcnt(0);
        unsigned nloc = b.st[0], nx = b.st[1];
        if (nloc == 0u) { xcd_barrier_complete(bar, bx, nloc, nx); b.st[0] = nloc; b.st[1] = nx; }
        __builtin_amdgcn_fence(__ATOMIC_ACQUIRE, "agent");
        const unsigned old = xb_add(&bar[XB_XSUB(bx)], 1u);
        const unsigned gen = old / nloc;
        if (old + 1u == (gen + 1u) * nloc) {
            __builtin_amdgcn_fence(__ATOMIC_RELEASE, "agent");
            asm volatile("s_waitcnt vmcnt(0)" ::: "memory");
            (void)xb_add(&bar[XB_TOP], 1u);
            XB_SPIN(xb_ld(&bar[XB_TOP]) < (gen + 1u) * nx, bar);
            asm volatile("s_waitcnt vmcnt(0)" ::: "memory");
        } else {
            XB_SPIN(xb_ld(&bar[XB_TOP]) < (gen + 1u) * nx, bar);
            asm volatile("s_waitcnt vmcnt(0)" ::: "memory");
        }
    }
    __syncthreads();
}

__device__ __forceinline__ void bg_cvt(unsigned char* ws, LAS unsigned char* lds, int wave, int lane, volatile LAS unsigned* flag) {
    const InP in = kin(); LAS float* scr = (LAS float*)(lds + wave * CVT_SCR); volatile LAS unsigned* cur = flag + 1;
    const unsigned c = blockIdx.x, G = gridDim.x;
    const unsigned H = G >> 1, SR = G + H;
    auto own = [&](unsigned k) -> unsigned { if (c >= H) return k * SR + c; return (k >> 1) * SR + (k & 1u) * G + c; };
    for (;;) {
        if (*flag != 0u) break;
        if (own(*cur) >= (unsigned)IT_BG) break;
        unsigned k = 0u; if (lane == 0) k = __hip_atomic_fetch_add((LAS unsigned*)cur, 1u, __ATOMIC_RELAXED, __HIP_MEMORY_SCOPE_WORKGROUP); k = (unsigned)__builtin_amdgcn_readfirstlane((int)k);
        const unsigned it = own(k); if (it >= (unsigned)IT_BG) break;
        cvt_item(in, ws, bg_item((int)it), scr, lane);
    }
}
__device__ __forceinline__ void xcd_barrier_bg(const XcdBarrier& b, unsigned char* ws, LAS unsigned char* lds, volatile LAS unsigned* flag) {
    asm volatile("s_waitcnt vmcnt(0)" ::: "memory");
    if (threadIdx.x == 0) *flag = 0u;
    __syncthreads();
    const int wave = __builtin_amdgcn_readfirstlane((int)threadIdx.x >> 6), lane = threadIdx.x & 63;
    if (wave != 0) { bg_cvt(ws, lds, wave, lane, flag); asm volatile("s_waitcnt vmcnt(0)" ::: "memory"); }
    else if (threadIdx.x == 0) {
        unsigned* bar = b.bar; unsigned bx = b.x;
        asm volatile("" : "+s"(bar), "+s"(bx));
        __builtin_amdgcn_s_waitcnt(0);
        unsigned nloc = b.st[0], nx = b.st[1];
        if (nloc == 0u) { xcd_barrier_complete(bar, bx, nloc, nx); b.st[0] = nloc; b.st[1] = nx; }
        __builtin_amdgcn_fence(__ATOMIC_ACQUIRE, "agent");
        const unsigned old = xb_add(&bar[XB_XSUB(bx)], 1u);
        const unsigned gen = old / nloc;
        if (old + 1u == (gen + 1u) * nloc) {
            __builtin_amdgcn_fence(__ATOMIC_RELEASE, "agent");
            asm volatile("s_waitcnt vmcnt(0)" ::: "memory");
            (void)xb_add(&bar[XB_TOP], 1u);
            XB_SPIN(xb_ld(&bar[XB_TOP]) < (gen + 1u) * nx, bar);
            asm volatile("s_waitcnt vmcnt(0)" ::: "memory");
        } else {
            XB_SPIN(xb_ld(&bar[XB_TOP]) < (gen + 1u) * nx, bar);
            asm volatile("s_waitcnt vmcnt(0)" ::: "memory");
        }
        *flag = 1u;
    }
    __syncthreads();
}

struct Frame { unsigned char* ws; float* out; LAS unsigned char* lds; int bid, G; };
#define TID_LANE_WAVE const int tid = threadIdx.x, lane = tid & 63, wave = __builtin_amdgcn_readfirstlane(tid >> 6); (void)tid; (void)lane; (void)wave

__device__ __forceinline__ void ph_prologue(const Frame& F) {
    TID_LANE_WAVE;
    const InP in = kin(); unsigned char* ws = opq(F.ws);
    LAS float* sc = (LAS float*)F.lds; LAS float* red = (LAS float*)(F.lds + 32768);
    __syncthreads();
    if (F.bid < ADA_ITEMS) {
        for (int i = tid; i < 8 * 1024; i += 512) sc[i] = siluf(in->c[i]);
        __syncthreads();
        for (int it = F.bid; it < ADA_ITEMS; it += F.G) ada_item(in, (float*)(ws + WS_MODS), it, sc, red, tid);
    }
    __syncthreads();
    LAS float* scr = (LAS float*)(F.lds + wave * CVT_SCR);
    const int gw = F.bid * 8 + wave, ngw = F.G * 8;
    for (int it = gw; it < IT_FG; it += ngw) cvt_item(in, ws, fg_item(it), scr, lane);
    bf16_t* wsb = (bf16_t*)(ws + WS_WS);
    for (int i = F.bid * 512 + tid; i < 8 * 128 * 128; i += F.G * 512) { const int s = i & 127, t = (i >> 7) & 127; wsb[i] = (bf16_t)f2bf(s <= t ? in->w_s[i] : 0.f); }
}
__device__ __forceinline__ void ph_norm0(const Frame& F) {
    TID_LANE_WAVE; const InP in = kin(); unsigned char* ws = opq(F.ws);
    const float* mods = (const float*)(ws + WS_MODS); LAS float* PN = (LAS float*)F.lds;
    for (int grp = F.bid; grp < T / 128; grp += F.G) { const int b = grp >> 5;
        __syncthreads();
        stage_vec(PN, in->norm_mix_g, tid); stage_vec(PN + 1024, mods + (size_t)b * 6144 + 0, tid); stage_vec(PN + 2048, mods + (size_t)b * 6144 + 1024, tid);
        __syncthreads();
#pragma unroll 4
        for (int i = 0; i < 16; ++i) { const int r = grp * 128 + wave * 16 + i; const float* xrow = in->x + (size_t)r * DM; unsigned char* orow = ws + WS_XN8 + (size_t)r * DM;
            f32x4 v[4]; float s = 0.f;
#pragma unroll
            for (int j = 0; j < 4; ++j) { v[j] = ((const f32x4*)xrow)[lane + 64 * j]; s += (v[j].x * v[j].x + v[j].y * v[j].y) + (v[j].z * v[j].z + v[j].w * v[j].w); }
            const float rstd = 1.f / sqrtf(wave_sum(s) * (1.f / 1024.f) + EPS);
#pragma unroll
            for (int j = 0; j < 4; ++j) { const f32x4 gg = ((const LAS f32x4*)PN)[lane + 64 * j], s0 = ((const LAS f32x4*)(PN + 1024))[lane + 64 * j], s1 = ((const LAS f32x4*)(PN + 2048))[lane + 64 * j];
                const f32x4 h = (v[j] * rstd * gg) * (1.f + s1) + s0; ((unsigned*)orow)[lane + 64 * j] = pk4_fp8s(h.x, h.y, h.z, h.w); } }
    }
}
__device__ __forceinline__ void ph_norm_router(const Frame& F, int L) {
    TID_LANE_WAVE; const InP in = kin(); unsigned char* ws = opq(F.ws);
    LAS u32x4* WPB = (LAS u32x4*)F.lds;
    LAS float* lg = (LAS float*)(F.lds + 131072) + wave * 512;
    LAS int* hist = (LAS int*)(F.lds + 131072 + 16384);
    LAS float* rs_s = (LAS float*)(F.lds + 131072 + 16384 + 256) + wave * 16;
    LAS float* pb = (LAS float*)(F.lds + 131072);
    LAS float* rbl = (LAS float*)(F.lds + 131072 + 16384 + 256 + 512);
    const float* mods = (const float*)(ws + WS_MODS) + (size_t)L * 8 * 6144;
    const bf16_t* XR = (const bf16_t*)(ws + WS_XR);
    for (int grp = F.bid; grp < 256; grp += F.G) {
        const int b = grp >> 5; const float* gsc = mods + (size_t)b * 6144 + 4096; const float* gg = in->norm_ffn_g + L * 1024; const float* rw = in->router_w + (size_t)L * 1024 * 32;
        __syncthreads();
        LAS float* PR = (LAS float*)(F.lds + 148480);
        stage_vec(PR, gg, tid); stage_vec(PR + 1024, mods + (size_t)b * 6144 + 3072, tid); stage_vec(PR + 2048, gsc, tid);
        __syncthreads();
        float bpart = 0.f;
#pragma unroll 4
        for (int cidx = tid; cidx < 32 * 2 * 64; cidx += 512) { const int l = cidx & 63, hh = (cidx >> 6) & 1, s2 = cidx >> 7, e = 16 * hh + (l & 15), k0 = 32 * s2 + 8 * (l >> 4);
            unsigned hi[4], lo[4];
#pragma unroll
            for (int h2 = 0; h2 < 2; ++h2) { const f32x4 g4 = *(const LAS f32x4*)(PR + k0 + 4 * h2), s4 = *(const LAS f32x4*)(PR + 2048 + k0 + 4 * h2), h4 = *(const LAS f32x4*)(PR + 1024 + k0 + 4 * h2); float wv[4];
#pragma unroll
                for (int q = 0; q < 4; ++q) { const float r_ = rw[(k0 + 4 * h2 + q) * 32 + e]; wv[q] = g4[q] * (1.f + s4[q]) * r_; bpart += h4[q] * r_; }
#pragma unroll
                for (int q = 0; q < 4; q += 2) { const unsigned a0 = f2bf(wv[q]), a1 = f2bf(wv[q + 1]); hi[2 * h2 + (q >> 1)] = a0 | (a1 << 16);
                    lo[2 * h2 + (q >> 1)] = f2bf(wv[q] - __uint_as_float(a0 << 16)) | (f2bf(wv[q + 1] - __uint_as_float(a1 << 16)) << 16); } }
            WPB[((s2 * 2 + 0) * 2 + hh) * 64 + l] = (u32x4){hi[0], hi[1], hi[2], hi[3]}; WPB[((s2 * 2 + 1) * 2 + hh) * 64 + l] = (u32x4){lo[0], lo[1], lo[2], lo[3]}; }
        pb[tid] = bpart;
        if (tid < 32) hist[tid] = 0;
        __syncthreads();
        if (tid < 32) { float t = in->router_b[L * 32 + tid];
#pragma unroll
            for (int p = 0; p < 16; ++p) t += pb[((p >> 2) << 7) | ((tid >> 4) << 6) | ((p & 3) << 4) | (tid & 15)];
            rbl[tid] = t; }
        __syncthreads();
        const int r0 = grp * 128 + wave * 16, j = lane & 15, kq = lane >> 4;
        {
            const bf16_t* xrow = XR + (size_t)(r0 + j) * DM + 8 * kq;
            f32x4 acc0 = {0.f, 0.f, 0.f, 0.f}, acc1 = {0.f, 0.f, 0.f, 0.f}; float ssq = 0.f;
#pragma unroll 16
            for (int s2 = 0; s2 < 32; ++s2) {
                const u32x4 xw = *(const u32x4*)(xrow + 32 * s2); f32x4 xa, xb; bf8_to_f32(xw, xa, xb);
                ssq += ((xa.x * xa.x + xa.y * xa.y) + (xa.z * xa.z + xa.w * xa.w)) + ((xb.x * xb.x + xb.y * xb.y) + (xb.z * xb.z + xb.w * xb.w));
                const bf16x8 xf = __builtin_bit_cast(bf16x8, xw);
#pragma unroll
                for (int pc = 0; pc < 2; ++pc) { const bf16x8 w0 = __builtin_bit_cast(bf16x8, WPB[((s2 * 2 + pc) * 2 + 0) * 64 + lane]), w1 = __builtin_bit_cast(bf16x8, WPB[((s2 * 2 + pc) * 2 + 1) * 64 + lane]);
                    acc0 = __builtin_amdgcn_mfma_f32_16x16x32_bf16(w0, xf, acc0, 0, 0, 0); acc1 = __builtin_amdgcn_mfma_f32_16x16x32_bf16(w1, xf, acc1, 0, 0, 0); }
            }
            ssq += __shfl_xor(ssq, 16); ssq += __shfl_xor(ssq, 32);
            const float rstd = 1.f / sqrtf(ssq * (1.f / 1024.f) + EPS);
            const f32x4 b0 = *(const LAS f32x4*)(rbl + 4 * kq), b1 = *(const LAS f32x4*)(rbl + 16 + 4 * kq);
            *(LAS f32x4*)(lg + j * 32 + 4 * kq) = acc0 * rstd + b0; *(LAS f32x4*)(lg + j * 32 + 16 + 4 * kq) = acc1 * rstd + b1;
            if (kq == 0) rs_s[j] = rstd;
        }
        __builtin_amdgcn_s_waitcnt(0xc07f); asm volatile("" ::: "memory");
        if (lane < 16) {
            float v[32];
#pragma unroll
            for (int q = 0; q < 8; ++q) { const f32x4 t4 = *(const LAS f32x4*)(lg + lane * 32 + 4 * q); v[4 * q] = t4.x; v[4 * q + 1] = t4.y; v[4 * q + 2] = t4.z; v[4 * q + 3] = t4.w; }
            int ti[4]; float tv[4];
#pragma unroll
            for (int p = 0; p < 4; ++p) { float bv = -INFINITY; int bi = 0;
#pragma unroll
                for (int e = 0; e < 32; ++e) { bool ok = v[e] > bv;
#pragma unroll
                    for (int pp = 0; pp < p; ++pp) ok = ok && (ti[pp] != e);
                    if (ok) { bv = v[e]; bi = e; } }
                ti[p] = bi; tv[p] = bv; }
            float tg[4]; float sm = 0.f;
#pragma unroll
            for (int p = 0; p < 4; ++p) { tg[p] = expf(tv[p] - tv[0]); sm += tg[p]; }
            const int r = r0 + lane;
            *(i32x4*)((int*)(ws + WS_TOPE) + r * 4) = (i32x4){ti[0], ti[1], ti[2], ti[3]};
            *(f32x4*)((float*)(ws + WS_TOPG) + r * 4) = (f32x4){tg[0] / sm, tg[1] / sm, tg[2] / sm, tg[3] / sm};
#pragma unroll
            for (int p = 0; p < 4; ++p) __hip_atomic_fetch_add(&hist[ti[p]], 1, __ATOMIC_RELAXED, __HIP_MEMORY_SCOPE_WORKGROUP);
        }
#pragma unroll 4
        for (int i = 0; i < 16; ++i) { const int r = r0 + i; f32x4 v[4], h[4]; row_load_bf(XR + (size_t)r * DM, lane, v);
            row_modnorm_l(v, rs_s[i], PR, PR + 1024, PR + 2048, lane, h); row_store_fp8(ws + WS_XN8 + (size_t)r * DM, lane, h); }
        __syncthreads();
        if (tid < 32) ((int*)(ws + WS_HIST))[grp * 32 + tid] = hist[tid];
    }
}
__device__ __forceinline__ void ph_list(const Frame& F) {
    TID_LANE_WAVE; unsigned char* ws = opq(F.ws);
    LAS int* tot = (LAS int*)F.lds; LAS int* before = tot + 32; LAS int* pstart = tot + 64; LAS int* se = tot + 128; LAS int* part = tot + 640;
    const int* hist = (const int*)(ws + WS_HIST); const int* tope = (const int*)(ws + WS_TOPE); const float* topg = (const float*)(ws + WS_TOPG);
    int* dest = (int*)(ws + WS_DEST); int* list = (int*)(ws + WS_LIST); float* rowg = (float*)(ws + WS_ROWG); int* blke = (int*)(ws + WS_BLKE);
    for (int w = F.bid; w < 256; w += F.G) {
        __syncthreads();
        const int mye = tope[w * 512 + tid]; se[tid] = mye;
        { const int e = tid & 31, p = tid >> 5; int a = 0, bf = 0;
#pragma unroll 4
            for (int i = p * 16; i < p * 16 + 16; ++i) { const int h = hist[i * 32 + e]; a += h; bf += (i < w) ? h : 0; }
            part[p * 32 + e] = a; part[512 + p * 32 + e] = bf; }
        __syncthreads();
        if (tid < 32) { int a = 0, bf = 0;
#pragma unroll
            for (int p = 0; p < 16; ++p) { a += part[p * 32 + tid]; bf += part[512 + p * 32 + tid]; }
            tot[tid] = a; before[tid] = bf; }
        __syncthreads();
        if (tid == 0) { int p = 0; for (int e = 0; e < 32; ++e) { pstart[e] = p; p += (tot[e] + 255) / 256 * 256; } pstart[32] = p; }
        __syncthreads();
        { int rank = 0;
            for (int i4 = 0; i4 < 128; ++i4) { const i32x4 q = *(const LAS i32x4*)(se + 4 * i4); const int i0 = 4 * i4;
                rank += (q.x == mye && i0 < tid) + (q.y == mye && i0 + 1 < tid) + (q.z == mye && i0 + 2 < tid) + (q.w == mye && i0 + 3 < tid); }
            const int slot = w * 512 + tid, d = pstart[mye] + before[mye] + rank;
            dest[slot] = d; list[d] = slot >> 2; rowg[d] = topg[slot]; }
        if (w < 32) { const int e = w; for (int r = pstart[e] + tot[e] + tid; r < pstart[e + 1]; r += 512) { list[r] = -1; rowg[r] = 0.f; }
            for (int bk = pstart[e] / 256 + tid; bk < pstart[e + 1] / 256; bk += 512) blke[bk] = e; }
        if (w == 32 && tid == 0) blke[MAXBLK] = pstart[32] / 256;
    }
}
__device__ __forceinline__ void ph_combine(const Frame& F, int L) {
    TID_LANE_WAVE; const InP in = kin(); unsigned char* ws = opq(F.ws); float* out = F.out;
    LAS u32x4* WFB = (LAS u32x4*)F.lds;
    LAS float* rs_s = (LAS float*)(F.lds + 65536) + wave * 16;
    LAS float* pb = (LAS float*)(F.lds + 65536 + 1024);
    LAS float* fbl = (LAS float*)(F.lds + 65536 + 1024 + 2048);
    const float* mods = (const float*)(ws + WS_MODS);
    bf16_t* XR = (bf16_t*)(ws + WS_XR); const unsigned char* YB = ws + WS_YB; const int* dest = (const int*)(ws + WS_DEST);
    for (int grp = F.bid; grp < 256; grp += F.G) {
        const int b = grp >> 5, r0 = grp * 128 + wave * 16;
        if (L == 0) {
            __syncthreads();
            const float* ksc = mods + ((size_t)16 + b) * 6144 + 1024; const float* ksh = mods + ((size_t)16 + b) * 6144; float bpart = 0.f;
#pragma unroll 4
            for (int cidx = tid; cidx < 32 * 64; cidx += 512) { const int l = cidx & 63, s2 = cidx >> 6, e = l & 15, k0 = 32 * s2 + 8 * (l >> 4);
                unsigned hi[4], lo[4];
#pragma unroll
                for (int h2 = 0; h2 < 2; ++h2) { const f32x4 g4 = *(const f32x4*)(in->kv_norm_g + k0 + 4 * h2), s4 = *(const f32x4*)(ksc + k0 + 4 * h2), h4 = *(const f32x4*)(ksh + k0 + 4 * h2); float wv[4];
#pragma unroll
                    for (int q = 0; q < 4; ++q) { const float r_ = in->kv_w[(size_t)(k0 + 4 * h2 + q) * 2064 + 2048 + e]; wv[q] = g4[q] * (1.f + s4[q]) * r_; bpart += h4[q] * r_; }
#pragma unroll
                    for (int q = 0; q < 4; q += 2) { const unsigned a0 = f2bf(wv[q]), a1 = f2bf(wv[q + 1]); hi[2 * h2 + (q >> 1)] = a0 | (a1 << 16);
                        lo[2 * h2 + (q >> 1)] = f2bf(wv[q] - __uint_as_float(a0 << 16)) | (f2bf(wv[q + 1] - __uint_as_float(a1 << 16)) << 16); } }
                WFB[(s2 * 2 + 0) * 64 + l] = (u32x4){hi[0], hi[1], hi[2], hi[3]}; WFB[(s2 * 2 + 1) * 64 + l] = (u32x4){lo[0], lo[1], lo[2], lo[3]}; }
            pb[tid] = bpart;
            __syncthreads();
            if (tid < 16) { float t = in->fgate_b[tid];
#pragma unroll
                for (int p = 0; p < 32; ++p) t += pb[(p << 4) | tid];
                fbl[tid] = t; }
            __syncthreads();
        }
        LAS float* PV = (LAS float*)(F.lds + 73728);
        __syncthreads();
        stage_vec(PV, mods + ((size_t)L * 8 + b) * 6144 + 5120, tid);
        if (L == 0) { stage_vec(PV + 1024, in->norm_mix_g + 1024, tid); stage_vec(PV + 2048, mods + ((size_t)8 + b) * 6144 + 0, tid); stage_vec(PV + 3072, mods + ((size_t)8 + b) * 6144 + 1024, tid);
                      stage_vec(PV + 4096, in->kv_norm_g, tid); stage_vec(PV + 5120, mods + ((size_t)16 + b) * 6144 + 0, tid); stage_vec(PV + 6144, mods + ((size_t)16 + b) * 6144 + 1024, tid); }
        else stage_vec(PV + 1024, in->final_g, tid);
        __syncthreads();
        const LAS float* gt = PV;
#pragma unroll 1
        for (int i = 0; i < 16; ++i) {
            const int r = r0 + i; f32x4 v[4]; row_load_bf(XR + (size_t)r * DM, lane, v);
            f32x4 y[4];
#pragma unroll
            for (int j = 0; j < 4; ++j) y[j] = (f32x4){0.f, 0.f, 0.f, 0.f};
            const i32x4 d4 = *(const i32x4*)(dest + r * 4); const int dd[4] = {d4.x, d4.y, d4.z, d4.w};
#pragma unroll
            for (int q = 0; q < 4; ++q) { const unsigned char* yr = YB + (size_t)dd[q] * 1024;
#pragma unroll
                for (int j = 0; j < 2; ++j) { const u32x2 w = ((const u32x2*)yr)[lane + 64 * j]; y[2 * j] += fp8x4_to_f32(w.x); y[2 * j + 1] += fp8x4_to_f32(w.y); } }
#pragma unroll
            for (int j = 0; j < 4; ++j) v[j] = v[j] + row_vec_l(gt, lane, j) * (1.f / A8_SCALE) * y[j];
            const float rs = row_rstd(v);
            if (L == 1) { f32x4 o4[4];
#pragma unroll
                for (int j = 0; j < 4; ++j) o4[j] = v[j] * rs * row_vec_l(PV + 1024, lane, j);
                row_store_f32(out + (size_t)r * DM, lane, o4);
                continue;
            }
            row_store_bf16(XR + (size_t)r * DM, lane, v);
            f32x4 h[4];
            row_modnorm_l(v, rs, PV + 1024, PV + 2048, PV + 3072, lane, h);
            row_store_fp8(ws + WS_XN8 + (size_t)r * DM, lane, h);
            row_modnorm_l(v, rs, PV + 4096, PV + 5120, PV + 6144, lane, h);
            row_store_fp8(ws + WS_HKV + (size_t)r * DM, lane, h);
            if (lane == 0) rs_s[i] = rs;
        }
        if (L == 0) {
            __builtin_amdgcn_fence(__ATOMIC_RELEASE, "workgroup"); asm volatile("s_waitcnt vmcnt(0) lgkmcnt(0)" ::: "memory"); __builtin_amdgcn_fence(__ATOMIC_ACQUIRE, "workgroup");
            const int j = lane & 15, kq = lane >> 4; const bf16_t* xrow = XR + (size_t)(r0 + j) * DM + 8 * kq;
            f32x4 acc = {0.f, 0.f, 0.f, 0.f};
#pragma unroll 16
            for (int s2 = 0; s2 < 32; ++s2) { const bf16x8 xf = __builtin_bit_cast(bf16x8, __builtin_nontemporal_load((const u32x4*)(xrow + 32 * s2)));
#pragma unroll
                for (int pc = 0; pc < 2; ++pc) acc = __builtin_amdgcn_mfma_f32_16x16x32_bf16(__builtin_bit_cast(bf16x8, WFB[(s2 * 2 + pc) * 64 + lane]), xf, acc, 0, 0, 0); }
            const float rstd = rs_s[j]; const f32x4 fb = *(const LAS f32x4*)(fbl + 4 * kq);
            f32x4 lf;
#pragma unroll
            for (int q = 0; q < 4; ++q) { const float xg = acc[q] * rstd + fb[q]; lf[q] = fminf(xg, 0.f) - log1pf(expf(-fabsf(xg))); }
            *(f32x4*)((float*)(ws + WS_LOGF) + (size_t)(r0 + j) * 16 + 4 * kq) = lf;
        }
    }
}
__device__ __forceinline__ void ph_cumsum(const Frame& F) {
    TID_LANE_WAVE; unsigned char* ws = opq(F.ws); LAS float* wtot = (LAS float*)F.lds;
    for (int bh = F.bid; bh < NB * NH; bh += F.G) {
        const int b = bh >> 4, h = bh & 15;
        const float* lf = (const float*)(ws + WS_LOGF); float v[8]; float run = 0.f;
#pragma unroll
        for (int i = 0; i < 8; ++i) { run += lf[((size_t)b * SEQ + tid * 8 + i) * 16 + h]; v[i] = run; }
        float inc = run;
#pragma unroll
        for (int o = 1; o < 64; o <<= 1) { const float t = __shfl_up(inc, o); if (lane >= o) inc += t; }
        if (lane == 63) wtot[wave] = inc;
        __syncthreads();
        float off = inc - run;
        for (int w8 = 0; w8 < wave; ++w8) off += wtot[w8];
        float* fc = (float*)(ws + WS_FC) + (size_t)bh * SEQ; unsigned long long* g3 = (unsigned long long*)(ws + WS_G3) + (size_t)bh * SEQ;
#pragma unroll
        for (int i = 0; i < 8; ++i) { const float Fv = v[i] + off; fc[tid * 8 + i] = Fv;
            const float g = -Fv * LOG2E; const unsigned b1 = f2bf(g); const float r1 = g - __uint_as_float(b1 << 16); const unsigned b2 = f2bf(r1); const float r2 = r1 - __uint_as_float(b2 << 16); const unsigned b3 = f2bf(r2);
            g3[tid * 8 + i] = (unsigned long long)(b1 | (b2 << 16)) | ((unsigned long long)(b3 | (0x3f80u << 16)) << 32); }
        __syncthreads();
    }
}


typedef short s16x4 __attribute__((ext_vector_type(4)));
__device__ __forceinline__ s16x4 ds_tr16(LAS unsigned char* p) { return __builtin_bit_cast(s16x4, __builtin_amdgcn_ds_read_tr16_b64_v4i16((LAS s16x4*)p)); }
__device__ __forceinline__ void ph_spatial(const Frame& F) {
    const InP in = kin(); unsigned char* ws = opq(F.ws);
    LAS unsigned char* L = F.lds;
    constexpr int VN_STRIDE = 544, WC_STRIDE = 272, OFF_VN = 0, OFF_WC = 128 * VN_STRIDE, OFF_ST = OFF_WC + 128 * WC_STRIDE;
    LAS float* st = (LAS float*)(L + OFF_ST);
    const bf16_t* Z = (const bf16_t*)(ws + WS_Z); unsigned char* GT = ws + WS_GATED; const bf16_t* WSB = (const bf16_t*)(ws + WS_WS);
    for (int ch = F.bid; ch < T / 128; ch += F.G) {
        const int t0 = ch * 128;
        __syncthreads();
        { int tid_ = threadIdx.x; asm volatile("" : "+v"(tid_)); const int lane = tid_ & 63, wave = __builtin_amdgcn_readfirstlane(tid_ >> 6);
#pragma unroll 4
        for (int i = 0; i < 16; ++i) {
            const int tl = wave * 16 + i; const bf16_t* vrow = Z + (size_t)(t0 + tl) * 4096 + 2048;
            float v[32]; float s = 0.f;
#pragma unroll
            for (int j = 0; j < 4; ++j) { const u32x4 w = *(const u32x4*)(vrow + (lane + 64 * j) * 8); const unsigned ww[4] = {w.x, w.y, w.z, w.w};
#pragma unroll
                for (int q = 0; q < 4; ++q) { v[j * 8 + 2 * q] = __uint_as_float(ww[q] << 16); v[j * 8 + 2 * q + 1] = __uint_as_float(ww[q] & 0xffff0000u); } }
#pragma unroll
            for (int q = 0; q < 32; ++q) s += v[q];
            const float mean = wave_sum(s) * (1.f / 2048.f); float qq = 0.f;
#pragma unroll
            for (int q = 0; q < 32; ++q) { const float d = v[q] - mean; qq += d * d; }
            const float rstd = 1.f / sqrtf(wave_sum(qq) * (1.f / 2048.f) + EPS);
            if (lane == 0) { st[2 * tl] = mean; st[2 * tl + 1] = rstd; }
        } }
        u32x4 vw[8], wcw[4];
        { int tid_ = threadIdx.x; asm volatile("" : "+v"(tid_)); const int tid = tid_, c8 = tid & 31;
#pragma unroll
            for (int q = 0; q < 8; ++q) vw[q] = *(const u32x4*)(Z + (size_t)(t0 + (tid >> 5) + 16 * q) * 4096 + 2048 + c8 * 8);
#pragma unroll
            for (int q = 0; q < 4; ++q) { const int cidx = tid + 512 * q, r = cidx >> 4, c16 = cidx & 15; wcw[q] = *(const u32x4*)(WSB + r * 128 + c16 * 8); } }
#pragma unroll 1
        for (int g = 0; g < 8; ++g) {
            int tid_ = threadIdx.x; asm volatile("" : "+v"(tid_));
            const int tid = tid_, lane = tid & 63, wave = __builtin_amdgcn_readfirstlane(tid >> 6), fr = lane & 15, fq = lane >> 4;
            __syncthreads();
#pragma unroll
            for (int q = 0; q < 4; ++q) { const int cidx = tid + 512 * q, r = cidx >> 4, c16 = cidx & 15; *(LAS u32x4*)(L + OFF_WC + r * WC_STRIDE + c16 * 16) = wcw[q]; }
            {
                const int c8 = tid & 31; const float* vg = in->v_g + g * 256 + c8 * 8; const float* vb = in->v_b + g * 256 + c8 * 8;
                const f32x4 g0 = *(const f32x4*)vg, g1 = *(const f32x4*)(vg + 4), b0 = *(const f32x4*)vb, b1 = *(const f32x4*)(vb + 4);
#pragma unroll
                for (int q = 0; q < 8; ++q) { const int s = (tid >> 5) + 16 * q;
                    const u32x4 w = vw[q];
                    const float mean = st[2 * s], rstd = st[2 * s + 1];
                    f32x4 x0 = {__uint_as_float(w.x << 16), __uint_as_float(w.x & 0xffff0000u), __uint_as_float(w.y << 16), __uint_as_float(w.y & 0xffff0000u)};
                    f32x4 x1 = {__uint_as_float(w.z << 16), __uint_as_float(w.z & 0xffff0000u), __uint_as_float(w.w << 16), __uint_as_float(w.w & 0xffff0000u)};
                    x0 = (x0 - mean) * rstd * g0 + b0; x1 = (x1 - mean) * rstd * g1 + b1;
                    u32x4 o; o.x = pk2(x0[0], x0[1]); o.y = pk2(x0[2], x0[3]); o.z = pk2(x1[0], x1[1]); o.w = pk2(x1[2], x1[3]);
                    *(LAS u32x4*)(L + OFF_VN + s * VN_STRIDE + c8 * 16) = o; }
            }
            u32x2 uw[8][2]; float bsv[8];
#pragma unroll
            for (int tb = 0; tb < 8; ++tb) { const int t = 16 * tb + fr; bsv[tb] = in->b_s[g * 128 + t];
#pragma unroll
                for (int db = 0; db < 2; ++db) uw[tb][db] = *(const u32x2*)(Z + (size_t)(t0 + t) * 4096 + 256 * g + 32 * wave + 16 * db + 4 * fq); }
            __syncthreads();
            if (g < 7) { const int c8 = tid & 31;
#pragma unroll
                for (int q = 0; q < 8; ++q) vw[q] = *(const u32x4*)(Z + (size_t)(t0 + (tid >> 5) + 16 * q) * 4096 + 2048 + (g + 1) * 256 + c8 * 8);
#pragma unroll
                for (int q = 0; q < 4; ++q) { const int cidx = tid + 512 * q, r = cidx >> 4, c16 = cidx & 15; wcw[q] = *(const u32x4*)(WSB + (size_t)(g + 1) * 16384 + r * 128 + c16 * 8); } }
            f32x4 acc[8][2];
#pragma unroll
            for (int tb = 0; tb < 8; ++tb) { acc[tb][0] = (f32x4){0.f, 0.f, 0.f, 0.f}; acc[tb][1] = (f32x4){0.f, 0.f, 0.f, 0.f}; }
#pragma unroll
            for (int ks = 0; ks < 4; ++ks) {
                const int s0 = 32 * ks; bf16x8 X[2];
#pragma unroll
                for (int db = 0; db < 2; ++db) { LAS unsigned char* p = L + OFF_VN + (s0 + 4 * fq + (fr >> 2)) * VN_STRIDE + (32 * wave + 16 * db + 4 * (fr & 3)) * 2;
                    const s16x4 lo = ds_tr16(p), hi = ds_tr16(p + 16 * VN_STRIDE);
                    X[db] = (bf16x8){lo[0], lo[1], lo[2], lo[3], hi[0], hi[1], hi[2], hi[3]}; }
#pragma unroll
                for (int tb = 0; tb < 8; ++tb) if (2 * ks <= tb) {
                    LAS unsigned char* p = L + OFF_WC + (16 * tb + fr) * WC_STRIDE + (s0 + 4 * fq) * 2;
                    const u32x2 y0 = *(LAS u32x2*)p, y1 = *(LAS u32x2*)(p + 32);
                    const bf16x8 Y = __builtin_bit_cast(bf16x8, (u32x4){y0.x, y0.y, y1.x, y1.y});
                    acc[tb][0] = __builtin_amdgcn_mfma_f32_16x16x32_bf16(X[0], Y, acc[tb][0], 0, 0, 0);
                    acc[tb][1] = __builtin_amdgcn_mfma_f32_16x16x32_bf16(X[1], Y, acc[tb][1], 0, 0, 0); }
            }
#pragma unroll
            for (int tb = 0; tb < 8; ++tb) { const int t = 16 * tb + fr;
#pragma unroll
                for (int db = 0; db < 2; ++db) { const int dd = 256 * g + 32 * wave + 16 * db + 4 * fq;
                    const u32x2 uwv = uw[tb][db];
                    const f32x4 m = acc[tb][db] + bsv[tb];
                    *(unsigned*)(GT + (size_t)(t0 + t) * 2048 + dd) = pk4_fp8s(__uint_as_float(uwv.x << 16) * m[0], __uint_as_float(uwv.x & 0xffff0000u) * m[1], __uint_as_float(uwv.y << 16) * m[2], __uint_as_float(uwv.y & 0xffff0000u) * m[3]); } }
        }
    }
}

constexpr int NPH = 18;
struct PA { In in; unsigned char* ws; float* out; int ph_lo, ph_hi, li, pad; };
__global__ void __launch_bounds__(512, 2) fwd(PA args) {
    extern __shared__ __attribute__((aligned(16))) unsigned char lds[];
    Frame F; F.ws = args.ws; F.out = args.out; F.lds = (LAS unsigned char*)lds;
    F.bid = blockIdx.x; F.G = gridDim.x;
    LAS unsigned char* ldsl = (LAS unsigned char*)lds;
    volatile LAS unsigned* MISC = (volatile LAS unsigned*)(ldsl + MISC_OFF);
    for (int u = threadIdx.x; u < (LDS_BYTES - LDSCTL_OFF) / 4; u += 512) ((LAS unsigned*)(ldsl + LDSCTL_OFF))[u] = 0u;
    __syncthreads();
    unsigned char* const ws0 = args.ws;
    XcdBarrier bar = xcd_barrier_post((unsigned*)(ws0 + WS_CTL) + CW_BAR + args.li * XCD_BAR_WORDS, MISC + 8);
    const int lo = args.ph_lo, hi = args.ph_hi;
#ifndef PHMASK
#define PHMASK 0x3ffffu
#endif
#define IN(k) (((PHMASK >> (k)) & 1u) && lo <= (k) && (k) < hi)
#define SEAM(k) do { if (lo <= (k) && (k) + 1 < hi) { if ((k) <= 13) xcd_barrier_bg(bar, ws0, ldsl, MISC + 12); else xcd_barrier(bar); } } while (0)
    const int c = (int)blockIdx.x, G = (int)gridDim.x;

    if (IN(0)) { ph_prologue(F); } SEAM(0);
    if (IN(1)) { ph_norm0(F); } SEAM(1);
    if (IN(2)) {
        unsigned char* ws = opq(ws0);
        pg::StaticOrder S; S.init(T / 256, 4096 / 256, G, c);
        pg::SrcPlain<true, true> src{(const char*)(ws + WS_WIN), 1024}; pg::EpGeluZ E{(bf16_t*)(ws + WS_Z), MOE_DESCALE};
        pg::gemm_phase<pg::EpGeluZ, pg::StaticOrder, pg::SrcPlain<true, true>, true>(ldsl, (const char*)(ws + WS_XN8), 512, S, src, E);
    } SEAM(2);
    if (IN(3)) { ph_spatial(F); } SEAM(3);
    if (IN(4)) {
        unsigned char* ws = opq(ws0); const float* mods = (const float*)(ws + WS_MODS);
        pg::StaticOrder S; S.init(T / 256, 1024 / 256, G, c);
        pg::SrcPlain<true, true> src{(const char*)(ws + WS_WOUT), 2048}; pg::EpResid<true> E{kin()->x, (bf16_t*)(ws + WS_XR), mods + 2048, MOE_DESCALE};
        pg::gemm_phase<pg::EpResid<true>, pg::StaticOrder, pg::SrcPlain<true, true>, true>(ldsl, (const char*)(ws + WS_GATED), 1024, S, src, E);
    } SEAM(4);
#define MOE_TAB_COPY int nblk; { LAS int* tw = (LAS int*)(ldsl + pg::STAGE_BYTES + 8192); for (int i = (int)threadIdx.x; i <= MAXBLK; i += 512) tw[i] = blke[i]; __syncthreads(); nblk = __builtin_amdgcn_readfirstlane(tw[MAXBLK]); }
#define MOE_STAGGER(NN) { const int nu = nblk * (NN), mx = (nu + G - 1) / G, mine = c < nu ? (nu - c + G - 1) / G : 0; \
          if (mine < mx) { const int r8 = (nu % G) >> 3, k = (c >> 3) - r8, nsl = (G >> 3) - r8, d = (k + 1) * 27 / (nsl + 1); for (int i = 0; i < d; ++i) __builtin_amdgcn_s_sleep(16); } }
#define LAYER_MOE(L, P0) \
    if (IN(P0)) { ph_norm_router(F, L); } SEAM(P0); \
    if (IN(P0 + 1)) { if ((P0) == 13) { TID_LANE_WAVE; if (tid == 0) MISC[12] = 0u; __syncthreads(); bg_cvt(ws0, ldsl, wave, lane, MISC + 12); } ph_list(F); } SEAM(P0 + 1); \
    if (IN(P0 + 2)) {     \
        unsigned char* ws = opq(ws0); const int* blke = (const int*)(ws + WS_BLKE); \
        MOE_TAB_COPY; pg::StaticOrder S; S.init(nblk, 8, G, c); \
        MOE_STAGGER(8); \
        pg::SrcMoeA src{(const char*)(ws + WS_W1) + (size_t)L * 32 * 2048 * 1024, (const int*)(ws + WS_LIST), blke, 1024, (const LAS int*)(ldsl + pg::STAGE_BYTES + 8192)}; pg::EpSwiglu E{ws + WS_ACT, kin()->exp_b1 + (size_t)L * 32 * 2048, blke}; \
        pg::gemm_phase<pg::EpSwiglu, pg::StaticOrder, pg::SrcMoeA, true>(ldsl, (const char*)(ws + WS_XN8), 512, S, src, E);     \
    } SEAM(P0 + 2); \
    if (IN(P0 + 3)) {     \
        unsigned char* ws = opq(ws0); const int* blke = (const int*)(ws + WS_BLKE); \
        MOE_TAB_COPY; pg::StaticOrder S; S.init(nblk, 4, G, c); \
        MOE_STAGGER(4); \
        pg::SrcMoeB src{(const char*)(ws + WS_W2) + (size_t)L * 32 * 1024 * 1024, blke, 1024, (const LAS int*)(ldsl + pg::STAGE_BYTES + 8192)}; pg::EpMoeOut E{ws + WS_YB, kin()->exp_b2 + (size_t)L * 32 * 1024, blke, (const float*)(ws + WS_ROWG)}; \
        pg::gemm_phase<pg::EpMoeOut, pg::StaticOrder, pg::SrcMoeB, true>(ldsl, (const char*)(ws + WS_ACT), 512, S, src, E); \
    } SEAM(P0 + 3); \
    if (IN(P0 + 4)) { ph_combine(F, L); } SEAM(P0 + 4);

    LAYER_MOE(0, 5)
    if (IN(10)) {
        unsigned char* ws = opq(ws0);
        ph_cumsum(F);
        pg::StaticOrder S; S.init(T / 256, 2048 / 256, G, c);
        { pg::SrcHeads src{(const char*)(ws + WS_WKV), 1024}; pg::EpHeads<0> E{(bf16_t*)(ws + WS_K), (bf16_t*)(ws + WS_V), kin()->k_norm_g};
          pg::gemm_phase<pg::EpHeads<0>, pg::StaticOrder, pg::SrcHeads, true>(ldsl, (const char*)(ws + WS_HKV), 512, S, src, E); }
        { pg::SrcHeads src{(const char*)(ws + WS_WQG), 1024}; pg::EpHeads<1> E{(bf16_t*)(ws + WS_Q), (bf16_t*)(ws + WS_GS), kin()->q_norm_g};
          pg::gemm_phase<pg::EpHeads<1>, pg::StaticOrder, pg::SrcHeads, true>(ldsl, (const char*)(ws + WS_XN8), 512, S, src, E); }
    } SEAM(10);
    if (IN(11)) {
        unsigned char* ws = opq(ws0);
        static_assert(attn_body::ATTN_LDS_BYTES <= RING_BYTES, "attention LDS");
        const attn_body::AttnTensors AT{(const attn_body::bf16*)(ws + WS_Q), (const attn_body::bf16*)(ws + WS_K), (const attn_body::bf16*)(ws + WS_V), (const attn_body::bf16*)(ws + WS_GS), (attn_body::bf16*)(ws + WS_O), (const unsigned long long*)(ws + WS_G3), kin()->q_norm_g, kin()->k_norm_g};
        attn_body::attn_phase<8>((char*)lds, AT, G, c);
    } SEAM(11);
    if (IN(12)) {
        unsigned char* ws = opq(ws0); const float* mods = (const float*)(ws + WS_MODS);
        pg::StaticOrder S; S.init(T / 256, 1024 / 256, G, c);
        pg::SrcPlain<true, true> src{(const char*)(ws + WS_WO), 1024}; pg::EpResid<false> E{(const bf16_t*)(ws + WS_XR), (bf16_t*)(ws + WS_XR), mods + 8 * 6144 + 2048, MOE_DESCALE};
        pg::gemm_phase<pg::EpResid<false>, pg::StaticOrder, pg::SrcPlain<true, true>, true>(ldsl, (const char*)(ws + WS_O), 512, S, src, E);
    } SEAM(12);
    LAYER_MOE(1, 13)
#undef LAYER_MOE
#undef IN
#undef SEAM
}

#include <cstring>
extern "C" void kernel_launch(void* const* d_in, const int* in_sizes, int n_in, void* d_out, int out_size, void* d_ws, size_t ws_size, hipStream_t stream) {
    if (n_in != 28 || ws_size < WS_END || out_size != T * DM) { fprintf(stderr, "kernel_launch: unexpected arguments (n_in %d, ws %zu, out %d)\n", n_in, ws_size, out_size); return; }
    static int grid = 0;
    if (grid == 0) {
        int dev = 0, cus = 0, per_cu = 0;
        if (hipGetDevice(&dev) != hipSuccess || hipDeviceGetAttribute(&cus, hipDeviceAttributeMultiprocessorCount, dev) != hipSuccess) { grid = -1; return; }
        if (hipFuncSetAttribute((const void*)fwd, hipFuncAttributeMaxDynamicSharedMemorySize, LDS_BYTES) != hipSuccess) { fprintf(stderr, "kernel_launch: hipFuncSetAttribute failed\n"); grid = -1; return; }
        if (hipOccupancyMaxActiveBlocksPerMultiprocessor(&per_cu, (const void*)fwd, 512, LDS_BYTES) != hipSuccess || per_cu < 1) fprintf(stderr, "kernel_launch: occupancy query says %d\n", per_cu);
        (void)hipGetLastError();
        grid = cus;
    }
    if (grid < 0) return;
    KA a; memset((void*)&a, 0, sizeof(a));
    { const float** p = (const float**)&a.in; for (int i = 0; i < 28; ++i) p[i] = (const float*)d_in[i]; }
    a.ws = (unsigned char*)d_ws; a.out = (float*)d_out;
    PA pa; memset((void*)&pa, 0, sizeof(pa)); pa.in = a.in; pa.ws = a.ws; pa.out = a.out;
    (void)hipMemsetAsync((unsigned char*)d_ws + WS_CTL, 0, 64 * 1024, stream);
    pa.ph_lo = 0; pa.ph_hi = NPH; pa.li = 0;
    hipLaunchKernelGGL(fwd, dim3(grid), dim3(512), LDS_BYTES, stream, pa);
}
```
